# Optimizing an MI355X kernel written in HIP

```python
import math
import jax, jax.numpy as jnp
from jax import lax
import numpy as np

D_MODEL = 1024
BATCH = 4
SEQ = 8192
DEPTH = 1

GDN_HEADS = 4
GDN_DK = 128
GDN_DV = 128
CONV_K = 4
CHUNK = 64
NSA_HEADS = 8
NSA_KV_HEADS = 2
NSA_GROUP = NSA_HEADS // NSA_KV_HEADS
NSA_DH = 64
CMP_LEN = 32
CMP_STRIDE = 16
CMP_HIDDEN = 128
SEL_BLOCK = 64
SEL_TOP_N = 16
WINDOW = 512
Q_BLOCK = 128
FORCE_BONUS = 1e4
N_BUCKETS = 32
MAX_DISTANCE = 1024
EPS = 1e-6
NEG = -1e30

GDN_QK_W = GDN_HEADS * GDN_DK
GDN_W = GDN_HEADS * GDN_DV
GDN_CONV_W = 2 * GDN_QK_W + GDN_W
NSA_W = NSA_HEADS * NSA_DH
KV_W = NSA_KV_HEADS * NSA_DH
MIX_W = GDN_W + NSA_W
PROJ_SIZES = (GDN_QK_W, GDN_QK_W, GDN_W, GDN_W, GDN_HEADS, GDN_HEADS,
              NSA_W, KV_W, KV_W, KV_W, KV_W, KV_W, KV_W, 3 * NSA_HEADS, NSA_W)
PROJ_W = sum(PROJ_SIZES)

kernel_name = "hymba_gdn_nsa_hybrid"


def rmsnorm(x, w):
    xf = x.astype(jnp.float32)
    y = xf * lax.rsqrt(jnp.mean(xf * xf, axis=-1, keepdims=True) + EPS)
    return (y * w.astype(jnp.float32)).astype(x.dtype)


def l2norm(t):
    return t * lax.rsqrt(jnp.sum(t * t, axis=-1, keepdims=True) + EPS)


def causal_conv(x, w):
    c = x.shape[-1]
    return lax.conv_general_dilated(x, w.astype(x.dtype)[:, None, :], window_strides=(1,),
                                    padding=[(CONV_K - 1, 0)],
                                    dimension_numbers=('NWC', 'WIO', 'NWC'),
                                    feature_group_count=c)


def rel_bucket(dist):
    n = jnp.maximum(dist, 0)
    max_exact = N_BUCKETS // 2
    large = max_exact + (jnp.log(jnp.maximum(n, max_exact).astype(jnp.float32) / max_exact)
                         / math.log(MAX_DISTANCE / max_exact) * (N_BUCKETS - max_exact)).astype(jnp.int32)
    return jnp.where(n < max_exact, n, jnp.minimum(large, N_BUCKETS - 1))


def gated_delta_rule(q, k, v, beta, g):
    B, S, H, dk = q.shape
    dv = v.shape[-1]
    N = S // CHUNK

    def chunk(t):
        return t.reshape((B, N, CHUNK, H) + t.shape[3:]).swapaxes(2, 3)

    q, k, v, beta, g = chunk(q), chunk(k), chunk(v), chunk(beta), chunk(g)
    g = jnp.cumsum(g, axis=-1)
    idx = jnp.arange(CHUNK)
    tril = idx[:, None] >= idx[None, :]
    tril_strict = idx[:, None] > idx[None, :]
    diff = g[..., :, None] - g[..., None, :]
    decay = jnp.where(tril, jnp.exp(jnp.where(tril, diff, 0.0)), 0.0)
    kb = k * beta[..., None]
    L = jnp.where(tril_strict, jnp.einsum('bnhcd,bnhed->bnhce', kb, k) * decay, 0.0)
    A = L + jnp.eye(CHUNK, dtype=L.dtype)
    rhs = jnp.concatenate([v * beta[..., None], kb * jnp.exp(g)[..., None]], axis=-1)
    sol = lax.linalg.triangular_solve(A, rhs, left_side=True, lower=True, unit_diagonal=True)
    u, w = sol[..., :dv], sol[..., dv:]
    attn_qk = jnp.where(tril, jnp.einsum('bnhcd,bnhed->bnhce', q, k) * decay, 0.0)
    g_last = g[..., -1]
    k_dec = k * jnp.exp(g_last[..., None] - g)[..., None]
    q_dec = q * jnp.exp(g)[..., None]

    def step(state, inp):
        qd, kd, u_, w_, a_, gl = inp
        v_new = u_ - jnp.einsum('bhcd,bhde->bhce', w_, state)
        o = jnp.einsum('bhcd,bhde->bhce', qd, state) + jnp.einsum('bhce,bhef->bhcf', a_, v_new)
        state = state * jnp.exp(gl)[..., None, None] + jnp.einsum('bhcd,bhce->bhde', kd, v_new)
        return state, o

    xs = tuple(jnp.moveaxis(t, 1, 0) for t in (q_dec, k_dec, u, w, attn_qk, g_last))
    s0 = jnp.zeros((B, H, dk, dv), jnp.float32)
    _, o = lax.scan(step, s0, xs)
    return jnp.moveaxis(o, 0, 1).swapaxes(2, 3).reshape(B, S, H, dv)


def compress(raw, pe, w1, w2):
    S = raw.shape[1]
    n_cmp = (S - CMP_LEN) // CMP_STRIDE + 1
    idx = CMP_STRIDE * np.arange(n_cmp)[:, None] + np.arange(CMP_LEN)[None, :]
    blocks = raw[:, idx] + pe[None, None, :, None, :]
    h = jax.nn.silu(jnp.einsum('bnlhd,ldf->bnhf', blocks, w1))
    return jnp.einsum('bnhf,fd->bhnd', h, w2)


def nsa_mixer(nq, kc, vc, ks, vs, kw, vw, ng, pe_k, pe_v, kw1, kw2, vw1, vw2, rel_bias):
    f32 = jnp.float32
    B, S, _ = nq.shape
    Hk, G, dh = NSA_KV_HEADS, NSA_GROUP, NSA_DH
    n_sel = S // SEL_BLOCK
    n_top = min(SEL_TOP_N, n_sel)
    n_cmp = (S - CMP_LEN) // CMP_STRIDE + 1
    q = nq.astype(f32).reshape(B, S, Hk, G, dh).transpose(0, 2, 3, 1, 4) * dh ** -0.5
    gates = jax.nn.sigmoid(ng.astype(f32)).reshape(B, S, 3, Hk, G).transpose(0, 3, 4, 1, 2)

    def heads(t):
        return t.astype(f32).reshape(B, S, Hk, dh)

    k_cmp = compress(heads(kc), pe_k.astype(f32), kw1.astype(f32), kw2.astype(f32))
    v_cmp = compress(heads(vc), pe_v.astype(f32), vw1.astype(f32), vw2.astype(f32))
    k_slc = heads(ks).transpose(0, 2, 1, 3).reshape(B, Hk, n_sel, SEL_BLOCK, dh)
    v_slc = heads(vs).transpose(0, 2, 1, 3).reshape(B, Hk, n_sel, SEL_BLOCK, dh)
    pad = ((0, 0), (0, 0), (WINDOW, 0), (0, 0))
    k_win = jnp.pad(heads(kw).transpose(0, 2, 1, 3), pad)
    v_win = jnp.pad(heads(vw).transpose(0, 2, 1, 3), pad)
    rel_tab = rel_bias.astype(f32).reshape(N_BUCKETS, Hk, G)

    cs = CMP_STRIDE * np.arange(n_cmp)
    ss = SEL_BLOCK * np.arange(n_sel)
    overlap = jnp.asarray(((cs[:, None] < ss[None, :] + SEL_BLOCK) &
                           (cs[:, None] + CMP_LEN > ss[None, :])).astype(np.float32))
    cmp_end = jnp.asarray((cs + CMP_LEN - 1).astype(np.int32))
    b_ix = jnp.arange(B)[:, None, None, None]
    h_ix = jnp.arange(Hk)[None, :, None, None]
    h_ix5 = jnp.arange(Hk)[None, :, None, None, None]
    g_ix5 = jnp.arange(G)[None, None, :, None, None]
    j = jnp.arange(n_sel)

    def block(qb):
        q0 = qb * Q_BLOCK
        t = q0 + jnp.arange(Q_BLOCK)
        qblk = lax.dynamic_slice_in_dim(q, q0, Q_BLOCK, axis=3)
        gblk = lax.dynamic_slice_in_dim(gates, q0, Q_BLOCK, axis=3)
        mask_c = cmp_end[None, :] <= t[:, None]
        bias_c = rel_tab[rel_bucket(t[:, None] - cmp_end[None, :])].transpose(2, 3, 0, 1)
        s_c = jnp.einsum('bhgtd,bhnd->bhgtn', qblk, k_cmp) + bias_c
        p_c = jax.nn.softmax(jnp.where(mask_c, s_c, NEG), axis=-1) * mask_c.astype(f32)
        o_c = jnp.einsum('bhgtn,bhnd->bhgtd', p_c, v_cmp)
        imp = jnp.einsum('bhgtn,nj->bhtj', p_c, overlap)
        cb = t // SEL_BLOCK
        valid = j[None, :] <= cb[:, None]
        forced = (j[None, :] == 0) | (j[None, :] == cb[:, None]) | (j[None, :] == cb[:, None] - 1)
        score = jnp.where(valid, imp + jnp.where(forced, FORCE_BONUS, 0.0), NEG)
        _, sel = lax.top_k(score, n_top)
        kb = k_slc[b_ix, h_ix, sel].reshape(B, Hk, Q_BLOCK, n_top * SEL_BLOCK, dh)
        vb = v_slc[b_ix, h_ix, sel].reshape(B, Hk, Q_BLOCK, n_top * SEL_BLOCK, dh)
        pos = (sel[..., None] * SEL_BLOCK + jnp.arange(SEL_BLOCK)).reshape(B, Hk, Q_BLOCK, n_top * SEL_BLOCK)
        dist_s = t[None, None, :, None] - pos
        bias_s = rel_tab[rel_bucket(dist_s)[:, :, None], h_ix5, g_ix5]
        s_s = jnp.einsum('bhgtd,bhtkd->bhgtk', qblk, kb) + bias_s
        p_s = jax.nn.softmax(jnp.where((dist_s >= 0)[:, :, None], s_s, NEG), axis=-1)
        o_s = jnp.einsum('bhgtk,bhtkd->bhgtd', p_s, vb)
        kwb = lax.dynamic_slice_in_dim(k_win, q0, WINDOW + Q_BLOCK, axis=2)
        vwb = lax.dynamic_slice_in_dim(v_win, q0, WINDOW + Q_BLOCK, axis=2)
        kpos = q0 - WINDOW + jnp.arange(WINDOW + Q_BLOCK)
        dist_w = t[:, None] - kpos[None, :]
        mask_w = (dist_w >= 0) & (dist_w < WINDOW) & (kpos[None, :] >= 0)
        bias_w = rel_tab[rel_bucket(dist_w)].transpose(2, 3, 0, 1)
        s_w = jnp.einsum('bhgtd,bhkd->bhgtk', qblk, kwb) + bias_w
        p_w = jax.nn.softmax(jnp.where(mask_w, s_w, NEG), axis=-1)
        o_w = jnp.einsum('bhgtk,bhkd->bhgtd', p_w, vwb)
        return gblk[..., 0:1] * o_c + gblk[..., 1:2] * o_s + gblk[..., 2:3] * o_w

    outs = lax.map(block, jnp.arange(S // Q_BLOCK))
    return outs.transpose(1, 0, 4, 2, 3, 5).reshape(B, S, NSA_W)


def setup_inputs(seed: int = 0) -> dict:
    key = jax.random.key(seed)
    ks = jax.random.split(key, 18)
    nrm = jax.random.normal
    D = D_MODEL
    dt = jnp.exp(jax.random.uniform(ks[5], (DEPTH, GDN_HEADS)) * (math.log(0.1) - math.log(0.001)) + math.log(0.001))
    return {
        "x": nrm(ks[0], (BATCH, SEQ, D), jnp.float32),
        "norm_w": 1.0 + 0.02 * nrm(ks[1], (DEPTH, D)),
        "w_in": nrm(ks[2], (DEPTH, D, PROJ_W)) * D ** -0.5,
        "conv_w": nrm(ks[3], (DEPTH, CONV_K, GDN_CONV_W)) * CONV_K ** -0.5,
        "a_log": jnp.log(jax.random.uniform(ks[4], (DEPTH, GDN_HEADS), minval=1.0, maxval=16.0)),
        "dt_bias": dt + jnp.log(-jnp.expm1(-dt)),
        "gdn_norm_w": 1.0 + 0.02 * nrm(ks[6], (DEPTH, GDN_DV)),
        "cmp_pe_k": 0.1 * nrm(ks[7], (DEPTH, CMP_LEN, NSA_DH)),
        "cmp_pe_v": 0.1 * nrm(ks[8], (DEPTH, CMP_LEN, NSA_DH)),
        "cmp_k_w1": nrm(ks[9], (DEPTH, CMP_LEN, NSA_DH, CMP_HIDDEN)) * (CMP_LEN * NSA_DH) ** -0.5,
        "cmp_k_w2": nrm(ks[10], (DEPTH, CMP_HIDDEN, NSA_DH)) * CMP_HIDDEN ** -0.5,
        "cmp_v_w1": nrm(ks[11], (DEPTH, CMP_LEN, NSA_DH, CMP_HIDDEN)) * (CMP_LEN * NSA_DH) ** -0.5,
        "cmp_v_w2": nrm(ks[12], (DEPTH, CMP_HIDDEN, NSA_DH)) * CMP_HIDDEN ** -0.5,
        "w_out": nrm(ks[13], (DEPTH, MIX_W, D)) * MIX_W ** -0.5,
        "rel_bias": 0.5 * nrm(ks[14], (N_BUCKETS, NSA_HEADS)),
        "final_norm_w": 1.0 + 0.02 * nrm(ks[15], (D,)),
    }


def reference(x, norm_w, w_in, conv_w, a_log, dt_bias, gdn_norm_w, cmp_pe_k, cmp_pe_v,
              cmp_k_w1, cmp_k_w2, cmp_v_w1, cmp_v_w2, w_out, rel_bias, final_norm_w):
    f32 = jnp.float32
    B, S, _ = x.shape
    split_points = [int(p) for p in np.cumsum(PROJ_SIZES)[:-1]]
    h = x
    for layer in range(DEPTH):
        u = rmsnorm(h, norm_w[layer])
        proj = u @ w_in[layer]
        (gq, gk, gv, gz, gb, ga, nq, kc, vc, ks, vs, kw, vw, ng, nz) = jnp.split(proj, split_points, axis=-1)
        qkv = jax.nn.silu(causal_conv(jnp.concatenate([gq, gk, gv], axis=-1), conv_w[layer])).astype(f32)
        q, k, v = jnp.split(qkv, [GDN_QK_W, 2 * GDN_QK_W], axis=-1)
        q = l2norm(q.reshape(B, S, GDN_HEADS, GDN_DK)) * GDN_DK ** -0.5
        k = l2norm(k.reshape(B, S, GDN_HEADS, GDN_DK))
        v = v.reshape(B, S, GDN_HEADS, GDN_DV)
        beta = jax.nn.sigmoid(gb.astype(f32))
        g = -jnp.exp(a_log[layer].astype(f32)) * jax.nn.softplus(ga.astype(f32) + dt_bias[layer].astype(f32))
        o_g = gated_delta_rule(q, k, v, beta, g)
        o_g = o_g * lax.rsqrt(jnp.mean(o_g * o_g, axis=-1, keepdims=True) + EPS) * gdn_norm_w[layer].astype(f32)
        o_g = o_g.reshape(B, S, GDN_W) * jax.nn.silu(gz.astype(f32))
        o_n = nsa_mixer(nq, kc, vc, ks, vs, kw, vw, ng, cmp_pe_k[layer], cmp_pe_v[layer],
                        cmp_k_w1[layer], cmp_k_w2[layer], cmp_v_w1[layer], cmp_v_w2[layer], rel_bias)
        o_n = o_n * jax.nn.silu(nz.astype(f32))
        mix = jnp.concatenate([o_g, o_n], axis=-1).astype(x.dtype)
        h = h + mix @ w_out[layer]
    return rmsnorm(h, final_norm_w)
```

```cpp
#include <hip/hip_runtime.h>
#include <hip/hip_cooperative_groups.h>
#include <cstdio>
#include <cstdint>
namespace cg = cooperative_groups;
#ifndef MK_LAUNCHES
#define MK_LAUNCHES 6
#endif
namespace pg8 {
#define PG8_LAS __attribute__((address_space(3)))
typedef unsigned short bf16_t;
typedef short bf16x8 __attribute__((ext_vector_type(8)));
typedef float f32x4 __attribute__((ext_vector_type(4)));
typedef unsigned u32x4 __attribute__((ext_vector_type(4)));
constexpr int BM = 256, BK = 64, HALF = 128, HTB = HALF * BK * 2  , STAGE_BYTES = 8 * HTB, NXCD = 8, WGM = 8;

__host__ __device__ __forceinline__ int lds_byte(int r, int c) { const int st = (r >> 4) * 2 + (c >> 5), rr = r & 15, cc = c & 31, ob = rr * 64 + cc * 2; return st * 1024 + (ob ^ (((ob >> 9) & 1) << 5)); }
__host__ __device__ __forceinline__ void stage_rc(int b, int& R, int& C) { const int st = b / 1024, sb = b % 1024, swz = sb ^ (((sb >> 9) & 1) << 5); R = (st >> 1) * 16 + swz / 64; C = (st & 1) * 32 + (swz % 64) / 2; }
__host__ __device__ __forceinline__ int perm32(int rho) { const int n = rho >> 4, i = rho & 15; return 8 * (i >> 2) + 4 * n + (i & 3); }

struct Unit { int pm, pn; };
struct Gemm { const bf16_t* A; const bf16_t* Bt; int M, N, K; };

struct StaticOrder {
    int nM, nN, nwg, G, c;
    __host__ __device__ void init(int M, int N, int G_, int c_) { nM = M / BM; nN = N / BM; nwg = nM * nN; G = G_; c = c_; }
    __host__ __device__ bool next(int i, Unit& u) const {
        const long L = (long)i * G + c; if (L >= nwg) return false;
        int wgid = (int)L; { const int q = nwg / NXCD, r = nwg % NXCD, xcd = wgid % NXCD, off = wgid / NXCD; wgid = (xcd < r ? xcd * (q + 1) : r * (q + 1) + (xcd - r) * q) + off; }
        const int nig = WGM * nN, gid = wgid / nig, fm = gid * WGM, gsz = (nM - fm) < WGM ? (nM - fm) : WGM;
        u.pm = fm + ((wgid % nig) % gsz); u.pn = (wgid % nig) / gsz; return true;
    }
    __device__ __forceinline__ void a_ready(const Unit&) const {}
    __device__ __forceinline__ void done(const Unit&) const {}
};
__device__ __forceinline__ unsigned cvt_pk_bf16(float lo, float hi) { unsigned r; asm volatile("v_cvt_pk_bf16_f32 %0, %1, %2" : "=v"(r) : "v"(lo), "v"(hi)); return r; }
typedef float f32x2 __attribute__((ext_vector_type(2)));
template <class Epi, class Sched, bool STAMP = false>
__device__ __forceinline__ void gemm_phase(PG8_LAS unsigned char* lds, const Gemm g, const Sched& S, const Epi& E, unsigned long long* stamps) {
    const int tid = threadIdx.x, wid = __builtin_amdgcn_readfirstlane(tid >> 6), lane = tid & 63, wr = wid >> 2, wc = wid & 3, fr = lane & 15, fq = lane >> 4;
    const int K = g.K, nt = K / BK;
    int ts_lo = 0, ts_hi = 0, nts = 0; const unsigned long long rt_entry = STAMP ? (unsigned long long)wall_clock64() : 0ull;
#define PG8_STAMP() do { if (STAMP && wid == 0 && nts < 64) { const unsigned long long _c = (unsigned long long)clock64(); \
        ts_lo = (lane == nts) ? (int)(unsigned)_c : ts_lo; ts_hi = (lane == nts) ? (int)(unsigned)(_c >> 32) : ts_hi; ++nts; } } while (0)
    PG8_STAMP();
    unsigned voffA[2], voffB[2];
#pragma unroll
    for (int i = 0; i < 2; ++i) { int R, C; stage_rc(tid * 16 + i * 8192, R, C); const int Rb = Epi::PERM ? ((R & ~31) + perm32(R & 31)) : R;
        voffA[i] = (unsigned)(R * K + C) * 2u; voffB[i] = (unsigned)(Rb * K + C) * 2u; }
    const size_t kstep = (size_t)(BK * 2);
    const size_t hstep = (size_t)HALF * K * 2;
    const size_t tstep = 2 * hstep;
    const unsigned ldsw = (unsigned)wid * 1024u;
    const int aoff = lds_byte(wr * 64 + fr, fq * 8), boff = lds_byte(wc * 32 + fr, fq * 8);
#define PG8_SA(b, h) (((b) * 2 + (h)) * HTB)
#define PG8_SB(b, h) ((4 + (b) * 2 + (h)) * HTB)
#define PG8_STAGE(bufoff, gbase, voff) do { _Pragma("unroll") for (int _i = 0; _i < 2; ++_i) \
        __builtin_amdgcn_global_load_lds((const unsigned*)((const char*)(gbase) + (voff)[_i]), (PG8_LAS unsigned*)(lds + (bufoff) + ldsw + _i * 8192), 16, 0, 0); } while (0)
#define PG8_LDA(dst, b, h) do { _Pragma("unroll") for (int m = 0; m < 4; ++m) _Pragma("unroll") for (int k = 0; k < 2; ++k) dst[m][k] = *(const PG8_LAS bf16x8*)(lds + PG8_SA(b, h) + aoff + m * 2048 + k * 1024); } while (0)
#define PG8_LDB(dst, b, h) do { _Pragma("unroll") for (int n = 0; n < 2; ++n) _Pragma("unroll") for (int k = 0; k < 2; ++k) dst[n][k] = *(const PG8_LAS bf16x8*)(lds + PG8_SB(b, h) + boff + n * 2048 + k * 1024); } while (0)
#define PG8_MMA(ai, bj, At, Bt) do { __builtin_amdgcn_s_setprio(1); _Pragma("unroll") for (int m = 0; m < 4; ++m) _Pragma("unroll") for (int n = 0; n < 2; ++n) _Pragma("unroll") for (int k = 0; k < 2; ++k) \
        acc[ai][bj][m][n] = __builtin_amdgcn_mfma_f32_16x16x32_bf16(Bt[n][k], At[m][k], acc[ai][bj][m][n], 0, 0, 0); __builtin_amdgcn_s_setprio(0); } while (0)
#define PG8_WAIT_V(n) asm volatile("s_waitcnt vmcnt(" #n ")" ::: "memory")
#define PG8_WAIT_L(n) asm volatile("s_waitcnt lgkmcnt(" #n ")" ::: "memory")
#define PG8_BAR __builtin_amdgcn_s_barrier()
#define PG8_SCHED __builtin_amdgcn_sched_barrier(0)
    Unit cur, nxt; int ui = 0;
    if (!S.next(0, cur)) return;
    f32x4 acc[2][2][4][2];
#pragma unroll
    for (int a = 0; a < 2; ++a)
#pragma unroll
        for (int b = 0; b < 2; ++b)
#pragma unroll
            for (int m = 0; m < 4; ++m)
#pragma unroll
                for (int n = 0; n < 2; ++n) acc[a][b][m][n] = (f32x4){0.f, 0.f, 0.f, 0.f};
    bf16x8 At[4][2], B0[2][2], B1[2][2];
    const char* cA = (const char*)g.A + (size_t)cur.pm * tstep; const char* cB = (const char*)g.Bt + (size_t)cur.pn * tstep;
    S.a_ready(cur);
    PG8_STAGE(PG8_SB(0, 0), cB, voffB); PG8_STAGE(PG8_SA(0, 0), cA, voffA); PG8_STAGE(PG8_SB(0, 1), cB + hstep, voffB); PG8_STAGE(PG8_SA(0, 1), cA + hstep, voffA);
    if (wr == 1) PG8_BAR;
    PG8_WAIT_V(4); PG8_BAR;
    PG8_STAGE(PG8_SB(1, 0), cB + kstep, voffB); PG8_STAGE(PG8_SA(1, 0), cA + kstep, voffA); PG8_STAGE(PG8_SB(1, 1), cB + hstep + kstep, voffB);
    PG8_WAIT_V(6); PG8_BAR;
    PG8_STAMP();
    for (;;) {
        const bool has_next = S.next(ui + 1, nxt);
        const char* nA = has_next ? (const char*)g.A + (size_t)nxt.pm * tstep : cA; const char* nB = has_next ? (const char*)g.Bt + (size_t)nxt.pn * tstep : cB;
        for (int t = 0; t < nt; t += 2) {
            const bool last = (t == nt - 2);
            const char* a1 = cA + (size_t)(t + 1) * kstep;
            const char* a2 = last ? nA : cA + (size_t)(t + 2) * kstep; const char* b2 = last ? nB : cB + (size_t)(t + 2) * kstep;
            const char* a3 = a2 + kstep; const char* b3 = b2 + kstep;
            if (last && has_next) S.a_ready(nxt);
            PG8_LDB(B0, 0, 0); PG8_SCHED; PG8_LDA(At, 0, 0); PG8_STAGE(PG8_SA(1, 1), a1 + hstep, voffA);
            PG8_WAIT_L(8); PG8_BAR; PG8_WAIT_L(0); PG8_MMA(0, 0, At, B0); PG8_BAR; PG8_SCHED;
            PG8_LDB(B1, 0, 1); PG8_STAGE(PG8_SB(0, 0), b2, voffB);
            PG8_BAR; PG8_WAIT_L(0); PG8_MMA(0, 1, At, B1); PG8_BAR;
            PG8_LDA(At, 0, 1); PG8_STAGE(PG8_SA(0, 0), a2, voffA);
            PG8_BAR; PG8_WAIT_L(0); PG8_MMA(1, 0, At, B0); PG8_BAR; PG8_SCHED;
            PG8_STAGE(PG8_SB(0, 1), b2 + hstep, voffB);
            PG8_WAIT_V(6); PG8_BAR; PG8_MMA(1, 1, At, B1); PG8_BAR;
            PG8_LDB(B0, 1, 0); PG8_SCHED; PG8_LDA(At, 1, 0); PG8_STAGE(PG8_SA(0, 1), a2 + hstep, voffA);
            PG8_WAIT_L(8); PG8_BAR; PG8_WAIT_L(0); PG8_MMA(0, 0, At, B0); PG8_BAR; PG8_SCHED;
            PG8_LDB(B1, 1, 1); PG8_STAGE(PG8_SB(1, 0), b3, voffB);
            PG8_BAR; PG8_WAIT_L(0); PG8_MMA(0, 1, At, B1); PG8_BAR;
            PG8_LDA(At, 1, 1); PG8_STAGE(PG8_SA(1, 0), a3, voffA);
            PG8_BAR; PG8_WAIT_L(0); PG8_MMA(1, 0, At, B0); PG8_BAR; PG8_SCHED;
            PG8_STAGE(PG8_SB(1, 1), b3 + hstep, voffB);
            PG8_WAIT_V(6); PG8_BAR; PG8_MMA(1, 1, At, B1); PG8_BAR;
        }
        PG8_STAMP();
        if constexpr (!Epi::AFTER_DRAIN) { E(acc, cur, wr, wc, fr, fq); S.done(cur); }
        PG8_STAMP();
        if (!has_next) break;
#pragma unroll
        for (int a = 0; a < 2; ++a)
#pragma unroll
            for (int b = 0; b < 2; ++b)
#pragma unroll
                for (int m = 0; m < 4; ++m)
#pragma unroll
                    for (int n = 0; n < 2; ++n) acc[a][b][m][n] = (f32x4){0.f, 0.f, 0.f, 0.f};
        cur = nxt; cA = nA; cB = nB; ++ui;
    }
    PG8_WAIT_V(0);
    if (wr == 0) PG8_BAR;
    PG8_BAR;
    if constexpr (Epi::AFTER_DRAIN) { E.fused(acc, cur, wr, wc, fr, fq, lds, wid, lane); S.done(cur); }
    PG8_STAMP();
    if (STAMP && wid == 0) { stamps[lane] = lane < nts ? (((unsigned long long)(unsigned)ts_hi << 32) | (unsigned)ts_lo) : 0ull;
        if (lane == 62) stamps[62] = rt_entry; if (lane == 63) stamps[63] = (unsigned long long)wall_clock64(); }
#undef PG8_STAMP
#undef PG8_SA
#undef PG8_SB
#undef PG8_STAGE
#undef PG8_LDA
#undef PG8_LDB
#undef PG8_MMA
#undef PG8_WAIT_V
#undef PG8_WAIT_L
#undef PG8_BAR
#undef PG8_SCHED
}
}
#define LAS __attribute__((address_space(3)))
typedef unsigned short bf16;
typedef short bf16x8 __attribute__((ext_vector_type(8)));
typedef short bf16x4 __attribute__((ext_vector_type(4)));
typedef float f32x4 __attribute__((ext_vector_type(4)));
typedef unsigned u32x4 __attribute__((ext_vector_type(4)));
typedef unsigned u32x2 __attribute__((ext_vector_type(2)));
typedef float f32x2_ __attribute__((ext_vector_type(2)));
typedef __bf16 bf16x2n __attribute__((ext_vector_type(2)));
__device__ __forceinline__ unsigned cvt_pk_bf16(float lo, float hi) { const f32x2_ v = {lo, hi}; const bf16x2n b = __builtin_convertvector(v, bf16x2n); return __builtin_bit_cast(unsigned, b); }

constexpr int T_TOK = 32768, SEQ = 8192, DM = 1024, NPROJ = 3840, PROJ_W = 3872;
constexpr float EPS = 1e-6f;
constexpr size_t MiB = 1u << 20;
constexpr size_t WS_CTL = 0;
constexpr size_t WS_WTIN = 1 * MiB;
constexpr size_t WS_WTOUT = 9 * MiB;
constexpr size_t WS_W1FK = 11 * MiB + 256 * 1024;
constexpr size_t WS_W1FV = 11 * MiB + 768 * 1024;
constexpr size_t WS_W2FK = 12 * MiB + 256 * 1024;
constexpr size_t WS_W2FV = 12 * MiB + 288 * 1024;
constexpr size_t WS_CPE = 12 * MiB + 320 * 1024;
constexpr size_t WS_BT = 12 * MiB + 384 * 1024;
constexpr size_t WS_RS = 13 * MiB;
constexpr size_t WS_SMALL = 14 * MiB;
constexpr size_t WS_XB = 32 * MiB;
constexpr size_t WS_MIX = 32 * MiB;
constexpr size_t WS_GQKV = 96 * MiB;
constexpr size_t WS_GZ = 192 * MiB;
constexpr size_t WS_NQ = 224 * MiB;
constexpr size_t WS_NKV = 256 * MiB;
constexpr size_t WS_NZ = 304 * MiB;
constexpr size_t WS_GREC = 336 * MiB;
constexpr size_t GREC_BYTES = 73728;
constexpr size_t WS_KCMP = 480 * MiB;
constexpr size_t WS_VCMPT = 480 * MiB + 512 * 1024;
constexpr size_t WS_VST = 482 * MiB;
constexpr size_t WS_VWT = 490 * MiB;
constexpr size_t WS_GLAST = 498 * MiB;
constexpr size_t WS_END = 499 * MiB;
constexpr int LDS_BYTES = 158720;

__device__ __forceinline__ float bf2f(unsigned short h) { return __uint_as_float((unsigned)h << 16); }
__device__ __forceinline__ unsigned short f2bf(float f) { return (unsigned short)(cvt_pk_bf16(f, 0.f) & 0xffffu); }
__device__ __forceinline__ float sigmoidf_(float v) { return 1.0f / (1.0f + __expf(-v)); }
__device__ __forceinline__ float siluf_(float v) { return v / (1.0f + __expf(-v)); }
__device__ __forceinline__ f32x4 mfma16(bf16x8 a, bf16x8 b, f32x4 c) { return __builtin_amdgcn_mfma_f32_16x16x32_bf16(a, b, c, 0, 0, 0); }
__device__ __forceinline__ int kperm(int g, int j) { return j < 4 ? 4 * g + j : 16 + 4 * g + (j - 4); }

struct Frame {
    const float* in[16]; float* out; unsigned char* ws; LAS unsigned char* lds; unsigned char* ldsg;
    int tid, lane, wave;
};

struct EpiProj {
    static constexpr bool PERM = true, AFTER_DRAIN = false;
    bf16* gqkv; bf16* gz; bf16* nq; bf16* nkv; bf16* nz; const float* rs;
    __device__ __forceinline__ void operator()(const f32x4 (&acc)[2][2][4][2], const pg8::Unit& u, int wr, int wc, int fr, int fq) const {
        const int pn = u.pn; bf16* base; int ldc, colt, act;
        if (pn < 6) { base = gqkv; ldc = 1536; colt = pn * 256; act = 0; }
        else if (pn < 8) { base = gz; ldc = 512; colt = (pn - 6) * 256; act = 1; }
        else if (pn < 10) { base = nq; ldc = 512; colt = (pn - 8) * 256; act = 2; }
        else if (pn < 13) { base = nkv; ldc = 768; colt = (pn - 10) * 256; act = 0; }
        else { base = nz; ldc = 512; colt = (pn - 13) * 256; act = 1; }
        const int row0 = u.pm * 256 + wr * 64 + fr, col0 = colt + wc * 32 + 8 * fq;
#pragma unroll
        for (int ai = 0; ai < 2; ++ai)
#pragma unroll
            for (int m = 0; m < 4; ++m) {
                const int row = row0 + ai * 128 + m * 16; const float r = rs[row];
                bf16* rowp = base + (size_t)row * ldc + col0;
#pragma unroll
                for (int bj = 0; bj < 2; ++bj) {
                    f32x4 v0 = acc[ai][bj][m][0] * r, v1 = acc[ai][bj][m][1] * r;
                    if (act == 1) {
#pragma unroll
                        for (int j = 0; j < 4; ++j) { v0[j] = siluf_(v0[j]); v1[j] = siluf_(v1[j]); }
                    } else if (act == 2) { v0 = v0 * 0.125f; v1 = v1 * 0.125f; }
                    u32x4 w; w.x = cvt_pk_bf16(v0[0], v0[1]); w.y = cvt_pk_bf16(v0[2], v0[3]); w.z = cvt_pk_bf16(v1[0], v1[1]); w.w = cvt_pk_bf16(v1[2], v1[3]);
                    *(u32x4*)(rowp + bj * 128) = w;
                }
            }
    }
};
struct EpiOut {
    static constexpr bool PERM = false, AFTER_DRAIN = false;
    const float* x; float* out;
    __device__ __forceinline__ void operator()(const f32x4 (&acc)[2][2][4][2], const pg8::Unit& u, int wr, int wc, int fr, int fq) const {
        const int row0 = u.pm * 256 + wr * 64 + fr, col0 = u.pn * 256 + wc * 32 + 4 * fq;
#pragma unroll
        for (int ai = 0; ai < 2; ++ai)
#pragma unroll
            for (int m = 0; m < 4; ++m) {
                const size_t ro = (size_t)(row0 + ai * 128 + m * 16) * DM + col0;
#pragma unroll
                for (int bj = 0; bj < 2; ++bj)
#pragma unroll
                    for (int n = 0; n < 2; ++n) {
                        const f32x4 xv = *(const f32x4*)(x + ro + bj * 128 + n * 16);
                        *(f32x4*)(out + ro + bj * 128 + n * 16) = acc[ai][bj][m][n] + xv;
                    }
            }
    }
};

__device__ __forceinline__ int orig_col(int n) {
    return n < 2048 ? n : (n < 2560 ? 2056 + (n - 2048) : (n < 3328 ? 2568 + (n - 2560) : 3360 + (n - 3328)));
}
__device__ __forceinline__ int orig_small(int sc) { return sc < 8 ? 2048 + sc : 3336 + (sc - 8); }
__device__ __forceinline__ int rel_bucket(int dist) {
    const int n = dist < 0 ? 0 : dist;
    if (n < 16) return n;
    int b = 16;
    b += (n >= 21); b += (n >= 27); b += (n >= 35); b += (n >= 46); b += (n >= 59); b += (n >= 77); b += (n >= 99); b += (n >= 128);
    b += (n >= 166); b += (n >= 216); b += (n >= 280); b += (n >= 363); b += (n >= 470); b += (n >= 609); b += (n >= 790);
    return b;
}
__device__ __forceinline__ void transpose_tile(const Frame& F, const float* src, int sld, int srccol0, int k0, const float* scale, bf16* dst, int dld, int n0) {
    LAS float* tile = (LAS float*)F.lds;
    const int kk = F.tid >> 6, nn = F.tid & 63;
#pragma unroll
    for (int i = 0; i < 8; ++i) { const int k = kk + 8 * i; float v = src[(size_t)(k0 + k) * sld + srccol0 + nn]; if (scale) v *= scale[k0 + k]; tile[k * 65 + nn] = v; }
    __syncthreads();
    const int n2 = F.tid >> 3, kc = F.tid & 7;
    float e[8];
#pragma unroll
    for (int j = 0; j < 8; ++j) e[j] = tile[(8 * kc + j) * 65 + n2];
    u32x4 w; w.x = cvt_pk_bf16(e[0], e[1]); w.y = cvt_pk_bf16(e[2], e[3]); w.z = cvt_pk_bf16(e[4], e[5]); w.w = cvt_pk_bf16(e[6], e[7]);
    *(u32x4*)(dst + (size_t)(n0 + n2) * dld + k0 + 8 * kc) = w;
    __syncthreads();
}

__device__ __forceinline__ void p0_prep(const Frame& F) {
    const float* x = F.in[0]; const float* nw = F.in[1]; const float* w_in = F.in[2];
    unsigned char* ws = F.ws;
    const int G = gridDim.x, bid = blockIdx.x;
    for (int task = bid; task < 1365; task += G) {
        if (task < 960) { const int nt = task / 16, kt = task % 16; transpose_tile(F, w_in, PROJ_W, orig_col(nt * 64), kt * 64, nw, (bf16*)(ws + WS_WTIN), DM, nt * 64); }
        else if (task < 1216) { const int t2 = task - 960, nt = t2 / 16, kt = t2 % 16; transpose_tile(F, F.in[13], DM, nt * 64, kt * 64, nullptr, (bf16*)(ws + WS_WTOUT), DM, nt * 64); }
        else if (task < 1344) {
            const int t2 = task - 1216, which = t2 >> 6, sub = t2 & 63;
            const float* w1 = F.in[which ? 11 : 9]; bf16* dst = (bf16*)(ws + (which ? WS_W1FV : WS_W1FK));
            const int mt = F.tid >> 6, l = F.tid & 63, m = l & 15, kg = l >> 4, ks = sub;
            float e[8];
#pragma unroll
            for (int j = 0; j < 8; ++j) e[j] = w1[(size_t)(32 * ks + 8 * kg + j) * 128 + 16 * mt + m];
            u32x4 w; w.x = cvt_pk_bf16(e[0], e[1]); w.y = cvt_pk_bf16(e[2], e[3]); w.z = cvt_pk_bf16(e[4], e[5]); w.w = cvt_pk_bf16(e[6], e[7]);
            *(u32x4*)(dst + ((size_t)(ks * 8 + mt) * 64 + l) * 8) = w;
        } else if (task < 1346) {
            const int which = task - 1344; const float* w2 = F.in[which ? 12 : 10]; bf16* dst = (bf16*)(ws + (which ? WS_W2FV : WS_W2FK));
            for (int i = F.tid; i < 1024; i += 512) {
                const int l = i & 63, ks = (i >> 6) & 3, mt = i >> 8, m = l & 15, kg = l >> 4;
                float e[8];
#pragma unroll
                for (int j = 0; j < 8; ++j) e[j] = w2[(size_t)(32 * ks + kperm(kg, j)) * 64 + 16 * mt + m];
                u32x4 w; w.x = cvt_pk_bf16(e[0], e[1]); w.y = cvt_pk_bf16(e[2], e[3]); w.z = cvt_pk_bf16(e[4], e[5]); w.w = cvt_pk_bf16(e[6], e[7]);
                *(u32x4*)(dst + (size_t)i * 8) = w;
            }
        } else if (task < 1348) {
            const int which = task - 1346; const float* pe = F.in[which ? 8 : 7]; const float* w1 = F.in[which ? 11 : 9];
            float* dst = (float*)(ws + WS_CPE) + which * 128;
            if (F.tid < 128) { float s = 0.f; for (int k = 0; k < 2048; ++k) s += pe[k] * w1[(size_t)k * 128 + F.tid]; dst[F.tid] = s; }
        } else {
            const int i = (task - 1348) * 512 + F.tid;
            if (i < 8 * 1025) { const int head = i / 1025, dist = i % 1025; ((float*)(ws + WS_BT))[i] = F.in[14][rel_bucket(dist) * 8 + head]; }
        }
    }
    __syncthreads();
    {
        for (int i = F.tid; i < 32 * 2 * 64; i += 512) {
            const int l = i & 63, nt = (i >> 6) & 1, ks = i >> 7, kg = l >> 4, sc = 16 * nt + (l & 15), oc = orig_small(sc);
            float v[8], lo[8]; unsigned short hi[8];
#pragma unroll
            for (int j = 0; j < 8; ++j) { const int k = 32 * ks + 8 * kg + j; v[j] = w_in[(size_t)k * PROJ_W + oc] * nw[k]; hi[j] = f2bf(v[j]); lo[j] = v[j] - bf2f(hi[j]); }
            u32x4 wh, wl;
            wh.x = hi[0] | ((unsigned)hi[1] << 16); wh.y = hi[2] | ((unsigned)hi[3] << 16); wh.z = hi[4] | ((unsigned)hi[5] << 16); wh.w = hi[6] | ((unsigned)hi[7] << 16);
            wl.x = cvt_pk_bf16(lo[0], lo[1]); wl.y = cvt_pk_bf16(lo[2], lo[3]); wl.z = cvt_pk_bf16(lo[4], lo[5]); wl.w = cvt_pk_bf16(lo[6], lo[7]);
            *(LAS u32x4*)(F.lds + ((size_t)((ks * 2 + nt) * 2 + 0) * 64 + l) * 16) = wh;
            *(LAS u32x4*)(F.lds + ((size_t)((ks * 2 + nt) * 2 + 1) * 64 + l) * 16) = wl;
        }
    }
    __syncthreads();
    bf16* xb = (bf16*)(ws + WS_XB); float* rsv = (float*)(ws + WS_RS); float* small = (float*)(ws + WS_SMALL);
    const float* a_log = F.in[4]; const float* dt_bias = F.in[5];
    for (int tile = bid * 8 + F.wave; tile < T_TOK / 16; tile += G * 8) {
        const int l = F.lane, r = l & 15, kg = l >> 4; const int row = tile * 16 + r;
        const float* xr = x + (size_t)row * DM + 8 * kg;
        f32x4 acc0 = {0.f, 0.f, 0.f, 0.f}, acc1 = {0.f, 0.f, 0.f, 0.f};
        float ss = 0.f;
#pragma unroll 4
        for (int ks = 0; ks < 32; ++ks) {
            const f32x4 a0 = *(const f32x4*)(xr + 32 * ks), a1 = *(const f32x4*)(xr + 32 * ks + 4);
            ss += a0[0] * a0[0] + a0[1] * a0[1] + a0[2] * a0[2] + a0[3] * a0[3] + a1[0] * a1[0] + a1[1] * a1[1] + a1[2] * a1[2] + a1[3] * a1[3];
            u32x4 h; h.x = cvt_pk_bf16(a0[0], a0[1]); h.y = cvt_pk_bf16(a0[2], a0[3]); h.z = cvt_pk_bf16(a1[0], a1[1]); h.w = cvt_pk_bf16(a1[2], a1[3]);
            *(u32x4*)(xb + (size_t)row * DM + 32 * ks + 8 * kg) = h;
            u32x4 lo;
            lo.x = cvt_pk_bf16(a0[0] - __uint_as_float(h.x << 16), a0[1] - __uint_as_float(h.x & 0xffff0000u));
            lo.y = cvt_pk_bf16(a0[2] - __uint_as_float(h.y << 16), a0[3] - __uint_as_float(h.y & 0xffff0000u));
            lo.z = cvt_pk_bf16(a1[0] - __uint_as_float(h.z << 16), a1[1] - __uint_as_float(h.z & 0xffff0000u));
            lo.w = cvt_pk_bf16(a1[2] - __uint_as_float(h.w << 16), a1[3] - __uint_as_float(h.w & 0xffff0000u));
            const bf16x8 ah = __builtin_bit_cast(bf16x8, h), al = __builtin_bit_cast(bf16x8, lo);
            const LAS unsigned char* fb = F.lds + (size_t)(ks * 4) * 1024 + l * 16;
            const bf16x8 b0h = *(const LAS bf16x8*)(fb), b0l = *(const LAS bf16x8*)(fb + 1024), b1h = *(const LAS bf16x8*)(fb + 2048), b1l = *(const LAS bf16x8*)(fb + 3072);
            acc0 = mfma16(ah, b0h, acc0); acc0 = mfma16(al, b0h, acc0); acc0 = mfma16(ah, b0l, acc0);
            acc1 = mfma16(ah, b1h, acc1); acc1 = mfma16(al, b1h, acc1); acc1 = mfma16(ah, b1l, acc1);
        }
        ss += __shfl_xor(ss, 16); ss += __shfl_xor(ss, 32);
        const float rs = rsqrtf(ss * (1.0f / 1024.f) + EPS);
        if (kg == 0) rsv[row] = rs;
#pragma unroll
        for (int reg = 0; reg < 4; ++reg) {
            const int rr = 4 * kg + reg; const float rsr = __shfl(rs, rr);
            const int orow = tile * 16 + rr;
            {
                const float v = acc0[reg] * rsr; const int c = r; float o;
                if (c < 4) o = sigmoidf_(v);
                else if (c < 8) { const int h = c - 4; const float z = v + dt_bias[h]; const float sp = z > 20.f ? z : log1pf(expf(z)); o = -expf(a_log[h]) * sp; }
                else o = sigmoidf_(v);
                small[(size_t)orow * 32 + c] = o;
            }
            { const float v = acc1[reg] * rsr; small[(size_t)orow * 32 + 16 + r] = sigmoidf_(v); }
        }
    }
}

__device__ __forceinline__ void p5_final(const Frame& F) {
    const float* fw = F.in[15]; float* out = F.out;
    for (int r = blockIdx.x * 8 + F.wave; r < T_TOK; r += gridDim.x * 8) {
        f32x4* orow = (f32x4*)(out + (size_t)r * DM);
        f32x4 v[4]; float ss = 0.f;
#pragma unroll
        for (int i = 0; i < 4; ++i) { v[i] = orow[F.lane + 64 * i]; ss += v[i][0] * v[i][0] + v[i][1] * v[i][1] + v[i][2] * v[i][2] + v[i][3] * v[i][3]; }
#pragma unroll
        for (int o = 32; o > 0; o >>= 1) ss += __shfl_xor(ss, o);
        const float rs = rsqrtf(ss * (1.0f / 1024.f) + EPS);
#pragma unroll
        for (int i = 0; i < 4; ++i) { const f32x4 w = ((const f32x4*)fw)[F.lane + 64 * i]; orow[F.lane + 64 * i] = v[i] * rs * w; }
    }
}
constexpr int REC_WNEG = 0, REC_QDEC = 16384, REC_ATTN = 32768, REC_KDT = 40960, REC_U = 57344, REC_LDS_BYTES = 57344;
__device__ __forceinline__ void gdn_prep_item(const Frame& F, int item) {
    const int tid = F.tid;
    const int h = item & 3, n = (item >> 2) & 127, b = item >> 9;
    const int tok0 = b * SEQ + n * 64;
    LAS float* kf = (LAS float*)(F.lds); LAS float* vf = (LAS float*)(F.lds + 32768);
    LAS bf16* qb = (LAS bf16*)(F.lds + 65536); LAS bf16* kb = (LAS bf16*)(F.lds + 82944); LAS bf16* kbb = (LAS bf16*)(F.lds + 100352);
    LAS float* Lm = (LAS float*)(F.lds + 117760); LAS bf16* atb = (LAS bf16*)(F.lds + 134144); LAS float* gcs = (LAS float*)(F.lds + 143360);
    LAS bf16* wb = qb;
    unsigned char* rec = F.ws + WS_GREC + (size_t)item * GREC_BYTES;
    const float* small = (const float*)(F.ws + WS_SMALL);
    if (tid < 64) {
        const float beta = small[(size_t)(tok0 + tid) * 32 + h]; float c = small[(size_t)(tok0 + tid) * 32 + 4 + h];
#pragma unroll
        for (int o = 1; o < 64; o <<= 1) { const float t = __shfl_up(c, o); if (tid >= o) c += t; }
        gcs[tid] = c; gcs[64 + tid] = beta; gcs[128 + tid] = expf(c);
        if (tid == 63) ((float*)(F.ws + WS_GLAST))[item] = expf(c);
    }
    __syncthreads();
    {
        const bf16* gq = (const bf16*)(F.ws + WS_GQKV); const float* cw = F.in[3];
        const int grp = tid >> 4, li = tid & 15;
#pragma unroll
        for (int rr = 0; rr < 2; ++rr) {
            const int c = grp * 2 + rr, pos = n * 64 + c;
            const float betav = gcs[64 + c], egv = gcs[128 + c];
#pragma unroll
            for (int part = 0; part < 3; ++part) {
                const int ch = part * 512 + h * 128 + 8 * li;
                float y[8];
#pragma unroll
                for (int e = 0; e < 8; ++e) y[e] = 0.f;
#pragma unroll
                for (int j = 0; j < 4; ++j) {
                    const int p = pos - 3 + j;
                    if (p >= 0) {
                        const u32x4 xv = *(const u32x4*)(gq + (size_t)(b * SEQ + p) * 1536 + ch);
                        const f32x4 w0 = *(const f32x4*)(cw + j * 1536 + ch), w1 = *(const f32x4*)(cw + j * 1536 + ch + 4);
                        y[0] += w0[0] * __uint_as_float(xv.x << 16); y[1] += w0[1] * __uint_as_float(xv.x & 0xffff0000u);
                        y[2] += w0[2] * __uint_as_float(xv.y << 16); y[3] += w0[3] * __uint_as_float(xv.y & 0xffff0000u);
                        y[4] += w1[0] * __uint_as_float(xv.z << 16); y[5] += w1[1] * __uint_as_float(xv.z & 0xffff0000u);
                        y[6] += w1[2] * __uint_as_float(xv.w << 16); y[7] += w1[3] * __uint_as_float(xv.w & 0xffff0000u);
                    }
                }
                float ss = 0.f;
#pragma unroll
                for (int e = 0; e < 8; ++e) { y[e] = siluf_(y[e]); ss += y[e] * y[e]; }
                if (part < 2) {
                    ss += __shfl_xor(ss, 1); ss += __shfl_xor(ss, 2); ss += __shfl_xor(ss, 4); ss += __shfl_xor(ss, 8);
                    const float sc = rsqrtf(ss + EPS) * (part == 0 ? 0.08838834764831845f : 1.0f);
#pragma unroll
                    for (int e = 0; e < 8; ++e) y[e] *= sc;
                }
                if (part == 0) {
                    u32x4 w; w.x = cvt_pk_bf16(y[0], y[1]); w.y = cvt_pk_bf16(y[2], y[3]); w.z = cvt_pk_bf16(y[4], y[5]); w.w = cvt_pk_bf16(y[6], y[7]);
                    *(LAS u32x4*)(qb + c * 136 + 8 * li) = w;
                    const int mt = c >> 4, m = c & 15, ks = li >> 2, a = (li & 3) >> 1, g0 = (2 * (li & 3)) & 3, g1 = (2 * (li & 3) + 1) & 3;
                    u32x2 d0, d1; d0.x = cvt_pk_bf16(y[0] * egv, y[1] * egv); d0.y = cvt_pk_bf16(y[2] * egv, y[3] * egv); d1.x = cvt_pk_bf16(y[4] * egv, y[5] * egv); d1.y = cvt_pk_bf16(y[6] * egv, y[7] * egv);
                    unsigned char* fb = rec + REC_QDEC + (size_t)(mt * 4 + ks) * 1024 + a * 8;
                    *(u32x2*)(fb + (g0 * 16 + m) * 16) = d0; *(u32x2*)(fb + (g1 * 16 + m) * 16) = d1;
                } else if (part == 1) {
                    *(LAS f32x4*)(kf + c * 128 + 8 * li) = (f32x4){y[0], y[1], y[2], y[3]}; *(LAS f32x4*)(kf + c * 128 + 8 * li + 4) = (f32x4){y[4], y[5], y[6], y[7]};
                    u32x4 w; w.x = cvt_pk_bf16(y[0], y[1]); w.y = cvt_pk_bf16(y[2], y[3]); w.z = cvt_pk_bf16(y[4], y[5]); w.w = cvt_pk_bf16(y[6], y[7]);
                    *(LAS u32x4*)(kb + c * 136 + 8 * li) = w;
                    w.x = cvt_pk_bf16(y[0] * betav, y[1] * betav); w.y = cvt_pk_bf16(y[2] * betav, y[3] * betav); w.z = cvt_pk_bf16(y[4] * betav, y[5] * betav); w.w = cvt_pk_bf16(y[6] * betav, y[7] * betav);
                    *(LAS u32x4*)(kbb + c * 136 + 8 * li) = w;
                } else {
                    *(LAS f32x4*)(vf + c * 128 + 8 * li) = (f32x4){y[0], y[1], y[2], y[3]}; *(LAS f32x4*)(vf + c * 128 + 8 * li + 4) = (f32x4){y[4], y[5], y[6], y[7]};
                }
            }
        }
    }
    __syncthreads();
    {
        const int l = F.lane, m = l & 15, kg = l >> 4;
#pragma unroll
        for (int i = 0; i < 4; ++i) {
            const int tt = F.wave * 4 + i, which = tt >> 4, mi = (tt >> 2) & 3, ni = tt & 3;
            f32x4 acc = {0.f, 0.f, 0.f, 0.f};
            if (mi >= ni) {
                const LAS bf16* As = which ? qb : kbb;
#pragma unroll
                for (int ks = 0; ks < 4; ++ks) {
                    const bf16x8 a = *(const LAS bf16x8*)(As + (16 * mi + m) * 136 + 32 * ks + 8 * kg);
                    const bf16x8 bb = *(const LAS bf16x8*)(kb + (16 * ni + m) * 136 + 32 * ks + 8 * kg);
                    acc = mfma16(a, bb, acc);
                }
            }
#pragma unroll
            for (int r = 0; r < 4; ++r) {
                const int irow = 16 * mi + 4 * kg + r, jcol = 16 * ni + m;
                const float dec = (irow >= jcol) ? expf(gcs[irow] - gcs[jcol]) : 0.f;
                if (which == 0) Lm[jcol * 64 + irow] = (irow > jcol) ? acc[r] * dec : 0.f;
                else atb[irow * 72 + jcol] = f2bf((irow >= jcol) ? acc[r] * dec : 0.f);
            }
        }
    }
    __syncthreads();
    {
        const float gl = gcs[63];
#pragma unroll
        for (int q = 0; q < 2; ++q) {
            const int idx = tid + 512 * q, l = idx & 63, ks = (idx >> 6) & 1, mt = idx >> 7, m = l & 15, g = l >> 4;
            float e[8];
#pragma unroll
            for (int j = 0; j < 8; ++j) { const int cr = 32 * ks + kperm(g, j); e[j] = kf[cr * 128 + 16 * mt + m] * expf(gl - gcs[cr]); }
            u32x4 w; w.x = cvt_pk_bf16(e[0], e[1]); w.y = cvt_pk_bf16(e[2], e[3]); w.z = cvt_pk_bf16(e[4], e[5]); w.w = cvt_pk_bf16(e[6], e[7]);
            *(u32x4*)(rec + REC_KDT + (size_t)idx * 16) = w;
        }
        {
            const int idx = tid, l = idx & 63, ks = (idx >> 6) & 1, mt = idx >> 7, m = l & 15, g = l >> 4;
            const u32x2 a0 = *(const LAS u32x2*)(atb + (16 * mt + m) * 72 + 32 * ks + 4 * g), a1 = *(const LAS u32x2*)(atb + (16 * mt + m) * 72 + 32 * ks + 16 + 4 * g);
            *(u32x4*)(rec + REC_ATTN + (size_t)idx * 16) = (u32x4){a0.x, a0.y, a1.x, a1.y};
        }
    }
    __syncthreads();
    if (tid < 256) {
        const int c = tid; const bool isw = c >= 128;
        LAS float* base = isw ? (kf + (c - 128)) : (vf + c);
#pragma unroll
        for (int ib = 0; ib < 4; ++ib) {
            float r[16];
#pragma unroll
            for (int ii = 0; ii < 16; ++ii) { const int i = 16 * ib + ii; r[ii] = base[i * 128] * gcs[64 + i] * (isw ? gcs[128 + i] : 1.0f); }
            for (int j = 0; j < 16 * ib; ++j) {
                const float xj = base[j * 128];
                const LAS f32x4* lp = (const LAS f32x4*)(Lm + j * 64 + 16 * ib);
                const f32x4 l0 = lp[0], l1 = lp[1], l2 = lp[2], l3 = lp[3];
                r[0] -= l0[0] * xj; r[1] -= l0[1] * xj; r[2] -= l0[2] * xj; r[3] -= l0[3] * xj;
                r[4] -= l1[0] * xj; r[5] -= l1[1] * xj; r[6] -= l1[2] * xj; r[7] -= l1[3] * xj;
                r[8] -= l2[0] * xj; r[9] -= l2[1] * xj; r[10] -= l2[2] * xj; r[11] -= l2[3] * xj;
                r[12] -= l3[0] * xj; r[13] -= l3[1] * xj; r[14] -= l3[2] * xj; r[15] -= l3[3] * xj;
            }
#pragma unroll
            for (int jj = 0; jj < 15; ++jj) {
                const LAS f32x4* lp = (const LAS f32x4*)(Lm + (16 * ib + jj) * 64 + 16 * ib);
#pragma unroll
                for (int q = 0; q < 4; ++q) {
                    if (4 * q + 3 > jj) {
                        const f32x4 lv = lp[q];
#pragma unroll
                        for (int e = 0; e < 4; ++e) if (4 * q + e > jj) r[4 * q + e] -= lv[e] * r[jj];
                    }
                }
            }
#pragma unroll
            for (int ii = 0; ii < 16; ++ii) base[(16 * ib + ii) * 128] = r[ii];
        }
    }
    __syncthreads();
    {
#pragma unroll
        for (int q = 0; q < 4; ++q) {
            const int idx = tid + 512 * q, l = idx & 63, mt = (idx >> 6) & 3, sl = idx >> 8, g4 = l >> 4, nn = l & 15;
            const LAS float* up = vf + (16 * mt + 4 * g4) * 128 + 16 * sl + nn;
            u32x2 d; d.x = cvt_pk_bf16(up[0], up[128]); d.y = cvt_pk_bf16(up[256], up[384]);
            *(u32x2*)(rec + REC_U + (size_t)idx * 8) = d;
        }
#pragma unroll
        for (int q = 0; q < 2; ++q) {
            const int idx = tid + 512 * q, l = idx & 63, ks = (idx >> 6) & 3, mt = idx >> 8, m = l & 15, g = l >> 4;
            const f32x4 a0 = *(const LAS f32x4*)(kf + (16 * mt + m) * 128 + 32 * ks + 4 * g), a1 = *(const LAS f32x4*)(kf + (16 * mt + m) * 128 + 32 * ks + 16 + 4 * g);
            u32x4 w; w.x = cvt_pk_bf16(-a0[0], -a0[1]); w.y = cvt_pk_bf16(-a0[2], -a0[3]); w.z = cvt_pk_bf16(-a1[0], -a1[1]); w.w = cvt_pk_bf16(-a1[2], -a1[3]);
            *(u32x4*)(rec + REC_WNEG + (size_t)idx * 16) = w;
        }
    }
    __syncthreads();
}

__device__ __forceinline__ bf16x8 acc2frag(const f32x4& lo, const f32x4& hi) {
    u32x4 w; w.x = cvt_pk_bf16(lo[0], lo[1]); w.y = cvt_pk_bf16(lo[2], lo[3]); w.z = cvt_pk_bf16(hi[0], hi[1]); w.w = cvt_pk_bf16(hi[2], hi[3]);
    return __builtin_bit_cast(bf16x8, w);
}
__device__ __forceinline__ void gdn_scan(const Frame& F, int bh) {
    const int tid = F.tid, lane = F.lane, s = F.wave;
    const int b = bh >> 2, h = bh & 3;
    LAS unsigned char* buf0 = F.lds; LAS float* ox = (LAS float*)(F.lds + 2 * REC_LDS_BYTES);
    const float* glast = (const float*)(F.ws + WS_GLAST);
    const bf16* gz = (const bf16*)(F.ws + WS_GZ); const float* gnw = F.in[6]; bf16* mix = (bf16*)(F.ws + WS_MIX);
    f32x4 S[8];
#pragma unroll
    for (int t = 0; t < 8; ++t) S[t] = (f32x4){0.f, 0.f, 0.f, 0.f};
    const unsigned char* const recbase = F.ws + WS_GREC + (size_t)(b * 512 + h) * GREC_BYTES;
#define recp(n) (recbase + (size_t)(n) * 4 * GREC_BYTES)
#define GS_STAGE(n, bufsel) do { const unsigned char* _r = recp(n); _Pragma("unroll") for (int _i = 0; _i < 7; ++_i) \
        __builtin_amdgcn_global_load_lds((const unsigned*)(_r + (size_t)(_i * 512 + tid) * 16), (LAS unsigned*)(buf0 + (bufsel) * REC_LDS_BYTES + (_i * 8 + s) * 1024), 16, 0, 0); } while (0)
    GS_STAGE(0, 0);
    u32x2 un[4];
#pragma unroll
    for (int mt = 0; mt < 4; ++mt) un[mt] = *(const u32x2*)(recp(0) + REC_U + (size_t)((s * 4 + mt) * 64 + lane) * 8);
    float egn = glast[(b * 128 + 0) * 4 + h];
    for (int n = 0; n < 128; ++n) {
        const int cur = n & 1;
        asm volatile("s_waitcnt vmcnt(0)" ::: "memory");
        __syncthreads();
        u32x2 uc[4];
#pragma unroll
        for (int mt = 0; mt < 4; ++mt) uc[mt] = un[mt];
        const float egl = egn;
        if (n + 1 < 128) {
            GS_STAGE(n + 1, cur ^ 1);
#pragma unroll
            for (int mt = 0; mt < 4; ++mt) un[mt] = *(const u32x2*)(recp(n + 1) + REC_U + (size_t)((s * 4 + mt) * 64 + lane) * 8);
            egn = glast[(b * 128 + n + 1) * 4 + h];
        }
        const LAS unsigned char* bp = buf0 + cur * REC_LDS_BYTES + lane * 16;
        bf16x8 Sb[4];
#pragma unroll
        for (int ks = 0; ks < 4; ++ks) Sb[ks] = acc2frag(S[2 * ks], S[2 * ks + 1]);
        f32x4 vn[4], o[4];
#pragma unroll
        for (int mt = 0; mt < 4; ++mt) {
            vn[mt] = (f32x4){__uint_as_float(uc[mt].x << 16), __uint_as_float(uc[mt].x & 0xffff0000u), __uint_as_float(uc[mt].y << 16), __uint_as_float(uc[mt].y & 0xffff0000u)};
#pragma unroll
            for (int ks = 0; ks < 4; ++ks) vn[mt] = mfma16(*(const LAS bf16x8*)(bp + REC_WNEG + (mt * 4 + ks) * 1024), Sb[ks], vn[mt]);
        }
        bf16x8 Vb[2];
#pragma unroll
        for (int ks = 0; ks < 2; ++ks) Vb[ks] = acc2frag(vn[2 * ks], vn[2 * ks + 1]);
#pragma unroll
        for (int mt = 0; mt < 4; ++mt) {
            o[mt] = (f32x4){0.f, 0.f, 0.f, 0.f};
#pragma unroll
            for (int ks = 0; ks < 4; ++ks) o[mt] = mfma16(*(const LAS bf16x8*)(bp + REC_QDEC + (mt * 4 + ks) * 1024), Sb[ks], o[mt]);
#pragma unroll
            for (int ks = 0; ks < 2; ++ks) o[mt] = mfma16(*(const LAS bf16x8*)(bp + REC_ATTN + (mt * 2 + ks) * 1024), Vb[ks], o[mt]);
        }
#pragma unroll
        for (int t = 0; t < 8; ++t) {
            S[t] = S[t] * egl;
#pragma unroll
            for (int ks = 0; ks < 2; ++ks) S[t] = mfma16(*(const LAS bf16x8*)(bp + REC_KDT + (t * 2 + ks) * 1024), Vb[ks], S[t]);
        }
        {
            const int g4 = lane >> 4, nn = lane & 15;
#pragma unroll
            for (int mt = 0; mt < 4; ++mt)
#pragma unroll
                for (int r = 0; r < 4; ++r) ox[(16 * mt + 4 * g4 + r) * 132 + 16 * s + nn] = o[mt][r];
        }
        __syncthreads();
        {
            const int row = tid >> 3, part = tid & 7; const int tok = b * SEQ + n * 64 + row;
            float v[16]; float ss = 0.f;
#pragma unroll
            for (int q = 0; q < 4; ++q) { const f32x4 t4 = *(const LAS f32x4*)(ox + row * 132 + 16 * part + 4 * q); v[4 * q] = t4[0]; v[4 * q + 1] = t4[1]; v[4 * q + 2] = t4[2]; v[4 * q + 3] = t4[3]; }
#pragma unroll
            for (int e = 0; e < 16; ++e) ss += v[e] * v[e];
            ss += __shfl_xor(ss, 1); ss += __shfl_xor(ss, 2); ss += __shfl_xor(ss, 4);
            const float rs = rsqrtf(ss * (1.0f / 128.f) + EPS);
            const u32x4 z0 = *(const u32x4*)(gz + (size_t)tok * 512 + h * 128 + 16 * part), z1 = *(const u32x4*)(gz + (size_t)tok * 512 + h * 128 + 16 * part + 8);
            const unsigned zz[8] = {z0.x, z0.y, z0.z, z0.w, z1.x, z1.y, z1.z, z1.w};
            unsigned ow[8];
#pragma unroll
            for (int e = 0; e < 8; ++e) {
                const float w0 = gnw[16 * part + 2 * e], w1 = gnw[16 * part + 2 * e + 1];
                ow[e] = cvt_pk_bf16(v[2 * e] * rs * w0 * __uint_as_float(zz[e] << 16), v[2 * e + 1] * rs * w1 * __uint_as_float(zz[e] & 0xffff0000u));
            }
            bf16* mp = mix + (size_t)tok * DM + h * 128 + 16 * part;
            *(u32x4*)mp = (u32x4){ow[0], ow[1], ow[2], ow[3]}; *(u32x4*)(mp + 8) = (u32x4){ow[4], ow[5], ow[6], ow[7]};
        }
    }
#undef GS_STAGE
#undef recp
    asm volatile("s_waitcnt vmcnt(0)" ::: "memory");
    __syncthreads();
}
__device__ __forceinline__ void compress_wave(const Frame& F, int wt) {
    const int which = wt >> 8, bhk = (wt >> 5) & 7, rt = wt & 31, b = bhk >> 1, hk = bhk & 1;
    const int l = F.lane, n = l & 15, kg = l >> 4;
    const bf16* nkv = (const bf16*)(F.ws + WS_NKV);
    const bf16* w1f = (const bf16*)(F.ws + (which ? WS_W1FV : WS_W1FK)); const bf16* w2f = (const bf16*)(F.ws + (which ? WS_W2FV : WS_W2FK));
    const float* cpe = (const float*)(F.ws + WS_CPE) + which * 128;
    const int nc = 16 * rt + n;
    f32x4 acc[8];
#pragma unroll
    for (int t = 0; t < 8; ++t) acc[t] = (f32x4){0.f, 0.f, 0.f, 0.f};
    for (int ks = 0; ks < 64; ++ks) {
        int tok = 16 * nc + (ks >> 1); tok = tok < SEQ ? tok : SEQ - 1;
        const bf16x8 bfrag = *(const bf16x8*)(nkv + (size_t)(b * SEQ + tok) * 768 + which * 128 + hk * 64 + (ks & 1) * 32 + 8 * kg);
#pragma unroll
        for (int mt = 0; mt < 8; ++mt) acc[mt] = mfma16(*(const bf16x8*)(w1f + ((size_t)(ks * 8 + mt) * 64 + l) * 8), bfrag, acc[mt]);
    }
#pragma unroll
    for (int mt = 0; mt < 8; ++mt)
#pragma unroll
        for (int r = 0; r < 4; ++r) acc[mt][r] = siluf_(acc[mt][r] + cpe[16 * mt + 4 * kg + r]);
    f32x4 o[4];
#pragma unroll
    for (int mt = 0; mt < 4; ++mt) {
        o[mt] = (f32x4){0.f, 0.f, 0.f, 0.f};
#pragma unroll
        for (int ks = 0; ks < 4; ++ks) {
            u32x4 w; w.x = cvt_pk_bf16(acc[2 * ks][0], acc[2 * ks][1]); w.y = cvt_pk_bf16(acc[2 * ks][2], acc[2 * ks][3]); w.z = cvt_pk_bf16(acc[2 * ks + 1][0], acc[2 * ks + 1][1]); w.w = cvt_pk_bf16(acc[2 * ks + 1][2], acc[2 * ks + 1][3]);
            o[mt] = mfma16(*(const bf16x8*)(w2f + ((size_t)(mt * 4 + ks) * 64 + l) * 8), __builtin_bit_cast(bf16x8, w), o[mt]);
        }
    }
    const bool valid = nc < 511;
    if (which == 0) {
        bf16* kc = (bf16*)(F.ws + WS_KCMP) + ((size_t)bhk * 512 + nc) * 64;
#pragma unroll
        for (int mt = 0; mt < 4; ++mt) { u32x2 d; d.x = valid ? cvt_pk_bf16(o[mt][0], o[mt][1]) : 0u; d.y = valid ? cvt_pk_bf16(o[mt][2], o[mt][3]) : 0u; *(u32x2*)(kc + 16 * mt + 4 * kg) = d; }
    } else {
        bf16* vt = (bf16*)(F.ws + WS_VCMPT) + (size_t)bhk * 64 * 512 + nc;
#pragma unroll
        for (int mt = 0; mt < 4; ++mt)
#pragma unroll
            for (int r = 0; r < 4; ++r) vt[(size_t)(16 * mt + 4 * kg + r) * 512] = valid ? f2bf(o[mt][r]) : (unsigned short)0;
    }
}
__device__ __forceinline__ void vtranspose_task(const Frame& F, int task) {
    const int which = task >> 8, bhk = (task >> 5) & 7, tg = task & 31, b = bhk >> 1, hk = bhk & 1;
    const bf16* nkv = (const bf16*)(F.ws + WS_NKV); bf16* dst = (bf16*)(F.ws + (which ? WS_VWT : WS_VST)) + (size_t)bhk * 64 * SEQ;
    LAS bf16* tile = (LAS bf16*)F.lds;
    for (int sub = 0; sub < 4; ++sub) {
        const int t0 = tg * 256 + sub * 64;
        { const int tk = F.tid >> 3, dc = F.tid & 7;
          const u32x4 v = *(const u32x4*)(nkv + (size_t)(b * SEQ + t0 + tk) * 768 + 384 + which * 256 + hk * 64 + 8 * dc);
          const unsigned vv[4] = {v.x, v.y, v.z, v.w};
#pragma unroll
          for (int e = 0; e < 4; ++e) { tile[(8 * dc + 2 * e) * 72 + tk] = (unsigned short)(vv[e] & 0xffffu); tile[(8 * dc + 2 * e + 1) * 72 + tk] = (unsigned short)(vv[e] >> 16); } }
        __syncthreads();
        { const int d = F.tid >> 3, tc = F.tid & 7;
          *(u32x4*)(dst + (size_t)d * SEQ + t0 + 8 * tc) = *(const LAS u32x4*)(tile + d * 72 + 8 * tc); }
        __syncthreads();
    }
}

struct AttnAcc { f32x4 O[4]; float m, l; };
template <int MODE, bool PASS1, bool NORM>
__device__ __forceinline__ void attn_tile(const bf16* Kb, int kstride, const bf16* VT, int vlen, int kb, const bf16x8& q0, const bf16x8& q1, int trow, const float* btab,
                                          AttnAcc& A, float mfix, float linv, int lane, f32x4 (&pout)[2]) {
    const int m = lane & 15, kg = lane >> 4;
    f32x4 s[2];
#pragma unroll
    for (int mt = 0; mt < 2; ++mt) {
        const bf16* kr = Kb + (size_t)(kb + 16 * mt + m) * kstride + 8 * kg;
        s[mt] = mfma16(*(const bf16x8*)kr, q0, (f32x4){0.f, 0.f, 0.f, 0.f});
        s[mt] = mfma16(*(const bf16x8*)(kr + 32), q1, s[mt]);
    }
    bool ok[2][4]; float tmax = -1e30f;
#pragma unroll
    for (int mt = 0; mt < 2; ++mt)
#pragma unroll
        for (int r = 0; r < 4; ++r) {
            const int key = kb + 16 * mt + 4 * kg + r;
            const int dist = MODE == 0 ? trow - (16 * key + 31) : trow - key;
            ok[mt][r] = MODE == 2 ? (dist >= 0 && dist < 512) : (dist >= 0);
            const int di = dist < 0 ? 0 : (dist > 1024 ? 1024 : dist);
            s[mt][r] += btab[di];
            if (ok[mt][r]) tmax = fmaxf(tmax, s[mt][r]);
        }
    if (PASS1 || !NORM) {
        tmax = fmaxf(tmax, __shfl_xor(tmax, 16)); tmax = fmaxf(tmax, __shfl_xor(tmax, 32));
        const float mnew = fmaxf(A.m, tmax), alpha = __expf(A.m - mnew);
        float ps = 0.f;
#pragma unroll
        for (int mt = 0; mt < 2; ++mt)
#pragma unroll
            for (int r = 0; r < 4; ++r) { const float p = ok[mt][r] ? __expf(s[mt][r] - mnew) : 0.f; s[mt][r] = p; ps += p; }
        ps += __shfl_xor(ps, 16); ps += __shfl_xor(ps, 32);
        A.l = A.l * alpha + ps; A.m = mnew;
        if (!PASS1) {
#pragma unroll
            for (int t = 0; t < 4; ++t) A.O[t] = A.O[t] * alpha;
        }
    } else {
#pragma unroll
        for (int mt = 0; mt < 2; ++mt)
#pragma unroll
            for (int r = 0; r < 4; ++r) s[mt][r] = ok[mt][r] ? __expf(s[mt][r] - mfix) * linv : 0.f;
    }
    pout[0] = s[0]; pout[1] = s[1];
    if (!PASS1) {
        u32x4 w; w.x = cvt_pk_bf16(s[0][0], s[0][1]); w.y = cvt_pk_bf16(s[0][2], s[0][3]); w.z = cvt_pk_bf16(s[1][0], s[1][1]); w.w = cvt_pk_bf16(s[1][2], s[1][3]);
        const bf16x8 pf = __builtin_bit_cast(bf16x8, w);
#pragma unroll
        for (int t = 0; t < 4; ++t) {
            const bf16* vr = VT + (size_t)(16 * t + m) * vlen + kb + 4 * kg;
            const bf16x4 lo = *(const bf16x4*)vr, hi = *(const bf16x4*)(vr + 16);
            A.O[t] = mfma16(__builtin_shufflevector(lo, hi, 0, 1, 2, 3, 4, 5, 6, 7), pf, A.O[t]);
        }
    }
}

__device__ __forceinline__ void nsa_item(const Frame& F, int item) {
    const int bhk = item & 7, cb = 127 - (item >> 3), b = bhk >> 1, hk = bhk & 1;
    const int lane = F.lane, n = lane & 15, ts = n >> 2, g = n & 3, g4 = lane >> 4, kg = g4;
    const bf16* nq = (const bf16*)(F.ws + WS_NQ); const bf16* nkv = (const bf16*)(F.ws + WS_NKV) + (size_t)b * SEQ * 768;
    const bf16* kcmp = (const bf16*)(F.ws + WS_KCMP) + (size_t)bhk * 512 * 64; const bf16* vcmpt = (const bf16*)(F.ws + WS_VCMPT) + (size_t)bhk * 64 * 512;
    const bf16* vst = (const bf16*)(F.ws + WS_VST) + (size_t)bhk * 64 * SEQ; const bf16* vwt = (const bf16*)(F.ws + WS_VWT) + (size_t)bhk * 64 * SEQ;
    const float* btab = (const float*)(F.ws + WS_BT) + (hk * 4 + g) * 1025;
    const float* small = (const float*)(F.ws + WS_SMALL); const bf16* nz = (const bf16*)(F.ws + WS_NZ); bf16* mix = (bf16*)(F.ws + WS_MIX);
    LAS float* Gs = (LAS float*)(F.lds) + F.wave * 1152;
    LAS float* Ls = Gs + 512; LAS int* sel = (LAS int*)(Gs + 1024); LAS int* cnts = sel + 64;
    for (int grp = 0; grp < 2; ++grp) {
        const int t0 = cb * 64 + F.wave * 8 + grp * 4;
        const int trow = t0 + ts; const size_t tokg = (size_t)b * SEQ + trow;
        const bf16* qp = nq + tokg * 512 + (hk * 4 + g) * 64 + 8 * kg;
        const bf16x8 q0 = *(const bf16x8*)qp, q1 = *(const bf16x8*)(qp + 32);
        f32x4 tot[4];
#pragma unroll
        for (int t = 0; t < 4; ++t) tot[t] = (f32x4){0.f, 0.f, 0.f, 0.f};
        f32x4 pd[2];
        const int nmax = (t0 + 3 - 31) >> 4;
        AttnAcc C; C.m = -1e30f; C.l = 0.f;
#pragma unroll
        for (int t = 0; t < 4; ++t) C.O[t] = (f32x4){0.f, 0.f, 0.f, 0.f};
        if (nmax >= 0) {
            for (int kb = 0; kb <= nmax; kb += 32) attn_tile<0, true, false>(kcmp, 64, vcmpt, 512, kb, q0, q1, trow, btab, C, 0.f, 0.f, lane, pd);
            const float linv = C.l > 0.f ? 1.0f / C.l : 0.f;
            for (int kb = 0; kb <= nmax; kb += 32) {
                attn_tile<0, false, true>(kcmp, 64, vcmpt, 512, kb, q0, q1, trow, btab, C, C.m, linv, lane, pd);
#pragma unroll
                for (int mt = 0; mt < 2; ++mt) {
                    float gsum = pd[mt][0] + pd[mt][1] + pd[mt][2] + pd[mt][3], lv = pd[mt][3];
                    gsum += __shfl_xor(gsum, 1); gsum += __shfl_xor(gsum, 2); lv += __shfl_xor(lv, 1); lv += __shfl_xor(lv, 2);
                    const int j = (kb >> 2) + 4 * mt + g4;
                    if (g == 0) { Gs[ts * 128 + j] = gsum; Ls[ts * 128 + j] = lv; }
                }
            }
        }
        {   const float gate = small[tokg * 32 + 8 + hk * 4 + g];
#pragma unroll
            for (int t = 0; t < 4; ++t) tot[t] = tot[t] + C.O[t] * gate; }
        {
            const int tsl = lane >> 4, i = lane & 15;
            int cnt = 0;
            if (cb <= 15) {
                if (i <= cb) sel[tsl * 16 + i] = i;
                cnt = cb + 1;
            } else {
                float val[8];
#pragma unroll
                for (int q = 0; q < 8; ++q) { const int j = i + 16 * q; val[q] = (j >= 1 && j <= cb - 2) ? (Gs[tsl * 128 + j] + Ls[tsl * 128 + j - 1]) : -1.0f; }
                if (i == 0) { sel[tsl * 16 + 0] = 0; sel[tsl * 16 + 1] = cb - 1; sel[tsl * 16 + 2] = cb; }
                for (int round = 0; round < 13; ++round) {
                    float bv = -2.0f; int bj = 1 << 20;
#pragma unroll
                    for (int q = 0; q < 8; ++q) if (val[q] > bv) { bv = val[q]; bj = i + 16 * q; }
#pragma unroll
                    for (int off = 1; off < 16; off <<= 1) {
                        const float ov = __shfl_xor(bv, off); const int oj = __shfl_xor(bj, off);
                        if (ov > bv || (ov == bv && oj < bj)) { bv = ov; bj = oj; }
                    }
#pragma unroll
                    for (int q = 0; q < 8; ++q) if (bj == i + 16 * q) val[q] = -3.0f;
                    if (i == 0) sel[tsl * 16 + 3 + round] = bj;
                }
                cnt = 16;
            }
            if (i == 0) cnts[tsl] = cnt;
        }
        for (int tsel = 0; tsel < 4; ++tsel) {
            const int tt = t0 + tsel; const size_t tokq = (size_t)b * SEQ + tt;
            const bf16* qps = nq + tokq * 512 + (hk * 4 + g) * 64 + 8 * kg;
            const bf16x8 qs0 = *(const bf16x8*)qps, qs1 = *(const bf16x8*)(qps + 32);
            AttnAcc Sx; Sx.m = -1e30f; Sx.l = 0.f;
#pragma unroll
            for (int t = 0; t < 4; ++t) Sx.O[t] = (f32x4){0.f, 0.f, 0.f, 0.f};
            const int cnt = __builtin_amdgcn_readfirstlane(cnts[tsel]);
            for (int idx = 0; idx < cnt; ++idx) {
                const int j = __builtin_amdgcn_readfirstlane(sel[tsel * 16 + idx]);
#pragma unroll
                for (int half = 0; half < 2; ++half)
                    attn_tile<1, false, false>(nkv + 256 + hk * 64, 768, vst, SEQ, 64 * j + 32 * half, qs0, qs1, tt, btab, Sx, 0.f, 0.f, lane, pd);
            }
            const float gate = small[tokq * 32 + 16 + hk * 4 + g];
            const float sc = (ts == tsel && Sx.l > 0.f) ? gate / Sx.l : 0.f;
#pragma unroll
            for (int t = 0; t < 4; ++t) tot[t] = tot[t] + Sx.O[t] * sc;
        }
        {
            AttnAcc W; W.m = -1e30f; W.l = 0.f;
#pragma unroll
            for (int t = 0; t < 4; ++t) W.O[t] = (f32x4){0.f, 0.f, 0.f, 0.f};
            int k0 = t0 - 511; k0 = k0 < 0 ? 0 : (k0 & ~31);
            for (int kb = k0; kb <= t0 + 3; kb += 32) attn_tile<2, false, false>(nkv + 512 + hk * 64, 768, vwt, SEQ, kb, q0, q1, trow, btab, W, 0.f, 0.f, lane, pd);
            const float gate = small[tokg * 32 + 24 + hk * 4 + g];
            const float sc = W.l > 0.f ? gate / W.l : 0.f;
#pragma unroll
            for (int t = 0; t < 4; ++t) tot[t] = tot[t] + W.O[t] * sc;
        }
#pragma unroll
        for (int t = 0; t < 4; ++t) {
            const size_t off = tokg * 512 + (hk * 4 + g) * 64 + 16 * t + 4 * g4;
            const u32x2 z = *(const u32x2*)(nz + off);
            u32x2 d; d.x = cvt_pk_bf16(tot[t][0] * __uint_as_float(z.x << 16), tot[t][1] * __uint_as_float(z.x & 0xffff0000u));
            d.y = cvt_pk_bf16(tot[t][2] * __uint_as_float(z.y << 16), tot[t][3] * __uint_as_float(z.y & 0xffff0000u));
            *(u32x2*)(mix + tokg * DM + 512 + (hk * 4 + g) * 64 + 16 * t + 4 * g4) = d;
        }
    }
}
__device__ __forceinline__ void p2_phase(const Frame& F) {
    for (int task = blockIdx.x; task < 2624; task += gridDim.x) {
        if (task < 2048) gdn_prep_item(F, task);
        else if (task < 2112) compress_wave(F, (task - 2048) * 8 + F.wave);
        else vtranspose_task(F, task - 2112);
    }
}
__device__ __forceinline__ void p3_phase(const Frame& F) {
    for (int bh = blockIdx.x; bh < 16; bh += gridDim.x) gdn_scan(F, bh);
    unsigned* ctr = (unsigned*)(F.ws + WS_CTL) + 64;
    LAS int* nxt = (LAS int*)(F.lds + 40960);
    for (;;) {
        __syncthreads();
        if (F.tid == 0) *nxt = (int)atomicAdd(ctr, 1u);
        __syncthreads();
        const int item = *nxt;
        if (item >= 1024) break;
        nsa_item(F, item);
    }
}
struct Args { const float* in[16]; float* out; unsigned char* ws; int ph_lo, ph_hi, coop, pad; };
constexpr int N_PHASES = 6;

__global__ void __launch_bounds__(512, 2) hymba_fwd(Args a) {
    extern __shared__ __attribute__((aligned(16))) unsigned char lds_raw[];
    Frame F;
#pragma unroll
    for (int i = 0; i < 16; ++i) F.in[i] = a.in[i];
    F.out = a.out; F.ws = a.ws; F.lds = (LAS unsigned char*)lds_raw; F.ldsg = lds_raw;
    F.tid = threadIdx.x; F.lane = F.tid & 63; F.wave = __builtin_amdgcn_readfirstlane(F.tid >> 6);
    unsigned char* ws = a.ws;
    const int lo = a.ph_lo, hi = a.ph_hi;
#define IN(k) (lo <= (k) && (k) < hi)
#define SEAM(k) do { if (IN(k) && IN((k) + 1)) { if (a.coop) cg::this_grid().sync(); } __syncthreads(); } while (0)
    if (IN(0)) p0_prep(F);
    SEAM(0);
    if (IN(1)) {
        pg8::Gemm g{(const bf16*)(ws + WS_XB), (const bf16*)(ws + WS_WTIN), T_TOK, NPROJ, DM};
        pg8::StaticOrder S; S.init(T_TOK, NPROJ, (int)gridDim.x, (int)blockIdx.x);
        EpiProj E{(bf16*)(ws + WS_GQKV), (bf16*)(ws + WS_GZ), (bf16*)(ws + WS_NQ), (bf16*)(ws + WS_NKV), (bf16*)(ws + WS_NZ), (const float*)(ws + WS_RS)};
        pg8::gemm_phase<EpiProj, pg8::StaticOrder, false>(F.lds, g, S, E, nullptr);
    }
    SEAM(1);
    if (IN(2)) p2_phase(F);
    SEAM(2);
    if (IN(3)) p3_phase(F);
    SEAM(3);
    if (IN(4)) {
        pg8::Gemm g{(const bf16*)(ws + WS_MIX), (const bf16*)(ws + WS_WTOUT), T_TOK, DM, DM};
        pg8::StaticOrder S; S.init(T_TOK, DM, (int)gridDim.x, (int)blockIdx.x);
        EpiOut E{F.in[0], F.out};
        pg8::gemm_phase<EpiOut, pg8::StaticOrder, false>(F.lds, g, S, E, nullptr);
    }
    SEAM(4);
    if (IN(5)) p5_final(F);
#undef IN
#undef SEAM
}

extern "C" void kernel_launch(void* const* d_in, const int* in_sizes, int n_in, void* d_out, int out_size, void* d_ws, size_t ws_size, hipStream_t stream) {
    static int grid = 0;
    if (grid == 0) {
        if (n_in != 16 || in_sizes[0] != T_TOK * DM || out_size != T_TOK * DM || ws_size < WS_END) { fprintf(stderr, "kernel_launch: unexpected shapes (n_in %d, ws %zu)\n", n_in, ws_size); grid = -1; return; }
        int dev = 0, cus = 0, per_cu = 0;
        if (hipGetDevice(&dev) != hipSuccess || hipDeviceGetAttribute(&cus, hipDeviceAttributeMultiprocessorCount, dev) != hipSuccess) { grid = -1; return; }
        if (hipFuncSetAttribute((const void*)hymba_fwd, hipFuncAttributeMaxDynamicSharedMemorySize, LDS_BYTES) != hipSuccess) { fprintf(stderr, "kernel_launch: hipFuncSetAttribute failed\n"); grid = -1; return; }
        if (hipOccupancyMaxActiveBlocksPerMultiprocessor(&per_cu, (const void*)hymba_fwd, 512, LDS_BYTES) != hipSuccess || per_cu < 1) { fprintf(stderr, "kernel_launch: occupancy query says %d\n", per_cu); per_cu = 1; }
        (void)hipGetLastError();
        grid = cus;
    }
    if (grid < 0) return;
    (void)hipMemsetAsync((char*)d_ws + WS_CTL, 0, 1 * MiB, stream);
    Args a{};
    for (int i = 0; i < 16; ++i) a.in[i] = (const float*)d_in[i];
    a.out = (float*)d_out; a.ws = (unsigned char*)d_ws;
#if MK_LAUNCHES == 1
    a.ph_lo = 0; a.ph_hi = N_PHASES; a.coop = 1;
    void* args[] = {&a};
    hipError_t e = hipLaunchCooperativeKernel((const void*)hymba_fwd, dim3(grid), dim3(512), args, LDS_BYTES, stream);
    if (e != hipSuccess) fprintf(stderr, "cooperative launch failed: %s (grid %d)\n", hipGetErrorString(e), grid);
#else
    for (int ph = 0; ph < N_PHASES; ++ph) {
        a.ph_lo = ph; a.ph_hi = ph + 1; a.coop = 0;
        hipLaunchKernelGGL(hymba_fwd, dim3(grid), dim3(512), LDS_BYTES, stream, a);
    }
#endif
}
```

```cpp
#include <hip/hip_runtime.h>
#include <hip/hip_cooperative_groups.h>
#include <cstdio>
#include <cstdint>
namespace cg = cooperative_groups;
#ifndef MK_LAUNCHES
#define MK_LAUNCHES 1
#endif
namespace pg8 {
#define PG8_LAS __attribute__((address_space(3)))
typedef unsigned short bf16_t;
typedef short bf16x8 __attribute__((ext_vector_type(8)));
typedef float f32x4 __attribute__((ext_vector_type(4)));
typedef unsigned u32x4 __attribute__((ext_vector_type(4)));
constexpr int BM = 256, BK = 64, HALF = 128, HTB = HALF * BK * 2  , STAGE_BYTES = 8 * HTB, NXCD = 8, WGM = 8;

__host__ __device__ __forceinline__ int lds_byte(int r, int c) { const int st = (r >> 4) * 2 + (c >> 5), rr = r & 15, cc = c & 31, ob = rr * 64 + cc * 2; return st * 1024 + (ob ^ (((ob >> 9) & 1) << 5)); }
__host__ __device__ __forceinline__ void stage_rc(int b, int& R, int& C) { const int st = b / 1024, sb = b % 1024, swz = sb ^ (((sb >> 9) & 1) << 5); R = (st >> 1) * 16 + swz / 64; C = (st & 1) * 32 + (swz % 64) / 2; }
__host__ __device__ __forceinline__ int perm32(int rho) { const int n = rho >> 4, i = rho & 15; return 8 * (i >> 2) + 4 * n + (i & 3); }

struct Unit { int pm, pn; };
struct Gemm { const bf16_t* A; const bf16_t* Bt; int M, N, K; };

struct StaticOrder {
    int nM, nN, nwg, G, c;
    __host__ __device__ void init(int M, int N, int G_, int c_) { nM = M / BM; nN = N / BM; nwg = nM * nN; G = G_; c = c_; }
    __host__ __device__ bool next(int i, Unit& u) const {
        const long L = (long)i * G + c; if (L >= nwg) return false;
        int wgid = (int)L; { const int q = nwg / NXCD, r = nwg % NXCD, xcd = wgid % NXCD, off = wgid / NXCD; wgid = (xcd < r ? xcd * (q + 1) : r * (q + 1) + (xcd - r) * q) + off; }
        const int nig = WGM * nN, gid = wgid / nig, fm = gid * WGM, gsz = (nM - fm) < WGM ? (nM - fm) : WGM;
        u.pm = fm + ((wgid % nig) % gsz); u.pn = (wgid % nig) / gsz; return true;
    }
    __device__ __forceinline__ void a_ready(const Unit&) const {}
    __device__ __forceinline__ void done(const Unit&) const {}
};
__device__ __forceinline__ unsigned cvt_pk_bf16(float lo, float hi) { unsigned r; asm volatile("v_cvt_pk_bf16_f32 %0, %1, %2" : "=v"(r) : "v"(lo), "v"(hi)); return r; }
typedef float f32x2 __attribute__((ext_vector_type(2)));
template <class Epi, class Sched, bool STAMP = false>
__device__ __forceinline__ void gemm_phase(PG8_LAS unsigned char* lds, const Gemm g, const Sched& S, const Epi& E, unsigned long long* stamps) {
    const int tid = threadIdx.x, wid = __builtin_amdgcn_readfirstlane(tid >> 6), lane = tid & 63, wr = wid >> 2, wc = wid & 3, fr = lane & 15, fq = lane >> 4;
    const int K = g.K, nt = K / BK;
    int ts_lo = 0, ts_hi = 0, nts = 0; const unsigned long long rt_entry = STAMP ? (unsigned long long)wall_clock64() : 0ull;
#define PG8_STAMP() do { if (STAMP && wid == 0 && nts < 64) { const unsigned long long _c = (unsigned long long)clock64(); \
        ts_lo = (lane == nts) ? (int)(unsigned)_c : ts_lo; ts_hi = (lane == nts) ? (int)(unsigned)(_c >> 32) : ts_hi; ++nts; } } while (0)
    PG8_STAMP();
    unsigned voffA[2], voffB[2];
#pragma unroll
    for (int i = 0; i < 2; ++i) { int R, C; stage_rc(tid * 16 + i * 8192, R, C); const int Rb = Epi::PERM ? ((R & ~31) + perm32(R & 31)) : R;
        voffA[i] = (unsigned)(R * K + C) * 2u; voffB[i] = (unsigned)(Rb * K + C) * 2u; }
    const size_t kstep = (size_t)(BK * 2);
    const size_t hstep = (size_t)HALF * K * 2;
    const size_t tstep = 2 * hstep;
    const unsigned ldsw = (unsigned)wid * 1024u;
    const int aoff = lds_byte(wr * 64 + fr, fq * 8), boff = lds_byte(wc * 32 + fr, fq * 8);
#define PG8_SA(b, h) (((b) * 2 + (h)) * HTB)
#define PG8_SB(b, h) ((4 + (b) * 2 + (h)) * HTB)
#define PG8_STAGE(bufoff, gbase, voff) do { _Pragma("unroll") for (int _i = 0; _i < 2; ++_i) \
        __builtin_amdgcn_global_load_lds((const unsigned*)((const char*)(gbase) + (voff)[_i]), (PG8_LAS unsigned*)(lds + (bufoff) + ldsw + _i * 8192), 16, 0, 0); } while (0)
#define PG8_LDA(dst, b, h) do { _Pragma("unroll") for (int m = 0; m < 4; ++m) _Pragma("unroll") for (int k = 0; k < 2; ++k) dst[m][k] = *(const PG8_LAS bf16x8*)(lds + PG8_SA(b, h) + aoff + m * 2048 + k * 1024); } while (0)
#define PG8_LDB(dst, b, h) do { _Pragma("unroll") for (int n = 0; n < 2; ++n) _Pragma("unroll") for (int k = 0; k < 2; ++k) dst[n][k] = *(const PG8_LAS bf16x8*)(lds + PG8_SB(b, h) + boff + n * 2048 + k * 1024); } while (0)
#define PG8_MMA(ai, bj, At, Bt) do { __builtin_amdgcn_s_setprio(1); _Pragma("unroll") for (int m = 0; m < 4; ++m) _Pragma("unroll") for (int n = 0; n < 2; ++n) _Pragma("unroll") for (int k = 0; k < 2; ++k) \
        acc[ai][bj][m][n] = __builtin_amdgcn_mfma_f32_16x16x32_bf16(Bt[n][k], At[m][k], acc[ai][bj][m][n], 0, 0, 0); __builtin_amdgcn_s_setprio(0); } while (0)
#define PG8_WAIT_V(n) asm volatile("s_waitcnt vmcnt(" #n ")" ::: "memory")
#define PG8_WAIT_L(n) asm volatile("s_waitcnt lgkmcnt(" #n ")" ::: "memory")
#define PG8_BAR __builtin_amdgcn_s_barrier()
#define PG8_SCHED __builtin_amdgcn_sched_barrier(0)
    Unit cur, nxt; int ui = 0;
    if (!S.next(0, cur)) return;
    f32x4 acc[2][2][4][2];
#pragma unroll
    for (int a = 0; a < 2; ++a)
#pragma unroll
        for (int b = 0; b < 2; ++b)
#pragma unroll
            for (int m = 0; m < 4; ++m)
#pragma unroll
                for (int n = 0; n < 2; ++n) acc[a][b][m][n] = (f32x4){0.f, 0.f, 0.f, 0.f};
    bf16x8 At[4][2], B0[2][2], B1[2][2];
    const char* cA = (const char*)g.A + (size_t)cur.pm * tstep; const char* cB = (const char*)g.Bt + (size_t)cur.pn * tstep;
    S.a_ready(cur);
    PG8_STAGE(PG8_SB(0, 0), cB, voffB); PG8_STAGE(PG8_SA(0, 0), cA, voffA); PG8_STAGE(PG8_SB(0, 1), cB + hstep, voffB); PG8_STAGE(PG8_SA(0, 1), cA + hstep, voffA);
    if (wr == 1) PG8_BAR;
    PG8_WAIT_V(4); PG8_BAR;
    PG8_STAGE(PG8_SB(1, 0), cB + kstep, voffB); PG8_STAGE(PG8_SA(1, 0), cA + kstep, voffA); PG8_STAGE(PG8_SB(1, 1), cB + hstep + kstep, voffB);
    PG8_WAIT_V(6); PG8_BAR;
    PG8_STAMP();
    for (;;) {
        const bool has_next = S.next(ui + 1, nxt);
        const char* nA = has_next ? (const char*)g.A + (size_t)nxt.pm * tstep : cA; const char* nB = has_next ? (const char*)g.Bt + (size_t)nxt.pn * tstep : cB;
        for (int t = 0; t < nt; t += 2) {
            const bool last = (t == nt - 2);
            const char* a1 = cA + (size_t)(t + 1) * kstep;
            const char* a2 = last ? nA : cA + (size_t)(t + 2) * kstep; const char* b2 = last ? nB : cB + (size_t)(t + 2) * kstep;
            const char* a3 = a2 + kstep; const char* b3 = b2 + kstep;
            if (last && has_next) S.a_ready(nxt);
            PG8_LDB(B0, 0, 0); PG8_SCHED; PG8_LDA(At, 0, 0); PG8_STAGE(PG8_SA(1, 1), a1 + hstep, voffA);
            PG8_WAIT_L(8); PG8_BAR; PG8_WAIT_L(0); PG8_MMA(0, 0, At, B0); PG8_BAR; PG8_SCHED;
            PG8_LDB(B1, 0, 1); PG8_STAGE(PG8_SB(0, 0), b2, voffB);
            PG8_BAR; PG8_WAIT_L(0); PG8_MMA(0, 1, At, B1); PG8_BAR;
            PG8_LDA(At, 0, 1); PG8_STAGE(PG8_SA(0, 0), a2, voffA);
            PG8_BAR; PG8_WAIT_L(0); PG8_MMA(1, 0, At, B0); PG8_BAR; PG8_SCHED;
            PG8_STAGE(PG8_SB(0, 1), b2 + hstep, voffB);
            PG8_WAIT_V(6); PG8_BAR; PG8_MMA(1, 1, At, B1); PG8_BAR;
            PG8_LDB(B0, 1, 0); PG8_SCHED; PG8_LDA(At, 1, 0); PG8_STAGE(PG8_SA(0, 1), a2 + hstep, voffA);
            PG8_WAIT_L(8); PG8_BAR; PG8_WAIT_L(0); PG8_MMA(0, 0, At, B0); PG8_BAR; PG8_SCHED;
            PG8_LDB(B1, 1, 1); PG8_STAGE(PG8_SB(1, 0), b3, voffB);
            PG8_BAR; PG8_WAIT_L(0); PG8_MMA(0, 1, At, B1); PG8_BAR;
            PG8_LDA(At, 1, 1); PG8_STAGE(PG8_SA(1, 0), a3, voffA);
            PG8_BAR; PG8_WAIT_L(0); PG8_MMA(1, 0, At, B0); PG8_BAR; PG8_SCHED;
            PG8_STAGE(PG8_SB(1, 1), b3 + hstep, voffB);
            PG8_WAIT_V(6); PG8_BAR; PG8_MMA(1, 1, At, B1); PG8_BAR;
        }
        PG8_STAMP();
        if constexpr (!Epi::AFTER_DRAIN) { E(acc, cur, wr, wc, fr, fq); S.done(cur); }
        PG8_STAMP();
        if (!has_next) break;
#pragma unroll
        for (int a = 0; a < 2; ++a)
#pragma unroll
            for (int b = 0; b < 2; ++b)
#pragma unroll
                for (int m = 0; m < 4; ++m)
#pragma unroll
                    for (int n = 0; n < 2; ++n) acc[a][b][m][n] = (f32x4){0.f, 0.f, 0.f, 0.f};
        cur = nxt; cA = nA; cB = nB; ++ui;
    }
    PG8_WAIT_V(0);
    if (wr == 0) PG8_BAR;
    PG8_BAR;
    if constexpr (Epi::AFTER_DRAIN) { E.fused(acc, cur, wr, wc, fr, fq, lds, wid, lane); S.done(cur); }
    PG8_STAMP();
    if (STAMP && wid == 0) { stamps[lane] = lane < nts ? (((unsigned long long)(unsigned)ts_hi << 32) | (unsigned)ts_lo) : 0ull;
        if (lane == 62) stamps[62] = rt_entry; if (lane == 63) stamps[63] = (unsigned long long)wall_clock64(); }
#undef PG8_STAMP
#undef PG8_SA
#undef PG8_SB
#undef PG8_STAGE
#undef PG8_LDA
#undef PG8_LDB
#undef PG8_MMA
#undef PG8_WAIT_V
#undef PG8_WAIT_L
#undef PG8_BAR
#undef PG8_SCHED
}
}
#define LAS __attribute__((address_space(3)))
typedef unsigned short bf16;
typedef short bf16x8 __attribute__((ext_vector_type(8)));
typedef short bf16x4 __attribute__((ext_vector_type(4)));
typedef float f32x4 __attribute__((ext_vector_type(4)));
typedef unsigned u32x4 __attribute__((ext_vector_type(4)));
typedef unsigned u32x2 __attribute__((ext_vector_type(2)));
typedef float f32x2_ __attribute__((ext_vector_type(2)));
typedef __bf16 bf16x2n __attribute__((ext_vector_type(2)));
__device__ __forceinline__ unsigned cvt_pk_bf16(float lo, float hi) { const f32x2_ v = {lo, hi}; const bf16x2n b = __builtin_convertvector(v, bf16x2n); return __builtin_bit_cast(unsigned, b); }

constexpr int T_TOK = 32768, SEQ = 8192, DM = 1024, NPROJ = 3840, PROJ_W = 3872;
constexpr float EPS = 1e-6f;
constexpr size_t MiB = 1u << 20;
constexpr size_t WS_CTL = 0;
constexpr size_t WS_WTIN = 1 * MiB;
constexpr size_t WS_WTOUT = 9 * MiB;
constexpr size_t WS_W1FK = 11 * MiB + 256 * 1024;
constexpr size_t WS_W1FV = 11 * MiB + 768 * 1024;
constexpr size_t WS_W2FK = 12 * MiB + 256 * 1024;
constexpr size_t WS_W2FV = 12 * MiB + 288 * 1024;
constexpr size_t WS_CPE = 12 * MiB + 320 * 1024;
constexpr size_t WS_BT = 12 * MiB + 384 * 1024;
constexpr size_t WS_RS = 13 * MiB;
constexpr size_t WS_SMALL = 14 * MiB;
constexpr size_t WS_XB = 32 * MiB;
constexpr size_t WS_MIX = 32 * MiB;
constexpr size_t WS_GQKV = 96 * MiB;
constexpr size_t WS_GZ = 192 * MiB;
constexpr size_t WS_NQ = 224 * MiB;
constexpr size_t WS_NKV = 256 * MiB;
constexpr size_t WS_NZ = 304 * MiB;
constexpr size_t WS_GREC = 336 * MiB;
constexpr size_t GREC_BYTES = 73728;
constexpr size_t WS_KCMP = 480 * MiB;
constexpr size_t WS_VCMPT = 480 * MiB + 512 * 1024;
constexpr size_t WS_VST = 482 * MiB;
constexpr size_t WS_VWT = 490 * MiB;
constexpr size_t WS_GLAST = 498 * MiB;
constexpr size_t WS_END = 499 * MiB;
constexpr int LDS_BYTES = 158720;

__device__ __forceinline__ float bf2f(unsigned short h) { return __uint_as_float((unsigned)h << 16); }
__device__ __forceinline__ unsigned short f2bf(float f) { return (unsigned short)(cvt_pk_bf16(f, 0.f) & 0xffffu); }
__device__ __forceinline__ float sigmoidf_(float v) { return 1.0f / (1.0f + __expf(-v)); }
__device__ __forceinline__ float siluf_(float v) { return v / (1.0f + __expf(-v)); }
__device__ __forceinline__ f32x4 mfma16(bf16x8 a, bf16x8 b, f32x4 c) { return __builtin_amdgcn_mfma_f32_16x16x32_bf16(a, b, c, 0, 0, 0); }
__device__ __forceinline__ int kperm(int g, int j) { return j < 4 ? 4 * g + j : 16 + 4 * g + (j - 4); }

struct Frame {
    const float* in[16]; float* out; unsigned char* ws; LAS unsigned char* lds; unsigned char* ldsg;
    int tid, lane, wave;
};

struct EpiProj {
    static constexpr bool PERM = true, AFTER_DRAIN = false;
    bf16* gqkv; bf16* gz; bf16* nq; bf16* nkv; bf16* nz; const float* rs;
    __device__ __forceinline__ void operator()(const f32x4 (&acc)[2][2][4][2], const pg8::Unit& u, int wr, int wc, int fr, int fq) const {
        const int pn = u.pn; bf16* base; int ldc, colt, act;
        if (pn < 6) { base = gqkv; ldc = 1536; colt = pn * 256; act = 0; }
        else if (pn < 8) { base = gz; ldc = 512; colt = (pn - 6) * 256; act = 1; }
        else if (pn < 10) { base = nq; ldc = 512; colt = (pn - 8) * 256; act = 2; }
        else if (pn < 13) { base = nkv; ldc = 768; colt = (pn - 10) * 256; act = 0; }
        else { base = nz; ldc = 512; colt = (pn - 13) * 256; act = 1; }
        const int row0 = u.pm * 256 + wr * 64 + fr, col0 = colt + wc * 32 + 8 * fq;
#pragma unroll
        for (int ai = 0; ai < 2; ++ai)
#pragma unroll
            for (int m = 0; m < 4; ++m) {
                const int row = row0 + ai * 128 + m * 16; const float r = rs[row];
                bf16* rowp = base + (size_t)row * ldc + col0;
#pragma unroll
                for (int bj = 0; bj < 2; ++bj) {
                    f32x4 v0 = acc[ai][bj][m][0] * r, v1 = acc[ai][bj][m][1] * r;
                    if (act == 1) {
#pragma unroll
                        for (int j = 0; j < 4; ++j) { v0[j] = siluf_(v0[j]); v1[j] = siluf_(v1[j]); }
                    } else if (act == 2) { v0 = v0 * 0.125f; v1 = v1 * 0.125f; }
                    u32x4 w; w.x = cvt_pk_bf16(v0[0], v0[1]); w.y = cvt_pk_bf16(v0[2], v0[3]); w.z = cvt_pk_bf16(v1[0], v1[1]); w.w = cvt_pk_bf16(v1[2], v1[3]);
                    *(u32x4*)(rowp + bj * 128) = w;
                }
            }
    }
};
struct EpiOut {
    static constexpr bool PERM = false, AFTER_DRAIN = false;
    const float* x; float* out;
    __device__ __forceinline__ void operator()(const f32x4 (&acc)[2][2][4][2], const pg8::Unit& u, int wr, int wc, int fr, int fq) const {
        const int row0 = u.pm * 256 + wr * 64 + fr, col0 = u.pn * 256 + wc * 32 + 4 * fq;
#pragma unroll
        for (int ai = 0; ai < 2; ++ai)
#pragma unroll
            for (int m = 0; m < 4; ++m) {
                const size_t ro = (size_t)(row0 + ai * 128 + m * 16) * DM + col0;
#pragma unroll
                for (int bj = 0; bj < 2; ++bj)
#pragma unroll
                    for (int n = 0; n < 2; ++n) {
                        const f32x4 xv = *(const f32x4*)(x + ro + bj * 128 + n * 16);
                        *(f32x4*)(out + ro + bj * 128 + n * 16) = acc[ai][bj][m][n] + xv;
                    }
            }
    }
};

__device__ __forceinline__ int orig_col(int n) {
    return n < 2048 ? n : (n < 2560 ? 2056 + (n - 2048) : (n < 3328 ? 2568 + (n - 2560) : 3360 + (n - 3328)));
}
__device__ __forceinline__ int orig_small(int sc) { return sc < 8 ? 2048 + sc : 3336 + (sc - 8); }
__device__ __forceinline__ int rel_bucket(int dist) {
    const int n = dist < 0 ? 0 : dist;
    if (n < 16) return n;
    int b = 16;
    b += (n >= 21); b += (n >= 27); b += (n >= 35); b += (n >= 46); b += (n >= 59); b += (n >= 77); b += (n >= 99); b += (n >= 128);
    b += (n >= 166); b += (n >= 216); b += (n >= 280); b += (n >= 363); b += (n >= 470); b += (n >= 609); b += (n >= 790);
    return b;
}
__device__ __forceinline__ void transpose_tile(const Frame& F, const float* src, int sld, int srccol0, int k0, const float* scale, bf16* dst, int dld, int n0) {
    LAS float* tile = (LAS float*)F.lds;
    const int kk = F.tid >> 6, nn = F.tid & 63;
#pragma unroll
    for (int i = 0; i < 8; ++i) { const int k = kk + 8 * i; float v = src[(size_t)(k0 + k) * sld + srccol0 + nn]; if (scale) v *= scale[k0 + k]; tile[k * 65 + nn] = v; }
    __syncthreads();
    const int n2 = F.tid >> 3, kc = F.tid & 7;
    float e[8];
#pragma unroll
    for (int j = 0; j < 8; ++j) e[j] = tile[(8 * kc + j) * 65 + n2];
    u32x4 w; w.x = cvt_pk_bf16(e[0], e[1]); w.y = cvt_pk_bf16(e[2], e[3]); w.z = cvt_pk_bf16(e[4], e[5]); w.w = cvt_pk_bf16(e[6], e[7]);
    *(u32x4*)(dst + (size_t)(n0 + n2) * dld + k0 + 8 * kc) = w;
    __syncthreads();
}

__device__ __forceinline__ void p0_prep(const Frame& F) {
    const float* x = F.in[0]; const float* nw = F.in[1]; const float* w_in = F.in[2];
    unsigned char* ws = F.ws;
    const int G = gridDim.x, bid = blockIdx.x;
    for (int task = bid; task < 1365; task += G) {
        if (task < 960) { const int nt = task / 16, kt = task % 16; transpose_tile(F, w_in, PROJ_W, orig_col(nt * 64), kt * 64, nw, (bf16*)(ws + WS_WTIN), DM, nt * 64); }
        else if (task < 1216) { const int t2 = task - 960, nt = t2 / 16, kt = t2 % 16; transpose_tile(F, F.in[13], DM, nt * 64, kt * 64, nullptr, (bf16*)(ws + WS_WTOUT), DM, nt * 64); }
        else if (task < 1344) {
            const int t2 = task - 1216, which = t2 >> 6, sub = t2 & 63;
            const float* w1 = F.in[which ? 11 : 9]; bf16* dst = (bf16*)(ws + (which ? WS_W1FV : WS_W1FK));
            const int mt = F.tid >> 6, l = F.tid & 63, m = l & 15, kg = l >> 4, ks = sub;
            float e[8];
#pragma unroll
            for (int j = 0; j < 8; ++j) e[j] = w1[(size_t)(32 * ks + 8 * kg + j) * 128 + 16 * mt + m];
            u32x4 w; w.x = cvt_pk_bf16(e[0], e[1]); w.y = cvt_pk_bf16(e[2], e[3]); w.z = cvt_pk_bf16(e[4], e[5]); w.w = cvt_pk_bf16(e[6], e[7]);
            *(u32x4*)(dst + ((size_t)(ks * 8 + mt) * 64 + l) * 8) = w;
        } else if (task < 1346) {
            const int which = task - 1344; const float* w2 = F.in[which ? 12 : 10]; bf16* dst = (bf16*)(ws + (which ? WS_W2FV : WS_W2FK));
            for (int i = F.tid; i < 1024; i += 512) {
                const int l = i & 63, ks = (i >> 6) & 3, mt = i >> 8, m = l & 15, kg = l >> 4;
                float e[8];
#pragma unroll
                for (int j = 0; j < 8; ++j) e[j] = w2[(size_t)(32 * ks + kperm(kg, j)) * 64 + 16 * mt + m];
                u32x4 w; w.x = cvt_pk_bf16(e[0], e[1]); w.y = cvt_pk_bf16(e[2], e[3]); w.z = cvt_pk_bf16(e[4], e[5]); w.w = cvt_pk_bf16(e[6], e[7]);
                *(u32x4*)(dst + (size_t)i * 8) = w;
            }
        } else if (task < 1348) {
            const int which = task - 1346; const float* pe = F.in[which ? 8 : 7]; const float* w1 = F.in[which ? 11 : 9];
            float* dst = (float*)(ws + WS_CPE) + which * 128;
            if (F.tid < 128) { float s = 0.f; for (int k = 0; k < 2048; ++k) s += pe[k] * w1[(size_t)k * 128 + F.tid]; dst[F.tid] = s; }
        } else {
            const int i = (task - 1348) * 512 + F.tid;
            if (i < 8 * 1025) { const int head = i / 1025, dist = i % 1025; ((float*)(ws + WS_BT))[i] = F.in[14][rel_bucket(dist) * 8 + head]; }
        }
    }
    __syncthreads();
    {
        for (int i = F.tid; i < 32 * 2 * 64; i += 512) {
            const int l = i & 63, nt = (i >> 6) & 1, ks = i >> 7, kg = l >> 4, sc = 16 * nt + (l & 15), oc = orig_small(sc);
            float v[8], lo[8]; unsigned short hi[8];
#pragma unroll
            for (int j = 0; j < 8; ++j) { const int k = 32 * ks + 8 * kg + j; v[j] = w_in[(size_t)k * PROJ_W + oc] * nw[k]; hi[j] = f2bf(v[j]); lo[j] = v[j] - bf2f(hi[j]); }
            u32x4 wh, wl;
            wh.x = hi[0] | ((unsigned)hi[1] << 16); wh.y = hi[2] | ((unsigned)hi[3] << 16); wh.z = hi[4] | ((unsigned)hi[5] << 16); wh.w = hi[6] | ((unsigned)hi[7] << 16);
            wl.x = cvt_pk_bf16(lo[0], lo[1]); wl.y = cvt_pk_bf16(lo[2], lo[3]); wl.z = cvt_pk_bf16(lo[4], lo[5]); wl.w = cvt_pk_bf16(lo[6], lo[7]);
            *(LAS u32x4*)(F.lds + ((size_t)((ks * 2 + nt) * 2 + 0) * 64 + l) * 16) = wh;
            *(LAS u32x4*)(F.lds + ((size_t)((ks * 2 + nt) * 2 + 1) * 64 + l) * 16) = wl;
        }
    }
    __syncthreads();
    bf16* xb = (bf16*)(ws + WS_XB); float* rsv = (float*)(ws + WS_RS); float* small = (float*)(ws + WS_SMALL);
    const float* a_log = F.in[4]; const float* dt_bias = F.in[5];
    for (int tile = bid * 8 + F.wave; tile < T_TOK / 16; tile += G * 8) {
        const int l = F.lane, r = l & 15, kg = l >> 4; const int row = tile * 16 + r;
        const float* xr = x + (size_t)row * DM + 8 * kg;
        f32x4 acc0 = {0.f, 0.f, 0.f, 0.f}, acc1 = {0.f, 0.f, 0.f, 0.f};
        float ss = 0.f;
#pragma unroll 4
        for (int ks = 0; ks < 32; ++ks) {
            const f32x4 a0 = *(const f32x4*)(xr + 32 * ks), a1 = *(const f32x4*)(xr + 32 * ks + 4);
            ss += a0[0] * a0[0] + a0[1] * a0[1] + a0[2] * a0[2] + a0[3] * a0[3] + a1[0] * a1[0] + a1[1] * a1[1] + a1[2] * a1[2] + a1[3] * a1[3];
            u32x4 h; h.x = cvt_pk_bf16(a0[0], a0[1]); h.y = cvt_pk_bf16(a0[2], a0[3]); h.z = cvt_pk_bf16(a1[0], a1[1]); h.w = cvt_pk_bf16(a1[2], a1[3]);
            *(u32x4*)(xb + (size_t)row * DM + 32 * ks + 8 * kg) = h;
            u32x4 lo;
            lo.x = cvt_pk_bf16(a0[0] - __uint_as_float(h.x << 16), a0[1] - __uint_as_float(h.x & 0xffff0000u));
            lo.y = cvt_pk_bf16(a0[2] - __uint_as_float(h.y << 16), a0[3] - __uint_as_float(h.y & 0xffff0000u));
            lo.z = cvt_pk_bf16(a1[0] - __uint_as_float(h.z << 16), a1[1] - __uint_as_float(h.z & 0xffff0000u));
            lo.w = cvt_pk_bf16(a1[2] - __uint_as_float(h.w << 16), a1[3] - __uint_as_float(h.w & 0xffff0000u));
            const bf16x8 ah = __builtin_bit_cast(bf16x8, h), al = __builtin_bit_cast(bf16x8, lo);
            const LAS unsigned char* fb = F.lds + (size_t)(ks * 4) * 1024 + l * 16;
            const bf16x8 b0h = *(const LAS bf16x8*)(fb), b0l = *(const LAS bf16x8*)(fb + 1024), b1h = *(const LAS bf16x8*)(fb + 2048), b1l = *(const LAS bf16x8*)(fb + 3072);
            acc0 = mfma16(ah, b0h, acc0); acc0 = mfma16(al, b0h, acc0); acc0 = mfma16(ah, b0l, acc0);
            acc1 = mfma16(ah, b1h, acc1); acc1 = mfma16(al, b1h, acc1); acc1 = mfma16(ah, b1l, acc1);
        }
        ss += __shfl_xor(ss, 16); ss += __shfl_xor(ss, 32);
        const float rs = rsqrtf(ss * (1.0f / 1024.f) + EPS);
        if (kg == 0) rsv[row] = rs;
#pragma unroll
        for (int reg = 0; reg < 4; ++reg) {
            const int rr = 4 * kg + reg; const float rsr = __shfl(rs, rr);
            const int orow = tile * 16 + rr;
            {
                const float v = acc0[reg] * rsr; const int c = r; float o;
                if (c < 4) o = sigmoidf_(v);
                else if (c < 8) { const int h = c - 4; const float z = v + dt_bias[h]; const float sp = z > 20.f ? z : log1pf(expf(z)); o = -expf(a_log[h]) * sp; }
                else o = sigmoidf_(v);
                small[(size_t)orow * 32 + c] = o;
            }
            { const float v = acc1[reg] * rsr; small[(size_t)orow * 32 + 16 + r] = sigmoidf_(v); }
        }
    }
}

__device__ __forceinline__ void p5_final(const Frame& F) {
    const float* fw = F.in[15]; float* out = F.out;
    for (int r = blockIdx.x * 8 + F.wave; r < T_TOK; r += gridDim.x * 8) {
        f32x4* orow = (f32x4*)(out + (size_t)r * DM);
        f32x4 v[4]; float ss = 0.f;
#pragma unroll
        for (int i = 0; i < 4; ++i) { v[i] = orow[F.lane + 64 * i]; ss += v[i][0] * v[i][0] + v[i][1] * v[i][1] + v[i][2] * v[i][2] + v[i][3] * v[i][3]; }
#pragma unroll
        for (int o = 32; o > 0; o >>= 1) ss += __shfl_xor(ss, o);
        const float rs = rsqrtf(ss * (1.0f / 1024.f) + EPS);
#pragma unroll
        for (int i = 0; i < 4; ++i) { const f32x4 w = ((const f32x4*)fw)[F.lane + 64 * i]; orow[F.lane + 64 * i] = v[i] * rs * w; }
    }
}
constexpr int REC_WNEG = 0, REC_QDEC = 16384, REC_ATTN = 32768, REC_KDT = 40960, REC_U = 57344, REC_LDS_BYTES = 57344;
__device__ __forceinline__ void gdn_prep_item(const Frame& F, int item) {
    const int tid = F.tid;
    const int h = item & 3, n = (item >> 2) & 127, b = item >> 9;
    const int tok0 = b * SEQ + n * 64;
    LAS float* kf = (LAS float*)(F.lds); LAS float* vf = (LAS float*)(F.lds + 32768);
    LAS bf16* qb = (LAS bf16*)(F.lds + 65536); LAS bf16* kb = (LAS bf16*)(F.lds + 82944); LAS bf16* kbb = (LAS bf16*)(F.lds + 100352);
    LAS float* Lm = (LAS float*)(F.lds + 117760); LAS bf16* atb = (LAS bf16*)(F.lds + 134144); LAS float* gcs = (LAS float*)(F.lds + 143360);
    LAS bf16* wb = qb;
    unsigned char* rec = F.ws + WS_GREC + (size_t)item * GREC_BYTES;
    const float* small = (const float*)(F.ws + WS_SMALL);
    if (tid < 64) {
        const float beta = small[(size_t)(tok0 + tid) * 32 + h]; float c = small[(size_t)(tok0 + tid) * 32 + 4 + h];
#pragma unroll
        for (int o = 1; o < 64; o <<= 1) { const float t = __shfl_up(c, o); if (tid >= o) c += t; }
        gcs[tid] = c; gcs[64 + tid] = beta; gcs[128 + tid] = expf(c);
        if (tid == 63) ((float*)(F.ws + WS_GLAST))[item] = expf(c);
    }
    __syncthreads();
    {
        const bf16* gq = (const bf16*)(F.ws + WS_GQKV); const float* cw = F.in[3];
        const int grp = tid >> 4, li = tid & 15;
#pragma unroll
        for (int rr = 0; rr < 2; ++rr) {
            const int c = grp * 2 + rr, pos = n * 64 + c;
            const float betav = gcs[64 + c], egv = gcs[128 + c];
#pragma unroll
            for (int part = 0; part < 3; ++part) {
                const int ch = part * 512 + h * 128 + 8 * li;
                float y[8];
#pragma unroll
                for (int e = 0; e < 8; ++e) y[e] = 0.f;
#pragma unroll
                for (int j = 0; j < 4; ++j) {
                    const int p = pos - 3 + j;
                    if (p >= 0) {
                        const u32x4 xv = *(const u32x4*)(gq + (size_t)(b * SEQ + p) * 1536 + ch);
                        const f32x4 w0 = *(const f32x4*)(cw + j * 1536 + ch), w1 = *(const f32x4*)(cw + j * 1536 + ch + 4);
                        y[0] += w0[0] * __uint_as_float(xv.x << 16); y[1] += w0[1] * __uint_as_float(xv.x & 0xffff0000u);
                        y[2] += w0[2] * __uint_as_float(xv.y << 16); y[3] += w0[3] * __uint_as_float(xv.y & 0xffff0000u);
                        y[4] += w1[0] * __uint_as_float(xv.z << 16); y[5] += w1[1] * __uint_as_float(xv.z & 0xffff0000u);
                        y[6] += w1[2] * __uint_as_float(xv.w << 16); y[7] += w1[3] * __uint_as_float(xv.w & 0xffff0000u);
                    }
                }
                float ss = 0.f;
#pragma unroll
                for (int e = 0; e < 8; ++e) { y[e] = siluf_(y[e]); ss += y[e] * y[e]; }
                if (part < 2) {
                    ss += __shfl_xor(ss, 1); ss += __shfl_xor(ss, 2); ss += __shfl_xor(ss, 4); ss += __shfl_xor(ss, 8);
                    const float sc = rsqrtf(ss + EPS) * (part == 0 ? 0.08838834764831845f : 1.0f);
#pragma unroll
                    for (int e = 0; e < 8; ++e) y[e] *= sc;
                }
                if (part == 0) {
                    u32x4 w; w.x = cvt_pk_bf16(y[0], y[1]); w.y = cvt_pk_bf16(y[2], y[3]); w.z = cvt_pk_bf16(y[4], y[5]); w.w = cvt_pk_bf16(y[6], y[7]);
                    *(LAS u32x4*)(qb + c * 136 + 8 * li) = w;
                    const int mt = c >> 4, m = c & 15, ks = li >> 2, a = (li & 3) >> 1, g0 = (2 * (li & 3)) & 3, g1 = (2 * (li & 3) + 1) & 3;
                    u32x2 d0, d1; d0.x = cvt_pk_bf16(y[0] * egv, y[1] * egv); d0.y = cvt_pk_bf16(y[2] * egv, y[3] * egv); d1.x = cvt_pk_bf16(y[4] * egv, y[5] * egv); d1.y = cvt_pk_bf16(y[6] * egv, y[7] * egv);
                    unsigned char* fb = rec + REC_QDEC + (size_t)(mt * 4 + ks) * 1024 + a * 8;
                    *(u32x2*)(fb + (g0 * 16 + m) * 16) = d0; *(u32x2*)(fb + (g1 * 16 + m) * 16) = d1;
                } else if (part == 1) {
                    *(LAS f32x4*)(kf + c * 128 + 8 * li) = (f32x4){y[0], y[1], y[2], y[3]}; *(LAS f32x4*)(kf + c * 128 + 8 * li + 4) = (f32x4){y[4], y[5], y[6], y[7]};
                    u32x4 w; w.x = cvt_pk_bf16(y[0], y[1]); w.y = cvt_pk_bf16(y[2], y[3]); w.z = cvt_pk_bf16(y[4], y[5]); w.w = cvt_pk_bf16(y[6], y[7]);
                    *(LAS u32x4*)(kb + c * 136 + 8 * li) = w;
                    w.x = cvt_pk_bf16(y[0] * betav, y[1] * betav); w.y = cvt_pk_bf16(y[2] * betav, y[3] * betav); w.z = cvt_pk_bf16(y[4] * betav, y[5] * betav); w.w = cvt_pk_bf16(y[6] * betav, y[7] * betav);
                    *(LAS u32x4*)(kbb + c * 136 + 8 * li) = w;
                } else {
                    *(LAS f32x4*)(vf + c * 128 + 8 * li) = (f32x4){y[0], y[1], y[2], y[3]}; *(LAS f32x4*)(vf + c * 128 + 8 * li + 4) = (f32x4){y[4], y[5], y[6], y[7]};
                }
            }
        }
    }
    __syncthreads();
    {
        const int l = F.lane, m = l & 15, kg = l >> 4;
#pragma unroll
        for (int i = 0; i < 4; ++i) {
            const int tt = F.wave * 4 + i, which = tt >> 4, mi = (tt >> 2) & 3, ni = tt & 3;
            f32x4 acc = {0.f, 0.f, 0.f, 0.f};
            if (mi >= ni) {
                const LAS bf16* As = which ? qb : kbb;
#pragma unroll
                for (int ks = 0; ks < 4; ++ks) {
                    const bf16x8 a = *(const LAS bf16x8*)(As + (16 * mi + m) * 136 + 32 * ks + 8 * kg);
                    const bf16x8 bb = *(const LAS bf16x8*)(kb + (16 * ni + m) * 136 + 32 * ks + 8 * kg);
                    acc = mfma16(a, bb, acc);
                }
            }
#pragma unroll
            for (int r = 0; r < 4; ++r) {
                const int irow = 16 * mi + 4 * kg + r, jcol = 16 * ni + m;
                const float dec = (irow >= jcol) ? expf(gcs[irow] - gcs[jcol]) : 0.f;
                if (which == 0) Lm[jcol * 64 + irow] = (irow > jcol) ? acc[r] * dec : 0.f;
                else atb[irow * 72 + jcol] = f2bf((irow >= jcol) ? acc[r] * dec : 0.f);
            }
        }
    }
    __syncthreads();
    {
        const float gl = gcs[63];
#pragma unroll
        for (int q = 0; q < 2; ++q) {
            const int idx = tid + 512 * q, l = idx & 63, ks = (idx >> 6) & 1, mt = idx >> 7, m = l & 15, g = l >> 4;
            float e[8];
#pragma unroll
            for (int j = 0; j < 8; ++j) { const int cr = 32 * ks + kperm(g, j); e[j] = kf[cr * 128 + 16 * mt + m] * expf(gl - gcs[cr]); }
            u32x4 w; w.x = cvt_pk_bf16(e[0], e[1]); w.y = cvt_pk_bf16(e[2], e[3]); w.z = cvt_pk_bf16(e[4], e[5]); w.w = cvt_pk_bf16(e[6], e[7]);
            *(u32x4*)(rec + REC_KDT + (size_t)idx * 16) = w;
        }
        {
            const int idx = tid, l = idx & 63, ks = (idx >> 6) & 1, mt = idx >> 7, m = l & 15, g = l >> 4;
            const u32x2 a0 = *(const LAS u32x2*)(atb + (16 * mt + m) * 72 + 32 * ks + 4 * g), a1 = *(const LAS u32x2*)(atb + (16 * mt + m) * 72 + 32 * ks + 16 + 4 * g);
            *(u32x4*)(rec + REC_ATTN + (size_t)idx * 16) = (u32x4){a0.x, a0.y, a1.x, a1.y};
        }
    }
    __syncthreads();
    if (tid < 256) {
        const int c = tid; const bool isw = c >= 128;
        LAS float* base = isw ? (kf + (c - 128)) : (vf + c);
#pragma unroll
        for (int ib = 0; ib < 4; ++ib) {
            float r[16];
#pragma unroll
            for (int ii = 0; ii < 16; ++ii) { const int i = 16 * ib + ii; r[ii] = base[i * 128] * gcs[64 + i] * (isw ? gcs[128 + i] : 1.0f); }
            for (int j = 0; j < 16 * ib; ++j) {
                const float xj = base[j * 128];
                const LAS f32x4* lp = (const LAS f32x4*)(Lm + j * 64 + 16 * ib);
                const f32x4 l0 = lp[0], l1 = lp[1], l2 = lp[2], l3 = lp[3];
                r[0] -= l0[0] * xj; r[1] -= l0[1] * xj; r[2] -= l0[2] * xj; r[3] -= l0[3] * xj;
                r[4] -= l1[0] * xj; r[5] -= l1[1] * xj; r[6] -= l1[2] * xj; r[7] -= l1[3] * xj;
                r[8] -= l2[0] * xj; r[9] -= l2[1] * xj; r[10] -= l2[2] * xj; r[11] -= l2[3] * xj;
                r[12] -= l3[0] * xj; r[13] -= l3[1] * xj; r[14] -= l3[2] * xj; r[15] -= l3[3] * xj;
            }
#pragma unroll
            for (int jj = 0; jj < 15; ++jj) {
                const LAS f32x4* lp = (const LAS f32x4*)(Lm + (16 * ib + jj) * 64 + 16 * ib);
#pragma unroll
                for (int q = 0; q < 4; ++q) {
                    if (4 * q + 3 > jj) {
                        const f32x4 lv = lp[q];
#pragma unroll
                        for (int e = 0; e < 4; ++e) if (4 * q + e > jj) r[4 * q + e] -= lv[e] * r[jj];
                    }
                }
            }
#pragma unroll
            for (int ii = 0; ii < 16; ++ii) base[(16 * ib + ii) * 128] = r[ii];
        }
    }
    __syncthreads();
    {
#pragma unroll
        for (int q = 0; q < 4; ++q) {
            const int idx = tid + 512 * q, l = idx & 63, mt = (idx >> 6) & 3, sl = idx >> 8, g4 = l >> 4, nn = l & 15;
            const LAS float* up = vf + (16 * mt + 4 * g4) * 128 + 16 * sl + nn;
            u32x2 d; d.x = cvt_pk_bf16(up[0], up[128]); d.y = cvt_pk_bf16(up[256], up[384]);
            *(u32x2*)(rec + REC_U + (size_t)idx * 8) = d;
        }
#pragma unroll
        for (int q = 0; q < 2; ++q) {
            const int idx = tid + 512 * q, l = idx & 63, ks = (idx >> 6) & 3, mt = idx >> 8, m = l & 15, g = l >> 4;
            const f32x4 a0 = *(const LAS f32x4*)(kf + (16 * mt + m) * 128 + 32 * ks + 4 * g), a1 = *(const LAS f32x4*)(kf + (16 * mt + m) * 128 + 32 * ks + 16 + 4 * g);
            u32x4 w; w.x = cvt_pk_bf16(-a0[0], -a0[1]); w.y = cvt_pk_bf16(-a0[2], -a0[3]); w.z = cvt_pk_bf16(-a1[0], -a1[1]); w.w = cvt_pk_bf16(-a1[2], -a1[3]);
            *(u32x4*)(rec + REC_WNEG + (size_t)idx * 16) = w;
        }
    }
    __syncthreads();
}

__device__ __forceinline__ bf16x8 acc2frag(const f32x4& lo, const f32x4& hi) {
    u32x4 w; w.x = cvt_pk_bf16(lo[0], lo[1]); w.y = cvt_pk_bf16(lo[2], lo[3]); w.z = cvt_pk_bf16(hi[0], hi[1]); w.w = cvt_pk_bf16(hi[2], hi[3]);
    return __builtin_bit_cast(bf16x8, w);
}
__device__ __forceinline__ void gdn_scan(const Frame& F, int bh) {
    const int tid = F.tid, lane = F.lane, s = F.wave;
    const int b = bh >> 2, h = bh & 3;
    LAS unsigned char* buf0 = F.lds; LAS float* ox = (LAS float*)(F.lds + 2 * REC_LDS_BYTES);
    const float* glast = (const float*)(F.ws + WS_GLAST);
    const bf16* gz = (const bf16*)(F.ws + WS_GZ); const float* gnw = F.in[6]; bf16* mix = (bf16*)(F.ws + WS_MIX);
    f32x4 S[8];
#pragma unroll
    for (int t = 0; t < 8; ++t) S[t] = (f32x4){0.f, 0.f, 0.f, 0.f};
    const unsigned char* const recbase = F.ws + WS_GREC + (size_t)(b * 512 + h) * GREC_BYTES;
#define recp(n) (recbase + (size_t)(n) * 4 * GREC_BYTES)
#define GS_STAGE(n, bufsel) do { const unsigned char* _r = recp(n); _Pragma("unroll") for (int _i = 0; _i < 7; ++_i) \
        __builtin_amdgcn_global_load_lds((const unsigned*)(_r + (size_t)(_i * 512 + tid) * 16), (LAS unsigned*)(buf0 + (bufsel) * REC_LDS_BYTES + (_i * 8 + s) * 1024), 16, 0, 0); } while (0)
    GS_STAGE(0, 0);
    u32x2 un[4];
#pragma unroll
    for (int mt = 0; mt < 4; ++mt) un[mt] = *(const u32x2*)(recp(0) + REC_U + (size_t)((s * 4 + mt) * 64 + lane) * 8);
    float egn = glast[(b * 128 + 0) * 4 + h];
    for (int n = 0; n < 128; ++n) {
        const int cur = n & 1;
        asm volatile("s_waitcnt vmcnt(0)" ::: "memory");
        __syncthreads();
        u32x2 uc[4];
#pragma unroll
        for (int mt = 0; mt < 4; ++mt) uc[mt] = un[mt];
        const float egl = egn;
        if (n + 1 < 128) {
            GS_STAGE(n + 1, cur ^ 1);
#pragma unroll
            for (int mt = 0; mt < 4; ++mt) un[mt] = *(const u32x2*)(recp(n + 1) + REC_U + (size_t)((s * 4 + mt) * 64 + lane) * 8);
            egn = glast[(b * 128 + n + 1) * 4 + h];
        }
        const LAS unsigned char* bp = buf0 + cur * REC_LDS_BYTES + lane * 16;
        bf16x8 Sb[4];
#pragma unroll
        for (int ks = 0; ks < 4; ++ks) Sb[ks] = acc2frag(S[2 * ks], S[2 * ks + 1]);
        f32x4 vn[4], o[4];
#pragma unroll
        for (int mt = 0; mt < 4; ++mt) {
            vn[mt] = (f32x4){__uint_as_float(uc[mt].x << 16), __uint_as_float(uc[mt].x & 0xffff0000u), __uint_as_float(uc[mt].y << 16), __uint_as_float(uc[mt].y & 0xffff0000u)};
#pragma unroll
            for (int ks = 0; ks < 4; ++ks) vn[mt] = mfma16(*(const LAS bf16x8*)(bp + REC_WNEG + (mt * 4 + ks) * 1024), Sb[ks], vn[mt]);
        }
        bf16x8 Vb[2];
#pragma unroll
        for (int ks = 0; ks < 2; ++ks) Vb[ks] = acc2frag(vn[2 * ks], vn[2 * ks + 1]);
#pragma unroll
        for (int mt = 0; mt < 4; ++mt) {
            o[mt] = (f32x4){0.f, 0.f, 0.f, 0.f};
#pragma unroll
            for (int ks = 0; ks < 4; ++ks) o[mt] = mfma16(*(const LAS bf16x8*)(bp + REC_QDEC + (mt * 4 + ks) * 1024), Sb[ks], o[mt]);
#pragma unroll
            for (int ks = 0; ks < 2; ++ks) o[mt] = mfma16(*(const LAS bf16x8*)(bp + REC_ATTN + (mt * 2 + ks) * 1024), Vb[ks], o[mt]);
        }
#pragma unroll
        for (int t = 0; t < 8; ++t) {
            S[t] = S[t] * egl;
#pragma unroll
            for (int ks = 0; ks < 2; ++ks) S[t] = mfma16(*(const LAS bf16x8*)(bp + REC_KDT + (t * 2 + ks) * 1024), Vb[ks], S[t]);
        }
        {
            const int g4 = lane >> 4, nn = lane & 15;
#pragma unroll
            for (int mt = 0; mt < 4; ++mt)
#pragma unroll
                for (int r = 0; r < 4; ++r) ox[(16 * mt + 4 * g4 + r) * 132 + 16 * s + nn] = o[mt][r];
        }
        __syncthreads();
        {
            const int row = tid >> 3, part = tid & 7; const int tok = b * SEQ + n * 64 + row;
            float v[16]; float ss = 0.f;
#pragma unroll
            for (int q = 0; q < 4; ++q) { const f32x4 t4 = *(const LAS f32x4*)(ox + row * 132 + 16 * part + 4 * q); v[4 * q] = t4[0]; v[4 * q + 1] = t4[1]; v[4 * q + 2] = t4[2]; v[4 * q + 3] = t4[3]; }
#pragma unroll
            for (int e = 0; e < 16; ++e) ss += v[e] * v[e];
            ss += __shfl_xor(ss, 1); ss += __shfl_xor(ss, 2); ss += __shfl_xor(ss, 4);
            const float rs = rsqrtf(ss * (1.0f / 128.f) + EPS);
            const u32x4 z0 = *(const u32x4*)(gz + (size_t)tok * 512 + h * 128 + 16 * part), z1 = *(const u32x4*)(gz + (size_t)tok * 512 + h * 128 + 16 * part + 8);
            const unsigned zz[8] = {z0.x, z0.y, z0.z, z0.w, z1.x, z1.y, z1.z, z1.w};
            unsigned ow[8];
#pragma unroll
            for (int e = 0; e < 8; ++e) {
                const float w0 = gnw[16 * part + 2 * e], w1 = gnw[16 * part + 2 * e + 1];
                ow[e] = cvt_pk_bf16(v[2 * e] * rs * w0 * __uint_as_float(zz[e] << 16), v[2 * e + 1] * rs * w1 * __uint_as_float(zz[e] & 0xffff0000u));
            }
            bf16* mp = mix + (size_t)tok * DM + h * 128 + 16 * part;
            *(u32x4*)mp = (u32x4){ow[0], ow[1], ow[2], ow[3]}; *(u32x4*)(mp + 8) = (u32x4){ow[4], ow[5], ow[6], ow[7]};
        }
    }
#undef GS_STAGE
#undef recp
    asm volatile("s_waitcnt vmcnt(0)" ::: "memory");
    __syncthreads();
}
__device__ __forceinline__ void compress_wave(const Frame& F, int wt) {
    const int which = wt >> 8, bhk = (wt >> 5) & 7, rt = wt & 31, b = bhk >> 1, hk = bhk & 1;
    const int l = F.lane, n = l & 15, kg = l >> 4;
    const bf16* nkv = (const bf16*)(F.ws + WS_NKV);
    const bf16* w1f = (const bf16*)(F.ws + (which ? WS_W1FV : WS_W1FK)); const bf16* w2f = (const bf16*)(F.ws + (which ? WS_W2FV : WS_W2FK));
    const float* cpe = (const float*)(F.ws + WS_CPE) + which * 128;
    const int nc = 16 * rt + n;
    f32x4 acc[8];
#pragma unroll
    for (int t = 0; t < 8; ++t) acc[t] = (f32x4){0.f, 0.f, 0.f, 0.f};
    for (int ks = 0; ks < 64; ++ks) {
        int tok = 16 * nc + (ks >> 1); tok = tok < SEQ ? tok : SEQ - 1;
        const bf16x8 bfrag = *(const bf16x8*)(nkv + (size_t)(b * SEQ + tok) * 768 + which * 128 + hk * 64 + (ks & 1) * 32 + 8 * kg);
#pragma unroll
        for (int mt = 0; mt < 8; ++mt) acc[mt] = mfma16(*(const bf16x8*)(w1f + ((size_t)(ks * 8 + mt) * 64 + l) * 8), bfrag, acc[mt]);
    }
#pragma unroll
    for (int mt = 0; mt < 8; ++mt)
#pragma unroll
        for (int r = 0; r < 4; ++r) acc[mt][r] = siluf_(acc[mt][r] + cpe[16 * mt + 4 * kg + r]);
    f32x4 o[4];
#pragma unroll
    for (int mt = 0; mt < 4; ++mt) {
        o[mt] = (f32x4){0.f, 0.f, 0.f, 0.f};
#pragma unroll
        for (int ks = 0; ks < 4; ++ks) {
            u32x4 w; w.x = cvt_pk_bf16(acc[2 * ks][0], acc[2 * ks][1]); w.y = cvt_pk_bf16(acc[2 * ks][2], acc[2 * ks][3]); w.z = cvt_pk_bf16(acc[2 * ks + 1][0], acc[2 * ks + 1][1]); w.w = cvt_pk_bf16(acc[2 * ks + 1][2], acc[2 * ks + 1][3]);
            o[mt] = mfma16(*(const bf16x8*)(w2f + ((size_t)(mt * 4 + ks) * 64 + l) * 8), __builtin_bit_cast(bf16x8, w), o[mt]);
        }
    }
    const bool valid = nc < 511;
    if (which == 0) {
        bf16* kc = (bf16*)(F.ws + WS_KCMP) + ((size_t)bhk * 512 + nc) * 64;
#pragma unroll
        for (int mt = 0; mt < 4; ++mt) { u32x2 d; d.x = valid ? cvt_pk_bf16(o[mt][0], o[mt][1]) : 0u; d.y = valid ? cvt_pk_bf16(o[mt][2], o[mt][3]) : 0u; *(u32x2*)(kc + 16 * mt + 4 * kg) = d; }
    } else {
        bf16* vt = (bf16*)(F.ws + WS_VCMPT) + (size_t)bhk * 64 * 512 + nc;
#pragma unroll
        for (int mt = 0; mt < 4; ++mt)
#pragma unroll
            for (int r = 0; r < 4; ++r) vt[(size_t)(16 * mt + 4 * kg + r) * 512] = valid ? f2bf(o[mt][r]) : (unsigned short)0;
    }
}
__device__ __forceinline__ void vtranspose_task(const Frame& F, int task) {
    const int which = task >> 8, bhk = (task >> 5) & 7, tg = task & 31, b = bhk >> 1, hk = bhk & 1;
    const bf16* nkv = (const bf16*)(F.ws + WS_NKV); bf16* dst = (bf16*)(F.ws + (which ? WS_VWT : WS_VST)) + (size_t)bhk * 64 * SEQ;
    LAS bf16* tile = (LAS bf16*)F.lds;
    for (int sub = 0; sub < 4; ++sub) {
        const int t0 = tg * 256 + sub * 64;
        { const int tk = F.tid >> 3, dc = F.tid & 7;
          const u32x4 v = *(const u32x4*)(nkv + (size_t)(b * SEQ + t0 + tk) * 768 + 384 + which * 256 + hk * 64 + 8 * dc);
          const unsigned vv[4] = {v.x, v.y, v.z, v.w};
#pragma unroll
          for (int e = 0; e < 4; ++e) { tile[(8 * dc + 2 * e) * 72 + tk] = (unsigned short)(vv[e] & 0xffffu); tile[(8 * dc + 2 * e + 1) * 72 + tk] = (unsigned short)(vv[e] >> 16); } }
        __syncthreads();
        { const int d = F.tid >> 3, tc = F.tid & 7;
          *(u32x4*)(dst + (size_t)d * SEQ + t0 + 8 * tc) = *(const LAS u32x4*)(tile + d * 72 + 8 * tc); }
        __syncthreads();
    }
}

struct AttnAcc { f32x4 O[4]; float m, l; };
template <int MODE, bool PASS1, bool NORM>
__device__ __forceinline__ void attn_tile(const bf16* Kb, int kstride, const bf16* VT, int vlen, int kb, const bf16x8& q0, const bf16x8& q1, int trow, const float* btab,
                                          AttnAcc& A, float mfix, float linv, int lane, f32x4 (&pout)[2]) {
    const int m = lane & 15, kg = lane >> 4;
    f32x4 s[2];
#pragma unroll
    for (int mt = 0; mt < 2; ++mt) {
        const bf16* kr = Kb + (size_t)(kb + 16 * mt + m) * kstride + 8 * kg;
        s[mt] = mfma16(*(const bf16x8*)kr, q0, (f32x4){0.f, 0.f, 0.f, 0.f});
        s[mt] = mfma16(*(const bf16x8*)(kr + 32), q1, s[mt]);
    }
    bool ok[2][4]; float tmax = -1e30f;
#pragma unroll
    for (int mt = 0; mt < 2; ++mt)
#pragma unroll
        for (int r = 0; r < 4; ++r) {
            const int key = kb + 16 * mt + 4 * kg + r;
            const int dist = MODE == 0 ? trow - (16 * key + 31) : trow - key;
            ok[mt][r] = MODE == 2 ? (dist >= 0 && dist < 512) : (dist >= 0);
            const int di = dist < 0 ? 0 : (dist > 1024 ? 1024 : dist);
            s[mt][r] += btab[di];
            if (ok[mt][r]) tmax = fmaxf(tmax, s[mt][r]);
        }
    if (PASS1 || !NORM) {
        tmax = fmaxf(tmax, __shfl_xor(tmax, 16)); tmax = fmaxf(tmax, __shfl_xor(tmax, 32));
        const float mnew = fmaxf(A.m, tmax), alpha = __expf(A.m - mnew);
        float ps = 0.f;
#pragma unroll
        for (int mt = 0; mt < 2; ++mt)
#pragma unroll
            for (int r = 0; r < 4; ++r) { const float p = ok[mt][r] ? __expf(s[mt][r] - mnew) : 0.f; s[mt][r] = p; ps += p; }
        ps += __shfl_xor(ps, 16); ps += __shfl_xor(ps, 32);
        A.l = A.l * alpha + ps; A.m = mnew;
        if (!PASS1) {
#pragma unroll
            for (int t = 0; t < 4; ++t) A.O[t] = A.O[t] * alpha;
        }
    } else {
#pragma unroll
        for (int mt = 0; mt < 2; ++mt)
#pragma unroll
            for (int r = 0; r < 4; ++r) s[mt][r] = ok[mt][r] ? __expf(s[mt][r] - mfix) * linv : 0.f;
    }
    pout[0] = s[0]; pout[1] = s[1];
    if (!PASS1) {
        u32x4 w; w.x = cvt_pk_bf16(s[0][0], s[0][1]); w.y = cvt_pk_bf16(s[0][2], s[0][3]); w.z = cvt_pk_bf16(s[1][0], s[1][1]); w.w = cvt_pk_bf16(s[1][2], s[1][3]);
        const bf16x8 pf = __builtin_bit_cast(bf16x8, w);
#pragma unroll
        for (int t = 0; t < 4; ++t) {
            const bf16* vr = VT + (size_t)(16 * t + m) * vlen + kb + 4 * kg;
            const bf16x4 lo = *(const bf16x4*)vr, hi = *(const bf16x4*)(vr + 16);
            A.O[t] = mfma16(__builtin_shufflevector(lo, hi, 0, 1, 2, 3, 4, 5, 6, 7), pf, A.O[t]);
        }
    }
}

__device__ __forceinline__ void nsa_item(const Frame& F, int item) {
    const int bhk = item & 7, cb = 127 - (item >> 3), b = bhk >> 1, hk = bhk & 1;
    const int lane = F.lane, n = lane & 15, ts = n >> 2, g = n & 3, g4 = lane >> 4, kg = g4;
    const bf16* nq = (const bf16*)(F.ws + WS_NQ); const bf16* nkv = (const bf16*)(F.ws + WS_NKV) + (size_t)b * SEQ * 768;
    const bf16* kcmp = (const bf16*)(F.ws + WS_KCMP) + (size_t)bhk * 512 * 64; const bf16* vcmpt = (const bf16*)(F.ws + WS_VCMPT) + (size_t)bhk * 64 * 512;
    const bf16* vst = (const bf16*)(F.ws + WS_VST) + (size_t)bhk * 64 * SEQ; const bf16* vwt = (const bf16*)(F.ws + WS_VWT) + (size_t)bhk * 64 * SEQ;
    const float* btab = (const float*)(F.ws + WS_BT) + (hk * 4 + g) * 1025;
    const float* small = (const float*)(F.ws + WS_SMALL); const bf16* nz = (const bf16*)(F.ws + WS_NZ); bf16* mix = (bf16*)(F.ws + WS_MIX);
    LAS float* Gs = (LAS float*)(F.lds) + F.wave * 1152;
    LAS float* Ls = Gs + 512; LAS int* sel = (LAS int*)(Gs + 1024); LAS int* cnts = sel + 64;
    for (int grp = 0; grp < 2; ++grp) {
        const int t0 = cb * 64 + F.wave * 8 + grp * 4;
        const int trow = t0 + ts; const size_t tokg = (size_t)b * SEQ + trow;
        const bf16* qp = nq + tokg * 512 + (hk * 4 + g) * 64 + 8 * kg;
        const bf16x8 q0 = *(const bf16x8*)qp, q1 = *(const bf16x8*)(qp + 32);
        f32x4 tot[4];
#pragma unroll
        for (int t = 0; t < 4; ++t) tot[t] = (f32x4){0.f, 0.f, 0.f, 0.f};
        f32x4 pd[2];
        const int nmax = (t0 + 3 - 31) >> 4;
        AttnAcc C; C.m = -1e30f; C.l = 0.f;
#pragma unroll
        for (int t = 0; t < 4; ++t) C.O[t] = (f32x4){0.f, 0.f, 0.f, 0.f};
        if (nmax >= 0) {
            for (int kb = 0; kb <= nmax; kb += 32) attn_tile<0, true, false>(kcmp, 64, vcmpt, 512, kb, q0, q1, trow, btab, C, 0.f, 0.f, lane, pd);
            const float linv = C.l > 0.f ? 1.0f / C.l : 0.f;
            for (int kb = 0; kb <= nmax; kb += 32) {
                attn_tile<0, false, true>(kcmp, 64, vcmpt, 512, kb, q0, q1, trow, btab, C, C.m, linv, lane, pd);
#pragma unroll
                for (int mt = 0; mt < 2; ++mt) {
                    float gsum = pd[mt][0] + pd[mt][1] + pd[mt][2] + pd[mt][3], lv = pd[mt][3];
                    gsum += __shfl_xor(gsum, 1); gsum += __shfl_xor(gsum, 2); lv += __shfl_xor(lv, 1); lv += __shfl_xor(lv, 2);
                    const int j = (kb >> 2) + 4 * mt + g4;
                    if (g == 0) { Gs[ts * 128 + j] = gsum; Ls[ts * 128 + j] = lv; }
                }
            }
        }
        {   const float gate = small[tokg * 32 + 8 + hk * 4 + g];
#pragma unroll
            for (int t = 0; t < 4; ++t) tot[t] = tot[t] + C.O[t] * gate; }
        {
            const int tsl = lane >> 4, i = lane & 15;
            int cnt = 0;
            if (cb <= 15) {
                if (i <= cb) sel[tsl * 16 + i] = i;
                cnt = cb + 1;
            } else {
                float val[8];
#pragma unroll
                for (int q = 0; q < 8; ++q) { const int j = i + 16 * q; val[q] = (j >= 1 && j <= cb - 2) ? (Gs[tsl * 128 + j] + Ls[tsl * 128 + j - 1]) : -1.0f; }
                if (i == 0) { sel[tsl * 16 + 0] = 0; sel[tsl * 16 + 1] = cb - 1; sel[tsl * 16 + 2] = cb; }
                for (int round = 0; round < 13; ++round) {
                    float bv = -2.0f; int bj = 1 << 20;
#pragma unroll
                    for (int q = 0; q < 8; ++q) if (val[q] > bv) { bv = val[q]; bj = i + 16 * q; }
#pragma unroll
                    for (int off = 1; off < 16; off <<= 1) {
                        const float ov = __shfl_xor(bv, off); const int oj = __shfl_xor(bj, off);
                        if (ov > bv || (ov == bv && oj < bj)) { bv = ov; bj = oj; }
                    }
#pragma unroll
                    for (int q = 0; q < 8; ++q) if (bj == i + 16 * q) val[q] = -3.0f;
                    if (i == 0) sel[tsl * 16 + 3 + round] = bj;
                }
                cnt = 16;
            }
            if (i == 0) cnts[tsl] = cnt;
        }
        for (int tsel = 0; tsel < 4; ++tsel) {
            const int tt = t0 + tsel; const size_t tokq = (size_t)b * SEQ + tt;
            const bf16* qps = nq + tokq * 512 + (hk * 4 + g) * 64 + 8 * kg;
            const bf16x8 qs0 = *(const bf16x8*)qps, qs1 = *(const bf16x8*)(qps + 32);
            AttnAcc Sx; Sx.m = -1e30f; Sx.l = 0.f;
#pragma unroll
            for (int t = 0; t < 4; ++t) Sx.O[t] = (f32x4){0.f, 0.f, 0.f, 0.f};
            const int cnt = __builtin_amdgcn_readfirstlane(cnts[tsel]);
            for (int idx = 0; idx < cnt; ++idx) {
                const int j = __builtin_amdgcn_readfirstlane(sel[tsel * 16 + idx]);
#pragma unroll
                for (int half = 0; half < 2; ++half)
                    attn_tile<1, false, false>(nkv + 256 + hk * 64, 768, vst, SEQ, 64 * j + 32 * half, qs0, qs1, tt, btab, Sx, 0.f, 0.f, lane, pd);
            }
            const float gate = small[tokq * 32 + 16 + hk * 4 + g];
            const float sc = (ts == tsel && Sx.l > 0.f) ? gate / Sx.l : 0.f;
#pragma unroll
            for (int t = 0; t < 4; ++t) tot[t] = tot[t] + Sx.O[t] * sc;
        }
        {
            AttnAcc W; W.m = -1e30f; W.l = 0.f;
#pragma unroll
            for (int t = 0; t < 4; ++t) W.O[t] = (f32x4){0.f, 0.f, 0.f, 0.f};
            int k0 = t0 - 511; k0 = k0 < 0 ? 0 : (k0 & ~31);
            for (int kb = k0; kb <= t0 + 3; kb += 32) attn_tile<2, false, false>(nkv + 512 + hk * 64, 768, vwt, SEQ, kb, q0, q1, trow, btab, W, 0.f, 0.f, lane, pd);
            const float gate = small[tokg * 32 + 24 + hk * 4 + g];
            const float sc = W.l > 0.f ? gate / W.l : 0.f;
#pragma unroll
            for (int t = 0; t < 4; ++t) tot[t] = tot[t] + W.O[t] * sc;
        }
#pragma unroll
        for (int t = 0; t < 4; ++t) {
            const size_t off = tokg * 512 + (hk * 4 + g) * 64 + 16 * t + 4 * g4;
            const u32x2 z = *(const u32x2*)(nz + off);
            u32x2 d; d.x = cvt_pk_bf16(tot[t][0] * __uint_as_float(z.x << 16), tot[t][1] * __uint_as_float(z.x & 0xffff0000u));
            d.y = cvt_pk_bf16(tot[t][2] * __uint_as_float(z.y << 16), tot[t][3] * __uint_as_float(z.y & 0xffff0000u));
            *(u32x2*)(mix + tokg * DM + 512 + (hk * 4 + g) * 64 + 16 * t + 4 * g4) = d;
        }
    }
}
__device__ __forceinline__ void p2_phase(const Frame& F) {
    for (int task = blockIdx.x; task < 2624; task += gridDim.x) {
        if (task < 2048) gdn_prep_item(F, task);
        else if (task < 2112) compress_wave(F, (task - 2048) * 8 + F.wave);
        else vtranspose_task(F, task - 2112);
    }
}
__device__ __forceinline__ void p3_phase(const Frame& F) {
    for (int bh = blockIdx.x; bh < 16; bh += gridDim.x) gdn_scan(F, bh);
    unsigned* ctr = (unsigned*)(F.ws + WS_CTL) + 64;
    LAS int* nxt = (LAS int*)(F.lds + 40960);
    for (;;) {
        __syncthreads();
        if (F.tid == 0) *nxt = (int)atomicAdd(ctr, 1u);
        __syncthreads();
        const int item = *nxt;
        if (item >= 1024) break;
        nsa_item(F, item);
    }
}
struct Args { const float* in[16]; float* out; unsigned char* ws; int ph_lo, ph_hi, coop, pad; };
constexpr int N_PHASES = 6;

__global__ void __launch_bounds__(512, 2) hymba_fwd(Args a) {
    extern __shared__ __attribute__((aligned(16))) unsigned char lds_raw[];
    Frame F;
#pragma unroll
    for (int i = 0; i < 16; ++i) F.in[i] = a.in[i];
    F.out = a.out; F.ws = a.ws; F.lds = (LAS unsigned char*)lds_raw; F.ldsg = lds_raw;
    F.tid = threadIdx.x; F.lane = F.tid & 63; F.wave = __builtin_amdgcn_readfirstlane(F.tid >> 6);
    unsigned char* ws = a.ws;
    const int lo = a.ph_lo, hi = a.ph_hi;
#define IN(k) (lo <= (k) && (k) < hi)
#define SEAM(k) do { if (IN(k) && IN((k) + 1)) { if (a.coop) cg::this_grid().sync(); } __syncthreads(); } while (0)
    if (IN(0)) p0_prep(F);
    SEAM(0);
    if (IN(1)) {
        pg8::Gemm g{(const bf16*)(ws + WS_XB), (const bf16*)(ws + WS_WTIN), T_TOK, NPROJ, DM};
        pg8::StaticOrder S; S.init(T_TOK, NPROJ, (int)gridDim.x, (int)blockIdx.x);
        EpiProj E{(bf16*)(ws + WS_GQKV), (bf16*)(ws + WS_GZ), (bf16*)(ws + WS_NQ), (bf16*)(ws + WS_NKV), (bf16*)(ws + WS_NZ), (const float*)(ws + WS_RS)};
        pg8::gemm_phase<EpiProj, pg8::StaticOrder, false>(F.lds, g, S, E, nullptr);
    }
    SEAM(1);
    if (IN(2)) p2_phase(F);
    SEAM(2);
    if (IN(3)) p3_phase(F);
    SEAM(3);
    if (IN(4)) {
        pg8::Gemm g{(const bf16*)(ws + WS_MIX), (const bf16*)(ws + WS_WTOUT), T_TOK, DM, DM};
        pg8::StaticOrder S; S.init(T_TOK, DM, (int)gridDim.x, (int)blockIdx.x);
        EpiOut E{F.in[0], F.out};
        pg8::gemm_phase<EpiOut, pg8::StaticOrder, false>(F.lds, g, S, E, nullptr);
    }
    SEAM(4);
    if (IN(5)) p5_final(F);
#undef IN
#undef SEAM
}

extern "C" void kernel_launch(void* const* d_in, const int* in_sizes, int n_in, void* d_out, int out_size, void* d_ws, size_t ws_size, hipStream_t stream) {
    static int grid = 0;
    if (grid == 0) {
        if (n_in != 16 || in_sizes[0] != T_TOK * DM || out_size != T_TOK * DM || ws_size < WS_END) { fprintf(stderr, "kernel_launch: unexpected shapes (n_in %d, ws %zu)\n", n_in, ws_size); grid = -1; return; }
        int dev = 0, cus = 0, per_cu = 0;
        if (hipGetDevice(&dev) != hipSuccess || hipDeviceGetAttribute(&cus, hipDeviceAttributeMultiprocessorCount, dev) != hipSuccess) { grid = -1; return; }
        if (hipFuncSetAttribute((const void*)hymba_fwd, hipFuncAttributeMaxDynamicSharedMemorySize, LDS_BYTES) != hipSuccess) { fprintf(stderr, "kernel_launch: hipFuncSetAttribute failed\n"); grid = -1; return; }
        if (hipOccupancyMaxActiveBlocksPerMultiprocessor(&per_cu, (const void*)hymba_fwd, 512, LDS_BYTES) != hipSuccess || per_cu < 1) { fprintf(stderr, "kernel_launch: occupancy query says %d\n", per_cu); per_cu = 1; }
        (void)hipGetLastError();
        grid = cus;
    }
    if (grid < 0) return;
    (void)hipMemsetAsync((char*)d_ws + WS_CTL, 0, 1 * MiB, stream);
    Args a{};
    for (int i = 0; i < 16; ++i) a.in[i] = (const float*)d_in[i];
    a.out = (float*)d_out; a.ws = (unsigned char*)d_ws;
#if MK_LAUNCHES == 1
    a.ph_lo = 0; a.ph_hi = N_PHASES; a.coop = 1;
    void* args[] = {&a};
    hipError_t e = hipLaunchCooperativeKernel((const void*)hymba_fwd, dim3(grid), dim3(512), args, LDS_BYTES, stream);
    if (e != hipSuccess) fprintf(stderr, "cooperative launch failed: %s (grid %d)\n", hipGetErrorString(e), grid);
#else
    for (int ph = 0; ph < N_PHASES; ++ph) {
        a.ph_lo = ph; a.ph_hi = ph + 1; a.coop = 0;
        hipLaunchKernelGGL(hymba_fwd, dim3(grid), dim3(512), LDS_BYTES, stream, a);
    }
#endif
}
```

```cpp
#include <hip/hip_runtime.h>
#include <hip/hip_cooperative_groups.h>
#include <cstdio>
#include <cstdint>
namespace cg = cooperative_groups;
#ifndef MK_LAUNCHES
#define MK_LAUNCHES 1
#endif
namespace pg8 {
#define PG8_LAS __attribute__((address_space(3)))
typedef unsigned short bf16_t;
typedef short bf16x8 __attribute__((ext_vector_type(8)));
typedef float f32x4 __attribute__((ext_vector_type(4)));
typedef unsigned u32x4 __attribute__((ext_vector_type(4)));
constexpr int BM = 256, BK = 64, HALF = 128, HTB = HALF * BK * 2  , STAGE_BYTES = 8 * HTB, NXCD = 8, WGM = 8;

__host__ __device__ __forceinline__ int lds_byte(int r, int c) { const int st = (r >> 4) * 2 + (c >> 5), rr = r & 15, cc = c & 31, ob = rr * 64 + cc * 2; return st * 1024 + (ob ^ (((ob >> 9) & 1) << 5)); }
__host__ __device__ __forceinline__ void stage_rc(int b, int& R, int& C) { const int st = b / 1024, sb = b % 1024, swz = sb ^ (((sb >> 9) & 1) << 5); R = (st >> 1) * 16 + swz / 64; C = (st & 1) * 32 + (swz % 64) / 2; }
__host__ __device__ __forceinline__ int perm32(int rho) { const int n = rho >> 4, i = rho & 15; return 8 * (i >> 2) + 4 * n + (i & 3); }

struct Unit { int pm, pn; };
struct Gemm { const bf16_t* A; const bf16_t* Bt; int M, N, K; };

struct StaticOrder {
    int nM, nN, nwg, G, c;
    __host__ __device__ void init(int M, int N, int G_, int c_) { nM = M / BM; nN = N / BM; nwg = nM * nN; G = G_; c = c_; }
    __host__ __device__ bool next(int i, Unit& u) const {
        const long L = (long)i * G + c; if (L >= nwg) return false;
        int wgid = (int)L; { const int q = nwg / NXCD, r = nwg % NXCD, xcd = wgid % NXCD, off = wgid / NXCD; wgid = (xcd < r ? xcd * (q + 1) : r * (q + 1) + (xcd - r) * q) + off; }
        const int nig = WGM * nN, gid = wgid / nig, fm = gid * WGM, gsz = (nM - fm) < WGM ? (nM - fm) : WGM;
        u.pm = fm + ((wgid % nig) % gsz); u.pn = (wgid % nig) / gsz; return true;
    }
    __device__ __forceinline__ void a_ready(const Unit&) const {}
    __device__ __forceinline__ void done(const Unit&) const {}
};
__device__ __forceinline__ unsigned cvt_pk_bf16(float lo, float hi) { unsigned r; asm volatile("v_cvt_pk_bf16_f32 %0, %1, %2" : "=v"(r) : "v"(lo), "v"(hi)); return r; }
typedef float f32x2 __attribute__((ext_vector_type(2)));
template <class Epi, class Sched, bool STAMP = false>
__device__ __forceinline__ void gemm_phase(PG8_LAS unsigned char* lds, const Gemm g, const Sched& S, const Epi& E, unsigned long long* stamps) {
    const int tid = threadIdx.x, wid = __builtin_amdgcn_readfirstlane(tid >> 6), lane = tid & 63, wr = wid >> 2, wc = wid & 3, fr = lane & 15, fq = lane >> 4;
    const int K = g.K, nt = K / BK;
    int ts_lo = 0, ts_hi = 0, nts = 0; const unsigned long long rt_entry = STAMP ? (unsigned long long)wall_clock64() : 0ull;
#define PG8_STAMP() do { if (STAMP && wid == 0 && nts < 64) { const unsigned long long _c = (unsigned long long)clock64(); \
        ts_lo = (lane == nts) ? (int)(unsigned)_c : ts_lo; ts_hi = (lane == nts) ? (int)(unsigned)(_c >> 32) : ts_hi; ++nts; } } while (0)
    PG8_STAMP();
    unsigned voffA[2], voffB[2];
#pragma unroll
    for (int i = 0; i < 2; ++i) { int R, C; stage_rc(tid * 16 + i * 8192, R, C); const int Rb = Epi::PERM ? ((R & ~31) + perm32(R & 31)) : R;
        voffA[i] = (unsigned)(R * K + C) * 2u; voffB[i] = (unsigned)(Rb * K + C) * 2u; }
    const size_t kstep = (size_t)(BK * 2);
    const size_t hstep = (size_t)HALF * K * 2;
    const size_t tstep = 2 * hstep;
    const unsigned ldsw = (unsigned)wid * 1024u;
    const int aoff = lds_byte(wr * 64 + fr, fq * 8), boff = lds_byte(wc * 32 + fr, fq * 8);
#define PG8_SA(b, h) (((b) * 2 + (h)) * HTB)
#define PG8_SB(b, h) ((4 + (b) * 2 + (h)) * HTB)
#define PG8_STAGE(bufoff, gbase, voff) do { _Pragma("unroll") for (int _i = 0; _i < 2; ++_i) \
        __builtin_amdgcn_global_load_lds((const unsigned*)((const char*)(gbase) + (voff)[_i]), (PG8_LAS unsigned*)(lds + (bufoff) + ldsw + _i * 8192), 16, 0, 0); } while (0)
#define PG8_LDA(dst, b, h) do { _Pragma("unroll") for (int m = 0; m < 4; ++m) _Pragma("unroll") for (int k = 0; k < 2; ++k) dst[m][k] = *(const PG8_LAS bf16x8*)(lds + PG8_SA(b, h) + aoff + m * 2048 + k * 1024); } while (0)
#define PG8_LDB(dst, b, h) do { _Pragma("unroll") for (int n = 0; n < 2; ++n) _Pragma("unroll") for (int k = 0; k < 2; ++k) dst[n][k] = *(const PG8_LAS bf16x8*)(lds + PG8_SB(b, h) + boff + n * 2048 + k * 1024); } while (0)
#define PG8_MMA(ai, bj, At, Bt) do { __builtin_amdgcn_s_setprio(1); _Pragma("unroll") for (int m = 0; m < 4; ++m) _Pragma("unroll") for (int n = 0; n < 2; ++n) _Pragma("unroll") for (int k = 0; k < 2; ++k) \
        acc[ai][bj][m][n] = __builtin_amdgcn_mfma_f32_16x16x32_bf16(Bt[n][k], At[m][k], acc[ai][bj][m][n], 0, 0, 0); __builtin_amdgcn_s_setprio(0); } while (0)
#define PG8_WAIT_V(n) asm volatile("s_waitcnt vmcnt(" #n ")" ::: "memory")
#define PG8_WAIT_L(n) asm volatile("s_waitcnt lgkmcnt(" #n ")" ::: "memory")
#define PG8_BAR __builtin_amdgcn_s_barrier()
#define PG8_SCHED __builtin_amdgcn_sched_barrier(0)
    Unit cur, nxt; int ui = 0;
    if (!S.next(0, cur)) return;
    f32x4 acc[2][2][4][2];
#pragma unroll
    for (int a = 0; a < 2; ++a)
#pragma unroll
        for (int b = 0; b < 2; ++b)
#pragma unroll
            for (int m = 0; m < 4; ++m)
#pragma unroll
                for (int n = 0; n < 2; ++n) acc[a][b][m][n] = (f32x4){0.f, 0.f, 0.f, 0.f};
    bf16x8 At[4][2], B0[2][2], B1[2][2];
    const char* cA = (const char*)g.A + (size_t)cur.pm * tstep; const char* cB = (const char*)g.Bt + (size_t)cur.pn * tstep;
    S.a_ready(cur);
    PG8_STAGE(PG8_SB(0, 0), cB, voffB); PG8_STAGE(PG8_SA(0, 0), cA, voffA); PG8_STAGE(PG8_SB(0, 1), cB + hstep, voffB); PG8_STAGE(PG8_SA(0, 1), cA + hstep, voffA);
    if (wr == 1) PG8_BAR;
    PG8_WAIT_V(4); PG8_BAR;
    PG8_STAGE(PG8_SB(1, 0), cB + kstep, voffB); PG8_STAGE(PG8_SA(1, 0), cA + kstep, voffA); PG8_STAGE(PG8_SB(1, 1), cB + hstep + kstep, voffB);
    PG8_WAIT_V(6); PG8_BAR;
    PG8_STAMP();
    for (;;) {
        const bool has_next = S.next(ui + 1, nxt);
        const char* nA = has_next ? (const char*)g.A + (size_t)nxt.pm * tstep : cA; const char* nB = has_next ? (const char*)g.Bt + (size_t)nxt.pn * tstep : cB;
        for (int t = 0; t < nt; t += 2) {
            const bool last = (t == nt - 2);
            const char* a1 = cA + (size_t)(t + 1) * kstep;
            const char* a2 = last ? nA : cA + (size_t)(t + 2) * kstep; const char* b2 = last ? nB : cB + (size_t)(t + 2) * kstep;
            const char* a3 = a2 + kstep; const char* b3 = b2 + kstep;
            if (last && has_next) S.a_ready(nxt);
            PG8_LDB(B0, 0, 0); PG8_SCHED; PG8_LDA(At, 0, 0); PG8_STAGE(PG8_SA(1, 1), a1 + hstep, voffA);
            PG8_WAIT_L(8); PG8_BAR; PG8_WAIT_L(0); PG8_MMA(0, 0, At, B0); PG8_BAR; PG8_SCHED;
            PG8_LDB(B1, 0, 1); PG8_STAGE(PG8_SB(0, 0), b2, voffB);
            PG8_BAR; PG8_WAIT_L(0); PG8_MMA(0, 1, At, B1); PG8_BAR;
            PG8_LDA(At, 0, 1); PG8_STAGE(PG8_SA(0, 0), a2, voffA);
            PG8_BAR; PG8_WAIT_L(0); PG8_MMA(1, 0, At, B0); PG8_BAR; PG8_SCHED;
            PG8_STAGE(PG8_SB(0, 1), b2 + hstep, voffB);
            PG8_WAIT_V(6); PG8_BAR; PG8_MMA(1, 1, At, B1); PG8_BAR;
            PG8_LDB(B0, 1, 0); PG8_SCHED; PG8_LDA(At, 1, 0); PG8_STAGE(PG8_SA(0, 1), a2 + hstep, voffA);
            PG8_WAIT_L(8); PG8_BAR; PG8_WAIT_L(0); PG8_MMA(0, 0, At, B0); PG8_BAR; PG8_SCHED;
            PG8_LDB(B1, 1, 1); PG8_STAGE(PG8_SB(1, 0), b3, voffB);
            PG8_BAR; PG8_WAIT_L(0); PG8_MMA(0, 1, At, B1); PG8_BAR;
            PG8_LDA(At, 1, 1); PG8_STAGE(PG8_SA(1, 0), a3, voffA);
            PG8_BAR; PG8_WAIT_L(0); PG8_MMA(1, 0, At, B0); PG8_BAR; PG8_SCHED;
            PG8_STAGE(PG8_SB(1, 1), b3 + hstep, voffB);
            PG8_WAIT_V(6); PG8_BAR; PG8_MMA(1, 1, At, B1); PG8_BAR;
        }
        PG8_STAMP();
        if constexpr (!Epi::AFTER_DRAIN) { E(acc, cur, wr, wc, fr, fq); S.done(cur); }
        PG8_STAMP();
        if (!has_next) break;
#pragma unroll
        for (int a = 0; a < 2; ++a)
#pragma unroll
            for (int b = 0; b < 2; ++b)
#pragma unroll
                for (int m = 0; m < 4; ++m)
#pragma unroll
                    for (int n = 0; n < 2; ++n) acc[a][b][m][n] = (f32x4){0.f, 0.f, 0.f, 0.f};
        cur = nxt; cA = nA; cB = nB; ++ui;
    }
    PG8_WAIT_V(0);
    if (wr == 0) PG8_BAR;
    PG8_BAR;
    if constexpr (Epi::AFTER_DRAIN) { E.fused(acc, cur, wr, wc, fr, fq, lds, wid, lane); S.done(cur); }
    PG8_STAMP();
    if (STAMP && wid == 0) { stamps[lane] = lane < nts ? (((unsigned long long)(unsigned)ts_hi << 32) | (unsigned)ts_lo) : 0ull;
        if (lane == 62) stamps[62] = rt_entry; if (lane == 63) stamps[63] = (unsigned long long)wall_clock64(); }
#undef PG8_STAMP
#undef PG8_SA
#undef PG8_SB
#undef PG8_STAGE
#undef PG8_LDA
#undef PG8_LDB
#undef PG8_MMA
#undef PG8_WAIT_V
#undef PG8_WAIT_L
#undef PG8_BAR
#undef PG8_SCHED
}
}
#define LAS __attribute__((address_space(3)))
typedef unsigned short bf16;
typedef short bf16x8 __attribute__((ext_vector_type(8)));
typedef short bf16x4 __attribute__((ext_vector_type(4)));
typedef float f32x4 __attribute__((ext_vector_type(4)));
typedef unsigned u32x4 __attribute__((ext_vector_type(4)));
typedef unsigned u32x2 __attribute__((ext_vector_type(2)));
typedef float f32x2_ __attribute__((ext_vector_type(2)));
typedef __bf16 bf16x2n __attribute__((ext_vector_type(2)));
__device__ __forceinline__ unsigned cvt_pk_bf16(float lo, float hi) { const f32x2_ v = {lo, hi}; const bf16x2n b = __builtin_convertvector(v, bf16x2n); return __builtin_bit_cast(unsigned, b); }

constexpr int T_TOK = 32768, SEQ = 8192, DM = 1024, NPROJ = 3840, PROJ_W = 3872;
constexpr float EPS = 1e-6f;
constexpr size_t MiB = 1u << 20;
constexpr size_t WS_CTL = 0;
constexpr size_t WS_WTIN = 1 * MiB;
constexpr size_t WS_WTOUT = 9 * MiB;
constexpr size_t WS_W1FK = 11 * MiB + 256 * 1024;
constexpr size_t WS_W1FV = 11 * MiB + 768 * 1024;
constexpr size_t WS_W2FK = 12 * MiB + 256 * 1024;
constexpr size_t WS_W2FV = 12 * MiB + 288 * 1024;
constexpr size_t WS_CPE = 12 * MiB + 320 * 1024;
constexpr size_t WS_BT = 12 * MiB + 384 * 1024;
constexpr size_t WS_RS = 13 * MiB;
constexpr size_t WS_SMALL = 14 * MiB;
constexpr size_t WS_XB = 32 * MiB;
constexpr size_t WS_MIX = 32 * MiB;
constexpr size_t WS_GQKV = 96 * MiB;
constexpr size_t WS_GZ = 192 * MiB;
constexpr size_t WS_NQ = 224 * MiB;
constexpr size_t WS_NKV = 256 * MiB;
constexpr size_t WS_NZ = 304 * MiB;
constexpr size_t WS_GREC = 336 * MiB;
constexpr size_t GREC_BYTES = 73728;
constexpr size_t WS_KCMP = 480 * MiB;
constexpr size_t WS_VCMPT = 480 * MiB + 512 * 1024;
constexpr size_t WS_VST = 482 * MiB;
constexpr size_t WS_VWT = 490 * MiB;
constexpr size_t WS_GLAST = 498 * MiB;
constexpr size_t WS_END = 499 * MiB;
constexpr int LDS_BYTES = 158720;

__device__ __forceinline__ float bf2f(unsigned short h) { return __uint_as_float((unsigned)h << 16); }
__device__ __forceinline__ unsigned short f2bf(float f) { return (unsigned short)(cvt_pk_bf16(f, 0.f) & 0xffffu); }
__device__ __forceinline__ float sigmoidf_(float v) { return 1.0f / (1.0f + __expf(-v)); }
__device__ __forceinline__ float siluf_(float v) { return v / (1.0f + __expf(-v)); }
__device__ __forceinline__ f32x4 mfma16(bf16x8 a, bf16x8 b, f32x4 c) { return __builtin_amdgcn_mfma_f32_16x16x32_bf16(a, b, c, 0, 0, 0); }
__device__ __forceinline__ int kperm(int g, int j) { return j < 4 ? 4 * g + j : 16 + 4 * g + (j - 4); }

struct Frame {
    const float* in[16]; float* out; unsigned char* ws; LAS unsigned char* lds; unsigned char* ldsg;
    int tid, lane, wave;
};

struct EpiProj {
    static constexpr bool PERM = true, AFTER_DRAIN = false;
    bf16* gqkv; bf16* gz; bf16* nq; bf16* nkv; bf16* nz; const float* rs;
    __device__ __forceinline__ void operator()(const f32x4 (&acc)[2][2][4][2], const pg8::Unit& u, int wr, int wc, int fr, int fq) const {
        const int pn = u.pn; bf16* base; int ldc, colt, act;
        if (pn < 6) { base = gqkv; ldc = 1536; colt = pn * 256; act = 0; }
        else if (pn < 8) { base = gz; ldc = 512; colt = (pn - 6) * 256; act = 1; }
        else if (pn < 10) { base = nq; ldc = 512; colt = (pn - 8) * 256; act = 2; }
        else if (pn < 13) { base = nkv; ldc = 768; colt = (pn - 10) * 256; act = 0; }
        else { base = nz; ldc = 512; colt = (pn - 13) * 256; act = 1; }
        const int row0 = u.pm * 256 + wr * 64 + fr, col0 = colt + wc * 32 + 8 * fq;
#pragma unroll
        for (int ai = 0; ai < 2; ++ai)
#pragma unroll
            for (int m = 0; m < 4; ++m) {
                const int row = row0 + ai * 128 + m * 16; const float r = rs[row];
                bf16* rowp = base + (size_t)row * ldc + col0;
#pragma unroll
                for (int bj = 0; bj < 2; ++bj) {
                    f32x4 v0 = acc[ai][bj][m][0] * r, v1 = acc[ai][bj][m][1] * r;
                    if (act == 1) {
#pragma unroll
                        for (int j = 0; j < 4; ++j) { v0[j] = siluf_(v0[j]); v1[j] = siluf_(v1[j]); }
                    } else if (act == 2) { v0 = v0 * 0.18033688011112042f; v1 = v1 * 0.18033688011112042f; }
                    u32x4 w; w.x = cvt_pk_bf16(v0[0], v0[1]); w.y = cvt_pk_bf16(v0[2], v0[3]); w.z = cvt_pk_bf16(v1[0], v1[1]); w.w = cvt_pk_bf16(v1[2], v1[3]);
                    *(u32x4*)(rowp + bj * 128) = w;
                }
            }
    }
};
struct EpiOut {
    static constexpr bool PERM = false, AFTER_DRAIN = false;
    const float* x; float* out;
    __device__ __forceinline__ void operator()(const f32x4 (&acc)[2][2][4][2], const pg8::Unit& u, int wr, int wc, int fr, int fq) const {
        const int row0 = u.pm * 256 + wr * 64 + fr, col0 = u.pn * 256 + wc * 32 + 4 * fq;
#pragma unroll
        for (int ai = 0; ai < 2; ++ai)
#pragma unroll
            for (int m = 0; m < 4; ++m) {
                const size_t ro = (size_t)(row0 + ai * 128 + m * 16) * DM + col0;
#pragma unroll
                for (int bj = 0; bj < 2; ++bj)
#pragma unroll
                    for (int n = 0; n < 2; ++n) {
                        const f32x4 xv = *(const f32x4*)(x + ro + bj * 128 + n * 16);
                        *(f32x4*)(out + ro + bj * 128 + n * 16) = acc[ai][bj][m][n] + xv;
                    }
            }
    }
};

__device__ __forceinline__ int orig_col(int n) {
    return n < 2048 ? n : (n < 2560 ? 2056 + (n - 2048) : (n < 3328 ? 2568 + (n - 2560) : 3360 + (n - 3328)));
}
__device__ __forceinline__ int orig_small(int sc) { return sc < 8 ? 2048 + sc : 3336 + (sc - 8); }
__device__ __forceinline__ int rel_bucket(int dist) {
    const int n = dist < 0 ? 0 : dist;
    if (n < 16) return n;
    int b = 16;
    b += (n >= 21); b += (n >= 27); b += (n >= 35); b += (n >= 46); b += (n >= 59); b += (n >= 77); b += (n >= 99); b += (n >= 128);
    b += (n >= 166); b += (n >= 216); b += (n >= 280); b += (n >= 363); b += (n >= 470); b += (n >= 609); b += (n >= 790);
    return b;
}
__device__ __forceinline__ void transpose_tile(const Frame& F, const float* src, int sld, int srccol0, int k0, const float* scale, bf16* dst, int dld, int n0) {
    LAS float* tile = (LAS float*)F.lds;
    const int kk = F.tid >> 6, nn = F.tid & 63;
#pragma unroll
    for (int i = 0; i < 8; ++i) { const int k = kk + 8 * i; float v = src[(size_t)(k0 + k) * sld + srccol0 + nn]; if (scale) v *= scale[k0 + k]; tile[k * 65 + nn] = v; }
    __syncthreads();
    const int n2 = F.tid >> 3, kc = F.tid & 7;
    float e[8];
#pragma unroll
    for (int j = 0; j < 8; ++j) e[j] = tile[(8 * kc + j) * 65 + n2];
    u32x4 w; w.x = cvt_pk_bf16(e[0], e[1]); w.y = cvt_pk_bf16(e[2], e[3]); w.z = cvt_pk_bf16(e[4], e[5]); w.w = cvt_pk_bf16(e[6], e[7]);
    *(u32x4*)(dst + (size_t)(n0 + n2) * dld + k0 + 8 * kc) = w;
    __syncthreads();
}

__device__ __forceinline__ void p0_prep(const Frame& F) {
    const float* x = F.in[0]; const float* nw = F.in[1]; const float* w_in = F.in[2];
    unsigned char* ws = F.ws;
    const int G = gridDim.x, bid = blockIdx.x;
    for (int task = bid; task < 1365; task += G) {
        if (task < 960) { const int nt = task / 16, kt = task % 16; transpose_tile(F, w_in, PROJ_W, orig_col(nt * 64), kt * 64, nw, (bf16*)(ws + WS_WTIN), DM, nt * 64); }
        else if (task < 1216) { const int t2 = task - 960, nt = t2 / 16, kt = t2 % 16; transpose_tile(F, F.in[13], DM, nt * 64, kt * 64, nullptr, (bf16*)(ws + WS_WTOUT), DM, nt * 64); }
        else if (task < 1344) {
            const int t2 = task - 1216, which = t2 >> 6, sub = t2 & 63;
            const float* w1 = F.in[which ? 11 : 9]; bf16* dst = (bf16*)(ws + (which ? WS_W1FV : WS_W1FK));
            const int mt = F.tid >> 6, l = F.tid & 63, m = l & 15, kg = l >> 4, ks = sub;
            float e[8];
#pragma unroll
            for (int j = 0; j < 8; ++j) e[j] = w1[(size_t)(32 * ks + 8 * kg + j) * 128 + 16 * mt + m];
            u32x4 w; w.x = cvt_pk_bf16(e[0], e[1]); w.y = cvt_pk_bf16(e[2], e[3]); w.z = cvt_pk_bf16(e[4], e[5]); w.w = cvt_pk_bf16(e[6], e[7]);
            *(u32x4*)(dst + ((size_t)(ks * 8 + mt) * 64 + l) * 8) = w;
        } else if (task < 1346) {
            const int which = task - 1344; const float* w2 = F.in[which ? 12 : 10]; bf16* dst = (bf16*)(ws + (which ? WS_W2FV : WS_W2FK));
            for (int i = F.tid; i < 1024; i += 512) {
                const int l = i & 63, ks = (i >> 6) & 3, mt = i >> 8, m = l & 15, kg = l >> 4;
                float e[8];
#pragma unroll
                for (int j = 0; j < 8; ++j) e[j] = w2[(size_t)(32 * ks + kperm(kg, j)) * 64 + 16 * mt + m];
                u32x4 w; w.x = cvt_pk_bf16(e[0], e[1]); w.y = cvt_pk_bf16(e[2], e[3]); w.z = cvt_pk_bf16(e[4], e[5]); w.w = cvt_pk_bf16(e[6], e[7]);
                *(u32x4*)(dst + (size_t)i * 8) = w;
            }
        } else if (task < 1348) {
            const int which = task - 1346; const float* pe = F.in[which ? 8 : 7]; const float* w1 = F.in[which ? 11 : 9];
            float* dst = (float*)(ws + WS_CPE) + which * 128;
            if (F.tid < 128) { float s = 0.f; for (int k = 0; k < 2048; ++k) s += pe[k] * w1[(size_t)k * 128 + F.tid]; dst[F.tid] = s; }
        } else {
            const int i = (task - 1348) * 512 + F.tid;
            if (i < 8 * 1025) { const int head = i / 1025, dist = i % 1025; ((float*)(ws + WS_BT))[i] = F.in[14][rel_bucket(dist) * 8 + head] * 1.4426950408889634f; }
        }
    }
    __syncthreads();
    {
        for (int i = F.tid; i < 32 * 2 * 64; i += 512) {
            const int l = i & 63, nt = (i >> 6) & 1, ks = i >> 7, kg = l >> 4, sc = 16 * nt + (l & 15), oc = orig_small(sc);
            float v[8], lo[8]; unsigned short hi[8];
#pragma unroll
            for (int j = 0; j < 8; ++j) { const int k = 32 * ks + 8 * kg + j; v[j] = w_in[(size_t)k * PROJ_W + oc] * nw[k]; hi[j] = f2bf(v[j]); lo[j] = v[j] - bf2f(hi[j]); }
            u32x4 wh, wl;
            wh.x = hi[0] | ((unsigned)hi[1] << 16); wh.y = hi[2] | ((unsigned)hi[3] << 16); wh.z = hi[4] | ((unsigned)hi[5] << 16); wh.w = hi[6] | ((unsigned)hi[7] << 16);
            wl.x = cvt_pk_bf16(lo[0], lo[1]); wl.y = cvt_pk_bf16(lo[2], lo[3]); wl.z = cvt_pk_bf16(lo[4], lo[5]); wl.w = cvt_pk_bf16(lo[6], lo[7]);
            *(LAS u32x4*)(F.lds + ((size_t)((ks * 2 + nt) * 2 + 0) * 64 + l) * 16) = wh;
            *(LAS u32x4*)(F.lds + ((size_t)((ks * 2 + nt) * 2 + 1) * 64 + l) * 16) = wl;
        }
    }
    __syncthreads();
    bf16* xb = (bf16*)(ws + WS_XB); float* rsv = (float*)(ws + WS_RS); float* small = (float*)(ws + WS_SMALL);
    const float* a_log = F.in[4]; const float* dt_bias = F.in[5];
    for (int tile = bid * 8 + F.wave; tile < T_TOK / 16; tile += G * 8) {
        const int l = F.lane, r = l & 15, kg = l >> 4; const int row = tile * 16 + r;
        const float* xr = x + (size_t)row * DM + 8 * kg;
        f32x4 acc0 = {0.f, 0.f, 0.f, 0.f}, acc1 = {0.f, 0.f, 0.f, 0.f};
        float ss = 0.f;
#pragma unroll 4
        for (int ks = 0; ks < 32; ++ks) {
            const f32x4 a0 = *(const f32x4*)(xr + 32 * ks), a1 = *(const f32x4*)(xr + 32 * ks + 4);
            ss += a0[0] * a0[0] + a0[1] * a0[1] + a0[2] * a0[2] + a0[3] * a0[3] + a1[0] * a1[0] + a1[1] * a1[1] + a1[2] * a1[2] + a1[3] * a1[3];
            u32x4 h; h.x = cvt_pk_bf16(a0[0], a0[1]); h.y = cvt_pk_bf16(a0[2], a0[3]); h.z = cvt_pk_bf16(a1[0], a1[1]); h.w = cvt_pk_bf16(a1[2], a1[3]);
            *(u32x4*)(xb + (size_t)row * DM + 32 * ks + 8 * kg) = h;
            u32x4 lo;
            lo.x = cvt_pk_bf16(a0[0] - __uint_as_float(h.x << 16), a0[1] - __uint_as_float(h.x & 0xffff0000u));
            lo.y = cvt_pk_bf16(a0[2] - __uint_as_float(h.y << 16), a0[3] - __uint_as_float(h.y & 0xffff0000u));
            lo.z = cvt_pk_bf16(a1[0] - __uint_as_float(h.z << 16), a1[1] - __uint_as_float(h.z & 0xffff0000u));
            lo.w = cvt_pk_bf16(a1[2] - __uint_as_float(h.w << 16), a1[3] - __uint_as_float(h.w & 0xffff0000u));
            const bf16x8 ah = __builtin_bit_cast(bf16x8, h), al = __builtin_bit_cast(bf16x8, lo);
            const LAS unsigned char* fb = F.lds + (size_t)(ks * 4) * 1024 + l * 16;
            const bf16x8 b0h = *(const LAS bf16x8*)(fb), b0l = *(const LAS bf16x8*)(fb + 1024), b1h = *(const LAS bf16x8*)(fb + 2048), b1l = *(const LAS bf16x8*)(fb + 3072);
            acc0 = mfma16(ah, b0h, acc0); acc0 = mfma16(al, b0h, acc0); acc0 = mfma16(ah, b0l, acc0);
            acc1 = mfma16(ah, b1h, acc1); acc1 = mfma16(al, b1h, acc1); acc1 = mfma16(ah, b1l, acc1);
        }
        ss += __shfl_xor(ss, 16); ss += __shfl_xor(ss, 32);
        const float rs = rsqrtf(ss * (1.0f / 1024.f) + EPS);
        if (kg == 0) rsv[row] = rs;
#pragma unroll
        for (int reg = 0; reg < 4; ++reg) {
            const int rr = 4 * kg + reg; const float rsr = __shfl(rs, rr);
            const int orow = tile * 16 + rr;
            {
                const float v = acc0[reg] * rsr; const int c = r; float o;
                if (c < 4) o = sigmoidf_(v);
                else if (c < 8) { const int h = c - 4; const float z = v + dt_bias[h]; const float sp = z > 20.f ? z : log1pf(expf(z)); o = -expf(a_log[h]) * sp; }
                else o = sigmoidf_(v);
                small[(size_t)orow * 32 + c] = o;
            }
            { const float v = acc1[reg] * rsr; small[(size_t)orow * 32 + 16 + r] = sigmoidf_(v); }
        }
    }
}

__device__ __forceinline__ void p5_final(const Frame& F) {
    const float* fw = F.in[15]; float* out = F.out;
    for (int r = blockIdx.x * 8 + F.wave; r < T_TOK; r += gridDim.x * 8) {
        f32x4* orow = (f32x4*)(out + (size_t)r * DM);
        f32x4 v[4]; float ss = 0.f;
#pragma unroll
        for (int i = 0; i < 4; ++i) { v[i] = orow[F.lane + 64 * i]; ss += v[i][0] * v[i][0] + v[i][1] * v[i][1] + v[i][2] * v[i][2] + v[i][3] * v[i][3]; }
#pragma unroll
        for (int o = 32; o > 0; o >>= 1) ss += __shfl_xor(ss, o);
        const float rs = rsqrtf(ss * (1.0f / 1024.f) + EPS);
#pragma unroll
        for (int i = 0; i < 4; ++i) { const f32x4 w = ((const f32x4*)fw)[F.lane + 64 * i]; orow[F.lane + 64 * i] = v[i] * rs * w; }
    }
}
constexpr int REC_WNEG = 0, REC_QDEC = 16384, REC_ATTN = 32768, REC_KDT = 40960, REC_U = 57344, REC_LDS_BYTES = 57344;
__device__ __forceinline__ void gdn_prep_item(const Frame& F, int item) {
    const int tid = F.tid;
    const int h = item & 3, n = (item >> 2) & 127, b = item >> 9;
    const int tok0 = b * SEQ + n * 64;
    LAS float* kf = (LAS float*)(F.lds); LAS float* vf = (LAS float*)(F.lds + 32768);
    LAS bf16* qb = (LAS bf16*)(F.lds + 65536); LAS bf16* kb = (LAS bf16*)(F.lds + 82944); LAS bf16* kbb = (LAS bf16*)(F.lds + 100352);
    LAS float* Lm = (LAS float*)(F.lds + 117760); LAS bf16* atb = (LAS bf16*)(F.lds + 134144); LAS float* gcs = (LAS float*)(F.lds + 143360);
    LAS bf16* wb = qb;
    unsigned char* rec = F.ws + WS_GREC + (size_t)item * GREC_BYTES;
    const float* small = (const float*)(F.ws + WS_SMALL);
    if (tid < 64) {
        const float beta = small[(size_t)(tok0 + tid) * 32 + h]; float c = small[(size_t)(tok0 + tid) * 32 + 4 + h];
#pragma unroll
        for (int o = 1; o < 64; o <<= 1) { const float t = __shfl_up(c, o); if (tid >= o) c += t; }
        gcs[tid] = c; gcs[64 + tid] = beta; gcs[128 + tid] = expf(c);
        if (tid == 63) ((float*)(F.ws + WS_GLAST))[item] = expf(c);
    }
    __syncthreads();
    {
        const bf16* gq = (const bf16*)(F.ws + WS_GQKV); const float* cw = F.in[3];
        const int grp = tid >> 4, li = tid & 15;
#pragma unroll
        for (int rr = 0; rr < 2; ++rr) {
            const int c = grp * 2 + rr, pos = n * 64 + c;
            const float betav = gcs[64 + c], egv = gcs[128 + c];
#pragma unroll
            for (int part = 0; part < 3; ++part) {
                const int ch = part * 512 + h * 128 + 8 * li;
                float y[8];
#pragma unroll
                for (int e = 0; e < 8; ++e) y[e] = 0.f;
#pragma unroll
                for (int j = 0; j < 4; ++j) {
                    const int p = pos - 3 + j;
                    if (p >= 0) {
                        const u32x4 xv = *(const u32x4*)(gq + (size_t)(b * SEQ + p) * 1536 + ch);
                        const f32x4 w0 = *(const f32x4*)(cw + j * 1536 + ch), w1 = *(const f32x4*)(cw + j * 1536 + ch + 4);
                        y[0] += w0[0] * __uint_as_float(xv.x << 16); y[1] += w0[1] * __uint_as_float(xv.x & 0xffff0000u);
                        y[2] += w0[2] * __uint_as_float(xv.y << 16); y[3] += w0[3] * __uint_as_float(xv.y & 0xffff0000u);
                        y[4] += w1[0] * __uint_as_float(xv.z << 16); y[5] += w1[1] * __uint_as_float(xv.z & 0xffff0000u);
                        y[6] += w1[2] * __uint_as_float(xv.w << 16); y[7] += w1[3] * __uint_as_float(xv.w & 0xffff0000u);
                    }
                }
                float ss = 0.f;
#pragma unroll
                for (int e = 0; e < 8; ++e) { y[e] = siluf_(y[e]); ss += y[e] * y[e]; }
                if (part < 2) {
                    ss += __shfl_xor(ss, 1); ss += __shfl_xor(ss, 2); ss += __shfl_xor(ss, 4); ss += __shfl_xor(ss, 8);
                    const float sc = rsqrtf(ss + EPS) * (part == 0 ? 0.08838834764831845f : 1.0f);
#pragma unroll
                    for (int e = 0; e < 8; ++e) y[e] *= sc;
                }
                if (part == 0) {
                    u32x4 w; w.x = cvt_pk_bf16(y[0], y[1]); w.y = cvt_pk_bf16(y[2], y[3]); w.z = cvt_pk_bf16(y[4], y[5]); w.w = cvt_pk_bf16(y[6], y[7]);
                    *(LAS u32x4*)(qb + c * 136 + 8 * li) = w;
                    const int mt = c >> 4, m = c & 15, ks = li >> 2, a = (li & 3) >> 1, g0 = (2 * (li & 3)) & 3, g1 = (2 * (li & 3) + 1) & 3;
                    u32x2 d0, d1; d0.x = cvt_pk_bf16(y[0] * egv, y[1] * egv); d0.y = cvt_pk_bf16(y[2] * egv, y[3] * egv); d1.x = cvt_pk_bf16(y[4] * egv, y[5] * egv); d1.y = cvt_pk_bf16(y[6] * egv, y[7] * egv);
                    unsigned char* fb = rec + REC_QDEC + (size_t)(mt * 4 + ks) * 1024 + a * 8;
                    *(u32x2*)(fb + (g0 * 16 + m) * 16) = d0; *(u32x2*)(fb + (g1 * 16 + m) * 16) = d1;
                } else if (part == 1) {
                    *(LAS f32x4*)(kf + c * 128 + 8 * li) = (f32x4){y[0], y[1], y[2], y[3]}; *(LAS f32x4*)(kf + c * 128 + 8 * li + 4) = (f32x4){y[4], y[5], y[6], y[7]};
                    u32x4 w; w.x = cvt_pk_bf16(y[0], y[1]); w.y = cvt_pk_bf16(y[2], y[3]); w.z = cvt_pk_bf16(y[4], y[5]); w.w = cvt_pk_bf16(y[6], y[7]);
                    *(LAS u32x4*)(kb + c * 136 + 8 * li) = w;
                    w.x = cvt_pk_bf16(y[0] * betav, y[1] * betav); w.y = cvt_pk_bf16(y[2] * betav, y[3] * betav); w.z = cvt_pk_bf16(y[4] * betav, y[5] * betav); w.w = cvt_pk_bf16(y[6] * betav, y[7] * betav);
                    *(LAS u32x4*)(kbb + c * 136 + 8 * li) = w;
                } else {
                    *(LAS f32x4*)(vf + c * 128 + 8 * li) = (f32x4){y[0], y[1], y[2], y[3]}; *(LAS f32x4*)(vf + c * 128 + 8 * li + 4) = (f32x4){y[4], y[5], y[6], y[7]};
                }
            }
        }
    }
    __syncthreads();
    {
        const int l = F.lane, m = l & 15, kg = l >> 4;
#pragma unroll
        for (int i = 0; i < 4; ++i) {
            const int tt = F.wave * 4 + i, which = tt >> 4, mi = (tt >> 2) & 3, ni = tt & 3;
            f32x4 acc = {0.f, 0.f, 0.f, 0.f};
            if (mi >= ni) {
                const LAS bf16* As = which ? qb : kbb;
#pragma unroll
                for (int ks = 0; ks < 4; ++ks) {
                    const bf16x8 a = *(const LAS bf16x8*)(As + (16 * mi + m) * 136 + 32 * ks + 8 * kg);
                    const bf16x8 bb = *(const LAS bf16x8*)(kb + (16 * ni + m) * 136 + 32 * ks + 8 * kg);
                    acc = mfma16(a, bb, acc);
                }
            }
#pragma unroll
            for (int r = 0; r < 4; ++r) {
                const int irow = 16 * mi + 4 * kg + r, jcol = 16 * ni + m;
                const float dec = (irow >= jcol) ? expf(gcs[irow] - gcs[jcol]) : 0.f;
                if (which == 0) Lm[jcol * 64 + irow] = (irow > jcol) ? acc[r] * dec : 0.f;
                else atb[irow * 72 + jcol] = f2bf((irow >= jcol) ? acc[r] * dec : 0.f);
            }
        }
    }
    __syncthreads();
    {
        const float gl = gcs[63];
#pragma unroll
        for (int q = 0; q < 2; ++q) {
            const int idx = tid + 512 * q, l = idx & 63, ks = (idx >> 6) & 1, mt = idx >> 7, m = l & 15, g = l >> 4;
            float e[8];
#pragma unroll
            for (int j = 0; j < 8; ++j) { const int cr = 32 * ks + kperm(g, j); e[j] = kf[cr * 128 + 16 * mt + m] * expf(gl - gcs[cr]); }
            u32x4 w; w.x = cvt_pk_bf16(e[0], e[1]); w.y = cvt_pk_bf16(e[2], e[3]); w.z = cvt_pk_bf16(e[4], e[5]); w.w = cvt_pk_bf16(e[6], e[7]);
            *(u32x4*)(rec + REC_KDT + (size_t)idx * 16) = w;
        }
        {
            const int idx = tid, l = idx & 63, ks = (idx >> 6) & 1, mt = idx >> 7, m = l & 15, g = l >> 4;
            const u32x2 a0 = *(const LAS u32x2*)(atb + (16 * mt + m) * 72 + 32 * ks + 4 * g), a1 = *(const LAS u32x2*)(atb + (16 * mt + m) * 72 + 32 * ks + 16 + 4 * g);
            *(u32x4*)(rec + REC_ATTN + (size_t)idx * 16) = (u32x4){a0.x, a0.y, a1.x, a1.y};
        }
    }
    __syncthreads();
    if (tid < 256) {
        const int c = tid; const bool isw = c >= 128;
        LAS float* base = isw ? (kf + (c - 128)) : (vf + c);
#pragma unroll
        for (int ib = 0; ib < 4; ++ib) {
            float r[16];
#pragma unroll
            for (int ii = 0; ii < 16; ++ii) { const int i = 16 * ib + ii; r[ii] = base[i * 128] * gcs[64 + i] * (isw ? gcs[128 + i] : 1.0f); }
            for (int j = 0; j < 16 * ib; ++j) {
                const float xj = base[j * 128];
                const LAS f32x4* lp = (const LAS f32x4*)(Lm + j * 64 + 16 * ib);
                const f32x4 l0 = lp[0], l1 = lp[1], l2 = lp[2], l3 = lp[3];
                r[0] -= l0[0] * xj; r[1] -= l0[1] * xj; r[2] -= l0[2] * xj; r[3] -= l0[3] * xj;
                r[4] -= l1[0] * xj; r[5] -= l1[1] * xj; r[6] -= l1[2] * xj; r[7] -= l1[3] * xj;
                r[8] -= l2[0] * xj; r[9] -= l2[1] * xj; r[10] -= l2[2] * xj; r[11] -= l2[3] * xj;
                r[12] -= l3[0] * xj; r[13] -= l3[1] * xj; r[14] -= l3[2] * xj; r[15] -= l3[3] * xj;
            }
#pragma unroll
            for (int jj = 0; jj < 15; ++jj) {
                const LAS f32x4* lp = (const LAS f32x4*)(Lm + (16 * ib + jj) * 64 + 16 * ib);
#pragma unroll
                for (int q = 0; q < 4; ++q) {
                    if (4 * q + 3 > jj) {
                        const f32x4 lv = lp[q];
#pragma unroll
                        for (int e = 0; e < 4; ++e) if (4 * q + e > jj) r[4 * q + e] -= lv[e] * r[jj];
                    }
                }
            }
#pragma unroll
            for (int ii = 0; ii < 16; ++ii) base[(16 * ib + ii) * 128] = r[ii];
        }
    }
    __syncthreads();
    {
#pragma unroll
        for (int q = 0; q < 4; ++q) {
            const int idx = tid + 512 * q, l = idx & 63, mt = (idx >> 6) & 3, sl = idx >> 8, g4 = l >> 4, nn = l & 15;
            const LAS float* up = vf + (16 * mt + 4 * g4) * 128 + 16 * sl + nn;
            u32x2 d; d.x = cvt_pk_bf16(up[0], up[128]); d.y = cvt_pk_bf16(up[256], up[384]);
            *(u32x2*)(rec + REC_U + (size_t)idx * 8) = d;
        }
#pragma unroll
        for (int q = 0; q < 2; ++q) {
            const int idx = tid + 512 * q, l = idx & 63, ks = (idx >> 6) & 3, mt = idx >> 8, m = l & 15, g = l >> 4;
            const f32x4 a0 = *(const LAS f32x4*)(kf + (16 * mt + m) * 128 + 32 * ks + 4 * g), a1 = *(const LAS f32x4*)(kf + (16 * mt + m) * 128 + 32 * ks + 16 + 4 * g);
            u32x4 w; w.x = cvt_pk_bf16(-a0[0], -a0[1]); w.y = cvt_pk_bf16(-a0[2], -a0[3]); w.z = cvt_pk_bf16(-a1[0], -a1[1]); w.w = cvt_pk_bf16(-a1[2], -a1[3]);
            *(u32x4*)(rec + REC_WNEG + (size_t)idx * 16) = w;
        }
    }
    __syncthreads();
}

__device__ __forceinline__ bf16x8 acc2frag(const f32x4& lo, const f32x4& hi) {
    u32x4 w; w.x = cvt_pk_bf16(lo[0], lo[1]); w.y = cvt_pk_bf16(lo[2], lo[3]); w.z = cvt_pk_bf16(hi[0], hi[1]); w.w = cvt_pk_bf16(hi[2], hi[3]);
    return __builtin_bit_cast(bf16x8, w);
}
__device__ __forceinline__ void gdn_scan(const Frame& F, int bh) {
    const int tid = F.tid, lane = F.lane, s = F.wave;
    const int b = bh >> 2, h = bh & 3;
    LAS unsigned char* buf0 = F.lds; LAS float* ox = (LAS float*)(F.lds + 2 * REC_LDS_BYTES);
    const float* glast = (const float*)(F.ws + WS_GLAST);
    const bf16* gz = (const bf16*)(F.ws + WS_GZ); const float* gnw = F.in[6]; bf16* mix = (bf16*)(F.ws + WS_MIX);
    f32x4 S[8];
#pragma unroll
    for (int t = 0; t < 8; ++t) S[t] = (f32x4){0.f, 0.f, 0.f, 0.f};
    const unsigned char* const recbase = F.ws + WS_GREC + (size_t)(b * 512 + h) * GREC_BYTES;
#define recp(n) (recbase + (size_t)(n) * 4 * GREC_BYTES)
#define GS_STAGE(n, bufsel) do { const unsigned char* _r = recp(n); _Pragma("unroll") for (int _i = 0; _i < 7; ++_i) \
        __builtin_amdgcn_global_load_lds((const unsigned*)(_r + (size_t)(_i * 512 + tid) * 16), (LAS unsigned*)(buf0 + (bufsel) * REC_LDS_BYTES + (_i * 8 + s) * 1024), 16, 0, 0); } while (0)
    GS_STAGE(0, 0);
    u32x2 un[4];
#pragma unroll
    for (int mt = 0; mt < 4; ++mt) un[mt] = *(const u32x2*)(recp(0) + REC_U + (size_t)((s * 4 + mt) * 64 + lane) * 8);
    float egn = glast[(b * 128 + 0) * 4 + h];
    for (int n = 0; n < 128; ++n) {
        const int cur = n & 1;
        asm volatile("s_waitcnt vmcnt(0)" ::: "memory");
        __syncthreads();
        u32x2 uc[4];
#pragma unroll
        for (int mt = 0; mt < 4; ++mt) uc[mt] = un[mt];
        const float egl = egn;
        if (n + 1 < 128) {
            GS_STAGE(n + 1, cur ^ 1);
#pragma unroll
            for (int mt = 0; mt < 4; ++mt) un[mt] = *(const u32x2*)(recp(n + 1) + REC_U + (size_t)((s * 4 + mt) * 64 + lane) * 8);
            egn = glast[(b * 128 + n + 1) * 4 + h];
        }
        const LAS unsigned char* bp = buf0 + cur * REC_LDS_BYTES + lane * 16;
        bf16x8 Sb[4];
#pragma unroll
        for (int ks = 0; ks < 4; ++ks) Sb[ks] = acc2frag(S[2 * ks], S[2 * ks + 1]);
        f32x4 vn[4], o[4];
#pragma unroll
        for (int mt = 0; mt < 4; ++mt) {
            vn[mt] = (f32x4){__uint_as_float(uc[mt].x << 16), __uint_as_float(uc[mt].x & 0xffff0000u), __uint_as_float(uc[mt].y << 16), __uint_as_float(uc[mt].y & 0xffff0000u)};
#pragma unroll
            for (int ks = 0; ks < 4; ++ks) vn[mt] = mfma16(*(const LAS bf16x8*)(bp + REC_WNEG + (mt * 4 + ks) * 1024), Sb[ks], vn[mt]);
        }
        bf16x8 Vb[2];
#pragma unroll
        for (int ks = 0; ks < 2; ++ks) Vb[ks] = acc2frag(vn[2 * ks], vn[2 * ks + 1]);
#pragma unroll
        for (int mt = 0; mt < 4; ++mt) {
            o[mt] = (f32x4){0.f, 0.f, 0.f, 0.f};
#pragma unroll
            for (int ks = 0; ks < 4; ++ks) o[mt] = mfma16(*(const LAS bf16x8*)(bp + REC_QDEC + (mt * 4 + ks) * 1024), Sb[ks], o[mt]);
#pragma unroll
            for (int ks = 0; ks < 2; ++ks) o[mt] = mfma16(*(const LAS bf16x8*)(bp + REC_ATTN + (mt * 2 + ks) * 1024), Vb[ks], o[mt]);
        }
#pragma unroll
        for (int t = 0; t < 8; ++t) {
            S[t] = S[t] * egl;
#pragma unroll
            for (int ks = 0; ks < 2; ++ks) S[t] = mfma16(*(const LAS bf16x8*)(bp + REC_KDT + (t * 2 + ks) * 1024), Vb[ks], S[t]);
        }
        {
            const int g4 = lane >> 4, nn = lane & 15;
#pragma unroll
            for (int mt = 0; mt < 4; ++mt)
#pragma unroll
                for (int r = 0; r < 4; ++r) ox[(16 * mt + 4 * g4 + r) * 132 + 16 * s + nn] = o[mt][r];
        }
        __syncthreads();
        {
            const int row = tid >> 3, part = tid & 7; const int tok = b * SEQ + n * 64 + row;
            float v[16]; float ss = 0.f;
#pragma unroll
            for (int q = 0; q < 4; ++q) { const f32x4 t4 = *(const LAS f32x4*)(ox + row * 132 + 16 * part + 4 * q); v[4 * q] = t4[0]; v[4 * q + 1] = t4[1]; v[4 * q + 2] = t4[2]; v[4 * q + 3] = t4[3]; }
#pragma unroll
            for (int e = 0; e < 16; ++e) ss += v[e] * v[e];
            ss += __shfl_xor(ss, 1); ss += __shfl_xor(ss, 2); ss += __shfl_xor(ss, 4);
            const float rs = rsqrtf(ss * (1.0f / 128.f) + EPS);
            const u32x4 z0 = *(const u32x4*)(gz + (size_t)tok * 512 + h * 128 + 16 * part), z1 = *(const u32x4*)(gz + (size_t)tok * 512 + h * 128 + 16 * part + 8);
            const unsigned zz[8] = {z0.x, z0.y, z0.z, z0.w, z1.x, z1.y, z1.z, z1.w};
            unsigned ow[8];
#pragma unroll
            for (int e = 0; e < 8; ++e) {
                const float w0 = gnw[16 * part + 2 * e], w1 = gnw[16 * part + 2 * e + 1];
                ow[e] = cvt_pk_bf16(v[2 * e] * rs * w0 * __uint_as_float(zz[e] << 16), v[2 * e + 1] * rs * w1 * __uint_as_float(zz[e] & 0xffff0000u));
            }
            bf16* mp = mix + (size_t)tok * DM + h * 128 + 16 * part;
            *(u32x4*)mp = (u32x4){ow[0], ow[1], ow[2], ow[3]}; *(u32x4*)(mp + 8) = (u32x4){ow[4], ow[5], ow[6], ow[7]};
        }
    }
#undef GS_STAGE
#undef recp
    asm volatile("s_waitcnt vmcnt(0)" ::: "memory");
    __syncthreads();
}
__device__ __forceinline__ int pos32(int key) { return (key & ~31) | (8 * ((key >> 2) & 3) + 4 * ((key >> 4) & 1) + (key & 3)); }
__device__ __forceinline__ void compress_wave(const Frame& F, int wt) {
    const int which = wt >> 8, bhk = (wt >> 5) & 7, rt = wt & 31, b = bhk >> 1, hk = bhk & 1;
    const int l = F.lane, n = l & 15, kg = l >> 4;
    const bf16* nkv = (const bf16*)(F.ws + WS_NKV);
    const bf16* w1f = (const bf16*)(F.ws + (which ? WS_W1FV : WS_W1FK)); const bf16* w2f = (const bf16*)(F.ws + (which ? WS_W2FV : WS_W2FK));
    const float* cpe = (const float*)(F.ws + WS_CPE) + which * 128;
    const int nc = 16 * rt + n;
    f32x4 acc[8];
#pragma unroll
    for (int t = 0; t < 8; ++t) acc[t] = (f32x4){0.f, 0.f, 0.f, 0.f};
    for (int ks = 0; ks < 64; ++ks) {
        int tok = 16 * nc + (ks >> 1); tok = tok < SEQ ? tok : SEQ - 1;
        const bf16x8 bfrag = *(const bf16x8*)(nkv + (size_t)(b * SEQ + tok) * 768 + which * 128 + hk * 64 + (ks & 1) * 32 + 8 * kg);
#pragma unroll
        for (int mt = 0; mt < 8; ++mt) acc[mt] = mfma16(*(const bf16x8*)(w1f + ((size_t)(ks * 8 + mt) * 64 + l) * 8), bfrag, acc[mt]);
    }
#pragma unroll
    for (int mt = 0; mt < 8; ++mt)
#pragma unroll
        for (int r = 0; r < 4; ++r) acc[mt][r] = siluf_(acc[mt][r] + cpe[16 * mt + 4 * kg + r]);
    f32x4 o[4];
#pragma unroll
    for (int mt = 0; mt < 4; ++mt) {
        o[mt] = (f32x4){0.f, 0.f, 0.f, 0.f};
#pragma unroll
        for (int ks = 0; ks < 4; ++ks) {
            u32x4 w; w.x = cvt_pk_bf16(acc[2 * ks][0], acc[2 * ks][1]); w.y = cvt_pk_bf16(acc[2 * ks][2], acc[2 * ks][3]); w.z = cvt_pk_bf16(acc[2 * ks + 1][0], acc[2 * ks + 1][1]); w.w = cvt_pk_bf16(acc[2 * ks + 1][2], acc[2 * ks + 1][3]);
            o[mt] = mfma16(*(const bf16x8*)(w2f + ((size_t)(mt * 4 + ks) * 64 + l) * 8), __builtin_bit_cast(bf16x8, w), o[mt]);
        }
    }
    const bool valid = nc < 511;
    if (which == 0) {
        bf16* kc = (bf16*)(F.ws + WS_KCMP) + ((size_t)bhk * 512 + nc) * 64;
#pragma unroll
        for (int mt = 0; mt < 4; ++mt) { u32x2 d; d.x = valid ? cvt_pk_bf16(o[mt][0], o[mt][1]) : 0u; d.y = valid ? cvt_pk_bf16(o[mt][2], o[mt][3]) : 0u; *(u32x2*)(kc + 16 * mt + 4 * kg) = d; }
    } else {
        bf16* vt = (bf16*)(F.ws + WS_VCMPT) + (size_t)bhk * 64 * 512 + pos32(nc);
#pragma unroll
        for (int mt = 0; mt < 4; ++mt)
#pragma unroll
            for (int r = 0; r < 4; ++r) vt[(size_t)(16 * mt + 4 * kg + r) * 512] = valid ? f2bf(o[mt][r]) : (unsigned short)0;
    }
}
__device__ __forceinline__ void vtranspose_task(const Frame& F, int task) {
    const int which = task >> 8, bhk = (task >> 5) & 7, tg = task & 31, b = bhk >> 1, hk = bhk & 1;
    const bf16* nkv = (const bf16*)(F.ws + WS_NKV); bf16* dst = (bf16*)(F.ws + (which ? WS_VWT : WS_VST)) + (size_t)bhk * 64 * SEQ;
    LAS bf16* tile = (LAS bf16*)F.lds;
    for (int sub = 0; sub < 4; ++sub) {
        const int t0 = tg * 256 + sub * 64;
        { const int tk = F.tid >> 3, dc = F.tid & 7;
          const u32x4 v = *(const u32x4*)(nkv + (size_t)(b * SEQ + t0 + tk) * 768 + 384 + which * 256 + hk * 64 + 8 * dc);
          const unsigned vv[4] = {v.x, v.y, v.z, v.w};
#pragma unroll
          for (int e = 0; e < 4; ++e) { tile[(8 * dc + 2 * e) * 72 + pos32(tk)] = (unsigned short)(vv[e] & 0xffffu); tile[(8 * dc + 2 * e + 1) * 72 + pos32(tk)] = (unsigned short)(vv[e] >> 16); } }
        __syncthreads();
        { const int d = F.tid >> 3, tc = F.tid & 7;
          *(u32x4*)(dst + (size_t)d * SEQ + t0 + 8 * tc) = *(const LAS u32x4*)(tile + d * 72 + 8 * tc); }
        __syncthreads();
    }
}

constexpr int NL_BT = 0, NL_IMP = 16448, NL_MASK = 49728, NL_SMASK = 50752, NL_KV = 51200, NL_NXT = 83968, NL_TOT = 84992;
constexpr int TM_C1 = 0, TM_C2 = 1, TM_SD = 2, TM_SS = 3, TM_W = 4;
struct Stage { u32x4 k, v; };
__device__ __forceinline__ void stage_issue(Stage& st, const bf16* Kb, int kstride, const bf16* VT, int vlen, int key0, bool needV, int tid) {
    const int row = tid >> 3, ch = tid & 7;
    st.k = *(const u32x4*)(Kb + (size_t)(key0 + row) * kstride + 8 * ch);
    if (needV) st.v = *(const u32x4*)(VT + (size_t)row * vlen + key0 + 8 * ch);
}
__device__ __forceinline__ void stage_commit(const Stage& st, LAS unsigned char* buf, bool needV, int tid) {
    const int row = tid >> 3, ch = tid & 7; const int off = row * 128 + ((ch ^ (row & 7)) << 4);
    *(LAS u32x4*)(buf + off) = st.k;
    if (needV) *(LAS u32x4*)(buf + 8192 + off) = st.v;
}
__device__ __forceinline__ bf16x8 tile_frag(const LAS unsigned char* buf, int row, int chunk) { return *(const LAS bf16x8*)(buf + row * 128 + ((chunk ^ (row & 7)) << 4)); }

struct SlotState { f32x4 O[4]; float m, l; };
template <int MODE>
__device__ __forceinline__ void slot_tile(const bf16x8 (&kf)[4][2], const LAS unsigned char* vb0, const LAS unsigned char* vb1, const bf16x8 (&q)[2], int key0, int trow, const LAS float* bt, SlotState& A,
                                          float linv, float mrow, bool nearb, LAS float* imp_row, int lane) {
    const int kg = lane >> 4;
    f32x4 s[4];
#pragma unroll
    for (int mt = 0; mt < 4; ++mt) { s[mt] = mfma16(kf[mt][0], q[0], (f32x4){0.f, 0.f, 0.f, 0.f}); s[mt] = mfma16(kf[mt][1], q[1], s[mt]); }
    if (MODE == TM_SS) {
        if (nearb) {
#pragma unroll
            for (int mt = 0; mt < 4; ++mt)
#pragma unroll
                for (int r = 0; r < 4; ++r) { int d = trow - (key0 + 16 * mt + 4 * kg + r); d = d > 1024 ? 1024 : d; s[mt][r] += bt[d]; }
        }
        float ps = 0.f;
#pragma unroll
        for (int mt = 0; mt < 4; ++mt)
#pragma unroll
            for (int r = 0; r < 4; ++r) { const float p = __builtin_amdgcn_exp2f(s[mt][r] - mrow); s[mt][r] = p; ps += p; }
        ps += __shfl_xor(ps, 16); ps += __shfl_xor(ps, 32);
        A.l += ps;
    } else {
        float tmax = -1e30f;
#pragma unroll
        for (int mt = 0; mt < 4; ++mt)
#pragma unroll
            for (int r = 0; r < 4; ++r) {
                const int key = key0 + 16 * mt + 4 * kg + r;
                const int dist = (MODE == TM_C1 || MODE == TM_C2) ? trow - (16 * key + 31) : trow - key;
                const bool ok = (MODE == TM_W) ? (dist >= 0 && dist < 512) : (dist >= 0);
                const int di = dist < 0 ? 0 : (dist > 1024 ? 1024 : dist);
                s[mt][r] = ok ? s[mt][r] + bt[di] : -1e30f;
                tmax = fmaxf(tmax, s[mt][r]);
            }
        if (MODE == TM_C2) {
#pragma unroll
            for (int mt = 0; mt < 4; ++mt)
#pragma unroll
                for (int r = 0; r < 4; ++r) s[mt][r] = __builtin_amdgcn_exp2f(s[mt][r] - A.m) * linv;
            const int g = lane & 3;
#pragma unroll
            for (int mt = 0; mt < 4; ++mt) {
                float gsum = s[mt][0] + s[mt][1] + s[mt][2] + s[mt][3], lv = s[mt][3];
                gsum += __shfl_xor(gsum, 1); gsum += __shfl_xor(gsum, 2); lv += __shfl_xor(lv, 1); lv += __shfl_xor(lv, 2);
                const int j = (key0 >> 2) + 4 * mt + kg;
                if (g == 0) { atomicAdd((float*)(imp_row + j), gsum); atomicAdd((float*)(imp_row + j + 1), lv); }
            }
        } else {
            tmax = fmaxf(tmax, __shfl_xor(tmax, 16)); tmax = fmaxf(tmax, __shfl_xor(tmax, 32));
            const float mnew = fmaxf(A.m, tmax), msafe = fmaxf(mnew, -1e29f), alpha = __builtin_amdgcn_exp2f(A.m - msafe);
            float ps = 0.f;
#pragma unroll
            for (int mt = 0; mt < 4; ++mt)
#pragma unroll
                for (int r = 0; r < 4; ++r) { const float p = __builtin_amdgcn_exp2f(s[mt][r] - msafe); s[mt][r] = p; ps += p; }
            ps += __shfl_xor(ps, 16); ps += __shfl_xor(ps, 32);
            A.l = A.l * alpha + ps; A.m = mnew;
            if (MODE != TM_C1) {
#pragma unroll
                for (int t = 0; t < 4; ++t) A.O[t] = A.O[t] * alpha;
            }
        }
    }
    if (MODE != TM_C1) {
        bf16x8 pf[2];
#pragma unroll
        for (int k2 = 0; k2 < 2; ++k2) {
            u32x4 w; w.x = cvt_pk_bf16(s[2 * k2][0], s[2 * k2][1]); w.y = cvt_pk_bf16(s[2 * k2][2], s[2 * k2][3]); w.z = cvt_pk_bf16(s[2 * k2 + 1][0], s[2 * k2 + 1][1]); w.w = cvt_pk_bf16(s[2 * k2 + 1][2], s[2 * k2 + 1][3]);
            pf[k2] = __builtin_bit_cast(bf16x8, w);
        }
#pragma unroll
        for (int t = 0; t < 4; ++t) { A.O[t] = mfma16(*(const LAS bf16x8*)(vb0 + t * 2048), pf[0], A.O[t]); A.O[t] = mfma16(*(const LAS bf16x8*)(vb1 + t * 2048), pf[1], A.O[t]); }
    }
}

__device__ __forceinline__ void nsa_item(const Frame& F, int item) {
    const int bhk = item & 7, cb = 127 - (item >> 3), b = bhk >> 1, hk = bhk & 1;
    const int tid = F.tid, lane = F.lane, wave = F.wave, n = lane & 15, ts = n >> 2, g = n & 3, kg = lane >> 4;
    const bf16* nq = (const bf16*)(F.ws + WS_NQ); const bf16* nkv = (const bf16*)(F.ws + WS_NKV) + (size_t)b * SEQ * 768;
    const bf16* kcmp = (const bf16*)(F.ws + WS_KCMP) + (size_t)bhk * 512 * 64; const bf16* vcmpt = (const bf16*)(F.ws + WS_VCMPT) + (size_t)bhk * 64 * 512;
    const bf16* vst = (const bf16*)(F.ws + WS_VST) + (size_t)bhk * 64 * SEQ; const bf16* vwt = (const bf16*)(F.ws + WS_VWT) + (size_t)bhk * 64 * SEQ;
    const float* small = (const float*)(F.ws + WS_SMALL); const bf16* nz = (const bf16*)(F.ws + WS_NZ); bf16* mix = (bf16*)(F.ws + WS_MIX);
    LAS float* btl = (LAS float*)(F.lds + NL_BT); LAS float* imp = (LAS float*)(F.lds + NL_IMP);
    LAS unsigned* maskw = (LAS unsigned*)(F.lds + NL_MASK); LAS unsigned* smaskw = (LAS unsigned*)(F.lds + NL_SMASK);
    LAS unsigned char* kvb = F.lds + NL_KV;
    const LAS float* bt = btl + g * 1028;
    { const float* btg = (const float*)(F.ws + WS_BT) + (size_t)(hk * 4) * 1025;
      for (int i = tid; i < 4 * 1025; i += 512) { const int hh = i / 1025, d = i - hh * 1025; btl[hh * 1028 + d] = btg[i]; }
      for (int i = lane; i < 8 * 130; i += 64) imp[wave * 8 * 130 + i] = 0.f; }
    const int tw0 = cb * 64 + wave * 8;
    int trow[2]; size_t tokg[2]; bf16x8 q[2][2];
    LAS float* totp = (LAS float*)(F.lds + NL_TOT) + ((wave * 8 + ts) * 4 + g) * 68 + 4 * kg;
#pragma unroll
    for (int sl = 0; sl < 2; ++sl) {
        trow[sl] = tw0 + 4 * sl + ts; tokg[sl] = (size_t)b * SEQ + trow[sl];
        const bf16* qp = nq + tokg[sl] * 512 + (hk * 4 + g) * 64 + 8 * kg;
        q[sl][0] = *(const bf16x8*)qp; q[sl][1] = *(const bf16x8*)(qp + 32);
    }
    SlotState A[2];
    Stage st;
    bf16x8 kf[4][2];
    const int fb0 = n * 128 + ((kg ^ (n & 7)) << 4), fb1 = n * 128 + (((4 + kg) ^ (n & 7)) << 4);
#define NS_LOADK(buf) do { _Pragma("unroll") for (int _mt = 0; _mt < 4; ++_mt) { kf[_mt][0] = *(const LAS bf16x8*)((buf) + fb0 + _mt * 2048); kf[_mt][1] = *(const LAS bf16x8*)((buf) + fb1 + _mt * 2048); } } while (0)
#define NS_LOADV(buf) do { _Pragma("unroll") for (int _t = 0; _t < 4; ++_t) _Pragma("unroll") for (int _ks = 0; _ks < 2; ++_ks) vf[_t][_ks] = tile_frag((buf) + 8192, 16 * _t + n, 4 * _ks + kg); } while (0)
#define NS_RESET() do { _Pragma("unroll") for (int _s = 0; _s < 2; ++_s) { A[_s].m = -1e30f; A[_s].l = 0.f; _Pragma("unroll") for (int _t = 0; _t < 4; ++_t) A[_s].O[_t] = (f32x4){0.f, 0.f, 0.f, 0.f}; } } while (0)
#define NS_PIPE(NT, KEY0, KB, KSTR, VTB, VLEN, NEEDV, ...) do { \
        const int _nt = (NT); \
        stage_issue(st, KB, KSTR, VTB, VLEN, KEY0(0), NEEDV, tid); stage_commit(st, kvb, NEEDV, tid); __syncthreads(); \
        for (int ti = 0; ti < _nt; ++ti) { \
            const LAS unsigned char* cbuf = kvb + (ti & 1) * 16384; \
            if (ti + 1 < _nt) stage_issue(st, KB, KSTR, VTB, VLEN, KEY0(ti + 1), NEEDV, tid); \
            __VA_ARGS__ \
            if (ti + 1 < _nt) stage_commit(st, kvb + ((ti + 1) & 1) * 16384, NEEDV, tid); \
            __syncthreads(); \
        } } while (0)
    __syncthreads();
    const int ntc = ((4 * cb + 2) >> 6) + 1;
#define KEY0_LIN(i) (64 * (i))
    NS_RESET();
    NS_PIPE(ntc, KEY0_LIN, kcmp, 64, vcmpt, 512, false, {
        NS_LOADK(cbuf);
        slot_tile<TM_C1>(kf, cbuf + 8192 + fb0, cbuf + 8192 + fb1, q[0], 64 * ti, trow[0], bt, A[0], 0.f, 0.f, false, nullptr, lane);
        slot_tile<TM_C1>(kf, cbuf + 8192 + fb0, cbuf + 8192 + fb1, q[1], 64 * ti, trow[1], bt, A[1], 0.f, 0.f, false, nullptr, lane);
    });
    {
        const float li0 = A[0].l > 0.f ? 1.0f / A[0].l : 0.f, li1 = A[1].l > 0.f ? 1.0f / A[1].l : 0.f;
        NS_PIPE(ntc, KEY0_LIN, kcmp, 64, vcmpt, 512, true, {
            NS_LOADK(cbuf);
            slot_tile<TM_C2>(kf, cbuf + 8192 + fb0, cbuf + 8192 + fb1, q[0], 64 * ti, trow[0], bt, A[0], li0, 0.f, false, imp + (wave * 8 + ts) * 130, lane);
            slot_tile<TM_C2>(kf, cbuf + 8192 + fb0, cbuf + 8192 + fb1, q[1], 64 * ti, trow[1], bt, A[1], li1, 0.f, false, imp + (wave * 8 + 4 + ts) * 130, lane);
        });
#pragma unroll
        for (int sl = 0; sl < 2; ++sl) { const float gate = small[tokg[sl] * 32 + 8 + hk * 4 + g];
#pragma unroll
            for (int t = 0; t < 4; ++t) *(LAS f32x4*)(totp + sl * 16 * 68 + 16 * t) = A[sl].O[t] * gate; }
    }
#pragma unroll
    for (int sl = 0; sl < 2; ++sl) {
        const int tsl = lane >> 4, i = lane & 15; const int tk = wave * 8 + 4 * sl + tsl;
        unsigned mw0 = 0u, mw1 = 0u, mw2 = 0u, mw3 = 0u;
#define NS_SETBIT(j) do { const unsigned _b = 1u << ((j) & 31); const int _w = (j) >> 5; mw0 |= _w == 0 ? _b : 0u; mw1 |= _w == 1 ? _b : 0u; mw2 |= _w == 2 ? _b : 0u; mw3 |= _w == 3 ? _b : 0u; } while (0)
        if (cb <= 15) { mw0 = (2u << cb) - 1u; }
        else {
            float val[8];
#pragma unroll
            for (int qq = 0; qq < 8; ++qq) { const int j = i + 16 * qq; val[qq] = (j >= 1 && j <= cb - 2) ? imp[tk * 130 + j] : -1.0f; }
            NS_SETBIT(0); NS_SETBIT(cb - 1); NS_SETBIT(cb);
            for (int round = 0; round < 13; ++round) {
                float bv = -2.0f; int bj = 1 << 20;
#pragma unroll
                for (int qq = 0; qq < 8; ++qq) if (val[qq] > bv) { bv = val[qq]; bj = i + 16 * qq; }
#pragma unroll
                for (int off = 1; off < 16; off <<= 1) {
                    const float ov = __shfl_xor(bv, off); const int oj = __shfl_xor(bj, off);
                    if (ov > bv || (ov == bv && oj < bj)) { bv = ov; bj = oj; }
                }
#pragma unroll
                for (int qq = 0; qq < 8; ++qq) if (bj == i + 16 * qq) val[qq] = -3.0f;
                NS_SETBIT(bj);
            }
        }
        if (i == 0) { maskw[tk * 4 + 0] = mw0; maskw[tk * 4 + 1] = mw1; maskw[tk * 4 + 2] = mw2; maskw[tk * 4 + 3] = mw3; }
        mw0 |= __shfl_xor(mw0, 16); mw0 |= __shfl_xor(mw0, 32); mw1 |= __shfl_xor(mw1, 16); mw1 |= __shfl_xor(mw1, 32);
        mw2 |= __shfl_xor(mw2, 16); mw2 |= __shfl_xor(mw2, 32); mw3 |= __shfl_xor(mw3, 16); mw3 |= __shfl_xor(mw3, 32);
        if (lane == 0) { const int so = (wave * 2 + sl) * 4; smaskw[so] = mw0; smaskw[so + 1] = mw1; smaskw[so + 2] = mw2; smaskw[so + 3] = mw3; }
    }
    {
#define KEY0_SEL(i) (64 * (cb == 0 ? 0 : (cb == 1 ? 1 - (i) : ((i) == 0 ? cb : ((i) == 1 ? cb - 1 : ((i) == 2 ? 0 : (i) - 2))))))
        NS_RESET();
        const int tk0 = wave * 8 + ts;
        NS_PIPE(cb + 1, KEY0_SEL, nkv + 256 + hk * 64, 768, vst, SEQ, true, {
            const int key0 = KEY0_SEL(ti); const int j = key0 >> 6;
            const bool dense = (cb < 2) || (ti < 3);
            if (dense) {
                NS_LOADK(cbuf);
                slot_tile<TM_SD>(kf, cbuf + 8192 + fb0, cbuf + 8192 + fb1, q[0], key0, trow[0], bt, A[0], 0.f, 0.f, false, nullptr, lane);
                slot_tile<TM_SD>(kf, cbuf + 8192 + fb0, cbuf + 8192 + fb1, q[1], key0, trow[1], bt, A[1], 0.f, 0.f, false, nullptr, lane);
            } else {
                const unsigned sm0 = __builtin_amdgcn_readfirstlane(smaskw[(wave * 2 + 0) * 4 + (j >> 5)]), sm1 = __builtin_amdgcn_readfirstlane(smaskw[(wave * 2 + 1) * 4 + (j >> 5)]);
                const bool a0 = (sm0 >> (j & 31)) & 1u, a1 = (sm1 >> (j & 31)) & 1u;
                if (a0 || a1) {
                    NS_LOADK(cbuf);
                    const bool nearb = (cb - j) < 14;
                    const float bfar = nearb ? 0.f : bt[1024];
                    if (a0) { const bool selr = (maskw[tk0 * 4 + (j >> 5)] >> (j & 31)) & 1u;
                        slot_tile<TM_SS>(kf, cbuf + 8192 + fb0, cbuf + 8192 + fb1, q[0], key0, trow[0], bt, A[0], 0.f, selr ? A[0].m - bfar : 1e30f, nearb, nullptr, lane); }
                    if (a1) { const bool selr = (maskw[(tk0 + 4) * 4 + (j >> 5)] >> (j & 31)) & 1u;
                        slot_tile<TM_SS>(kf, cbuf + 8192 + fb0, cbuf + 8192 + fb1, q[1], key0, trow[1], bt, A[1], 0.f, selr ? A[1].m - bfar : 1e30f, nearb, nullptr, lane); }
                }
            }
        });
#pragma unroll
        for (int sl = 0; sl < 2; ++sl) { const float gate = small[tokg[sl] * 32 + 16 + hk * 4 + g]; const float sc = A[sl].l > 0.f ? gate / A[sl].l : 0.f;
#pragma unroll
            for (int t = 0; t < 4; ++t) { LAS f32x4* tp = (LAS f32x4*)(totp + sl * 16 * 68 + 16 * t); *tp = *tp + A[sl].O[t] * sc; } }
    }
    {
        const int jw0 = cb >= 8 ? cb - 8 : 0;
#define KEY0_WIN(i) (64 * (jw0 + (i)))
        NS_RESET();
        NS_PIPE(cb - jw0 + 1, KEY0_WIN, nkv + 512 + hk * 64, 768, vwt, SEQ, true, {
            NS_LOADK(cbuf);
            slot_tile<TM_W>(kf, cbuf + 8192 + fb0, cbuf + 8192 + fb1, q[0], KEY0_WIN(ti), trow[0], bt, A[0], 0.f, 0.f, false, nullptr, lane);
            slot_tile<TM_W>(kf, cbuf + 8192 + fb0, cbuf + 8192 + fb1, q[1], KEY0_WIN(ti), trow[1], bt, A[1], 0.f, 0.f, false, nullptr, lane);
        });
#pragma unroll
        for (int sl = 0; sl < 2; ++sl) { const float gate = small[tokg[sl] * 32 + 24 + hk * 4 + g]; const float sc = A[sl].l > 0.f ? gate / A[sl].l : 0.f;
#pragma unroll
            for (int t = 0; t < 4; ++t) { LAS f32x4* tp = (LAS f32x4*)(totp + sl * 16 * 68 + 16 * t); *tp = *tp + A[sl].O[t] * sc; } }
    }
#pragma unroll
    for (int sl = 0; sl < 2; ++sl)
#pragma unroll
        for (int t = 0; t < 4; ++t) {
            const size_t off = tokg[sl] * 512 + (hk * 4 + g) * 64 + 16 * t + 4 * kg;
            const u32x2 z = *(const u32x2*)(nz + off);
            const f32x4 tv = *(const LAS f32x4*)(totp + sl * 16 * 68 + 16 * t);
            u32x2 d; d.x = cvt_pk_bf16(tv[0] * __uint_as_float(z.x << 16), tv[1] * __uint_as_float(z.x & 0xffff0000u));
            d.y = cvt_pk_bf16(tv[2] * __uint_as_float(z.y << 16), tv[3] * __uint_as_float(z.y & 0xffff0000u));
            *(u32x2*)(mix + tokg[sl] * DM + 512 + (hk * 4 + g) * 64 + 16 * t + 4 * kg) = d;
        }
    __syncthreads();
#undef NS_LOADK
#undef NS_LOADV
#undef NS_RESET
#undef NS_PIPE
#undef NS_SETBIT
}
__device__ __forceinline__ void p2_phase(const Frame& F) {
    for (int task = blockIdx.x; task < 2624; task += gridDim.x) {
        if (task < 2048) gdn_prep_item(F, task);
        else if (task < 2112) compress_wave(F, (task - 2048) * 8 + F.wave);
        else vtranspose_task(F, task - 2112);
    }
}
__device__ __forceinline__ void p3_phase(const Frame& F) {
    for (int bh = blockIdx.x; bh < 16; bh += gridDim.x) gdn_scan(F, bh);
    unsigned* ctr = (unsigned*)(F.ws + WS_CTL) + 64;
    LAS int* nxt = (LAS int*)(F.lds + NL_NXT);
    for (;;) {
        __syncthreads();
        if (F.tid == 0) *nxt = (int)atomicAdd(ctr, 1u);
        __syncthreads();
        const int item = *nxt;
        if (item >= 1024) break;
        nsa_item(F, item);
    }
}
struct Args { const float* in[16]; float* out; unsigned char* ws; int ph_lo, ph_hi, coop, pad; };
constexpr int N_PHASES = 6;

__global__ void __launch_bounds__(512, 2) hymba_fwd(Args a) {
    extern __shared__ __attribute__((aligned(16))) unsigned char lds_raw[];
    Frame F;
#pragma unroll
    for (int i = 0; i < 16; ++i) F.in[i] = a.in[i];
    F.out = a.out; F.ws = a.ws; F.lds = (LAS unsigned char*)lds_raw; F.ldsg = lds_raw;
    F.tid = threadIdx.x; F.lane = F.tid & 63; F.wave = __builtin_amdgcn_readfirstlane(F.tid >> 6);
    unsigned char* ws = a.ws;
    const int lo = a.ph_lo, hi = a.ph_hi;
#define IN(k) (lo <= (k) && (k) < hi)
#define SEAM(k) do { if (IN(k) && IN((k) + 1)) { if (a.coop) cg::this_grid().sync(); } __syncthreads(); } while (0)
    if (IN(0)) p0_prep(F);
    SEAM(0);
    if (IN(1)) {
        pg8::Gemm g{(const bf16*)(ws + WS_XB), (const bf16*)(ws + WS_WTIN), T_TOK, NPROJ, DM};
        pg8::StaticOrder S; S.init(T_TOK, NPROJ, (int)gridDim.x, (int)blockIdx.x);
        EpiProj E{(bf16*)(ws + WS_GQKV), (bf16*)(ws + WS_GZ), (bf16*)(ws + WS_NQ), (bf16*)(ws + WS_NKV), (bf16*)(ws + WS_NZ), (const float*)(ws + WS_RS)};
        pg8::gemm_phase<EpiProj, pg8::StaticOrder, false>(F.lds, g, S, E, nullptr);
    }
    SEAM(1);
    if (IN(2)) p2_phase(F);
    SEAM(2);
    if (IN(3)) p3_phase(F);
    SEAM(3);
    if (IN(4)) {
        pg8::Gemm g{(const bf16*)(ws + WS_MIX), (const bf16*)(ws + WS_WTOUT), T_TOK, DM, DM};
        pg8::StaticOrder S; S.init(T_TOK, DM, (int)gridDim.x, (int)blockIdx.x);
        EpiOut E{F.in[0], F.out};
        pg8::gemm_phase<EpiOut, pg8::StaticOrder, false>(F.lds, g, S, E, nullptr);
    }
    SEAM(4);
    if (IN(5)) p5_final(F);
#undef IN
#undef SEAM
}

extern "C" void kernel_launch(void* const* d_in, const int* in_sizes, int n_in, void* d_out, int out_size, void* d_ws, size_t ws_size, hipStream_t stream) {
    static int grid = 0;
    if (grid == 0) {
        if (n_in != 16 || in_sizes[0] != T_TOK * DM || out_size != T_TOK * DM || ws_size < WS_END) { fprintf(stderr, "kernel_launch: unexpected shapes (n_in %d, ws %zu)\n", n_in, ws_size); grid = -1; return; }
        int dev = 0, cus = 0, per_cu = 0;
        if (hipGetDevice(&dev) != hipSuccess || hipDeviceGetAttribute(&cus, hipDeviceAttributeMultiprocessorCount, dev) != hipSuccess) { grid = -1; return; }
        if (hipFuncSetAttribute((const void*)hymba_fwd, hipFuncAttributeMaxDynamicSharedMemorySize, LDS_BYTES) != hipSuccess) { fprintf(stderr, "kernel_launch: hipFuncSetAttribute failed\n"); grid = -1; return; }
        if (hipOccupancyMaxActiveBlocksPerMultiprocessor(&per_cu, (const void*)hymba_fwd, 512, LDS_BYTES) != hipSuccess || per_cu < 1) { fprintf(stderr, "kernel_launch: occupancy query says %d\n", per_cu); per_cu = 1; }
        (void)hipGetLastError();
        grid = cus;
    }
    if (grid < 0) return;
    (void)hipMemsetAsync((char*)d_ws + WS_CTL, 0, 1 * MiB, stream);
    Args a{};
    for (int i = 0; i < 16; ++i) a.in[i] = (const float*)d_in[i];
    a.out = (float*)d_out; a.ws = (unsigned char*)d_ws;
#if MK_LAUNCHES == 1
    a.ph_lo = 0; a.ph_hi = N_PHASES; a.coop = 1;
    void* args[] = {&a};
    hipError_t e = hipLaunchCooperativeKernel((const void*)hymba_fwd, dim3(grid), dim3(512), args, LDS_BYTES, stream);
    if (e != hipSuccess) fprintf(stderr, "cooperative launch failed: %s (grid %d)\n", hipGetErrorString(e), grid);
#else
    for (int ph = 0; ph < N_PHASES; ++ph) {
        a.ph_lo = ph; a.ph_hi = ph + 1; a.coop = 0;
        hipLaunchKernelGGL(hymba_fwd, dim3(grid), dim3(512), LDS_BYTES, stream, a);
    }
#endif
}
```

```cpp
#include <hip/hip_runtime.h>
#include <hip/hip_cooperative_groups.h>
#include <cstdio>
#include <cstdint>
namespace cg = cooperative_groups;
#ifndef MK_LAUNCHES
#define MK_LAUNCHES 1
#endif

namespace pg8 {
#define PG8_LAS __attribute__((address_space(3)))
typedef unsigned short bf16_t;
typedef short bf16x8 __attribute__((ext_vector_type(8)));
typedef float f32x4 __attribute__((ext_vector_type(4)));
typedef unsigned u32x4 __attribute__((ext_vector_type(4)));
constexpr int BM = 256, BK = 64, HALF = 128, HTB = HALF * BK * 2  , STAGE_BYTES = 8 * HTB, NXCD = 8, WGM = 8;

__host__ __device__ __forceinline__ int lds_byte(int r, int c) { const int st = (r >> 4) * 2 + (c >> 5), rr = r & 15, cc = c & 31, ob = rr * 64 + cc * 2; return st * 1024 + (ob ^ (((ob >> 9) & 1) << 5)); }
__host__ __device__ __forceinline__ void stage_rc(int b, int& R, int& C) { const int st = b / 1024, sb = b % 1024, swz = sb ^ (((sb >> 9) & 1) << 5); R = (st >> 1) * 16 + swz / 64; C = (st & 1) * 32 + (swz % 64) / 2; }
__host__ __device__ __forceinline__ int perm32(int rho) { const int n = rho >> 4, i = rho & 15; return 8 * (i >> 2) + 4 * n + (i & 3); }

struct Unit { int pm, pn; };
struct Gemm { const bf16_t* A; const bf16_t* Bt; int M, N, K; };

struct StaticOrder {
    int nM, nN, nwg, G, c;
    __host__ __device__ void init(int M, int N, int G_, int c_) { nM = M / BM; nN = N / BM; nwg = nM * nN; G = G_; c = c_; }
    __host__ __device__ bool next(int i, Unit& u) const {
        const long L = (long)i * G + c; if (L >= nwg) return false;
        int wgid = (int)L; { const int q = nwg / NXCD, r = nwg % NXCD, xcd = wgid % NXCD, off = wgid / NXCD; wgid = (xcd < r ? xcd * (q + 1) : r * (q + 1) + (xcd - r) * q) + off; }
        const int nig = WGM * nN, gid = wgid / nig, fm = gid * WGM, gsz = (nM - fm) < WGM ? (nM - fm) : WGM;
        u.pm = fm + ((wgid % nig) % gsz); u.pn = (wgid % nig) / gsz; return true;
    }
    __device__ __forceinline__ void a_ready(const Unit&) const {}
    __device__ __forceinline__ void done(const Unit&) const {}
};
__device__ __forceinline__ unsigned cvt_pk_bf16(float lo, float hi) { unsigned r; asm volatile("v_cvt_pk_bf16_f32 %0, %1, %2" : "=v"(r) : "v"(lo), "v"(hi)); return r; }
typedef float f32x2 __attribute__((ext_vector_type(2)));
template <class Epi, class Sched, bool STAMP = false>
__device__ __forceinline__ void gemm_phase(PG8_LAS unsigned char* lds, const Gemm g, const Sched& S, const Epi& E, unsigned long long* stamps) {
    const int tid = threadIdx.x, wid = __builtin_amdgcn_readfirstlane(tid >> 6), lane = tid & 63, wr = wid >> 2, wc = wid & 3, fr = lane & 15, fq = lane >> 4;
    const int K = g.K, nt = K / BK;
    int ts_lo = 0, ts_hi = 0, nts = 0; const unsigned long long rt_entry = STAMP ? (unsigned long long)wall_clock64() : 0ull;
#define PG8_STAMP() do { if (STAMP && wid == 0 && nts < 64) { const unsigned long long _c = (unsigned long long)clock64(); \
        ts_lo = (lane == nts) ? (int)(unsigned)_c : ts_lo; ts_hi = (lane == nts) ? (int)(unsigned)(_c >> 32) : ts_hi; ++nts; } } while (0)
    PG8_STAMP();
    unsigned voffA[2], voffB[2];
#pragma unroll
    for (int i = 0; i < 2; ++i) { int R, C; stage_rc(tid * 16 + i * 8192, R, C); const int Rb = Epi::PERM ? ((R & ~31) + perm32(R & 31)) : R;
        voffA[i] = (unsigned)(R * K + C) * 2u; voffB[i] = (unsigned)(Rb * K + C) * 2u; }
    const size_t kstep = (size_t)(BK * 2);
    const size_t hstep = (size_t)HALF * K * 2;
    const size_t tstep = 2 * hstep;
    const unsigned ldsw = (unsigned)wid * 1024u;
    const int aoff = lds_byte(wr * 64 + fr, fq * 8), boff = lds_byte(wc * 32 + fr, fq * 8);
#define PG8_SA(b, h) (((b) * 2 + (h)) * HTB)
#define PG8_SB(b, h) ((4 + (b) * 2 + (h)) * HTB)
#define PG8_STAGE(bufoff, gbase, voff) do { _Pragma("unroll") for (int _i = 0; _i < 2; ++_i) \
        __builtin_amdgcn_global_load_lds((const unsigned*)((const char*)(gbase) + (voff)[_i]), (PG8_LAS unsigned*)(lds + (bufoff) + ldsw + _i * 8192), 16, 0, 0); } while (0)
#define PG8_LDA(dst, b, h) do { _Pragma("unroll") for (int m = 0; m < 4; ++m) _Pragma("unroll") for (int k = 0; k < 2; ++k) dst[m][k] = *(const PG8_LAS bf16x8*)(lds + PG8_SA(b, h) + aoff + m * 2048 + k * 1024); } while (0)
#define PG8_LDB(dst, b, h) do { _Pragma("unroll") for (int n = 0; n < 2; ++n) _Pragma("unroll") for (int k = 0; k < 2; ++k) dst[n][k] = *(const PG8_LAS bf16x8*)(lds + PG8_SB(b, h) + boff + n * 2048 + k * 1024); } while (0)
#define PG8_MMA(ai, bj, At, Bt) do { __builtin_amdgcn_s_setprio(1); _Pragma("unroll") for (int m = 0; m < 4; ++m) _Pragma("unroll") for (int n = 0; n < 2; ++n) _Pragma("unroll") for (int k = 0; k < 2; ++k) \
        acc[ai][bj][m][n] = __builtin_amdgcn_mfma_f32_16x16x32_bf16(Bt[n][k], At[m][k], acc[ai][bj][m][n], 0, 0, 0); __builtin_amdgcn_s_setprio(0); } while (0)
#define PG8_WAIT_V(n) asm volatile("s_waitcnt vmcnt(" #n ")" ::: "memory")
#define PG8_WAIT_L(n) asm volatile("s_waitcnt lgkmcnt(" #n ")" ::: "memory")
#define PG8_BAR __builtin_amdgcn_s_barrier()
#define PG8_SCHED __builtin_amdgcn_sched_barrier(0)
    Unit cur, nxt; int ui = 0;
    if (!S.next(0, cur)) return;
    f32x4 acc[2][2][4][2];
#pragma unroll
    for (int a = 0; a < 2; ++a)
#pragma unroll
        for (int b = 0; b < 2; ++b)
#pragma unroll
            for (int m = 0; m < 4; ++m)
#pragma unroll
                for (int n = 0; n < 2; ++n) acc[a][b][m][n] = (f32x4){0.f, 0.f, 0.f, 0.f};
    bf16x8 At[4][2], B0[2][2], B1[2][2];
    const char* cA = (const char*)g.A + (size_t)cur.pm * tstep; const char* cB = (const char*)g.Bt + (size_t)cur.pn * tstep;
    S.a_ready(cur);
    PG8_STAGE(PG8_SB(0, 0), cB, voffB); PG8_STAGE(PG8_SA(0, 0), cA, voffA); PG8_STAGE(PG8_SB(0, 1), cB + hstep, voffB); PG8_STAGE(PG8_SA(0, 1), cA + hstep, voffA);
    if (wr == 1) PG8_BAR;
    PG8_WAIT_V(4); PG8_BAR;
    PG8_STAGE(PG8_SB(1, 0), cB + kstep, voffB); PG8_STAGE(PG8_SA(1, 0), cA + kstep, voffA); PG8_STAGE(PG8_SB(1, 1), cB + hstep + kstep, voffB);
    PG8_WAIT_V(6); PG8_BAR;
    PG8_STAMP();
    for (;;) {
        const bool has_next = S.next(ui + 1, nxt);
        const char* nA = has_next ? (const char*)g.A + (size_t)nxt.pm * tstep : cA; const char* nB = has_next ? (const char*)g.Bt + (size_t)nxt.pn * tstep : cB;
        for (int t = 0; t < nt; t += 2) {
            const bool last = (t == nt - 2);
            const char* a1 = cA + (size_t)(t + 1) * kstep;
            const char* a2 = last ? nA : cA + (size_t)(t + 2) * kstep; const char* b2 = last ? nB : cB + (size_t)(t + 2) * kstep;
            const char* a3 = a2 + kstep; const char* b3 = b2 + kstep;
            if (last && has_next) S.a_ready(nxt);
            PG8_LDB(B0, 0, 0); PG8_SCHED; PG8_LDA(At, 0, 0); PG8_STAGE(PG8_SA(1, 1), a1 + hstep, voffA);
            PG8_WAIT_L(8); PG8_BAR; PG8_WAIT_L(0); PG8_MMA(0, 0, At, B0); PG8_BAR; PG8_SCHED;
            PG8_LDB(B1, 0, 1); PG8_STAGE(PG8_SB(0, 0), b2, voffB);
            PG8_BAR; PG8_WAIT_L(0); PG8_MMA(0, 1, At, B1); PG8_BAR;
            PG8_LDA(At, 0, 1); PG8_STAGE(PG8_SA(0, 0), a2, voffA);
            PG8_BAR; PG8_WAIT_L(0); PG8_MMA(1, 0, At, B0); PG8_BAR; PG8_SCHED;
            PG8_STAGE(PG8_SB(0, 1), b2 + hstep, voffB);
            PG8_WAIT_V(6); PG8_BAR; PG8_MMA(1, 1, At, B1); PG8_BAR;
            PG8_LDB(B0, 1, 0); PG8_SCHED; PG8_LDA(At, 1, 0); PG8_STAGE(PG8_SA(0, 1), a2 + hstep, voffA);
            PG8_WAIT_L(8); PG8_BAR; PG8_WAIT_L(0); PG8_MMA(0, 0, At, B0); PG8_BAR; PG8_SCHED;
            PG8_LDB(B1, 1, 1); PG8_STAGE(PG8_SB(1, 0), b3, voffB);
            PG8_BAR; PG8_WAIT_L(0); PG8_MMA(0, 1, At, B1); PG8_BAR;
            PG8_LDA(At, 1, 1); PG8_STAGE(PG8_SA(1, 0), a3, voffA);
            PG8_BAR; PG8_WAIT_L(0); PG8_MMA(1, 0, At, B0); PG8_BAR; PG8_SCHED;
            PG8_STAGE(PG8_SB(1, 1), b3 + hstep, voffB);
            PG8_WAIT_V(6); PG8_BAR; PG8_MMA(1, 1, At, B1); PG8_BAR;
        }
        PG8_STAMP();
        if constexpr (!Epi::AFTER_DRAIN) { E(acc, cur, wr, wc, fr, fq); S.done(cur); }
        PG8_STAMP();
        if (!has_next) break;
#pragma unroll
        for (int a = 0; a < 2; ++a)
#pragma unroll
            for (int b = 0; b < 2; ++b)
#pragma unroll
                for (int m = 0; m < 4; ++m)
#pragma unroll
                    for (int n = 0; n < 2; ++n) acc[a][b][m][n] = (f32x4){0.f, 0.f, 0.f, 0.f};
        cur = nxt; cA = nA; cB = nB; ++ui;
    }
    PG8_WAIT_V(0);
    if (wr == 0) PG8_BAR;
    PG8_BAR;
    if constexpr (Epi::AFTER_DRAIN) { E.fused(acc, cur, wr, wc, fr, fq, lds, wid, lane); S.done(cur); }
    PG8_STAMP();
    if (STAMP && wid == 0) { stamps[lane] = lane < nts ? (((unsigned long long)(unsigned)ts_hi << 32) | (unsigned)ts_lo) : 0ull;
        if (lane == 62) stamps[62] = rt_entry; if (lane == 63) stamps[63] = (unsigned long long)wall_clock64(); }
#undef PG8_STAMP
#undef PG8_SA
#undef PG8_SB
#undef PG8_STAGE
#undef PG8_LDA
#undef PG8_LDB
#undef PG8_MMA
#undef PG8_WAIT_V
#undef PG8_WAIT_L
#undef PG8_BAR
#undef PG8_SCHED
}
}
#define LAS __attribute__((address_space(3)))
typedef unsigned short bf16;
typedef short bf16x8 __attribute__((ext_vector_type(8)));
typedef short bf16x4 __attribute__((ext_vector_type(4)));
typedef float f32x4 __attribute__((ext_vector_type(4)));
typedef unsigned u32x4 __attribute__((ext_vector_type(4)));
typedef unsigned u32x2 __attribute__((ext_vector_type(2)));
typedef float f32x2_ __attribute__((ext_vector_type(2)));
typedef __bf16 bf16x2n __attribute__((ext_vector_type(2)));
__device__ __forceinline__ unsigned cvt_pk_bf16(float lo, float hi) { const f32x2_ v = {lo, hi}; const bf16x2n b = __builtin_convertvector(v, bf16x2n); return __builtin_bit_cast(unsigned, b); }

constexpr int T_TOK = 32768, SEQ = 8192, DM = 1024, NPROJ = 3840, PROJ_W = 3872;
constexpr float EPS = 1e-6f;
constexpr size_t MiB = 1u << 20;
constexpr size_t WS_CTL = 0;
constexpr size_t WS_WTIN = 1 * MiB;
constexpr size_t WS_WTOUT = 9 * MiB;
constexpr size_t WS_W1FK = 11 * MiB + 256 * 1024;
constexpr size_t WS_W1FV = 11 * MiB + 768 * 1024;
constexpr size_t WS_W2FK = 12 * MiB + 256 * 1024;
constexpr size_t WS_W2FV = 12 * MiB + 288 * 1024;
constexpr size_t WS_CPE = 12 * MiB + 320 * 1024;
constexpr size_t WS_BT = 12 * MiB + 384 * 1024;
constexpr size_t WS_RS = 13 * MiB;
constexpr size_t WS_SMALL = 14 * MiB;
constexpr size_t WS_XB = 32 * MiB;
constexpr size_t WS_MIX = 32 * MiB;
constexpr size_t WS_GQKV = 96 * MiB;
constexpr size_t WS_GZ = 192 * MiB;
constexpr size_t WS_NQ = 224 * MiB;
constexpr size_t WS_NKV = 256 * MiB;
constexpr size_t WS_NZ = 304 * MiB;
constexpr size_t WS_GREC = 336 * MiB;
constexpr size_t GREC_BYTES = 73728;
constexpr size_t WS_KCMP = 480 * MiB;
constexpr size_t WS_VCMPT = 480 * MiB + 512 * 1024;
constexpr size_t WS_VST = 482 * MiB;
constexpr size_t WS_VWT = 490 * MiB;
constexpr size_t WS_GLAST = 498 * MiB;
constexpr size_t WS_END = 499 * MiB;
constexpr int LDS_BYTES = 158720;

__device__ __forceinline__ float bf2f(unsigned short h) { return __uint_as_float((unsigned)h << 16); }
__device__ __forceinline__ unsigned short f2bf(float f) { return (unsigned short)(cvt_pk_bf16(f, 0.f) & 0xffffu); }
__device__ __forceinline__ float sigmoidf_(float v) { return 1.0f / (1.0f + __expf(-v)); }
__device__ __forceinline__ float siluf_(float v) { return v / (1.0f + __expf(-v)); }
__device__ __forceinline__ f32x4 mfma16(bf16x8 a, bf16x8 b, f32x4 c) { return __builtin_amdgcn_mfma_f32_16x16x32_bf16(a, b, c, 0, 0, 0); }
__device__ __forceinline__ int kperm(int g, int j) { return j < 4 ? 4 * g + j : 16 + 4 * g + (j - 4); }

struct Frame {
    const float* in[16]; float* out; unsigned char* ws; LAS unsigned char* lds; unsigned char* ldsg;
    int tid, lane, wave;
};

struct EpiProj {
    static constexpr bool PERM = true, AFTER_DRAIN = false;
    bf16* gqkv; bf16* gz; bf16* nq; bf16* nkv; bf16* nz; const float* rs;
    __device__ __forceinline__ void operator()(const f32x4 (&acc)[2][2][4][2], const pg8::Unit& u, int wr, int wc, int fr, int fq) const {
        const int pn = u.pn; bf16* base; int ldc, colt, act;
        if (pn < 6) { base = gqkv; ldc = 1536; colt = pn * 256; act = 0; }
        else if (pn < 8) { base = gz; ldc = 512; colt = (pn - 6) * 256; act = 1; }
        else if (pn < 10) { base = nq; ldc = 512; colt = (pn - 8) * 256; act = 2; }
        else if (pn < 13) { base = nkv; ldc = 768; colt = (pn - 10) * 256; act = 0; }
        else { base = nz; ldc = 512; colt = (pn - 13) * 256; act = 1; }
        const int row0 = u.pm * 256 + wr * 64 + fr, col0 = colt + wc * 32 + 8 * fq;
#pragma unroll
        for (int ai = 0; ai < 2; ++ai)
#pragma unroll
            for (int m = 0; m < 4; ++m) {
                const int row = row0 + ai * 128 + m * 16; const float r = rs[row];
                bf16* rowp = base + (size_t)row * ldc + col0;
#pragma unroll
                for (int bj = 0; bj < 2; ++bj) {
                    f32x4 v0 = acc[ai][bj][m][0] * r, v1 = acc[ai][bj][m][1] * r;
                    if (act == 1) {
#pragma unroll
                        for (int j = 0; j < 4; ++j) { v0[j] = siluf_(v0[j]); v1[j] = siluf_(v1[j]); }
                    } else if (act == 2) { v0 = v0 * 0.18033688011112042f; v1 = v1 * 0.18033688011112042f; }
                    u32x4 w; w.x = cvt_pk_bf16(v0[0], v0[1]); w.y = cvt_pk_bf16(v0[2], v0[3]); w.z = cvt_pk_bf16(v1[0], v1[1]); w.w = cvt_pk_bf16(v1[2], v1[3]);
                    *(u32x4*)(rowp + bj * 128) = w;
                }
            }
    }
};
struct EpiOut {
    static constexpr bool PERM = false, AFTER_DRAIN = false;
    const float* x; float* out;
    __device__ __forceinline__ void operator()(const f32x4 (&acc)[2][2][4][2], const pg8::Unit& u, int wr, int wc, int fr, int fq) const {
        const int row0 = u.pm * 256 + wr * 64 + fr, col0 = u.pn * 256 + wc * 32 + 4 * fq;
#pragma unroll
        for (int ai = 0; ai < 2; ++ai)
#pragma unroll
            for (int m = 0; m < 4; ++m) {
                const size_t ro = (size_t)(row0 + ai * 128 + m * 16) * DM + col0;
#pragma unroll
                for (int bj = 0; bj < 2; ++bj)
#pragma unroll
                    for (int n = 0; n < 2; ++n) {
                        const f32x4 xv = *(const f32x4*)(x + ro + bj * 128 + n * 16);
                        *(f32x4*)(out + ro + bj * 128 + n * 16) = acc[ai][bj][m][n] + xv;
                    }
            }
    }
};

__device__ __forceinline__ int orig_col(int n) {
    return n < 2048 ? n : (n < 2560 ? 2056 + (n - 2048) : (n < 3328 ? 2568 + (n - 2560) : 3360 + (n - 3328)));
}
__device__ __forceinline__ int orig_small(int sc) { return sc < 8 ? 2048 + sc : 3336 + (sc - 8); }
__device__ __forceinline__ int rel_bucket(int dist) {
    const int n = dist < 0 ? 0 : dist;
    if (n < 16) return n;
    int b = 16;
    b += (n >= 21); b += (n >= 27); b += (n >= 35); b += (n >= 46); b += (n >= 59); b += (n >= 77); b += (n >= 99); b += (n >= 128);
    b += (n >= 166); b += (n >= 216); b += (n >= 280); b += (n >= 363); b += (n >= 470); b += (n >= 609); b += (n >= 790);
    return b;
}
__device__ __forceinline__ void transpose_tile(const Frame& F, const float* src, int sld, int srccol0, int k0, const float* scale, bf16* dst, int dld, int n0) {
    LAS float* tile = (LAS float*)F.lds;
    const int kk = F.tid >> 6, nn = F.tid & 63;
#pragma unroll
    for (int i = 0; i < 8; ++i) { const int k = kk + 8 * i; float v = src[(size_t)(k0 + k) * sld + srccol0 + nn]; if (scale) v *= scale[k0 + k]; tile[k * 65 + nn] = v; }
    __syncthreads();
    const int n2 = F.tid >> 3, kc = F.tid & 7;
    float e[8];
#pragma unroll
    for (int j = 0; j < 8; ++j) e[j] = tile[(8 * kc + j) * 65 + n2];
    u32x4 w; w.x = cvt_pk_bf16(e[0], e[1]); w.y = cvt_pk_bf16(e[2], e[3]); w.z = cvt_pk_bf16(e[4], e[5]); w.w = cvt_pk_bf16(e[6], e[7]);
    *(u32x4*)(dst + (size_t)(n0 + n2) * dld + k0 + 8 * kc) = w;
    __syncthreads();
}

__device__ __forceinline__ void p0_prep(const Frame& F) {
    const float* x = F.in[0]; const float* nw = F.in[1]; const float* w_in = F.in[2];
    unsigned char* ws = F.ws;
    const int G = gridDim.x, bid = blockIdx.x;
    for (int task = bid; task < 1365; task += G) {
        if (task < 960) { const int nt = task / 16, kt = task % 16; transpose_tile(F, w_in, PROJ_W, orig_col(nt * 64), kt * 64, nw, (bf16*)(ws + WS_WTIN), DM, nt * 64); }
        else if (task < 1216) { const int t2 = task - 960, nt = t2 / 16, kt = t2 % 16; transpose_tile(F, F.in[13], DM, nt * 64, kt * 64, nullptr, (bf16*)(ws + WS_WTOUT), DM, nt * 64); }
        else if (task < 1344) {
            const int t2 = task - 1216, which = t2 >> 6, sub = t2 & 63;
            const float* w1 = F.in[which ? 11 : 9]; bf16* dst = (bf16*)(ws + (which ? WS_W1FV : WS_W1FK));
            const int mt = F.tid >> 6, l = F.tid & 63, m = l & 15, kg = l >> 4, ks = sub;
            float e[8];
#pragma unroll
            for (int j = 0; j < 8; ++j) e[j] = w1[(size_t)(32 * ks + 8 * kg + j) * 128 + 16 * mt + m];
            u32x4 w; w.x = cvt_pk_bf16(e[0], e[1]); w.y = cvt_pk_bf16(e[2], e[3]); w.z = cvt_pk_bf16(e[4], e[5]); w.w = cvt_pk_bf16(e[6], e[7]);
            *(u32x4*)(dst + ((size_t)(ks * 8 + mt) * 64 + l) * 8) = w;
        } else if (task < 1346) {
            const int which = task - 1344; const float* w2 = F.in[which ? 12 : 10]; bf16* dst = (bf16*)(ws + (which ? WS_W2FV : WS_W2FK));
            for (int i = F.tid; i < 1024; i += 512) {
                const int l = i & 63, ks = (i >> 6) & 3, mt = i >> 8, m = l & 15, kg = l >> 4;
                float e[8];
#pragma unroll
                for (int j = 0; j < 8; ++j) e[j] = w2[(size_t)(32 * ks + kperm(kg, j)) * 64 + 16 * mt + m];
                u32x4 w; w.x = cvt_pk_bf16(e[0], e[1]); w.y = cvt_pk_bf16(e[2], e[3]); w.z = cvt_pk_bf16(e[4], e[5]); w.w = cvt_pk_bf16(e[6], e[7]);
                *(u32x4*)(dst + (size_t)i * 8) = w;
            }
        } else if (task < 1348) {
            const int which = task - 1346; const float* pe = F.in[which ? 8 : 7]; const float* w1 = F.in[which ? 11 : 9];
            float* dst = (float*)(ws + WS_CPE) + which * 128;
            if (F.tid < 128) { float s = 0.f; for (int k = 0; k < 2048; ++k) s += pe[k] * w1[(size_t)k * 128 + F.tid]; dst[F.tid] = s; }
        } else {
            const int i = (task - 1348) * 512 + F.tid;
            if (i < 8 * 1025) { const int head = i / 1025, dist = i % 1025; ((float*)(ws + WS_BT))[i] = F.in[14][rel_bucket(dist) * 8 + head] * 1.4426950408889634f; }
        }
    }
    __syncthreads();
    {
        for (int i = F.tid; i < 32 * 2 * 64; i += 512) {
            const int l = i & 63, nt = (i >> 6) & 1, ks = i >> 7, kg = l >> 4, sc = 16 * nt + (l & 15), oc = orig_small(sc);
            float v[8], lo[8]; unsigned short hi[8];
#pragma unroll
            for (int j = 0; j < 8; ++j) { const int k = 32 * ks + 8 * kg + j; v[j] = w_in[(size_t)k * PROJ_W + oc] * nw[k]; hi[j] = f2bf(v[j]); lo[j] = v[j] - bf2f(hi[j]); }
            u32x4 wh, wl;
            wh.x = hi[0] | ((unsigned)hi[1] << 16); wh.y = hi[2] | ((unsigned)hi[3] << 16); wh.z = hi[4] | ((unsigned)hi[5] << 16); wh.w = hi[6] | ((unsigned)hi[7] << 16);
            wl.x = cvt_pk_bf16(lo[0], lo[1]); wl.y = cvt_pk_bf16(lo[2], lo[3]); wl.z = cvt_pk_bf16(lo[4], lo[5]); wl.w = cvt_pk_bf16(lo[6], lo[7]);
            *(LAS u32x4*)(F.lds + ((size_t)((ks * 2 + nt) * 2 + 0) * 64 + l) * 16) = wh;
            *(LAS u32x4*)(F.lds + ((size_t)((ks * 2 + nt) * 2 + 1) * 64 + l) * 16) = wl;
        }
    }
    __syncthreads();
    bf16* xb = (bf16*)(ws + WS_XB); float* rsv = (float*)(ws + WS_RS); float* small = (float*)(ws + WS_SMALL);
    const float* a_log = F.in[4]; const float* dt_bias = F.in[5];
    for (int tile = bid * 8 + F.wave; tile < T_TOK / 16; tile += G * 8) {
        const int l = F.lane, r = l & 15, kg = l >> 4; const int row = tile * 16 + r;
        const float* xr = x + (size_t)row * DM + 8 * kg;
        f32x4 acc0 = {0.f, 0.f, 0.f, 0.f}, acc1 = {0.f, 0.f, 0.f, 0.f};
        float ss = 0.f;
#pragma unroll 4
        for (int ks = 0; ks < 32; ++ks) {
            const f32x4 a0 = *(const f32x4*)(xr + 32 * ks), a1 = *(const f32x4*)(xr + 32 * ks + 4);
            ss += a0[0] * a0[0] + a0[1] * a0[1] + a0[2] * a0[2] + a0[3] * a0[3] + a1[0] * a1[0] + a1[1] * a1[1] + a1[2] * a1[2] + a1[3] * a1[3];
            u32x4 h; h.x = cvt_pk_bf16(a0[0], a0[1]); h.y = cvt_pk_bf16(a0[2], a0[3]); h.z = cvt_pk_bf16(a1[0], a1[1]); h.w = cvt_pk_bf16(a1[2], a1[3]);
            *(u32x4*)(xb + (size_t)row * DM + 32 * ks + 8 * kg) = h;
            u32x4 lo;
            lo.x = cvt_pk_bf16(a0[0] - __uint_as_float(h.x << 16), a0[1] - __uint_as_float(h.x & 0xffff0000u));
            lo.y = cvt_pk_bf16(a0[2] - __uint_as_float(h.y << 16), a0[3] - __uint_as_float(h.y & 0xffff0000u));
            lo.z = cvt_pk_bf16(a1[0] - __uint_as_float(h.z << 16), a1[1] - __uint_as_float(h.z & 0xffff0000u));
            lo.w = cvt_pk_bf16(a1[2] - __uint_as_float(h.w << 16), a1[3] - __uint_as_float(h.w & 0xffff0000u));
            const bf16x8 ah = __builtin_bit_cast(bf16x8, h), al = __builtin_bit_cast(bf16x8, lo);
            const LAS unsigned char* fb = F.lds + (size_t)(ks * 4) * 1024 + l * 16;
            const bf16x8 b0h = *(const LAS bf16x8*)(fb), b0l = *(const LAS bf16x8*)(fb + 1024), b1h = *(const LAS bf16x8*)(fb + 2048), b1l = *(const LAS bf16x8*)(fb + 3072);
            acc0 = mfma16(ah, b0h, acc0); acc0 = mfma16(al, b0h, acc0); acc0 = mfma16(ah, b0l, acc0);
            acc1 = mfma16(ah, b1h, acc1); acc1 = mfma16(al, b1h, acc1); acc1 = mfma16(ah, b1l, acc1);
        }
        ss += __shfl_xor(ss, 16); ss += __shfl_xor(ss, 32);
        const float rs = rsqrtf(ss * (1.0f / 1024.f) + EPS);
        if (kg == 0) rsv[row] = rs;
#pragma unroll
        for (int reg = 0; reg < 4; ++reg) {
            const int rr = 4 * kg + reg; const float rsr = __shfl(rs, rr);
            const int orow = tile * 16 + rr;
            {
                const float v = acc0[reg] * rsr; const int c = r; float o;
                if (c < 4) o = sigmoidf_(v);
                else if (c < 8) { const int h = c - 4; const float z = v + dt_bias[h]; const float sp = z > 20.f ? z : log1pf(expf(z)); o = -expf(a_log[h]) * sp; }
                else o = sigmoidf_(v);
                small[(size_t)orow * 32 + c] = o;
            }
            { const float v = acc1[reg] * rsr; small[(size_t)orow * 32 + 16 + r] = sigmoidf_(v); }
        }
    }
}

__device__ __forceinline__ void p5_final(const Frame& F) {
    const float* fw = F.in[15]; float* out = F.out;
    for (int r = blockIdx.x * 8 + F.wave; r < T_TOK; r += gridDim.x * 8) {
        f32x4* orow = (f32x4*)(out + (size_t)r * DM);
        f32x4 v[4]; float ss = 0.f;
#pragma unroll
        for (int i = 0; i < 4; ++i) { v[i] = orow[F.lane + 64 * i]; ss += v[i][0] * v[i][0] + v[i][1] * v[i][1] + v[i][2] * v[i][2] + v[i][3] * v[i][3]; }
#pragma unroll
        for (int o = 32; o > 0; o >>= 1) ss += __shfl_xor(ss, o);
        const float rs = rsqrtf(ss * (1.0f / 1024.f) + EPS);
#pragma unroll
        for (int i = 0; i < 4; ++i) { const f32x4 w = ((const f32x4*)fw)[F.lane + 64 * i]; orow[F.lane + 64 * i] = v[i] * rs * w; }
    }
}
constexpr int REC_WNEG = 0, REC_QDEC = 16384, REC_ATTN = 32768, REC_KDT = 40960, REC_U = 57344, REC_LDS_BYTES = 57344;
__device__ __forceinline__ void gdn_prep_item(const Frame& F, int item) {
    const int tid = F.tid;
    const int h = item & 3, n = (item >> 2) & 127, b = item >> 9;
    const int tok0 = b * SEQ + n * 64;
    LAS float* kf = (LAS float*)(F.lds); LAS float* vf = (LAS float*)(F.lds + 32768);
    LAS bf16* qb = (LAS bf16*)(F.lds + 65536); LAS bf16* kb = (LAS bf16*)(F.lds + 82944); LAS bf16* kbb = (LAS bf16*)(F.lds + 100352);
    LAS float* Lm = (LAS float*)(F.lds + 117760); LAS bf16* atb = (LAS bf16*)(F.lds + 134144); LAS float* gcs = (LAS float*)(F.lds + 143360);
    LAS bf16* wb = qb;
    unsigned char* rec = F.ws + WS_GREC + (size_t)item * GREC_BYTES;
    const float* small = (const float*)(F.ws + WS_SMALL);
    if (tid < 64) {
        const float beta = small[(size_t)(tok0 + tid) * 32 + h]; float c = small[(size_t)(tok0 + tid) * 32 + 4 + h];
#pragma unroll
        for (int o = 1; o < 64; o <<= 1) { const float t = __shfl_up(c, o); if (tid >= o) c += t; }
        gcs[tid] = c; gcs[64 + tid] = beta; gcs[128 + tid] = expf(c);
        if (tid == 63) ((float*)(F.ws + WS_GLAST))[item] = expf(c);
    }
    __syncthreads();
    {
        const bf16* gq = (const bf16*)(F.ws + WS_GQKV); const float* cw = F.in[3];
        const int grp = tid >> 4, li = tid & 15;
#pragma unroll
        for (int rr = 0; rr < 2; ++rr) {
            const int c = grp * 2 + rr, pos = n * 64 + c;
            const float betav = gcs[64 + c], egv = gcs[128 + c];
#pragma unroll
            for (int part = 0; part < 3; ++part) {
                const int ch = part * 512 + h * 128 + 8 * li;
                float y[8];
#pragma unroll
                for (int e = 0; e < 8; ++e) y[e] = 0.f;
#pragma unroll
                for (int j = 0; j < 4; ++j) {
                    const int p = pos - 3 + j;
                    if (p >= 0) {
                        const u32x4 xv = *(const u32x4*)(gq + (size_t)(b * SEQ + p) * 1536 + ch);
                        const f32x4 w0 = *(const f32x4*)(cw + j * 1536 + ch), w1 = *(const f32x4*)(cw + j * 1536 + ch + 4);
                        y[0] += w0[0] * __uint_as_float(xv.x << 16); y[1] += w0[1] * __uint_as_float(xv.x & 0xffff0000u);
                        y[2] += w0[2] * __uint_as_float(xv.y << 16); y[3] += w0[3] * __uint_as_float(xv.y & 0xffff0000u);
                        y[4] += w1[0] * __uint_as_float(xv.z << 16); y[5] += w1[1] * __uint_as_float(xv.z & 0xffff0000u);
                        y[6] += w1[2] * __uint_as_float(xv.w << 16); y[7] += w1[3] * __uint_as_float(xv.w & 0xffff0000u);
                    }
                }
                float ss = 0.f;
#pragma unroll
                for (int e = 0; e < 8; ++e) { y[e] = siluf_(y[e]); ss += y[e] * y[e]; }
                if (part < 2) {
                    ss += __shfl_xor(ss, 1); ss += __shfl_xor(ss, 2); ss += __shfl_xor(ss, 4); ss += __shfl_xor(ss, 8);
                    const float sc = rsqrtf(ss + EPS) * (part == 0 ? 0.08838834764831845f : 1.0f);
#pragma unroll
                    for (int e = 0; e < 8; ++e) y[e] *= sc;
                }
                if (part == 0) {
                    u32x4 w; w.x = cvt_pk_bf16(y[0], y[1]); w.y = cvt_pk_bf16(y[2], y[3]); w.z = cvt_pk_bf16(y[4], y[5]); w.w = cvt_pk_bf16(y[6], y[7]);
                    *(LAS u32x4*)(qb + c * 136 + 8 * li) = w;
                    const int mt = c >> 4, m = c & 15, ks = li >> 2, a = (li & 3) >> 1, g0 = (2 * (li & 3)) & 3, g1 = (2 * (li & 3) + 1) & 3;
                    u32x2 d0, d1; d0.x = cvt_pk_bf16(y[0] * egv, y[1] * egv); d0.y = cvt_pk_bf16(y[2] * egv, y[3] * egv); d1.x = cvt_pk_bf16(y[4] * egv, y[5] * egv); d1.y = cvt_pk_bf16(y[6] * egv, y[7] * egv);
                    unsigned char* fb = rec + REC_QDEC + (size_t)(mt * 4 + ks) * 1024 + a * 8;
                    *(u32x2*)(fb + (g0 * 16 + m) * 16) = d0; *(u32x2*)(fb + (g1 * 16 + m) * 16) = d1;
                } else if (part == 1) {
                    *(LAS f32x4*)(kf + c * 128 + 8 * li) = (f32x4){y[0], y[1], y[2], y[3]}; *(LAS f32x4*)(kf + c * 128 + 8 * li + 4) = (f32x4){y[4], y[5], y[6], y[7]};
                    u32x4 w; w.x = cvt_pk_bf16(y[0], y[1]); w.y = cvt_pk_bf16(y[2], y[3]); w.z = cvt_pk_bf16(y[4], y[5]); w.w = cvt_pk_bf16(y[6], y[7]);
                    *(LAS u32x4*)(kb + c * 136 + 8 * li) = w;
                    w.x = cvt_pk_bf16(y[0] * betav, y[1] * betav); w.y = cvt_pk_bf16(y[2] * betav, y[3] * betav); w.z = cvt_pk_bf16(y[4] * betav, y[5] * betav); w.w = cvt_pk_bf16(y[6] * betav, y[7] * betav);
                    *(LAS u32x4*)(kbb + c * 136 + 8 * li) = w;
                } else {
                    *(LAS f32x4*)(vf + c * 128 + 8 * li) = (f32x4){y[0], y[1], y[2], y[3]}; *(LAS f32x4*)(vf + c * 128 + 8 * li + 4) = (f32x4){y[4], y[5], y[6], y[7]};
                }
            }
        }
    }
    __syncthreads();
    {
        const int l = F.lane, m = l & 15, kg = l >> 4;
#pragma unroll
        for (int i = 0; i < 4; ++i) {
            const int tt = F.wave * 4 + i, which = tt >> 4, mi = (tt >> 2) & 3, ni = tt & 3;
            f32x4 acc = {0.f, 0.f, 0.f, 0.f};
            if (mi >= ni) {
                const LAS bf16* As = which ? qb : kbb;
#pragma unroll
                for (int ks = 0; ks < 4; ++ks) {
                    const bf16x8 a = *(const LAS bf16x8*)(As + (16 * mi + m) * 136 + 32 * ks + 8 * kg);
                    const bf16x8 bb = *(const LAS bf16x8*)(kb + (16 * ni + m) * 136 + 32 * ks + 8 * kg);
                    acc = mfma16(a, bb, acc);
                }
            }
#pragma unroll
            for (int r = 0; r < 4; ++r) {
                const int irow = 16 * mi + 4 * kg + r, jcol = 16 * ni + m;
                const float dec = (irow >= jcol) ? expf(gcs[irow] - gcs[jcol]) : 0.f;
                if (which == 0) Lm[jcol * 64 + irow] = (irow > jcol) ? acc[r] * dec : 0.f;
                else atb[irow * 72 + jcol] = f2bf((irow >= jcol) ? acc[r] * dec : 0.f);
            }
        }
    }
    __syncthreads();
    {
        const float gl = gcs[63];
#pragma unroll
        for (int q = 0; q < 2; ++q) {
            const int idx = tid + 512 * q, l = idx & 63, ks = (idx >> 6) & 1, mt = idx >> 7, m = l & 15, g = l >> 4;
            float e[8];
#pragma unroll
            for (int j = 0; j < 8; ++j) { const int cr = 32 * ks + kperm(g, j); e[j] = kf[cr * 128 + 16 * mt + m] * expf(gl - gcs[cr]); }
            u32x4 w; w.x = cvt_pk_bf16(e[0], e[1]); w.y = cvt_pk_bf16(e[2], e[3]); w.z = cvt_pk_bf16(e[4], e[5]); w.w = cvt_pk_bf16(e[6], e[7]);
            *(u32x4*)(rec + REC_KDT + (size_t)idx * 16) = w;
        }
        {
            const int idx = tid, l = idx & 63, ks = (idx >> 6) & 1, mt = idx >> 7, m = l & 15, g = l >> 4;
            const u32x2 a0 = *(const LAS u32x2*)(atb + (16 * mt + m) * 72 + 32 * ks + 4 * g), a1 = *(const LAS u32x2*)(atb + (16 * mt + m) * 72 + 32 * ks + 16 + 4 * g);
            *(u32x4*)(rec + REC_ATTN + (size_t)idx * 16) = (u32x4){a0.x, a0.y, a1.x, a1.y};
        }
    }
    __syncthreads();
    if (tid < 256) {
        const int c = tid; const bool isw = c >= 128;
        LAS float* base = isw ? (kf + (c - 128)) : (vf + c);
#pragma unroll
        for (int ib = 0; ib < 4; ++ib) {
            float r[16];
#pragma unroll
            for (int ii = 0; ii < 16; ++ii) { const int i = 16 * ib + ii; r[ii] = base[i * 128] * gcs[64 + i] * (isw ? gcs[128 + i] : 1.0f); }
#pragma unroll 4
            for (int j = 0; j < 16 * ib; ++j) {
                const float xj = base[j * 128];
                const LAS f32x4* lp = (const LAS f32x4*)(Lm + j * 64 + 16 * ib);
                const f32x4 l0 = lp[0], l1 = lp[1], l2 = lp[2], l3 = lp[3];
                r[0] -= l0[0] * xj; r[1] -= l0[1] * xj; r[2] -= l0[2] * xj; r[3] -= l0[3] * xj;
                r[4] -= l1[0] * xj; r[5] -= l1[1] * xj; r[6] -= l1[2] * xj; r[7] -= l1[3] * xj;
                r[8] -= l2[0] * xj; r[9] -= l2[1] * xj; r[10] -= l2[2] * xj; r[11] -= l2[3] * xj;
                r[12] -= l3[0] * xj; r[13] -= l3[1] * xj; r[14] -= l3[2] * xj; r[15] -= l3[3] * xj;
            }
#pragma unroll
            for (int jj = 0; jj < 15; ++jj) {
                const LAS f32x4* lp = (const LAS f32x4*)(Lm + (16 * ib + jj) * 64 + 16 * ib);
#pragma unroll
                for (int q = 0; q < 4; ++q) {
                    if (4 * q + 3 > jj) {
                        const f32x4 lv = lp[q];
#pragma unroll
                        for (int e = 0; e < 4; ++e) if (4 * q + e > jj) r[4 * q + e] -= lv[e] * r[jj];
                    }
                }
            }
#pragma unroll
            for (int ii = 0; ii < 16; ++ii) base[(16 * ib + ii) * 128] = r[ii];
        }
    }
    __syncthreads();
    {
#pragma unroll
        for (int q = 0; q < 4; ++q) {
            const int idx = tid + 512 * q, l = idx & 63, mt = (idx >> 6) & 3, sl = idx >> 8, g4 = l >> 4, nn = l & 15;
            const LAS float* up = vf + (16 * mt + 4 * g4) * 128 + 16 * sl + nn;
            u32x2 d; d.x = cvt_pk_bf16(up[0], up[128]); d.y = cvt_pk_bf16(up[256], up[384]);
            *(u32x2*)(rec + REC_U + (size_t)idx * 8) = d;
        }
#pragma unroll
        for (int q = 0; q < 2; ++q) {
            const int idx = tid + 512 * q, l = idx & 63, ks = (idx >> 6) & 3, mt = idx >> 8, m = l & 15, g = l >> 4;
            const f32x4 a0 = *(const LAS f32x4*)(kf + (16 * mt + m) * 128 + 32 * ks + 4 * g), a1 = *(const LAS f32x4*)(kf + (16 * mt + m) * 128 + 32 * ks + 16 + 4 * g);
            u32x4 w; w.x = cvt_pk_bf16(-a0[0], -a0[1]); w.y = cvt_pk_bf16(-a0[2], -a0[3]); w.z = cvt_pk_bf16(-a1[0], -a1[1]); w.w = cvt_pk_bf16(-a1[2], -a1[3]);
            *(u32x4*)(rec + REC_WNEG + (size_t)idx * 16) = w;
        }
    }
    __syncthreads();
}

__device__ __forceinline__ bf16x8 acc2frag(const f32x4& lo, const f32x4& hi) {
    u32x4 w; w.x = cvt_pk_bf16(lo[0], lo[1]); w.y = cvt_pk_bf16(lo[2], lo[3]); w.z = cvt_pk_bf16(hi[0], hi[1]); w.w = cvt_pk_bf16(hi[2], hi[3]);
    return __builtin_bit_cast(bf16x8, w);
}
__device__ __forceinline__ void gdn_scan(const Frame& F, int bh) {
    const int tid = F.tid, lane = F.lane, s = F.wave;
    const int b = bh >> 2, h = bh & 3;
    LAS unsigned char* buf0 = F.lds; LAS float* ox = (LAS float*)(F.lds + 2 * REC_LDS_BYTES);
    const float* glast = (const float*)(F.ws + WS_GLAST);
    const bf16* gz = (const bf16*)(F.ws + WS_GZ); const float* gnw = F.in[6]; bf16* mix = (bf16*)(F.ws + WS_MIX);
    f32x4 S[8];
#pragma unroll
    for (int t = 0; t < 8; ++t) S[t] = (f32x4){0.f, 0.f, 0.f, 0.f};
    const unsigned char* const recbase = F.ws + WS_GREC + (size_t)(b * 512 + h) * GREC_BYTES;
#define recp(n) (recbase + (size_t)(n) * 4 * GREC_BYTES)
#define GS_STAGE(n, bufsel) do { const unsigned char* _r = recp(n); _Pragma("unroll") for (int _i = 0; _i < 7; ++_i) \
        __builtin_amdgcn_global_load_lds((const unsigned*)(_r + (size_t)(_i * 512 + tid) * 16), (LAS unsigned*)(buf0 + (bufsel) * REC_LDS_BYTES + (_i * 8 + s) * 1024), 16, 0, 0); } while (0)
    GS_STAGE(0, 0);
    u32x2 un[4];
#pragma unroll
    for (int mt = 0; mt < 4; ++mt) un[mt] = *(const u32x2*)(recp(0) + REC_U + (size_t)((s * 4 + mt) * 64 + lane) * 8);
    float egn = glast[(b * 128 + 0) * 4 + h];
    for (int n = 0; n < 128; ++n) {
        const int cur = n & 1;
        asm volatile("s_waitcnt vmcnt(0)" ::: "memory");
        __syncthreads();
        u32x2 uc[4];
#pragma unroll
        for (int mt = 0; mt < 4; ++mt) uc[mt] = un[mt];
        const float egl = egn;
        if (n + 1 < 128) {
            GS_STAGE(n + 1, cur ^ 1);
#pragma unroll
            for (int mt = 0; mt < 4; ++mt) un[mt] = *(const u32x2*)(recp(n + 1) + REC_U + (size_t)((s * 4 + mt) * 64 + lane) * 8);
            egn = glast[(b * 128 + n + 1) * 4 + h];
        }
        const LAS unsigned char* bp = buf0 + cur * REC_LDS_BYTES + lane * 16;
        bf16x8 Sb[4];
#pragma unroll
        for (int ks = 0; ks < 4; ++ks) Sb[ks] = acc2frag(S[2 * ks], S[2 * ks + 1]);
        f32x4 vn[4], o[4];
#pragma unroll
        for (int mt = 0; mt < 4; ++mt) {
            vn[mt] = (f32x4){__uint_as_float(uc[mt].x << 16), __uint_as_float(uc[mt].x & 0xffff0000u), __uint_as_float(uc[mt].y << 16), __uint_as_float(uc[mt].y & 0xffff0000u)};
#pragma unroll
            for (int ks = 0; ks < 4; ++ks) vn[mt] = mfma16(*(const LAS bf16x8*)(bp + REC_WNEG + (mt * 4 + ks) * 1024), Sb[ks], vn[mt]);
        }
        bf16x8 Vb[2];
#pragma unroll
        for (int ks = 0; ks < 2; ++ks) Vb[ks] = acc2frag(vn[2 * ks], vn[2 * ks + 1]);
#pragma unroll
        for (int mt = 0; mt < 4; ++mt) {
            o[mt] = (f32x4){0.f, 0.f, 0.f, 0.f};
#pragma unroll
            for (int ks = 0; ks < 4; ++ks) o[mt] = mfma16(*(const LAS bf16x8*)(bp + REC_QDEC + (mt * 4 + ks) * 1024), Sb[ks], o[mt]);
#pragma unroll
            for (int ks = 0; ks < 2; ++ks) o[mt] = mfma16(*(const LAS bf16x8*)(bp + REC_ATTN + (mt * 2 + ks) * 1024), Vb[ks], o[mt]);
        }
#pragma unroll
        for (int t = 0; t < 8; ++t) {
            S[t] = S[t] * egl;
#pragma unroll
            for (int ks = 0; ks < 2; ++ks) S[t] = mfma16(*(const LAS bf16x8*)(bp + REC_KDT + (t * 2 + ks) * 1024), Vb[ks], S[t]);
        }
        {
            const int g4 = lane >> 4, nn = lane & 15;
#pragma unroll
            for (int mt = 0; mt < 4; ++mt)
#pragma unroll
                for (int r = 0; r < 4; ++r) ox[(16 * mt + 4 * g4 + r) * 132 + 16 * s + nn] = o[mt][r];
        }
        __syncthreads();
        {
            const int row = tid >> 3, part = tid & 7; const int tok = b * SEQ + n * 64 + row;
            float v[16]; float ss = 0.f;
#pragma unroll
            for (int q = 0; q < 4; ++q) { const f32x4 t4 = *(const LAS f32x4*)(ox + row * 132 + 16 * part + 4 * q); v[4 * q] = t4[0]; v[4 * q + 1] = t4[1]; v[4 * q + 2] = t4[2]; v[4 * q + 3] = t4[3]; }
#pragma unroll
            for (int e = 0; e < 16; ++e) ss += v[e] * v[e];
            ss += __shfl_xor(ss, 1); ss += __shfl_xor(ss, 2); ss += __shfl_xor(ss, 4);
            const float rs = rsqrtf(ss * (1.0f / 128.f) + EPS);
            const u32x4 z0 = *(const u32x4*)(gz + (size_t)tok * 512 + h * 128 + 16 * part), z1 = *(const u32x4*)(gz + (size_t)tok * 512 + h * 128 + 16 * part + 8);
            const unsigned zz[8] = {z0.x, z0.y, z0.z, z0.w, z1.x, z1.y, z1.z, z1.w};
            unsigned ow[8];
#pragma unroll
            for (int e = 0; e < 8; ++e) {
                const float w0 = gnw[16 * part + 2 * e], w1 = gnw[16 * part + 2 * e + 1];
                ow[e] = cvt_pk_bf16(v[2 * e] * rs * w0 * __uint_as_float(zz[e] << 16), v[2 * e + 1] * rs * w1 * __uint_as_float(zz[e] & 0xffff0000u));
            }
            bf16* mp = mix + (size_t)tok * DM + h * 128 + 16 * part;
            *(u32x4*)mp = (u32x4){ow[0], ow[1], ow[2], ow[3]}; *(u32x4*)(mp + 8) = (u32x4){ow[4], ow[5], ow[6], ow[7]};
        }
    }
#undef GS_STAGE
#undef recp
    asm volatile("s_waitcnt vmcnt(0)" ::: "memory");
    __syncthreads();
}
__device__ __forceinline__ int pos32(int key) { return (key & ~31) | (8 * ((key >> 2) & 3) + 4 * ((key >> 4) & 1) + (key & 3)); }
__device__ __forceinline__ void compress_block(const Frame& F, int task) {
    const int which = task >> 8, bhk = (task >> 5) & 7, rt = task & 31, b = bhk >> 1, hk = bhk & 1;
    const int l = F.lane, n = l & 15, kg = l >> 4, w = F.wave;
    const bf16* nkv = (const bf16*)(F.ws + WS_NKV);
    const bf16* w1f = (const bf16*)(F.ws + (which ? WS_W1FV : WS_W1FK)); const bf16* w2f = (const bf16*)(F.ws + (which ? WS_W2FV : WS_W2FK));
    const float* cpe = (const float*)(F.ws + WS_CPE) + which * 128;
    const int nc = 16 * rt + n;
    f32x4 acc[8];
#pragma unroll
    for (int t = 0; t < 8; ++t) acc[t] = (f32x4){0.f, 0.f, 0.f, 0.f};
#pragma unroll 2
    for (int k8 = 0; k8 < 8; ++k8) {
        const int ks = 8 * w + k8;
        int tok = 16 * nc + (ks >> 1); tok = tok < SEQ ? tok : SEQ - 1;
        const bf16x8 bfrag = *(const bf16x8*)(nkv + (size_t)(b * SEQ + tok) * 768 + which * 128 + hk * 64 + (ks & 1) * 32 + 8 * kg);
#pragma unroll
        for (int mt = 0; mt < 8; ++mt) acc[mt] = mfma16(*(const bf16x8*)(w1f + ((size_t)(ks * 8 + mt) * 64 + l) * 8), bfrag, acc[mt]);
    }
    LAS f32x4* part = (LAS f32x4*)F.lds;
    LAS unsigned char* hfrag = F.lds + 65536;
#pragma unroll
    for (int mt = 0; mt < 8; ++mt) part[(w * 8 + mt) * 64 + l] = acc[mt];
    __syncthreads();
    {
        f32x4 h = part[w * 64 + l];
#pragma unroll
        for (int p = 1; p < 8; ++p) h = h + part[(p * 8 + w) * 64 + l];
#pragma unroll
        for (int r = 0; r < 4; ++r) h[r] = siluf_(h[r] + cpe[16 * w + 4 * kg + r]);
        u32x2 d; d.x = cvt_pk_bf16(h[0], h[1]); d.y = cvt_pk_bf16(h[2], h[3]);
        *(LAS u32x2*)(hfrag + ((w >> 1) * 64 + l) * 16 + (w & 1) * 8) = d;
    }
    __syncthreads();
    if (w < 4) {
        f32x4 o = {0.f, 0.f, 0.f, 0.f};
#pragma unroll
        for (int ks = 0; ks < 4; ++ks) o = mfma16(*(const bf16x8*)(w2f + ((size_t)(w * 4 + ks) * 64 + l) * 8), *(const LAS bf16x8*)(hfrag + (ks * 64 + l) * 16), o);
        const bool valid = nc < 511;
        if (which == 0) {
            bf16* kc = (bf16*)(F.ws + WS_KCMP) + ((size_t)bhk * 512 + nc) * 64;
            u32x2 d; d.x = valid ? cvt_pk_bf16(o[0], o[1]) : 0u; d.y = valid ? cvt_pk_bf16(o[2], o[3]) : 0u; *(u32x2*)(kc + 16 * w + 4 * kg) = d;
        } else {
            bf16* vt = (bf16*)(F.ws + WS_VCMPT) + (size_t)bhk * 64 * 512 + pos32(nc);
#pragma unroll
            for (int r = 0; r < 4; ++r) vt[(size_t)(16 * w + 4 * kg + r) * 512] = valid ? f2bf(o[r]) : (unsigned short)0;
        }
    }
    __syncthreads();
}
__device__ __forceinline__ void vtranspose_task(const Frame& F, int task) {
    const int which = task >> 8, bhk = (task >> 5) & 7, tg = task & 31, b = bhk >> 1, hk = bhk & 1;
    const bf16* nkv = (const bf16*)(F.ws + WS_NKV); bf16* dst = (bf16*)(F.ws + (which ? WS_VWT : WS_VST)) + (size_t)bhk * 64 * SEQ;
    LAS bf16* tile = (LAS bf16*)F.lds;
    for (int sub = 0; sub < 4; ++sub) {
        const int t0 = tg * 256 + sub * 64;
        { const int tk = F.tid >> 3, dc = F.tid & 7;
          const u32x4 v = *(const u32x4*)(nkv + (size_t)(b * SEQ + t0 + tk) * 768 + 384 + which * 256 + hk * 64 + 8 * dc);
          const unsigned vv[4] = {v.x, v.y, v.z, v.w};
#pragma unroll
          for (int e = 0; e < 4; ++e) { tile[(8 * dc + 2 * e) * 72 + pos32(tk)] = (unsigned short)(vv[e] & 0xffffu); tile[(8 * dc + 2 * e + 1) * 72 + pos32(tk)] = (unsigned short)(vv[e] >> 16); } }
        __syncthreads();
        { const int d = F.tid >> 3, tc = F.tid & 7;
          *(u32x4*)(dst + (size_t)d * SEQ + t0 + 8 * tc) = *(const LAS u32x4*)(tile + d * 72 + 8 * tc); }
        __syncthreads();
    }
}

constexpr int NL_BT = 0, NL_IMP = 18496, NL_MASK = 51776, NL_SMASK = 52800, NL_KV = 53248, NL_NXT = 86016, NL_TOT = 86528;
#ifndef PRB_X1
#define PRB_X1 0
#endif
#ifndef PRB_S
#define PRB_S 0
#endif
#ifndef PRB_W
#define PRB_W 0
#endif
#ifndef PRB_C
#define PRB_C 0
#endif
constexpr int TM_C1 = 0, TM_C2 = 1, TM_SD = 2, TM_SS = 3, TM_W = 4;
__device__ __forceinline__ void stage_dma(LAS unsigned char* buf, const bf16* Kb, int kstride, const bf16* VT, int vlen, int key0, int wave, int lane) {
    const int row = wave * 8 + (lane >> 3), ch = (lane & 7) ^ ((lane >> 3) & 7);
    __builtin_amdgcn_global_load_lds((const unsigned*)(Kb + (size_t)(key0 + row) * kstride + 8 * ch), (LAS unsigned*)(buf + wave * 1024), 16, 0, 0);
    __builtin_amdgcn_global_load_lds((const unsigned*)(VT + (size_t)row * vlen + key0 + 8 * ch), (LAS unsigned*)(buf + 8192 + wave * 1024), 16, 0, 0);
}
__device__ __forceinline__ void wait_tiles(int newer) {
    if (newer >= 2) asm volatile("s_waitcnt vmcnt(4)" ::: "memory"); else if (newer == 1) asm volatile("s_waitcnt vmcnt(2)" ::: "memory"); else asm volatile("s_waitcnt vmcnt(0)" ::: "memory");
}
__device__ __forceinline__ bf16x8 tile_frag(const LAS unsigned char* buf, int row, int chunk) { return *(const LAS bf16x8*)(buf + row * 128 + ((chunk ^ (row & 7)) << 4)); }

struct SlotState { f32x4 O[4]; float m, l; };
constexpr int RT_LEN = 1156, RT_OFF = 1088;
template <int MODE, bool NEARB>
__device__ __forceinline__ void slot_tile(const bf16x8 (&kf)[4][2], const LAS unsigned char* vb0, const LAS unsigned char* vb1, const bf16x8 (&q)[2], int dbase, const LAS float* rt, SlotState& A,
                                          float linv, float mrow, float bfar, LAS float* imp_row, int key0, int lane) {
    const int kg = lane >> 4;
    __builtin_amdgcn_sched_barrier(0);
    f32x4 s[4];
#pragma unroll
    for (int mt = 0; mt < 4; ++mt) { s[mt] = mfma16(kf[mt][0], q[0], (f32x4){0.f, 0.f, 0.f, 0.f}); s[mt] = mfma16(kf[mt][1], q[1], s[mt]); }
    constexpr bool CMP = (MODE == TM_C1 || MODE == TM_C2);
    if (MODE == TM_SS) {
        if (NEARB) {
            const LAS float* rp = rt + (RT_OFF - dbase);
#pragma unroll
            for (int mt = 0; mt < 4; ++mt)
#pragma unroll
                for (int r = 0; r < 4; ++r) s[mt][r] += rp[16 * mt + r];
        }
        float ps = 0.f;
#pragma unroll
        for (int mt = 0; mt < 4; ++mt)
#pragma unroll
            for (int r = 0; r < 4; ++r) { const float p = __builtin_amdgcn_exp2f(s[mt][r] - mrow); s[mt][r] = p; ps += p; }
        ps += __shfl_xor(ps, 16); ps += __shfl_xor(ps, 32);
        A.l += ps;
    } else {
        float tmax = -1e30f;
        if (NEARB) {
            const LAS float* rp = rt + (RT_OFF - dbase);
#pragma unroll
            for (int mt = 0; mt < 4; ++mt)
#pragma unroll
                for (int r = 0; r < 4; ++r) {
                    const int c = 16 * mt + r;
                    if (CMP) {
                        const int dist = dbase - 16 * c; const int di = dist < 0 ? 0 : (dist > RT_OFF ? RT_OFF : dist);
                        s[mt][r] = dist >= 0 ? s[mt][r] + rt[RT_OFF - di] : -1e30f;
                    } else {
                        const int dist = dbase - c; const bool ok = (MODE == TM_W) ? (dist >= 0 && dist < 512) : (dist >= 0);
                        s[mt][r] = ok ? s[mt][r] + rp[c] : -1e30f;
                    }
                    tmax = fmaxf(tmax, s[mt][r]);
                }
        } else {
#pragma unroll
            for (int mt = 0; mt < 4; ++mt)
#pragma unroll
                for (int r = 0; r < 4; ++r) { s[mt][r] += bfar; tmax = fmaxf(tmax, s[mt][r]); }
        }
        if (MODE == TM_C2) {
#pragma unroll
            for (int mt = 0; mt < 4; ++mt)
#pragma unroll
                for (int r = 0; r < 4; ++r) s[mt][r] = __builtin_amdgcn_exp2f(s[mt][r] - A.m) * linv;
            const int g = lane & 3;
#pragma unroll
            for (int mt = 0; mt < 4; ++mt) {
                float gsum = s[mt][0] + s[mt][1] + s[mt][2] + s[mt][3], lv = s[mt][3];
                gsum += __shfl_xor(gsum, 1); gsum += __shfl_xor(gsum, 2); lv += __shfl_xor(lv, 1); lv += __shfl_xor(lv, 2);
                const int j = (key0 >> 2) + 4 * mt + kg;
                if (g == 0) { atomicAdd((float*)(imp_row + j), gsum); atomicAdd((float*)(imp_row + j + 1), lv); }
            }
        } else {
            tmax = fmaxf(tmax, __shfl_xor(tmax, 16)); tmax = fmaxf(tmax, __shfl_xor(tmax, 32));
            const float mnew = fmaxf(A.m, tmax), msafe = fmaxf(mnew, -1e29f), alpha = __builtin_amdgcn_exp2f(A.m - msafe);
            float ps = 0.f;
#pragma unroll
            for (int mt = 0; mt < 4; ++mt)
#pragma unroll
                for (int r = 0; r < 4; ++r) { const float p = __builtin_amdgcn_exp2f(s[mt][r] - msafe); s[mt][r] = p; ps += p; }
            ps += __shfl_xor(ps, 16); ps += __shfl_xor(ps, 32);
            A.l = A.l * alpha + ps; A.m = mnew;
            if (MODE != TM_C1) {
#pragma unroll
                for (int t = 0; t < 4; ++t) A.O[t] = A.O[t] * alpha;
            }
        }
    }
    if (MODE != TM_C1) {
        bf16x8 pf[2];
#pragma unroll
        for (int k2 = 0; k2 < 2; ++k2) {
            u32x4 w; w.x = cvt_pk_bf16(s[2 * k2][0], s[2 * k2][1]); w.y = cvt_pk_bf16(s[2 * k2][2], s[2 * k2][3]); w.z = cvt_pk_bf16(s[2 * k2 + 1][0], s[2 * k2 + 1][1]); w.w = cvt_pk_bf16(s[2 * k2 + 1][2], s[2 * k2 + 1][3]);
            pf[k2] = __builtin_bit_cast(bf16x8, w);
        }
#pragma unroll
        for (int t = 0; t < 4; ++t) { A.O[t] = mfma16(*(const LAS bf16x8*)(vb0 + t * 2048), pf[0], A.O[t]); A.O[t] = mfma16(*(const LAS bf16x8*)(vb1 + t * 2048), pf[1], A.O[t]); }
    }
}

template <bool NEARB>
__device__ __forceinline__ void slot_pair_ss(const bf16x8 (&kf)[4][2], const LAS unsigned char* vb0, const LAS unsigned char* vb1, const bf16x8 (&q0)[2], const bf16x8 (&q1)[2],
                                             int dbase0, int dbase1, const LAS float* rt, SlotState& A0, SlotState& A1, float mrow0, float mrow1) {
    f32x4 s0[4], s1[4];
#pragma unroll
    for (int mt = 0; mt < 4; ++mt) {
        s0[mt] = mfma16(kf[mt][0], q0[0], (f32x4){0.f, 0.f, 0.f, 0.f}); s1[mt] = mfma16(kf[mt][0], q1[0], (f32x4){0.f, 0.f, 0.f, 0.f});
        s0[mt] = mfma16(kf[mt][1], q0[1], s0[mt]); s1[mt] = mfma16(kf[mt][1], q1[1], s1[mt]);
    }
    if (NEARB) {
        const LAS float* rp0 = rt + (RT_OFF - dbase0); const LAS float* rp1 = rt + (RT_OFF - dbase1);
#pragma unroll
        for (int mt = 0; mt < 4; ++mt)
#pragma unroll
            for (int r = 0; r < 4; ++r) { s0[mt][r] += rp0[16 * mt + r]; s1[mt][r] += rp1[16 * mt + r]; }
    }
    float ps0 = 0.f, ps1 = 0.f;
#pragma unroll
    for (int mt = 0; mt < 4; ++mt)
#pragma unroll
        for (int r = 0; r < 4; ++r) {
            const float p0 = __builtin_amdgcn_exp2f(s0[mt][r] - mrow0), p1 = __builtin_amdgcn_exp2f(s1[mt][r] - mrow1);
            s0[mt][r] = p0; s1[mt][r] = p1; ps0 += p0; ps1 += p1;
        }
    bf16x8 pf0[2], pf1[2];
#pragma unroll
    for (int k2 = 0; k2 < 2; ++k2) {
        u32x4 w; w.x = cvt_pk_bf16(s0[2 * k2][0], s0[2 * k2][1]); w.y = cvt_pk_bf16(s0[2 * k2][2], s0[2 * k2][3]); w.z = cvt_pk_bf16(s0[2 * k2 + 1][0], s0[2 * k2 + 1][1]); w.w = cvt_pk_bf16(s0[2 * k2 + 1][2], s0[2 * k2 + 1][3]);
        pf0[k2] = __builtin_bit_cast(bf16x8, w);
        u32x4 v; v.x = cvt_pk_bf16(s1[2 * k2][0], s1[2 * k2][1]); v.y = cvt_pk_bf16(s1[2 * k2][2], s1[2 * k2][3]); v.z = cvt_pk_bf16(s1[2 * k2 + 1][0], s1[2 * k2 + 1][1]); v.w = cvt_pk_bf16(s1[2 * k2 + 1][2], s1[2 * k2 + 1][3]);
        pf1[k2] = __builtin_bit_cast(bf16x8, v);
    }
#pragma unroll
    for (int t = 0; t < 4; ++t) {
        const bf16x8 va = *(const LAS bf16x8*)(vb0 + t * 2048), vb = *(const LAS bf16x8*)(vb1 + t * 2048);
        A0.O[t] = mfma16(va, pf0[0], A0.O[t]); A1.O[t] = mfma16(va, pf1[0], A1.O[t]);
        A0.O[t] = mfma16(vb, pf0[1], A0.O[t]); A1.O[t] = mfma16(vb, pf1[1], A1.O[t]);
    }
    ps0 += __shfl_xor(ps0, 16); ps1 += __shfl_xor(ps1, 16); ps0 += __shfl_xor(ps0, 32); ps1 += __shfl_xor(ps1, 32);
    A0.l += ps0; A1.l += ps1;
}

__device__ __forceinline__ void nsa_item(const Frame& F, int item) {
    const int bhk = item & 7, cb = 127 - (item >> 3), b = bhk >> 1, hk = bhk & 1;
    int tid_ = F.tid, lane_ = F.lane; asm volatile("" : "+v"(tid_), "+v"(lane_));
    const int tid = tid_, lane = lane_, wave = F.wave, n = lane & 15, ts = n >> 2, g = n & 3, kg = lane >> 4;
    const bf16* nq = (const bf16*)(F.ws + WS_NQ); const bf16* nkv = (const bf16*)(F.ws + WS_NKV) + (size_t)b * SEQ * 768;
    const bf16* kcmp = (const bf16*)(F.ws + WS_KCMP) + (size_t)bhk * 512 * 64; const bf16* vcmpt = (const bf16*)(F.ws + WS_VCMPT) + (size_t)bhk * 64 * 512;
    const bf16* vst = (const bf16*)(F.ws + WS_VST) + (size_t)bhk * 64 * SEQ; const bf16* vwt = (const bf16*)(F.ws + WS_VWT) + (size_t)bhk * 64 * SEQ;
    const float* small = (const float*)(F.ws + WS_SMALL); const bf16* nz = (const bf16*)(F.ws + WS_NZ); bf16* mix = (bf16*)(F.ws + WS_MIX);
    LAS float* btl = (LAS float*)(F.lds + NL_BT); LAS float* imp = (LAS float*)(F.lds + NL_IMP);
    LAS unsigned* maskw = (LAS unsigned*)(F.lds + NL_MASK); LAS unsigned* smaskw = (LAS unsigned*)(F.lds + NL_SMASK);
    LAS unsigned char* kvb = F.lds + NL_KV;
    const LAS float* bt = btl + g * RT_LEN;
    { const float* btg = (const float*)(F.ws + WS_BT) + (size_t)(hk * 4) * 1025;
      for (int i = tid; i < 4 * RT_LEN; i += 512) { const int hh = i / RT_LEN, ii = i - hh * RT_LEN; const int d = RT_OFF - ii; btl[i] = d >= 0 ? btg[hh * 1025 + (d > 1024 ? 1024 : d)] : 0.f; }
      for (int i = lane; i < 8 * 130; i += 64) imp[wave * 8 * 130 + i] = 0.f; }
    const int tw0 = cb * 64 + wave * 8;
    int trow[2]; size_t tokg[2]; bf16x8 q[2][2];
    LAS float* totp = (LAS float*)(F.lds + NL_TOT) + ((wave * 8 + ts) * 4 + g) * 68 + 4 * kg;
#pragma unroll
    for (int sl = 0; sl < 2; ++sl) {
        trow[sl] = tw0 + 4 * sl + ts; tokg[sl] = (size_t)b * SEQ + trow[sl];
        const bf16* qp = nq + tokg[sl] * 512 + (hk * 4 + g) * 64 + 8 * kg;
        q[sl][0] = *(const bf16x8*)qp; q[sl][1] = *(const bf16x8*)(qp + 32);
    }
    SlotState A[2];
    bf16x8 kf[4][2];
    const int fb0 = n * 128 + ((kg ^ (n & 7)) << 4), fb1 = n * 128 + (((4 + kg) ^ (n & 7)) << 4);
#define NS_LOADK(buf) do { _Pragma("unroll") for (int _mt = 0; _mt < 4; ++_mt) { kf[_mt][0] = *(const LAS bf16x8*)((buf) + fb0 + _mt * 2048); kf[_mt][1] = *(const LAS bf16x8*)((buf) + fb1 + _mt * 2048); } } while (0)
#define NS_LOADV(buf) do { _Pragma("unroll") for (int _t = 0; _t < 4; ++_t) _Pragma("unroll") for (int _ks = 0; _ks < 2; ++_ks) vf[_t][_ks] = tile_frag((buf) + 8192, 16 * _t + n, 4 * _ks + kg); } while (0)
#define NS_RESET() do { _Pragma("unroll") for (int _s = 0; _s < 2; ++_s) { A[_s].m = -1e30f; A[_s].l = 0.f; _Pragma("unroll") for (int _t = 0; _t < 4; ++_t) A[_s].O[_t] = (f32x4){0.f, 0.f, 0.f, 0.f}; } } while (0)
#define NS_BAR() do { asm volatile("s_waitcnt lgkmcnt(0)" ::: "memory"); __builtin_amdgcn_s_barrier(); asm volatile("" ::: "memory"); } while (0)
#define NS_PIPE(NT, KEY0, KB, KSTR, VTB, VLEN, NB, BUF, ...) do { \
        const int _nt = (NT); \
        for (int _p = 0; _p < (NB) - 1 && _p < _nt; ++_p) stage_dma(BUF(_p), KB, KSTR, VTB, VLEN, KEY0(_p), wave, lane); \
        wait_tiles((_nt - 1) < ((NB) - 2) ? (_nt - 1) : ((NB) - 2)); NS_BAR(); \
        for (int ti = 0; ti < _nt; ++ti) { \
            const LAS unsigned char* cbuf = BUF(ti & ((NB) - 1)); \
            if (ti + (NB) - 1 < _nt) stage_dma(BUF((ti + (NB) - 1) & ((NB) - 1)), KB, KSTR, VTB, VLEN, KEY0(ti + (NB) - 1), wave, lane); \
            __VA_ARGS__ \
            { const int _rem = _nt - 2 - ti; wait_tiles(_rem < 0 ? 0 : (_rem < (NB) - 2 ? _rem : (NB) - 2)); } \
            NS_BAR(); \
        } } while (0)
#define BUF2(i) (kvb + (i) * 16384)
#define BUF4(i) ((i) < 2 ? kvb + (i) * 16384 : (LAS unsigned char*)(F.lds + NL_IMP) + ((i) - 2) * 16384)
    __syncthreads();
    const float bfarv = bt[RT_OFF - 1024];
    const int ntc = ((4 * cb + 2) >> 6) + 1;
#define KEY0_LIN(i) (64 * (i))
    for (int prb = 0; prb <= PRB_C; ++prb) {
    NS_RESET();
    NS_PIPE(ntc, KEY0_LIN, kcmp, 64, vcmpt, 512, 2, BUF2, {
        NS_LOADK(cbuf);
        const int db0 = trow[0] - 31 - 16 * (64 * ti + 4 * kg), db1 = trow[1] - 31 - 16 * (64 * ti + 4 * kg);
        if (64 * cb - 1024 * ti - 1039 >= 790) {
            slot_tile<TM_C1, false>(kf, cbuf + 8192 + fb0, cbuf + 8192 + fb1, q[0], db0, bt, A[0], 0.f, 0.f, bfarv, nullptr, 64 * ti, lane);
            slot_tile<TM_C1, false>(kf, cbuf + 8192 + fb0, cbuf + 8192 + fb1, q[1], db1, bt, A[1], 0.f, 0.f, bfarv, nullptr, 64 * ti, lane);
        } else {
            slot_tile<TM_C1, true>(kf, cbuf + 8192 + fb0, cbuf + 8192 + fb1, q[0], db0, bt, A[0], 0.f, 0.f, bfarv, nullptr, 64 * ti, lane);
            slot_tile<TM_C1, true>(kf, cbuf + 8192 + fb0, cbuf + 8192 + fb1, q[1], db1, bt, A[1], 0.f, 0.f, bfarv, nullptr, 64 * ti, lane);
        }
    });
    }
    {
        const float li0 = A[0].l > 0.f ? 1.0f / A[0].l : 0.f, li1 = A[1].l > 0.f ? 1.0f / A[1].l : 0.f;
        NS_PIPE(ntc, KEY0_LIN, kcmp, 64, vcmpt, 512, 2, BUF2, {
            NS_LOADK(cbuf);
            const int db0 = trow[0] - 31 - 16 * (64 * ti + 4 * kg), db1 = trow[1] - 31 - 16 * (64 * ti + 4 * kg);
            if (64 * cb - 1024 * ti - 1039 >= 790) {
                slot_tile<TM_C2, false>(kf, cbuf + 8192 + fb0, cbuf + 8192 + fb1, q[0], db0, bt, A[0], li0, 0.f, bfarv, imp + (wave * 8 + ts) * 130, 64 * ti, lane);
                slot_tile<TM_C2, false>(kf, cbuf + 8192 + fb0, cbuf + 8192 + fb1, q[1], db1, bt, A[1], li1, 0.f, bfarv, imp + (wave * 8 + 4 + ts) * 130, 64 * ti, lane);
            } else {
                slot_tile<TM_C2, true>(kf, cbuf + 8192 + fb0, cbuf + 8192 + fb1, q[0], db0, bt, A[0], li0, 0.f, bfarv, imp + (wave * 8 + ts) * 130, 64 * ti, lane);
                slot_tile<TM_C2, true>(kf, cbuf + 8192 + fb0, cbuf + 8192 + fb1, q[1], db1, bt, A[1], li1, 0.f, bfarv, imp + (wave * 8 + 4 + ts) * 130, 64 * ti, lane);
            }
        });
#pragma unroll
        for (int sl = 0; sl < 2; ++sl) { const float gate = small[tokg[sl] * 32 + 8 + hk * 4 + g];
#pragma unroll
            for (int t = 0; t < 4; ++t) *(LAS f32x4*)(totp + sl * 16 * 68 + 16 * t) = A[sl].O[t] * gate; }
    }
#pragma unroll
    for (int sl = 0; sl < 2; ++sl) {
        const int tsl = lane >> 4, i = lane & 15; const int tk = wave * 8 + 4 * sl + tsl;
        unsigned mw0 = 0u, mw1 = 0u, mw2 = 0u, mw3 = 0u;
#define NS_SETBIT(j) do { const unsigned _b = 1u << ((j) & 31); const int _w = (j) >> 5; mw0 |= _w == 0 ? _b : 0u; mw1 |= _w == 1 ? _b : 0u; mw2 |= _w == 2 ? _b : 0u; mw3 |= _w == 3 ? _b : 0u; } while (0)
        if (cb <= 15) { mw0 = (2u << cb) - 1u; }
        else {
            float val[8];
#pragma unroll
            for (int qq = 0; qq < 8; ++qq) { const int j = i + 16 * qq; val[qq] = (j >= 1 && j <= cb - 2) ? imp[tk * 130 + j] : -1.0f; }
            NS_SETBIT(0); NS_SETBIT(cb - 1); NS_SETBIT(cb);
            for (int round = 0; round < 13; ++round) {
                float bv = -2.0f; int bj = 1 << 20;
#pragma unroll
                for (int qq = 0; qq < 8; ++qq) if (val[qq] > bv) { bv = val[qq]; bj = i + 16 * qq; }
#pragma unroll
                for (int off = 1; off < 16; off <<= 1) {
                    const float ov = __shfl_xor(bv, off); const int oj = __shfl_xor(bj, off);
                    if (ov > bv || (ov == bv && oj < bj)) { bv = ov; bj = oj; }
                }
#pragma unroll
                for (int qq = 0; qq < 8; ++qq) if (bj == i + 16 * qq) val[qq] = -3.0f;
                NS_SETBIT(bj);
            }
        }
        if (i == 0) { maskw[tk * 4 + 0] = mw0; maskw[tk * 4 + 1] = mw1; maskw[tk * 4 + 2] = mw2; maskw[tk * 4 + 3] = mw3; }
        mw0 |= __shfl_xor(mw0, 16); mw0 |= __shfl_xor(mw0, 32); mw1 |= __shfl_xor(mw1, 16); mw1 |= __shfl_xor(mw1, 32);
        mw2 |= __shfl_xor(mw2, 16); mw2 |= __shfl_xor(mw2, 32); mw3 |= __shfl_xor(mw3, 16); mw3 |= __shfl_xor(mw3, 32);
        if (lane == 0) { const int so = (wave * 2 + sl) * 4; smaskw[so] = mw0; smaskw[so + 1] = mw1; smaskw[so + 2] = mw2; smaskw[so + 3] = mw3; }
    }
    __syncthreads();
    {
#define KEY0_SEL(i) (64 * (cb == 0 ? 0 : (cb == 1 ? 1 - (i) : ((i) == 0 ? cb : ((i) == 1 ? cb - 1 : ((i) == 2 ? 0 : (i) - 2))))))
        const int tk0 = wave * 8 + ts;
        unsigned smk0[4], smk1[4], rmk0[4], rmk1[4];
#pragma unroll
        for (int w4 = 0; w4 < 4; ++w4) {
            smk0[w4] = __builtin_amdgcn_readfirstlane(smaskw[(wave * 2 + 0) * 4 + w4]); smk1[w4] = __builtin_amdgcn_readfirstlane(smaskw[(wave * 2 + 1) * 4 + w4]);
            rmk0[w4] = maskw[tk0 * 4 + w4]; rmk1[w4] = maskw[(tk0 + 4) * 4 + w4];
        }
        const LAS unsigned char* const Kb_ = nullptr; (void)Kb_;
        const bf16* ksl = nkv + 256 + hk * 64;
        for (int prb = 0; prb <= PRB_S; ++prb) {
        NS_RESET();
        const int nt = cb + 1, np = (nt + 1) >> 1;
        stage_dma(BUF4(0), ksl, 768, vst, SEQ, KEY0_SEL(0), wave, lane); if (nt > 1) stage_dma(BUF4(1), ksl, 768, vst, SEQ, KEY0_SEL(1), wave, lane);
        wait_tiles(0); NS_BAR();
        for (int p = 0; p < np; ++p) {
            const int sb = (p & 1) * 2;
            if (p + 1 < np) { stage_dma(BUF4(2 - sb), ksl, 768, vst, SEQ, KEY0_SEL(2 * p + 2), wave, lane); if (2 * p + 3 < nt) stage_dma(BUF4(3 - sb), ksl, 768, vst, SEQ, KEY0_SEL(2 * p + 3), wave, lane); }
#pragma unroll 1
            for (int hh = 0; hh < 2; ++hh) {
                const int ti = 2 * p + hh; if (ti >= nt) break;
                const LAS unsigned char* cbuf = BUF4(sb + hh);
                const int key0 = KEY0_SEL(ti); const int j = key0 >> 6;
                const bool dense = (cb < 2) || (ti < 3);
                const int db0 = trow[0] - key0 - 4 * kg, db1 = trow[1] - key0 - 4 * kg;
                const bool nearb = (cb - j) < 14;
                if (dense) {
                    NS_LOADK(cbuf);
                    if (nearb) {
                        slot_tile<TM_SD, true>(kf, cbuf + 8192 + fb0, cbuf + 8192 + fb1, q[0], db0, bt, A[0], 0.f, 0.f, bfarv, nullptr, key0, lane);
                        slot_tile<TM_SD, true>(kf, cbuf + 8192 + fb0, cbuf + 8192 + fb1, q[1], db1, bt, A[1], 0.f, 0.f, bfarv, nullptr, key0, lane);
                    } else {
                        slot_tile<TM_SD, false>(kf, cbuf + 8192 + fb0, cbuf + 8192 + fb1, q[0], db0, bt, A[0], 0.f, 0.f, bfarv, nullptr, key0, lane);
                        slot_tile<TM_SD, false>(kf, cbuf + 8192 + fb0, cbuf + 8192 + fb1, q[1], db1, bt, A[1], 0.f, 0.f, bfarv, nullptr, key0, lane);
                    }
                } else {
                    const int w4 = j >> 5, bit = j & 31;
                    const unsigned sm0 = w4 == 0 ? smk0[0] : (w4 == 1 ? smk0[1] : (w4 == 2 ? smk0[2] : smk0[3])), sm1 = w4 == 0 ? smk1[0] : (w4 == 1 ? smk1[1] : (w4 == 2 ? smk1[2] : smk1[3]));
                    const bool a0 = (sm0 >> bit) & 1u, a1 = (sm1 >> bit) & 1u;
                    if (a0 || a1) {
                        NS_LOADK(cbuf);
                        const unsigned rm0 = w4 == 0 ? rmk0[0] : (w4 == 1 ? rmk0[1] : (w4 == 2 ? rmk0[2] : rmk0[3])), rm1 = w4 == 0 ? rmk1[0] : (w4 == 1 ? rmk1[1] : (w4 == 2 ? rmk1[2] : rmk1[3]));
                        const float boff = nearb ? 0.f : bfarv;
                        const float mr0 = ((rm0 >> bit) & 1u) ? A[0].m - boff : 1e30f, mr1 = ((rm1 >> bit) & 1u) ? A[1].m - boff : 1e30f;
                        if (a0 && a1) {
                            if (nearb) slot_pair_ss<true>(kf, cbuf + 8192 + fb0, cbuf + 8192 + fb1, q[0], q[1], db0, db1, bt, A[0], A[1], mr0, mr1);
                            else slot_pair_ss<false>(kf, cbuf + 8192 + fb0, cbuf + 8192 + fb1, q[0], q[1], db0, db1, bt, A[0], A[1], mr0, mr1);
                        } else if (a0) {
                            if (nearb) slot_tile<TM_SS, true>(kf, cbuf + 8192 + fb0, cbuf + 8192 + fb1, q[0], db0, bt, A[0], 0.f, mr0, 0.f, nullptr, key0, lane);
                            else slot_tile<TM_SS, false>(kf, cbuf + 8192 + fb0, cbuf + 8192 + fb1, q[0], db0, bt, A[0], 0.f, mr0, 0.f, nullptr, key0, lane);
                        } else {
                            if (nearb) slot_tile<TM_SS, true>(kf, cbuf + 8192 + fb0, cbuf + 8192 + fb1, q[1], db1, bt, A[1], 0.f, mr1, 0.f, nullptr, key0, lane);
                            else slot_tile<TM_SS, false>(kf, cbuf + 8192 + fb0, cbuf + 8192 + fb1, q[1], db1, bt, A[1], 0.f, mr1, 0.f, nullptr, key0, lane);
                        }
                    }
                }
            }
            wait_tiles(0); NS_BAR();
        }
        }
#pragma unroll
        for (int sl = 0; sl < 2; ++sl) { const float gate = small[tokg[sl] * 32 + 16 + hk * 4 + g]; const float sc = A[sl].l > 0.f ? gate / A[sl].l : 0.f;
#pragma unroll
            for (int t = 0; t < 4; ++t) { LAS f32x4* tp = (LAS f32x4*)(totp + sl * 16 * 68 + 16 * t); *tp = *tp + A[sl].O[t] * sc; } }
    }
    {
        const int jw0 = cb >= 8 ? cb - 8 : 0;
#define KEY0_WIN(i) (64 * (jw0 + (i)))
        for (int prb = 0; prb <= PRB_W; ++prb) {
        NS_RESET();
        NS_PIPE(cb - jw0 + 1, KEY0_WIN, nkv + 512 + hk * 64, 768, vwt, SEQ, 4, BUF4, {
            NS_LOADK(cbuf);
            slot_tile<TM_W, true>(kf, cbuf + 8192 + fb0, cbuf + 8192 + fb1, q[0], trow[0] - KEY0_WIN(ti) - 4 * kg, bt, A[0], 0.f, 0.f, 0.f, nullptr, KEY0_WIN(ti), lane);
            slot_tile<TM_W, true>(kf, cbuf + 8192 + fb0, cbuf + 8192 + fb1, q[1], trow[1] - KEY0_WIN(ti) - 4 * kg, bt, A[1], 0.f, 0.f, 0.f, nullptr, KEY0_WIN(ti), lane);
        });
        }
#pragma unroll
        for (int sl = 0; sl < 2; ++sl) { const float gate = small[tokg[sl] * 32 + 24 + hk * 4 + g]; const float sc = A[sl].l > 0.f ? gate / A[sl].l : 0.f;
#pragma unroll
            for (int t = 0; t < 4; ++t) { LAS f32x4* tp = (LAS f32x4*)(totp + sl * 16 * 68 + 16 * t); *tp = *tp + A[sl].O[t] * sc; } }
    }
    {
        int l2 = lane; asm volatile("" : "+v"(l2));
        const int n2 = l2 & 15, ts2 = n2 >> 2, g2 = n2 & 3, kg2 = l2 >> 4;
        const LAS float* tp2 = (const LAS float*)(F.lds + NL_TOT) + ((wave * 8 + ts2) * 4 + g2) * 68 + 4 * kg2;
#pragma unroll
        for (int sl = 0; sl < 2; ++sl) {
            const size_t tk = (size_t)b * SEQ + tw0 + 4 * sl + ts2;
#pragma unroll
            for (int t = 0; t < 4; ++t) {
                const u32x2 z = *(const u32x2*)(nz + tk * 512 + (hk * 4 + g2) * 64 + 16 * t + 4 * kg2);
                const f32x4 tv = *(const LAS f32x4*)(tp2 + sl * 16 * 68 + 16 * t);
                u32x2 d; d.x = cvt_pk_bf16(tv[0] * __uint_as_float(z.x << 16), tv[1] * __uint_as_float(z.x & 0xffff0000u));
                d.y = cvt_pk_bf16(tv[2] * __uint_as_float(z.y << 16), tv[3] * __uint_as_float(z.y & 0xffff0000u));
                *(u32x2*)(mix + tk * DM + 512 + (hk * 4 + g2) * 64 + 16 * t + 4 * kg2) = d;
            }
        }
    }
    __syncthreads();
#undef NS_LOADK
#undef NS_LOADV
#undef NS_RESET
#undef NS_PIPE
#undef NS_SETBIT
}
#ifndef DUP_P1
#define DUP_P1 0
#endif
#ifndef DUP_P2
#define DUP_P2 0
#endif
#ifndef DUP_SCAN
#define DUP_SCAN 0
#endif
#ifndef DUP_NSA
#define DUP_NSA 0
#endif
__device__ __forceinline__ void p2_phase(const Frame& F) {
    for (int rep = 0; rep <= DUP_P2; ++rep)
    for (int task = blockIdx.x; task < 3072; task += gridDim.x) {
        if (task < 2048) gdn_prep_item(F, task);
        else if (task < 2560) compress_block(F, task - 2048);
        else vtranspose_task(F, task - 2560);
    }
}
__device__ __forceinline__ void p3_phase(const Frame& F) {
    for (int rep = 0; rep <= DUP_SCAN; ++rep)
        for (int bh = blockIdx.x; bh < 16; bh += gridDim.x) gdn_scan(F, bh);
    LAS int* nxt = (LAS int*)(F.lds + NL_NXT);
    for (int rep = 0; rep <= DUP_NSA; ++rep) {
        const int bhk = blockIdx.x & 7;
        unsigned* ctr = (unsigned*)(F.ws + WS_CTL) + 64 + 64 * bhk + 1024 * rep;
        for (;;) {
            __syncthreads();
            if (F.tid == 0) *nxt = (int)atomicAdd(ctr, 1u);
            __syncthreads();
            const int qi = *nxt;
            if (qi >= 128) break;
            nsa_item(F, qi * 8 + bhk);
        }
    }
}
typedef __attribute__((address_space(1))) unsigned gu32;
#define XB_TMO      128
#define XB_XCNT(j)  (256  + 64 * (j))
#define XB_XSUB(j)  (1280 + 64 * (j))
#define XB_XGEN(j)  (2304 + 64 * (j))
#define XB_TOP      3328
#define XB_TOPGEN   3392
#define XCD_BAR_WORDS 3456
#define XB_SPIN_CAP (1u << 18)

__device__ __forceinline__ unsigned xb_ld(unsigned* p)              { return __hip_atomic_load(p, __ATOMIC_RELAXED, __HIP_MEMORY_SCOPE_AGENT); }
__device__ __forceinline__ unsigned xb_add(unsigned* p, unsigned v) { return __hip_atomic_fetch_add(p, v, __ATOMIC_RELAXED, __HIP_MEMORY_SCOPE_AGENT); }
__device__ __forceinline__ unsigned xb_xcc_id() { return (unsigned)__builtin_amdgcn_s_getreg((3 << 11) | 20) & 0xFu; }
#define XB_SPIN(cond, bar) do { unsigned _sp = 0; while (cond) { __builtin_amdgcn_s_sleep(1); \
    if ((++_sp & 255u) == 0u) { if (xb_ld(&(bar)[XB_TMO])) break; if (_sp > XB_SPIN_CAP) { atomicAdd(&(bar)[XB_TMO], 1u); break; } } } } while (0)

struct XcdBarrier {
    unsigned* bar; unsigned x;
    volatile LAS unsigned* st;
};

__device__ __forceinline__ XcdBarrier xcd_barrier_post(unsigned* bar, volatile LAS unsigned* st) {
    XcdBarrier b; b.bar = bar; b.x = xb_xcc_id(); b.st = st;
    if (threadIdx.x == 0) (void)xb_add(&bar[XB_XCNT(b.x)], 1u);
    return b;
}
__device__ __forceinline__ void xcd_barrier_complete(unsigned* bar, unsigned x, unsigned& nloc, unsigned& nx) {
    const unsigned G = gridDim.x * gridDim.y * gridDim.z;
    unsigned sum, cnt, mine, sp = 0u;
    for (;;) {
        sum = 0u; cnt = 0u; mine = 0u;
#pragma unroll
        for (unsigned j = 0; j < 16; ++j) { const unsigned c = xb_ld(&bar[XB_XCNT(j)]); sum += c; cnt += (c > 0u) ? 1u : 0u; mine = (j == x) ? c : mine; }
        if (sum == G) break;
        __builtin_amdgcn_s_sleep(1);
        if ((++sp & 255u) == 0u) { if (xb_ld(&bar[XB_TMO])) break; if (sp > XB_SPIN_CAP) { atomicAdd(&bar[XB_TMO], 1u); break; } }
    }
    nloc = mine > 0u ? mine : 1u; nx = cnt > 0u ? cnt : 1u;
}

__device__ __forceinline__ void xcd_barrier(const XcdBarrier& b) {
    asm volatile("s_waitcnt vmcnt(0)" ::: "memory");
    __syncthreads();
    if (threadIdx.x == 0) {
        unsigned* bar = b.bar;
        __builtin_amdgcn_s_waitcnt(0);
        unsigned nloc = b.st[0], nx = b.st[1];
        if (nloc == 0u) { xcd_barrier_complete(bar, b.x, nloc, nx); b.st[0] = nloc; b.st[1] = nx; }
        const unsigned old = xb_add(&bar[XB_XSUB(b.x)], 1u);
        const unsigned gen = old / nloc;
        if (old + 1u == (gen + 1u) * nloc) {
            __builtin_amdgcn_fence(__ATOMIC_RELEASE, "agent");
            asm volatile("s_waitcnt vmcnt(0)" ::: "memory");
            const unsigned og = xb_add(&bar[XB_TOP], 1u);
            const unsigned tg = og / nx;
            if (og + 1u == (tg + 1u) * nx) xb_add(&bar[XB_TOPGEN], 1u);
            else XB_SPIN(xb_ld(&bar[XB_TOPGEN]) == tg, bar);
            __builtin_amdgcn_fence(__ATOMIC_ACQUIRE, "agent");
            xb_add(&bar[XB_XGEN(b.x)], 1u);
            asm volatile("s_waitcnt vmcnt(0)" ::: "memory");
        } else {
            XB_SPIN(xb_ld(&bar[XB_XGEN(b.x)]) == gen, bar);
            __builtin_amdgcn_fence(__ATOMIC_ACQUIRE, "agent");
            asm volatile("s_waitcnt vmcnt(0)" ::: "memory");
        }
    }
    __syncthreads();
}

constexpr int LDS_BARST = LDS_BYTES - 64;
struct Args { const float* in[16]; float* out; unsigned char* ws; int ph_lo, ph_hi, coop, pad; };
constexpr int N_PHASES = 6;

__global__ void __launch_bounds__(512, 2) hymba_fwd(Args a) {
    extern __shared__ __attribute__((aligned(16))) unsigned char lds_raw[];
    Frame F;
#pragma unroll
    for (int i = 0; i < 16; ++i) F.in[i] = a.in[i];
    F.out = a.out; F.ws = a.ws; F.lds = (LAS unsigned char*)lds_raw; F.ldsg = lds_raw;
    F.tid = threadIdx.x; F.lane = F.tid & 63; F.wave = __builtin_amdgcn_readfirstlane(F.tid >> 6);
    unsigned char* ws = a.ws;
    volatile LAS unsigned* barst = (volatile LAS unsigned*)(F.lds + LDS_BARST);
    if (F.tid < 2) barst[F.tid] = 0u;
    __syncthreads();
    XcdBarrier xbar; xbar.bar = (unsigned*)(ws + WS_CTL) + 4096; xbar.x = 0; xbar.st = nullptr;
    if (a.coop) xbar = xcd_barrier_post((unsigned*)(ws + WS_CTL) + 4096, barst);
    const int lo = a.ph_lo, hi = a.ph_hi;
#define IN(k) (lo <= (k) && (k) < hi)
#define SEAM(k) do { if (IN(k) && IN((k) + 1) && a.coop) { if ((k) == 0) cg::this_grid().sync(); else xcd_barrier(xbar); } __syncthreads(); } while (0)
    if (IN(0)) p0_prep(F);
    SEAM(0);
    if (IN(1)) {
        pg8::Gemm g{(const bf16*)(ws + WS_XB), (const bf16*)(ws + WS_WTIN), T_TOK, NPROJ, DM};
        pg8::StaticOrder S; S.init(T_TOK, NPROJ, (int)gridDim.x, (int)blockIdx.x);
        EpiProj E{(bf16*)(ws + WS_GQKV), (bf16*)(ws + WS_GZ), (bf16*)(ws + WS_NQ), (bf16*)(ws + WS_NKV), (bf16*)(ws + WS_NZ), (const float*)(ws + WS_RS)};
        for (int rep = 0; rep <= DUP_P1; ++rep) pg8::gemm_phase<EpiProj, pg8::StaticOrder, false>(F.lds, g, S, E, nullptr);
    }
    SEAM(1);
    if (IN(2)) p2_phase(F);
    SEAM(2);
    if (IN(3)) p3_phase(F);
    SEAM(3);
    if (IN(4)) {
        pg8::Gemm g{(const bf16*)(ws + WS_MIX), (const bf16*)(ws + WS_WTOUT), T_TOK, DM, DM};
        pg8::StaticOrder S; S.init(T_TOK, DM, (int)gridDim.x, (int)blockIdx.x);
        EpiOut E{F.in[0], F.out};
        pg8::gemm_phase<EpiOut, pg8::StaticOrder, false>(F.lds, g, S, E, nullptr);
    }
    SEAM(4);
    if (IN(5)) p5_final(F);
#undef IN
#undef SEAM
}

extern "C" void kernel_launch(void* const* d_in, const int* in_sizes, int n_in, void* d_out, int out_size, void* d_ws, size_t ws_size, hipStream_t stream) {
    static int grid = 0;
    if (grid == 0) {
        if (n_in != 16 || in_sizes[0] != T_TOK * DM || out_size != T_TOK * DM || ws_size < WS_END) { fprintf(stderr, "kernel_launch: unexpected shapes (n_in %d, ws %zu)\n", n_in, ws_size); grid = -1; return; }
        int dev = 0, cus = 0, per_cu = 0;
        if (hipGetDevice(&dev) != hipSuccess || hipDeviceGetAttribute(&cus, hipDeviceAttributeMultiprocessorCount, dev) != hipSuccess) { grid = -1; return; }
        if (hipFuncSetAttribute((const void*)hymba_fwd, hipFuncAttributeMaxDynamicSharedMemorySize, LDS_BYTES) != hipSuccess) { fprintf(stderr, "kernel_launch: hipFuncSetAttribute failed\n"); grid = -1; return; }
        if (hipOccupancyMaxActiveBlocksPerMultiprocessor(&per_cu, (const void*)hymba_fwd, 512, LDS_BYTES) != hipSuccess || per_cu < 1) { fprintf(stderr, "kernel_launch: occupancy query says %d\n", per_cu); per_cu = 1; }
        (void)hipGetLastError();
        grid = cus;
    }
    if (grid < 0) return;
    (void)hipMemsetAsync((char*)d_ws + WS_CTL, 0, 1 * MiB, stream);
    Args a{};
    for (int i = 0; i < 16; ++i) a.in[i] = (const float*)d_in[i];
    a.out = (float*)d_out; a.ws = (unsigned char*)d_ws;
#if MK_LAUNCHES == 1
    a.ph_lo = 0; a.ph_hi = N_PHASES; a.coop = 1;
    void* args[] = {&a};
    hipError_t e = hipLaunchCooperativeKernel((const void*)hymba_fwd, dim3(grid), dim3(512), args, LDS_BYTES, stream);
    if (e != hipSuccess) fprintf(stderr, "cooperative launch failed: %s (grid %d)\n", hipGetErrorString(e), grid);
#else
    for (int ph = 0; ph < N_PHASES; ++ph) {
        a.ph_lo = ph; a.ph_hi = ph + 1; a.coop = 0;
        hipLaunchKernelGGL(hymba_fwd, dim3(grid), dim3(512), LDS_BYTES, stream, a);
    }
#endif
}
```

```cpp
#include <hip/hip_runtime.h>
#include <hip/hip_cooperative_groups.h>
#include <cstdio>
#include <cstdint>
namespace cg = cooperative_groups;
#ifndef MK_LAUNCHES
#define MK_LAUNCHES 1
#endif

namespace pg8 {
#define PG8_LAS __attribute__((address_space(3)))
typedef unsigned short bf16_t;
typedef short bf16x8 __attribute__((ext_vector_type(8)));
typedef float f32x4 __attribute__((ext_vector_type(4)));
typedef unsigned u32x4 __attribute__((ext_vector_type(4)));
constexpr int BM = 256, BK = 64, HALF = 128, HTB = HALF * BK * 2  , STAGE_BYTES = 8 * HTB, NXCD = 8, WGM = 8;

__host__ __device__ __forceinline__ int lds_byte(int r, int c) { const int st = (r >> 4) * 2 + (c >> 5), rr = r & 15, cc = c & 31, ob = rr * 64 + cc * 2; return st * 1024 + (ob ^ (((ob >> 9) & 1) << 5)); }
__host__ __device__ __forceinline__ void stage_rc(int b, int& R, int& C) { const int st = b / 1024, sb = b % 1024, swz = sb ^ (((sb >> 9) & 1) << 5); R = (st >> 1) * 16 + swz / 64; C = (st & 1) * 32 + (swz % 64) / 2; }
__host__ __device__ __forceinline__ int perm32(int rho) { const int n = rho >> 4, i = rho & 15; return 8 * (i >> 2) + 4 * n + (i & 3); }

struct Unit { int pm, pn; };
struct Gemm { const bf16_t* A; const bf16_t* Bt; int M, N, K; };

struct StaticOrder {
    int nM, nN, nwg, G, c;
    __host__ __device__ void init(int M, int N, int G_, int c_) { nM = M / BM; nN = N / BM; nwg = nM * nN; G = G_; c = c_; }
    __host__ __device__ bool next(int i, Unit& u) const {
        const long L = (long)i * G + c; if (L >= nwg) return false;
        int wgid = (int)L; { const int q = nwg / NXCD, r = nwg % NXCD, xcd = wgid % NXCD, off = wgid / NXCD; wgid = (xcd < r ? xcd * (q + 1) : r * (q + 1) + (xcd - r) * q) + off; }
        const int nig = WGM * nN, gid = wgid / nig, fm = gid * WGM, gsz = (nM - fm) < WGM ? (nM - fm) : WGM;
        u.pm = fm + ((wgid % nig) % gsz); u.pn = (wgid % nig) / gsz; return true;
    }
    __device__ __forceinline__ void a_ready(const Unit&) const {}
    __device__ __forceinline__ void done(const Unit&) const {}
};
__device__ __forceinline__ unsigned cvt_pk_bf16(float lo, float hi) { unsigned r; asm volatile("v_cvt_pk_bf16_f32 %0, %1, %2" : "=v"(r) : "v"(lo), "v"(hi)); return r; }
typedef float f32x2 __attribute__((ext_vector_type(2)));
template <class Epi, class Sched, bool STAMP = false>
__device__ __forceinline__ void gemm_phase(PG8_LAS unsigned char* lds, const Gemm g, const Sched& S, const Epi& E, unsigned long long* stamps) {
    const int tid = threadIdx.x, wid = __builtin_amdgcn_readfirstlane(tid >> 6), lane = tid & 63, wr = wid >> 2, wc = wid & 3, fr = lane & 15, fq = lane >> 4;
    const int K = g.K, nt = K / BK;
    int ts_lo = 0, ts_hi = 0, nts = 0; const unsigned long long rt_entry = STAMP ? (unsigned long long)wall_clock64() : 0ull;
#define PG8_STAMP() do { if (STAMP && wid == 0 && nts < 64) { const unsigned long long _c = (unsigned long long)clock64(); \
        ts_lo = (lane == nts) ? (int)(unsigned)_c : ts_lo; ts_hi = (lane == nts) ? (int)(unsigned)(_c >> 32) : ts_hi; ++nts; } } while (0)
    PG8_STAMP();
    unsigned voffA[2], voffB[2];
#pragma unroll
    for (int i = 0; i < 2; ++i) { int R, C; stage_rc(tid * 16 + i * 8192, R, C); const int Rb = Epi::PERM ? ((R & ~31) + perm32(R & 31)) : R;
        voffA[i] = (unsigned)(R * K + C) * 2u; voffB[i] = (unsigned)(Rb * K + C) * 2u; }
    const size_t kstep = (size_t)(BK * 2);
    const size_t hstep = (size_t)HALF * K * 2;
    const size_t tstep = 2 * hstep;
    const unsigned ldsw = (unsigned)wid * 1024u;
    const int aoff = lds_byte(wr * 64 + fr, fq * 8), boff = lds_byte(wc * 32 + fr, fq * 8);
#define PG8_SA(b, h) (((b) * 2 + (h)) * HTB)
#define PG8_SB(b, h) ((4 + (b) * 2 + (h)) * HTB)
#define PG8_STAGE(bufoff, gbase, voff) do { _Pragma("unroll") for (int _i = 0; _i < 2; ++_i) \
        __builtin_amdgcn_global_load_lds((const unsigned*)((const char*)(gbase) + (voff)[_i]), (PG8_LAS unsigned*)(lds + (bufoff) + ldsw + _i * 8192), 16, 0, 0); } while (0)
#define PG8_LDA(dst, b, h) do { _Pragma("unroll") for (int m = 0; m < 4; ++m) _Pragma("unroll") for (int k = 0; k < 2; ++k) dst[m][k] = *(const PG8_LAS bf16x8*)(lds + PG8_SA(b, h) + aoff + m * 2048 + k * 1024); } while (0)
#define PG8_LDB(dst, b, h) do { _Pragma("unroll") for (int n = 0; n < 2; ++n) _Pragma("unroll") for (int k = 0; k < 2; ++k) dst[n][k] = *(const PG8_LAS bf16x8*)(lds + PG8_SB(b, h) + boff + n * 2048 + k * 1024); } while (0)
#define PG8_MMA(ai, bj, At, Bt) do { __builtin_amdgcn_s_setprio(1); _Pragma("unroll") for (int m = 0; m < 4; ++m) _Pragma("unroll") for (int n = 0; n < 2; ++n) _Pragma("unroll") for (int k = 0; k < 2; ++k) \
        acc[ai][bj][m][n] = __builtin_amdgcn_mfma_f32_16x16x32_bf16(Bt[n][k], At[m][k], acc[ai][bj][m][n], 0, 0, 0); __builtin_amdgcn_s_setprio(0); } while (0)
#define PG8_WAIT_V(n) asm volatile("s_waitcnt vmcnt(" #n ")" ::: "memory")
#define PG8_WAIT_L(n) asm volatile("s_waitcnt lgkmcnt(" #n ")" ::: "memory")
#define PG8_BAR __builtin_amdgcn_s_barrier()
#define PG8_SCHED __builtin_amdgcn_sched_barrier(0)
    Unit cur, nxt; int ui = 0;
    if (!S.next(0, cur)) return;
    f32x4 acc[2][2][4][2];
#pragma unroll
    for (int a = 0; a < 2; ++a)
#pragma unroll
        for (int b = 0; b < 2; ++b)
#pragma unroll
            for (int m = 0; m < 4; ++m)
#pragma unroll
                for (int n = 0; n < 2; ++n) acc[a][b][m][n] = (f32x4){0.f, 0.f, 0.f, 0.f};
    bf16x8 At[4][2], B0[2][2], B1[2][2];
    const char* cA = (const char*)g.A + (size_t)cur.pm * tstep; const char* cB = (const char*)g.Bt + (size_t)cur.pn * tstep;
    S.a_ready(cur);
    PG8_STAGE(PG8_SB(0, 0), cB, voffB); PG8_STAGE(PG8_SA(0, 0), cA, voffA); PG8_STAGE(PG8_SB(0, 1), cB + hstep, voffB); PG8_STAGE(PG8_SA(0, 1), cA + hstep, voffA);
    if (wr == 1) PG8_BAR;
    PG8_WAIT_V(4); PG8_BAR;
    PG8_STAGE(PG8_SB(1, 0), cB + kstep, voffB); PG8_STAGE(PG8_SA(1, 0), cA + kstep, voffA); PG8_STAGE(PG8_SB(1, 1), cB + hstep + kstep, voffB);
    PG8_WAIT_V(6); PG8_BAR;
    PG8_STAMP();
    for (;;) {
        const bool has_next = S.next(ui + 1, nxt);
        const char* nA = has_next ? (const char*)g.A + (size_t)nxt.pm * tstep : cA; const char* nB = has_next ? (const char*)g.Bt + (size_t)nxt.pn * tstep : cB;
        for (int t = 0; t < nt; t += 2) {
            const bool last = (t == nt - 2);
            const char* a1 = cA + (size_t)(t + 1) * kstep;
            const char* a2 = last ? nA : cA + (size_t)(t + 2) * kstep; const char* b2 = last ? nB : cB + (size_t)(t + 2) * kstep;
            const char* a3 = a2 + kstep; const char* b3 = b2 + kstep;
            if (last && has_next) S.a_ready(nxt);
            PG8_LDB(B0, 0, 0); PG8_SCHED; PG8_LDA(At, 0, 0); PG8_STAGE(PG8_SA(1, 1), a1 + hstep, voffA);
            PG8_WAIT_L(8); PG8_BAR; PG8_WAIT_L(0); PG8_MMA(0, 0, At, B0); PG8_BAR; PG8_SCHED;
            PG8_LDB(B1, 0, 1); PG8_STAGE(PG8_SB(0, 0), b2, voffB);
            PG8_BAR; PG8_WAIT_L(0); PG8_MMA(0, 1, At, B1); PG8_BAR;
            PG8_LDA(At, 0, 1); PG8_STAGE(PG8_SA(0, 0), a2, voffA);
            PG8_BAR; PG8_WAIT_L(0); PG8_MMA(1, 0, At, B0); PG8_BAR; PG8_SCHED;
            PG8_STAGE(PG8_SB(0, 1), b2 + hstep, voffB);
            PG8_WAIT_V(6); PG8_BAR; PG8_MMA(1, 1, At, B1); PG8_BAR;
            PG8_LDB(B0, 1, 0); PG8_SCHED; PG8_LDA(At, 1, 0); PG8_STAGE(PG8_SA(0, 1), a2 + hstep, voffA);
            PG8_WAIT_L(8); PG8_BAR; PG8_WAIT_L(0); PG8_MMA(0, 0, At, B0); PG8_BAR; PG8_SCHED;
            PG8_LDB(B1, 1, 1); PG8_STAGE(PG8_SB(1, 0), b3, voffB);
            PG8_BAR; PG8_WAIT_L(0); PG8_MMA(0, 1, At, B1); PG8_BAR;
            PG8_LDA(At, 1, 1); PG8_STAGE(PG8_SA(1, 0), a3, voffA);
            PG8_BAR; PG8_WAIT_L(0); PG8_MMA(1, 0, At, B0); PG8_BAR; PG8_SCHED;
            PG8_STAGE(PG8_SB(1, 1), b3 + hstep, voffB);
            PG8_WAIT_V(6); PG8_BAR; PG8_MMA(1, 1, At, B1); PG8_BAR;
        }
        PG8_STAMP();
        if constexpr (!Epi::AFTER_DRAIN) { E(acc, cur, wr, wc, fr, fq); S.done(cur); }
        PG8_STAMP();
        if (!has_next) break;
#pragma unroll
        for (int a = 0; a < 2; ++a)
#pragma unroll
            for (int b = 0; b < 2; ++b)
#pragma unroll
                for (int m = 0; m < 4; ++m)
#pragma unroll
                    for (int n = 0; n < 2; ++n) acc[a][b][m][n] = (f32x4){0.f, 0.f, 0.f, 0.f};
        cur = nxt; cA = nA; cB = nB; ++ui;
    }
    PG8_WAIT_V(0);
    if (wr == 0) PG8_BAR;
    PG8_BAR;
    if constexpr (Epi::AFTER_DRAIN) { E.fused(acc, cur, wr, wc, fr, fq, lds, wid, lane); S.done(cur); }
    PG8_STAMP();
    if (STAMP && wid == 0) { stamps[lane] = lane < nts ? (((unsigned long long)(unsigned)ts_hi << 32) | (unsigned)ts_lo) : 0ull;
        if (lane == 62) stamps[62] = rt_entry; if (lane == 63) stamps[63] = (unsigned long long)wall_clock64(); }
#undef PG8_STAMP
#undef PG8_SA
#undef PG8_SB
#undef PG8_STAGE
#undef PG8_LDA
#undef PG8_LDB
#undef PG8_MMA
#undef PG8_WAIT_V
#undef PG8_WAIT_L
#undef PG8_BAR
#undef PG8_SCHED
}
}
#define LAS __attribute__((address_space(3)))
typedef unsigned short bf16;
typedef short bf16x8 __attribute__((ext_vector_type(8)));
typedef short bf16x4 __attribute__((ext_vector_type(4)));
typedef float f32x4 __attribute__((ext_vector_type(4)));
typedef unsigned u32x4 __attribute__((ext_vector_type(4)));
typedef unsigned u32x2 __attribute__((ext_vector_type(2)));
typedef float f32x2_ __attribute__((ext_vector_type(2)));
typedef __bf16 bf16x2n __attribute__((ext_vector_type(2)));
__device__ __forceinline__ unsigned cvt_pk_bf16(float lo, float hi) { const f32x2_ v = {lo, hi}; const bf16x2n b = __builtin_convertvector(v, bf16x2n); return __builtin_bit_cast(unsigned, b); }

constexpr int T_TOK = 32768, SEQ = 8192, DM = 1024, NPROJ = 3840, PROJ_W = 3872;
constexpr float EPS = 1e-6f;
constexpr size_t MiB = 1u << 20;
constexpr size_t WS_CTL = 0;
constexpr size_t WS_WTIN = 1 * MiB;
constexpr size_t WS_WTOUT = 9 * MiB;
constexpr size_t WS_W1FK = 11 * MiB + 256 * 1024;
constexpr size_t WS_W1FV = 11 * MiB + 768 * 1024;
constexpr size_t WS_W2FK = 12 * MiB + 256 * 1024;
constexpr size_t WS_W2FV = 12 * MiB + 288 * 1024;
constexpr size_t WS_CPE = 12 * MiB + 320 * 1024;
constexpr size_t WS_BT = 12 * MiB + 384 * 1024;
constexpr size_t WS_RS = 13 * MiB;
constexpr size_t WS_SMALL = 14 * MiB;
constexpr size_t WS_XB = 32 * MiB;
constexpr size_t WS_MIX = 32 * MiB;
constexpr size_t WS_GQKV = 96 * MiB;
constexpr size_t WS_GZ = 192 * MiB;
constexpr size_t WS_NQ = 224 * MiB;
constexpr size_t WS_NKV = 256 * MiB;
constexpr size_t WS_NZ = 304 * MiB;
constexpr size_t WS_GREC = 336 * MiB;
constexpr size_t GREC_BYTES = 73728;
constexpr size_t WS_KCMP = 480 * MiB;
constexpr size_t WS_VCMPT = 480 * MiB + 512 * 1024;
constexpr size_t WS_VST = 482 * MiB;
constexpr size_t WS_VWT = 490 * MiB;
constexpr size_t WS_GLAST = 498 * MiB;
constexpr size_t WS_END = 499 * MiB;
constexpr int LDS_BYTES = 158720;

__device__ __forceinline__ float bf2f(unsigned short h) { return __uint_as_float((unsigned)h << 16); }
__device__ __forceinline__ unsigned short f2bf(float f) { return (unsigned short)(cvt_pk_bf16(f, 0.f) & 0xffffu); }
__device__ __forceinline__ float sigmoidf_(float v) { return 1.0f / (1.0f + __expf(-v)); }
__device__ __forceinline__ float siluf_(float v) { return v / (1.0f + __expf(-v)); }
__device__ __forceinline__ f32x4 mfma16(bf16x8 a, bf16x8 b, f32x4 c) { return __builtin_amdgcn_mfma_f32_16x16x32_bf16(a, b, c, 0, 0, 0); }
__device__ __forceinline__ int kperm(int g, int j) { return j < 4 ? 4 * g + j : 16 + 4 * g + (j - 4); }

struct Frame {
    const float* in[16]; float* out; unsigned char* ws; LAS unsigned char* lds; unsigned char* ldsg;
    int tid, lane, wave;
};

struct EpiProj {
    static constexpr bool PERM = true, AFTER_DRAIN = false;
    bf16* gqkv; bf16* gz; bf16* nq; bf16* nkv; bf16* nz; const float* rs;
    __device__ __forceinline__ void operator()(const f32x4 (&acc)[2][2][4][2], const pg8::Unit& u, int wr, int wc, int fr, int fq) const {
        const int pn = u.pn; bf16* base; int ldc, colt, act;
        if (pn < 6) { base = gqkv; ldc = 1536; colt = pn * 256; act = 0; }
        else if (pn < 8) { base = gz; ldc = 512; colt = (pn - 6) * 256; act = 1; }
        else if (pn < 10) { base = nq; ldc = 512; colt = (pn - 8) * 256; act = 2; }
        else if (pn < 13) { base = nkv; ldc = 768; colt = (pn - 10) * 256; act = 0; }
        else { base = nz; ldc = 512; colt = (pn - 13) * 256; act = 1; }
        const int row0 = u.pm * 256 + wr * 64 + fr, col0 = colt + wc * 32 + 8 * fq;
#pragma unroll
        for (int ai = 0; ai < 2; ++ai)
#pragma unroll
            for (int m = 0; m < 4; ++m) {
                const int row = row0 + ai * 128 + m * 16; const float r = rs[row];
                bf16* rowp = base + (size_t)row * ldc + col0;
#pragma unroll
                for (int bj = 0; bj < 2; ++bj) {
                    f32x4 v0 = acc[ai][bj][m][0] * r, v1 = acc[ai][bj][m][1] * r;
                    if (act == 1) {
#pragma unroll
                        for (int j = 0; j < 4; ++j) { v0[j] = siluf_(v0[j]); v1[j] = siluf_(v1[j]); }
                    } else if (act == 2) { v0 = v0 * 0.18033688011112042f; v1 = v1 * 0.18033688011112042f; }
                    u32x4 w; w.x = cvt_pk_bf16(v0[0], v0[1]); w.y = cvt_pk_bf16(v0[2], v0[3]); w.z = cvt_pk_bf16(v1[0], v1[1]); w.w = cvt_pk_bf16(v1[2], v1[3]);
                    *(u32x4*)(rowp + bj * 128) = w;
                }
            }
    }
};
struct EpiOut {
    static constexpr bool PERM = false, AFTER_DRAIN = false;
    const float* x; float* out;
    __device__ __forceinline__ void operator()(const f32x4 (&acc)[2][2][4][2], const pg8::Unit& u, int wr, int wc, int fr, int fq) const {
        const int row0 = u.pm * 256 + wr * 64 + fr, col0 = u.pn * 256 + wc * 32 + 4 * fq;
#pragma unroll
        for (int ai = 0; ai < 2; ++ai)
#pragma unroll
            for (int m = 0; m < 4; ++m) {
                const size_t ro = (size_t)(row0 + ai * 128 + m * 16) * DM + col0;
#pragma unroll
                for (int bj = 0; bj < 2; ++bj)
#pragma unroll
                    for (int n = 0; n < 2; ++n) {
                        const f32x4 xv = *(const f32x4*)(x + ro + bj * 128 + n * 16);
                        *(f32x4*)(out + ro + bj * 128 + n * 16) = acc[ai][bj][m][n] + xv;
                    }
            }
    }
};

__device__ __forceinline__ int orig_col(int n) {
    return n < 2048 ? n : (n < 2560 ? 2056 + (n - 2048) : (n < 3328 ? 2568 + (n - 2560) : 3360 + (n - 3328)));
}
__device__ __forceinline__ int orig_small(int sc) { return sc < 8 ? 2048 + sc : 3336 + (sc - 8); }
__device__ __forceinline__ int rel_bucket(int dist) {
    const int n = dist < 0 ? 0 : dist;
    if (n < 16) return n;
    int b = 16;
    b += (n >= 21); b += (n >= 27); b += (n >= 35); b += (n >= 46); b += (n >= 59); b += (n >= 77); b += (n >= 99); b += (n >= 128);
    b += (n >= 166); b += (n >= 216); b += (n >= 280); b += (n >= 363); b += (n >= 470); b += (n >= 609); b += (n >= 790);
    return b;
}
__device__ __forceinline__ void transpose_tile(const Frame& F, const float* src, int sld, int srccol0, int k0, const float* scale, bf16* dst, int dld, int n0) {
    LAS float* tile = (LAS float*)F.lds;
    const int kk = F.tid >> 6, nn = F.tid & 63;
#pragma unroll
    for (int i = 0; i < 8; ++i) { const int k = kk + 8 * i; float v = src[(size_t)(k0 + k) * sld + srccol0 + nn]; if (scale) v *= scale[k0 + k]; tile[k * 65 + nn] = v; }
    __syncthreads();
    const int n2 = F.tid >> 3, kc = F.tid & 7;
    float e[8];
#pragma unroll
    for (int j = 0; j < 8; ++j) e[j] = tile[(8 * kc + j) * 65 + n2];
    u32x4 w; w.x = cvt_pk_bf16(e[0], e[1]); w.y = cvt_pk_bf16(e[2], e[3]); w.z = cvt_pk_bf16(e[4], e[5]); w.w = cvt_pk_bf16(e[6], e[7]);
    *(u32x4*)(dst + (size_t)(n0 + n2) * dld + k0 + 8 * kc) = w;
    __syncthreads();
}

__device__ __forceinline__ void p0_prep(const Frame& F) {
    const float* x = F.in[0]; const float* nw = F.in[1]; const float* w_in = F.in[2];
    unsigned char* ws = F.ws;
    const int G = gridDim.x, bid = blockIdx.x;
    for (int task = bid; task < 1365; task += G) {
        if (task < 960) { const int nt = task / 16, kt = task % 16; transpose_tile(F, w_in, PROJ_W, orig_col(nt * 64), kt * 64, nw, (bf16*)(ws + WS_WTIN), DM, nt * 64); }
        else if (task < 1216) { const int t2 = task - 960, nt = t2 / 16, kt = t2 % 16; transpose_tile(F, F.in[13], DM, nt * 64, kt * 64, nullptr, (bf16*)(ws + WS_WTOUT), DM, nt * 64); }
        else if (task < 1344) {
            const int t2 = task - 1216, which = t2 >> 6, sub = t2 & 63;
            const float* w1 = F.in[which ? 11 : 9]; bf16* dst = (bf16*)(ws + (which ? WS_W1FV : WS_W1FK));
            const int mt = F.tid >> 6, l = F.tid & 63, m = l & 15, kg = l >> 4, ks = sub;
            float e[8];
#pragma unroll
            for (int j = 0; j < 8; ++j) e[j] = w1[(size_t)(32 * ks + 8 * kg + j) * 128 + 16 * mt + m];
            u32x4 w; w.x = cvt_pk_bf16(e[0], e[1]); w.y = cvt_pk_bf16(e[2], e[3]); w.z = cvt_pk_bf16(e[4], e[5]); w.w = cvt_pk_bf16(e[6], e[7]);
            *(u32x4*)(dst + ((size_t)(ks * 8 + mt) * 64 + l) * 8) = w;
        } else if (task < 1346) {
            const int which = task - 1344; const float* w2 = F.in[which ? 12 : 10]; bf16* dst = (bf16*)(ws + (which ? WS_W2FV : WS_W2FK));
            for (int i = F.tid; i < 1024; i += 512) {
                const int l = i & 63, ks = (i >> 6) & 3, mt = i >> 8, m = l & 15, kg = l >> 4;
                float e[8];
#pragma unroll
                for (int j = 0; j < 8; ++j) e[j] = w2[(size_t)(32 * ks + kperm(kg, j)) * 64 + 16 * mt + m];
                u32x4 w; w.x = cvt_pk_bf16(e[0], e[1]); w.y = cvt_pk_bf16(e[2], e[3]); w.z = cvt_pk_bf16(e[4], e[5]); w.w = cvt_pk_bf16(e[6], e[7]);
                *(u32x4*)(dst + (size_t)i * 8) = w;
            }
        } else if (task < 1348) {
            const int which = task - 1346; const float* pe = F.in[which ? 8 : 7]; const float* w1 = F.in[which ? 11 : 9];
            float* dst = (float*)(ws + WS_CPE) + which * 128;
            if (F.tid < 128) { float s = 0.f; for (int k = 0; k < 2048; ++k) s += pe[k] * w1[(size_t)k * 128 + F.tid]; dst[F.tid] = s; }
        } else {
            const int i = (task - 1348) * 512 + F.tid;
            if (i < 8 * 1025) { const int head = i / 1025, dist = i % 1025; ((float*)(ws + WS_BT))[i] = F.in[14][rel_bucket(dist) * 8 + head] * 1.4426950408889634f; }
        }
    }
    __syncthreads();
    {
        for (int i = F.tid; i < 32 * 2 * 64; i += 512) {
            const int l = i & 63, nt = (i >> 6) & 1, ks = i >> 7, kg = l >> 4, sc = 16 * nt + (l & 15), oc = orig_small(sc);
            float v[8], lo[8]; unsigned short hi[8];
#pragma unroll
            for (int j = 0; j < 8; ++j) { const int k = 32 * ks + 8 * kg + j; v[j] = w_in[(size_t)k * PROJ_W + oc] * nw[k]; hi[j] = f2bf(v[j]); lo[j] = v[j] - bf2f(hi[j]); }
            u32x4 wh, wl;
            wh.x = hi[0] | ((unsigned)hi[1] << 16); wh.y = hi[2] | ((unsigned)hi[3] << 16); wh.z = hi[4] | ((unsigned)hi[5] << 16); wh.w = hi[6] | ((unsigned)hi[7] << 16);
            wl.x = cvt_pk_bf16(lo[0], lo[1]); wl.y = cvt_pk_bf16(lo[2], lo[3]); wl.z = cvt_pk_bf16(lo[4], lo[5]); wl.w = cvt_pk_bf16(lo[6], lo[7]);
            *(LAS u32x4*)(F.lds + ((size_t)((ks * 2 + nt) * 2 + 0) * 64 + l) * 16) = wh;
            *(LAS u32x4*)(F.lds + ((size_t)((ks * 2 + nt) * 2 + 1) * 64 + l) * 16) = wl;
        }
    }
    __syncthreads();
    bf16* xb = (bf16*)(ws + WS_XB); float* rsv = (float*)(ws + WS_RS); float* small = (float*)(ws + WS_SMALL);
    const float* a_log = F.in[4]; const float* dt_bias = F.in[5];
    for (int tile = bid * 8 + F.wave; tile < T_TOK / 16; tile += G * 8) {
        const int l = F.lane, r = l & 15, kg = l >> 4; const int row = tile * 16 + r;
        const float* xr = x + (size_t)row * DM + 8 * kg;
        f32x4 acc0 = {0.f, 0.f, 0.f, 0.f}, acc1 = {0.f, 0.f, 0.f, 0.f};
        float ss = 0.f;
#pragma unroll 4
        for (int ks = 0; ks < 32; ++ks) {
            const f32x4 a0 = *(const f32x4*)(xr + 32 * ks), a1 = *(const f32x4*)(xr + 32 * ks + 4);
            ss += a0[0] * a0[0] + a0[1] * a0[1] + a0[2] * a0[2] + a0[3] * a0[3] + a1[0] * a1[0] + a1[1] * a1[1] + a1[2] * a1[2] + a1[3] * a1[3];
            u32x4 h; h.x = cvt_pk_bf16(a0[0], a0[1]); h.y = cvt_pk_bf16(a0[2], a0[3]); h.z = cvt_pk_bf16(a1[0], a1[1]); h.w = cvt_pk_bf16(a1[2], a1[3]);
            *(u32x4*)(xb + (size_t)row * DM + 32 * ks + 8 * kg) = h;
            u32x4 lo;
            lo.x = cvt_pk_bf16(a0[0] - __uint_as_float(h.x << 16), a0[1] - __uint_as_float(h.x & 0xffff0000u));
            lo.y = cvt_pk_bf16(a0[2] - __uint_as_float(h.y << 16), a0[3] - __uint_as_float(h.y & 0xffff0000u));
            lo.z = cvt_pk_bf16(a1[0] - __uint_as_float(h.z << 16), a1[1] - __uint_as_float(h.z & 0xffff0000u));
            lo.w = cvt_pk_bf16(a1[2] - __uint_as_float(h.w << 16), a1[3] - __uint_as_float(h.w & 0xffff0000u));
            const bf16x8 ah = __builtin_bit_cast(bf16x8, h), al = __builtin_bit_cast(bf16x8, lo);
            const LAS unsigned char* fb = F.lds + (size_t)(ks * 4) * 1024 + l * 16;
            const bf16x8 b0h = *(const LAS bf16x8*)(fb), b0l = *(const LAS bf16x8*)(fb + 1024), b1h = *(const LAS bf16x8*)(fb + 2048), b1l = *(const LAS bf16x8*)(fb + 3072);
            acc0 = mfma16(ah, b0h, acc0); acc0 = mfma16(al, b0h, acc0); acc0 = mfma16(ah, b0l, acc0);
            acc1 = mfma16(ah, b1h, acc1); acc1 = mfma16(al, b1h, acc1); acc1 = mfma16(ah, b1l, acc1);
        }
        ss += __shfl_xor(ss, 16); ss += __shfl_xor(ss, 32);
        const float rs = rsqrtf(ss * (1.0f / 1024.f) + EPS);
        if (kg == 0) rsv[row] = rs;
#pragma unroll
        for (int reg = 0; reg < 4; ++reg) {
            const int rr = 4 * kg + reg; const float rsr = __shfl(rs, rr);
            const int orow = tile * 16 + rr;
            {
                const float v = acc0[reg] * rsr; const int c = r; float o;
                if (c < 4) o = sigmoidf_(v);
                else if (c < 8) { const int h = c - 4; const float z = v + dt_bias[h]; const float sp = z > 20.f ? z : log1pf(expf(z)); o = -expf(a_log[h]) * sp; }
                else o = sigmoidf_(v);
                small[(size_t)orow * 32 + c] = o;
            }
            { const float v = acc1[reg] * rsr; small[(size_t)orow * 32 + 16 + r] = sigmoidf_(v); }
        }
    }
}

__device__ __forceinline__ void p5_final(const Frame& F) {
    const float* fw = F.in[15]; float* out = F.out;
    for (int r = blockIdx.x * 8 + F.wave; r < T_TOK; r += gridDim.x * 8) {
        f32x4* orow = (f32x4*)(out + (size_t)r * DM);
        f32x4 v[4]; float ss = 0.f;
#pragma unroll
        for (int i = 0; i < 4; ++i) { v[i] = orow[F.lane + 64 * i]; ss += v[i][0] * v[i][0] + v[i][1] * v[i][1] + v[i][2] * v[i][2] + v[i][3] * v[i][3]; }
#pragma unroll
        for (int o = 32; o > 0; o >>= 1) ss += __shfl_xor(ss, o);
        const float rs = rsqrtf(ss * (1.0f / 1024.f) + EPS);
#pragma unroll
        for (int i = 0; i < 4; ++i) { const f32x4 w = ((const f32x4*)fw)[F.lane + 64 * i]; orow[F.lane + 64 * i] = v[i] * rs * w; }
    }
}
constexpr int REC_WNEG = 0, REC_QDEC = 16384, REC_ATTN = 32768, REC_KDT = 40960, REC_U = 57344, REC_LDS_BYTES = 57344;
__device__ __forceinline__ void gdn_prep_item(const Frame& F, int item) {
    int tid_ = F.tid; asm volatile("" : "+v"(tid_));
    const int tid = tid_;
    const int h = item & 3, n = (item >> 2) & 127, b = item >> 9;
    const int tok0 = b * SEQ + n * 64;
    LAS float* kf = (LAS float*)(F.lds); LAS float* vf = (LAS float*)(F.lds + 32768);
    LAS bf16* qb = (LAS bf16*)(F.lds + 65536); LAS bf16* kb = (LAS bf16*)(F.lds + 82944); LAS bf16* kbb = (LAS bf16*)(F.lds + 100352);
    LAS float* Lm = (LAS float*)(F.lds + 117760); LAS bf16* atb = (LAS bf16*)(F.lds + 134144); LAS float* gcs = (LAS float*)(F.lds + 143360);
    LAS float* tinv = (LAS float*)(F.lds + 144128);
    unsigned char* rec = F.ws + WS_GREC + (size_t)item * GREC_BYTES;
    const float* small = (const float*)(F.ws + WS_SMALL);
    if (tid < 64) {
        const float beta = small[(size_t)(tok0 + tid) * 32 + h]; float c = small[(size_t)(tok0 + tid) * 32 + 4 + h];
#pragma unroll
        for (int o = 1; o < 64; o <<= 1) { const float t = __shfl_up(c, o); if (tid >= o) c += t; }
        gcs[tid] = c; gcs[64 + tid] = beta; gcs[128 + tid] = expf(c);
        if (tid == 63) ((float*)(F.ws + WS_GLAST))[item] = expf(c);
    }
    __syncthreads();
    {
        const bf16* gq = (const bf16*)(F.ws + WS_GQKV); const float* cw = F.in[3];
        const int grp = tid >> 4, li = tid & 15;
#pragma unroll
        for (int rr = 0; rr < 2; ++rr) {
            const int c = grp * 2 + rr, pos = n * 64 + c;
            const float betav = gcs[64 + c], egv = gcs[128 + c];
#pragma unroll
            for (int part = 0; part < 3; ++part) {
                const int ch = part * 512 + h * 128 + 8 * li;
                float y[8];
#pragma unroll
                for (int e = 0; e < 8; ++e) y[e] = 0.f;
#pragma unroll
                for (int j = 0; j < 4; ++j) {
                    const int p = pos - 3 + j;
                    if (p >= 0) {
                        const u32x4 xv = *(const u32x4*)(gq + (size_t)(b * SEQ + p) * 1536 + ch);
                        const f32x4 w0 = *(const f32x4*)(cw + j * 1536 + ch), w1 = *(const f32x4*)(cw + j * 1536 + ch + 4);
                        y[0] += w0[0] * __uint_as_float(xv.x << 16); y[1] += w0[1] * __uint_as_float(xv.x & 0xffff0000u);
                        y[2] += w0[2] * __uint_as_float(xv.y << 16); y[3] += w0[3] * __uint_as_float(xv.y & 0xffff0000u);
                        y[4] += w1[0] * __uint_as_float(xv.z << 16); y[5] += w1[1] * __uint_as_float(xv.z & 0xffff0000u);
                        y[6] += w1[2] * __uint_as_float(xv.w << 16); y[7] += w1[3] * __uint_as_float(xv.w & 0xffff0000u);
                    }
                }
                float ss = 0.f;
#pragma unroll
                for (int e = 0; e < 8; ++e) { y[e] = siluf_(y[e]); ss += y[e] * y[e]; }
                if (part < 2) {
                    ss += __shfl_xor(ss, 1); ss += __shfl_xor(ss, 2); ss += __shfl_xor(ss, 4); ss += __shfl_xor(ss, 8);
                    const float sc = rsqrtf(ss + EPS) * (part == 0 ? 0.08838834764831845f : 1.0f);
#pragma unroll
                    for (int e = 0; e < 8; ++e) y[e] *= sc;
                }
                if (part == 0) {
                    u32x4 w; w.x = cvt_pk_bf16(y[0], y[1]); w.y = cvt_pk_bf16(y[2], y[3]); w.z = cvt_pk_bf16(y[4], y[5]); w.w = cvt_pk_bf16(y[6], y[7]);
                    *(LAS u32x4*)(qb + c * 136 + 8 * li) = w;
                    const int mt = c >> 4, m = c & 15, ks = li >> 2, a = (li & 3) >> 1, g0 = (2 * (li & 3)) & 3, g1 = (2 * (li & 3) + 1) & 3;
                    u32x2 d0, d1; d0.x = cvt_pk_bf16(y[0] * egv, y[1] * egv); d0.y = cvt_pk_bf16(y[2] * egv, y[3] * egv); d1.x = cvt_pk_bf16(y[4] * egv, y[5] * egv); d1.y = cvt_pk_bf16(y[6] * egv, y[7] * egv);
                    unsigned char* fb = rec + REC_QDEC + (size_t)(mt * 4 + ks) * 1024 + a * 8;
                    *(u32x2*)(fb + (g0 * 16 + m) * 16) = d0; *(u32x2*)(fb + (g1 * 16 + m) * 16) = d1;
                } else if (part == 1) {
                    *(LAS f32x4*)(kf + c * 128 + 8 * li) = (f32x4){y[0], y[1], y[2], y[3]}; *(LAS f32x4*)(kf + c * 128 + 8 * li + 4) = (f32x4){y[4], y[5], y[6], y[7]};
                    u32x4 w; w.x = cvt_pk_bf16(y[0], y[1]); w.y = cvt_pk_bf16(y[2], y[3]); w.z = cvt_pk_bf16(y[4], y[5]); w.w = cvt_pk_bf16(y[6], y[7]);
                    *(LAS u32x4*)(kb + c * 136 + 8 * li) = w;
                    w.x = cvt_pk_bf16(y[0] * betav, y[1] * betav); w.y = cvt_pk_bf16(y[2] * betav, y[3] * betav); w.z = cvt_pk_bf16(y[4] * betav, y[5] * betav); w.w = cvt_pk_bf16(y[6] * betav, y[7] * betav);
                    *(LAS u32x4*)(kbb + c * 136 + 8 * li) = w;
                } else {
                    *(LAS f32x4*)(vf + c * 128 + 8 * li) = (f32x4){y[0], y[1], y[2], y[3]}; *(LAS f32x4*)(vf + c * 128 + 8 * li + 4) = (f32x4){y[4], y[5], y[6], y[7]};
                }
            }
        }
    }
    __syncthreads();
    {
        const int l = (tid & 63), m = l & 15, kg = l >> 4;
#pragma unroll
        for (int i = 0; i < 4; ++i) {
            const int tt = F.wave * 4 + i, which = tt >> 4, mi = (tt >> 2) & 3, ni = tt & 3;
            f32x4 acc = {0.f, 0.f, 0.f, 0.f};
            if (mi >= ni) {
                const LAS bf16* As = which ? qb : kbb;
#pragma unroll
                for (int ks = 0; ks < 4; ++ks) {
                    const bf16x8 a = *(const LAS bf16x8*)(As + (16 * mi + m) * 136 + 32 * ks + 8 * kg);
                    const bf16x8 bb = *(const LAS bf16x8*)(kb + (16 * ni + m) * 136 + 32 * ks + 8 * kg);
                    acc = mfma16(a, bb, acc);
                }
            }
#pragma unroll
            for (int r = 0; r < 4; ++r) {
                const int irow = 16 * mi + 4 * kg + r, jcol = 16 * ni + m;
                const float dec = (irow >= jcol) ? expf(gcs[irow] - gcs[jcol]) : 0.f;
                if (which == 0) Lm[jcol * 64 + irow] = (irow > jcol) ? acc[r] * dec : 0.f;
                else atb[irow * 72 + jcol] = f2bf((irow >= jcol) ? acc[r] * dec : 0.f);
            }
        }
    }
    __syncthreads();
    if (tid < 64) {
        const int ib = tid >> 4, c = tid & 15;
        float x[16];
#pragma unroll
        for (int i = 0; i < 16; ++i) x[i] = (i == c) ? 1.0f : 0.0f;
#pragma unroll
        for (int j = 0; j < 15; ++j) {
            const LAS f32x4* lp = (const LAS f32x4*)(Lm + (16 * ib + j) * 64 + 16 * ib);
#pragma unroll
            for (int q4 = 0; q4 < 4; ++q4) {
                if (4 * q4 + 3 > j) {
                    const f32x4 lv = lp[q4];
#pragma unroll
                    for (int e = 0; e < 4; ++e) if (4 * q4 + e > j) x[4 * q4 + e] -= lv[e] * x[j];
                }
            }
            asm volatile("" ::: "memory");
        }
#pragma unroll
        for (int i = 0; i < 16; ++i) tinv[(ib * 16 + c) * 16 + i] = x[i];
    }
    {
        const float gl = gcs[63];
#pragma unroll
        for (int q = 0; q < 2; ++q) {
            const int idx = tid + 512 * q, l = idx & 63, ks = (idx >> 6) & 1, mt = idx >> 7, m = l & 15, g = l >> 4;
            float e[8];
#pragma unroll
            for (int j = 0; j < 8; ++j) { const int cr = 32 * ks + kperm(g, j); e[j] = kf[cr * 128 + 16 * mt + m] * expf(gl - gcs[cr]); }
            u32x4 w; w.x = cvt_pk_bf16(e[0], e[1]); w.y = cvt_pk_bf16(e[2], e[3]); w.z = cvt_pk_bf16(e[4], e[5]); w.w = cvt_pk_bf16(e[6], e[7]);
            *(u32x4*)(rec + REC_KDT + (size_t)idx * 16) = w;
        }
        {
            const int idx = tid, l = idx & 63, ks = (idx >> 6) & 1, mt = idx >> 7, m = l & 15, g = l >> 4;
            const u32x2 a0 = *(const LAS u32x2*)(atb + (16 * mt + m) * 72 + 32 * ks + 4 * g), a1 = *(const LAS u32x2*)(atb + (16 * mt + m) * 72 + 32 * ks + 16 + 4 * g);
            *(u32x4*)(rec + REC_ATTN + (size_t)idx * 16) = (u32x4){a0.x, a0.y, a1.x, a1.y};
        }
    }
    __syncthreads();
    {
        const int l = (tid & 63), li = l & 15, lk = l >> 4, w = F.wave; const bool isw = w >= 4;
        LAS float* base = isw ? (kf + 32 * (w - 4)) : (vf + 32 * w);
#pragma unroll
        for (int ib = 0; ib < 4; ++ib) {
            f32x4 acc[2];
#pragma unroll
            for (int nt = 0; nt < 2; ++nt)
#pragma unroll
                for (int r = 0; r < 4; ++r) { const int i = 16 * ib + 4 * lk + r; acc[nt][r] = base[i * 128 + 16 * nt + li] * gcs[64 + i] * (isw ? gcs[128 + i] : 1.0f); }
            for (int kk = 0; kk < 4 * ib; ++kk) {
                const float av = -Lm[(4 * kk + lk) * 64 + 16 * ib + li];
                acc[0] = __builtin_amdgcn_mfma_f32_16x16x4f32(av, base[(4 * kk + lk) * 128 + li], acc[0], 0, 0, 0);
                acc[1] = __builtin_amdgcn_mfma_f32_16x16x4f32(av, base[(4 * kk + lk) * 128 + 16 + li], acc[1], 0, 0, 0);
            }
#pragma unroll
            for (int nt = 0; nt < 2; ++nt)
#pragma unroll
                for (int r = 0; r < 4; ++r) base[(16 * ib + 4 * lk + r) * 128 + 16 * nt + li] = acc[nt][r];
            f32x4 y[2] = {(f32x4){0.f, 0.f, 0.f, 0.f}, (f32x4){0.f, 0.f, 0.f, 0.f}};
#pragma unroll
            for (int kk = 0; kk < 4; ++kk) {
                const float av = tinv[(ib * 16 + 4 * kk + lk) * 16 + li];
                y[0] = __builtin_amdgcn_mfma_f32_16x16x4f32(av, base[(16 * ib + 4 * kk + lk) * 128 + li], y[0], 0, 0, 0);
                y[1] = __builtin_amdgcn_mfma_f32_16x16x4f32(av, base[(16 * ib + 4 * kk + lk) * 128 + 16 + li], y[1], 0, 0, 0);
            }
#pragma unroll
            for (int nt = 0; nt < 2; ++nt)
#pragma unroll
                for (int r = 0; r < 4; ++r) base[(16 * ib + 4 * lk + r) * 128 + 16 * nt + li] = y[nt][r];
        }
    }
    __syncthreads();
    {
#pragma unroll
        for (int q = 0; q < 4; ++q) {
            const int idx = tid + 512 * q, l = idx & 63, mt = (idx >> 6) & 3, sl = idx >> 8, g4 = l >> 4, nn = l & 15;
            const LAS float* up = vf + (16 * mt + 4 * g4) * 128 + 16 * sl + nn;
            u32x2 d; d.x = cvt_pk_bf16(up[0], up[128]); d.y = cvt_pk_bf16(up[256], up[384]);
            *(u32x2*)(rec + REC_U + (size_t)idx * 8) = d;
        }
#pragma unroll
        for (int q = 0; q < 2; ++q) {
            const int idx = tid + 512 * q, l = idx & 63, ks = (idx >> 6) & 3, mt = idx >> 8, m = l & 15, g = l >> 4;
            const f32x4 a0 = *(const LAS f32x4*)(kf + (16 * mt + m) * 128 + 32 * ks + 4 * g), a1 = *(const LAS f32x4*)(kf + (16 * mt + m) * 128 + 32 * ks + 16 + 4 * g);
            u32x4 w; w.x = cvt_pk_bf16(-a0[0], -a0[1]); w.y = cvt_pk_bf16(-a0[2], -a0[3]); w.z = cvt_pk_bf16(-a1[0], -a1[1]); w.w = cvt_pk_bf16(-a1[2], -a1[3]);
            *(u32x4*)(rec + REC_WNEG + (size_t)idx * 16) = w;
        }
    }
    __syncthreads();
}

__device__ __forceinline__ bf16x8 acc2frag(const f32x4& lo, const f32x4& hi) {
    u32x4 w; w.x = cvt_pk_bf16(lo[0], lo[1]); w.y = cvt_pk_bf16(lo[2], lo[3]); w.z = cvt_pk_bf16(hi[0], hi[1]); w.w = cvt_pk_bf16(hi[2], hi[3]);
    return __builtin_bit_cast(bf16x8, w);
}
__device__ __forceinline__ void gdn_scan(const Frame& F, int bh) {
    const int tid = F.tid, lane = F.lane, s = F.wave;
    const int b = bh >> 2, h = bh & 3;
    LAS unsigned char* buf0 = F.lds; LAS float* ox = (LAS float*)(F.lds + 2 * REC_LDS_BYTES);
    const float* glast = (const float*)(F.ws + WS_GLAST);
    const bf16* gz = (const bf16*)(F.ws + WS_GZ); const float* gnw = F.in[6]; bf16* mix = (bf16*)(F.ws + WS_MIX);
    f32x4 S[8];
#pragma unroll
    for (int t = 0; t < 8; ++t) S[t] = (f32x4){0.f, 0.f, 0.f, 0.f};
    const unsigned char* const recbase = F.ws + WS_GREC + (size_t)(b * 512 + h) * GREC_BYTES;
#define recp(n) (recbase + (size_t)(n) * 4 * GREC_BYTES)
#define GS_STAGE(n, bufsel) do { const unsigned char* _r = recp(n); _Pragma("unroll") for (int _i = 0; _i < 7; ++_i) \
        __builtin_amdgcn_global_load_lds((const unsigned*)(_r + (size_t)(_i * 512 + tid) * 16), (LAS unsigned*)(buf0 + (bufsel) * REC_LDS_BYTES + (_i * 8 + s) * 1024), 16, 0, 0); } while (0)
    GS_STAGE(0, 0);
    u32x2 un[4];
#pragma unroll
    for (int mt = 0; mt < 4; ++mt) un[mt] = *(const u32x2*)(recp(0) + REC_U + (size_t)((s * 4 + mt) * 64 + lane) * 8);
    float egn = glast[(b * 128 + 0) * 4 + h];
    for (int n = 0; n < 128; ++n) {
        const int cur = n & 1;
        asm volatile("s_waitcnt vmcnt(0)" ::: "memory");
        __syncthreads();
        u32x2 uc[4];
#pragma unroll
        for (int mt = 0; mt < 4; ++mt) uc[mt] = un[mt];
        const float egl = egn;
        if (n + 1 < 128) {
            GS_STAGE(n + 1, cur ^ 1);
#pragma unroll
            for (int mt = 0; mt < 4; ++mt) un[mt] = *(const u32x2*)(recp(n + 1) + REC_U + (size_t)((s * 4 + mt) * 64 + lane) * 8);
            egn = glast[(b * 128 + n + 1) * 4 + h];
        }
        const LAS unsigned char* bp = buf0 + cur * REC_LDS_BYTES + lane * 16;
        bf16x8 Sb[4];
#pragma unroll
        for (int ks = 0; ks < 4; ++ks) Sb[ks] = acc2frag(S[2 * ks], S[2 * ks + 1]);
        f32x4 vn[4], o[4];
#pragma unroll
        for (int mt = 0; mt < 4; ++mt) {
            vn[mt] = (f32x4){__uint_as_float(uc[mt].x << 16), __uint_as_float(uc[mt].x & 0xffff0000u), __uint_as_float(uc[mt].y << 16), __uint_as_float(uc[mt].y & 0xffff0000u)};
#pragma unroll
            for (int ks = 0; ks < 4; ++ks) vn[mt] = mfma16(*(const LAS bf16x8*)(bp + REC_WNEG + (mt * 4 + ks) * 1024), Sb[ks], vn[mt]);
        }
        bf16x8 Vb[2];
#pragma unroll
        for (int ks = 0; ks < 2; ++ks) Vb[ks] = acc2frag(vn[2 * ks], vn[2 * ks + 1]);
#pragma unroll
        for (int mt = 0; mt < 4; ++mt) {
            o[mt] = (f32x4){0.f, 0.f, 0.f, 0.f};
#pragma unroll
            for (int ks = 0; ks < 4; ++ks) o[mt] = mfma16(*(const LAS bf16x8*)(bp + REC_QDEC + (mt * 4 + ks) * 1024), Sb[ks], o[mt]);
#pragma unroll
            for (int ks = 0; ks < 2; ++ks) o[mt] = mfma16(*(const LAS bf16x8*)(bp + REC_ATTN + (mt * 2 + ks) * 1024), Vb[ks], o[mt]);
        }
#pragma unroll
        for (int t = 0; t < 8; ++t) {
            S[t] = S[t] * egl;
#pragma unroll
            for (int ks = 0; ks < 2; ++ks) S[t] = mfma16(*(const LAS bf16x8*)(bp + REC_KDT + (t * 2 + ks) * 1024), Vb[ks], S[t]);
        }
        {
            const int g4 = lane >> 4, nn = lane & 15;
#pragma unroll
            for (int mt = 0; mt < 4; ++mt)
#pragma unroll
                for (int r = 0; r < 4; ++r) ox[(16 * mt + 4 * g4 + r) * 132 + 16 * s + nn] = o[mt][r];
        }
        __syncthreads();
        {
            const int row = tid >> 3, part = tid & 7; const int tok = b * SEQ + n * 64 + row;
            float v[16]; float ss = 0.f;
#pragma unroll
            for (int q = 0; q < 4; ++q) { const f32x4 t4 = *(const LAS f32x4*)(ox + row * 132 + 16 * part + 4 * q); v[4 * q] = t4[0]; v[4 * q + 1] = t4[1]; v[4 * q + 2] = t4[2]; v[4 * q + 3] = t4[3]; }
#pragma unroll
            for (int e = 0; e < 16; ++e) ss += v[e] * v[e];
            ss += __shfl_xor(ss, 1); ss += __shfl_xor(ss, 2); ss += __shfl_xor(ss, 4);
            const float rs = rsqrtf(ss * (1.0f / 128.f) + EPS);
            const u32x4 z0 = *(const u32x4*)(gz + (size_t)tok * 512 + h * 128 + 16 * part), z1 = *(const u32x4*)(gz + (size_t)tok * 512 + h * 128 + 16 * part + 8);
            const unsigned zz[8] = {z0.x, z0.y, z0.z, z0.w, z1.x, z1.y, z1.z, z1.w};
            unsigned ow[8];
#pragma unroll
            for (int e = 0; e < 8; ++e) {
                const float w0 = gnw[16 * part + 2 * e], w1 = gnw[16 * part + 2 * e + 1];
                ow[e] = cvt_pk_bf16(v[2 * e] * rs * w0 * __uint_as_float(zz[e] << 16), v[2 * e + 1] * rs * w1 * __uint_as_float(zz[e] & 0xffff0000u));
            }
            bf16* mp = mix + (size_t)tok * DM + h * 128 + 16 * part;
            *(u32x4*)mp = (u32x4){ow[0], ow[1], ow[2], ow[3]}; *(u32x4*)(mp + 8) = (u32x4){ow[4], ow[5], ow[6], ow[7]};
        }
    }
#undef GS_STAGE
#undef recp
    asm volatile("s_waitcnt vmcnt(0)" ::: "memory");
    __syncthreads();
}
__device__ __forceinline__ int pos32(int key) { return (key & ~31) | (8 * ((key >> 2) & 3) + 4 * ((key >> 4) & 1) + (key & 3)); }
__device__ __forceinline__ void compress_block(const Frame& F, int task) {
    const int which = task >> 8, bhk = (task >> 5) & 7, rt = task & 31, b = bhk >> 1, hk = bhk & 1;
    int l_ = F.lane; asm volatile("" : "+v"(l_));
    const int l = l_, n = l & 15, kg = l >> 4, w = F.wave;
    const bf16* nkv = (const bf16*)(F.ws + WS_NKV);
    const bf16* w1f = (const bf16*)(F.ws + (which ? WS_W1FV : WS_W1FK)); const bf16* w2f = (const bf16*)(F.ws + (which ? WS_W2FV : WS_W2FK));
    const float* cpe = (const float*)(F.ws + WS_CPE) + which * 128;
    const int nc = 16 * rt + n;
    f32x4 acc[8];
#pragma unroll
    for (int t = 0; t < 8; ++t) acc[t] = (f32x4){0.f, 0.f, 0.f, 0.f};
#pragma unroll 2
    for (int k8 = 0; k8 < 8; ++k8) {
        const int ks = 8 * w + k8;
        int tok = 16 * nc + (ks >> 1); tok = tok < SEQ ? tok : SEQ - 1;
        const bf16x8 bfrag = *(const bf16x8*)(nkv + (size_t)(b * SEQ + tok) * 768 + which * 128 + hk * 64 + (ks & 1) * 32 + 8 * kg);
#pragma unroll
        for (int mt = 0; mt < 8; ++mt) acc[mt] = mfma16(*(const bf16x8*)(w1f + ((size_t)(ks * 8 + mt) * 64 + l) * 8), bfrag, acc[mt]);
    }
    LAS f32x4* part = (LAS f32x4*)F.lds;
    LAS unsigned char* hfrag = F.lds + 65536;
#pragma unroll
    for (int mt = 0; mt < 8; ++mt) part[(w * 8 + mt) * 64 + l] = acc[mt];
    __syncthreads();
    {
        f32x4 h = part[w * 64 + l];
#pragma unroll
        for (int p = 1; p < 8; ++p) h = h + part[(p * 8 + w) * 64 + l];
#pragma unroll
        for (int r = 0; r < 4; ++r) h[r] = siluf_(h[r] + cpe[16 * w + 4 * kg + r]);
        u32x2 d; d.x = cvt_pk_bf16(h[0], h[1]); d.y = cvt_pk_bf16(h[2], h[3]);
        *(LAS u32x2*)(hfrag + ((w >> 1) * 64 + l) * 16 + (w & 1) * 8) = d;
    }
    __syncthreads();
    if (w < 4) {
        f32x4 o = {0.f, 0.f, 0.f, 0.f};
#pragma unroll
        for (int ks = 0; ks < 4; ++ks) o = mfma16(*(const bf16x8*)(w2f + ((size_t)(w * 4 + ks) * 64 + l) * 8), *(const LAS bf16x8*)(hfrag + (ks * 64 + l) * 16), o);
        const bool valid = nc < 511;
        if (which == 0) {
            bf16* kc = (bf16*)(F.ws + WS_KCMP) + ((size_t)bhk * 512 + nc) * 64;
            u32x2 d; d.x = valid ? cvt_pk_bf16(o[0], o[1]) : 0u; d.y = valid ? cvt_pk_bf16(o[2], o[3]) : 0u; *(u32x2*)(kc + 16 * w + 4 * kg) = d;
        } else {
            bf16* vt = (bf16*)(F.ws + WS_VCMPT) + (size_t)bhk * 64 * 512 + pos32(nc);
#pragma unroll
            for (int r = 0; r < 4; ++r) vt[(size_t)(16 * w + 4 * kg + r) * 512] = valid ? f2bf(o[r]) : (unsigned short)0;
        }
    }
    __syncthreads();
}
__device__ __forceinline__ void vtranspose_task(const Frame& F, int task) {
    const int which = task >> 8, bhk = (task >> 5) & 7, tg = task & 31, b = bhk >> 1, hk = bhk & 1;
    const bf16* nkv = (const bf16*)(F.ws + WS_NKV); bf16* dst = (bf16*)(F.ws + (which ? WS_VWT : WS_VST)) + (size_t)bhk * 64 * SEQ;
    LAS bf16* tile = (LAS bf16*)F.lds;
    for (int sub = 0; sub < 4; ++sub) {
        const int t0 = tg * 256 + sub * 64;
        { const int tk = F.tid >> 3, dc = F.tid & 7;
          const u32x4 v = *(const u32x4*)(nkv + (size_t)(b * SEQ + t0 + tk) * 768 + 384 + which * 256 + hk * 64 + 8 * dc);
          const unsigned vv[4] = {v.x, v.y, v.z, v.w};
#pragma unroll
          for (int e = 0; e < 4; ++e) { tile[(8 * dc + 2 * e) * 72 + pos32(tk)] = (unsigned short)(vv[e] & 0xffffu); tile[(8 * dc + 2 * e + 1) * 72 + pos32(tk)] = (unsigned short)(vv[e] >> 16); } }
        __syncthreads();
        { const int d = F.tid >> 3, tc = F.tid & 7;
          *(u32x4*)(dst + (size_t)d * SEQ + t0 + 8 * tc) = *(const LAS u32x4*)(tile + d * 72 + 8 * tc); }
        __syncthreads();
    }
}

constexpr int NL_BT = 0, NL_IMP = 18496, NL_MASK = 51776, NL_SMASK = 52800, NL_KV = 53248, NL_NXT = 86016, NL_TOT = 86528;
#ifndef PRB_X1
#define PRB_X1 0
#endif
#ifndef PRB_C2
#define PRB_C2 0
#endif
#ifndef PRB_SETUP
#define PRB_SETUP 0
#endif
#ifndef PRB_S
#define PRB_S 0
#endif
#ifndef PRB_W
#define PRB_W 0
#endif
#ifndef PRB_C
#define PRB_C 0
#endif
constexpr int TM_C1 = 0, TM_C2 = 1, TM_SD = 2, TM_SS = 3, TM_W = 4;
#ifndef PRB_DMA
#define PRB_DMA 0
#endif
__device__ __forceinline__ void stage_dma(LAS unsigned char* buf, const bf16* Kb, int kstride, const bf16* VT, int vlen, int key0, int wave, int lane) {
    const int row = wave * 8 + (lane >> 3), ch = (lane & 7) ^ ((lane >> 3) & 7);
#if PRB_DMA
    __builtin_amdgcn_global_load_lds((const unsigned*)(Kb + (size_t)(key0 + row) * kstride + 8 * ch), (LAS unsigned*)(buf + wave * 1024), 16, 0, 0);
    __builtin_amdgcn_global_load_lds((const unsigned*)(VT + (size_t)row * vlen + key0 + 8 * ch), (LAS unsigned*)(buf + 8192 + wave * 1024), 16, 0, 0);
#endif
    __builtin_amdgcn_global_load_lds((const unsigned*)(Kb + (size_t)(key0 + row) * kstride + 8 * ch), (LAS unsigned*)(buf + wave * 1024), 16, 0, 0);
    __builtin_amdgcn_global_load_lds((const unsigned*)(VT + (size_t)row * vlen + key0 + 8 * ch), (LAS unsigned*)(buf + 8192 + wave * 1024), 16, 0, 0);
}
__device__ __forceinline__ void wait_tiles(int newer) {
#if PRB_DMA
    if (newer >= 2) asm volatile("s_waitcnt vmcnt(8)" ::: "memory"); else if (newer == 1) asm volatile("s_waitcnt vmcnt(4)" ::: "memory"); else asm volatile("s_waitcnt vmcnt(0)" ::: "memory");
#else
    if (newer >= 2) asm volatile("s_waitcnt vmcnt(4)" ::: "memory"); else if (newer == 1) asm volatile("s_waitcnt vmcnt(2)" ::: "memory"); else asm volatile("s_waitcnt vmcnt(0)" ::: "memory");
#endif
}
__device__ __forceinline__ bf16x8 tile_frag(const LAS unsigned char* buf, int row, int chunk) { return *(const LAS bf16x8*)(buf + row * 128 + ((chunk ^ (row & 7)) << 4)); }

struct SlotState { f32x4 O[4]; float m, l; };
constexpr int RT_LEN = 1156, RT_OFF = 1088;
template <int MODE, bool NEARB>
__device__ __forceinline__ void slot_tile(const LAS unsigned char* tb0, const LAS unsigned char* tb1, const bf16x8 (&q)[2], int dbase, const LAS float* rt, SlotState& A,
                                          float linv, float mrow, float bfar, LAS float* imp_row, int key0, int lane) {
    const int kg = lane >> 4;
    __builtin_amdgcn_sched_barrier(0);
    bf16x8 fr[4][2];
#pragma unroll
    for (int mt = 0; mt < 4; ++mt) { fr[mt][0] = *(const LAS bf16x8*)(tb0 + mt * 2048); fr[mt][1] = *(const LAS bf16x8*)(tb1 + mt * 2048); }
    f32x4 s[4];
#pragma unroll
    for (int mt = 0; mt < 4; ++mt) { s[mt] = mfma16(fr[mt][0], q[0], (f32x4){0.f, 0.f, 0.f, 0.f}); s[mt] = mfma16(fr[mt][1], q[1], s[mt]); }
    if (MODE != TM_C1) {
        __builtin_amdgcn_sched_barrier(0);
#pragma unroll
        for (int t = 0; t < 4; ++t) { fr[t][0] = *(const LAS bf16x8*)(tb0 + 8192 + t * 2048); fr[t][1] = *(const LAS bf16x8*)(tb1 + 8192 + t * 2048); }
        __builtin_amdgcn_sched_barrier(0);
    }
    constexpr bool CMP = (MODE == TM_C1 || MODE == TM_C2);
    if (MODE == TM_SS) {
        if (NEARB) {
            const LAS float* rp = rt + (RT_OFF - dbase);
#pragma unroll
            for (int mt = 0; mt < 4; ++mt)
#pragma unroll
                for (int r = 0; r < 4; ++r) s[mt][r] += rp[16 * mt + r];
        }
        float ps = 0.f;
#pragma unroll
        for (int mt = 0; mt < 4; ++mt)
#pragma unroll
            for (int r = 0; r < 4; ++r) { const float p = __builtin_amdgcn_exp2f(s[mt][r] - mrow); s[mt][r] = p; ps += p; }
        ps += __shfl_xor(ps, 16); ps += __shfl_xor(ps, 32);
        A.l += ps;
    } else {
        float tmax = -1e30f;
        if (NEARB) {
            const LAS float* rp = rt + (RT_OFF - dbase);
#pragma unroll
            for (int mt = 0; mt < 4; ++mt)
#pragma unroll
                for (int r = 0; r < 4; ++r) {
                    const int c = 16 * mt + r;
                    if (CMP) {
                        const int dist = dbase - 16 * c; const int di = dist < 0 ? 0 : (dist > RT_OFF ? RT_OFF : dist);
                        s[mt][r] = dist >= 0 ? s[mt][r] + rt[RT_OFF - di] : -1e30f;
                    } else {
                        const int dist = dbase - c; const bool ok = (MODE == TM_W) ? (dist >= 0 && dist < 512) : (dist >= 0);
                        s[mt][r] = ok ? s[mt][r] + rp[c] : -1e30f;
                    }
                    tmax = fmaxf(tmax, s[mt][r]);
                }
        } else {
#pragma unroll
            for (int mt = 0; mt < 4; ++mt)
#pragma unroll
                for (int r = 0; r < 4; ++r) { s[mt][r] += bfar; tmax = fmaxf(tmax, s[mt][r]); }
        }
        if (MODE == TM_C2) {
#pragma unroll
            for (int mt = 0; mt < 4; ++mt)
#pragma unroll
                for (int r = 0; r < 4; ++r) s[mt][r] = __builtin_amdgcn_exp2f(s[mt][r] - A.m) * linv;
            const int g = lane & 3;
#pragma unroll
            for (int mt = 0; mt < 4; ++mt) {
                float gsum = s[mt][0] + s[mt][1] + s[mt][2] + s[mt][3], lv = s[mt][3];
                gsum += __shfl_xor(gsum, 1); gsum += __shfl_xor(gsum, 2); lv += __shfl_xor(lv, 1); lv += __shfl_xor(lv, 2);
                const int j = (key0 >> 2) + 4 * mt + kg;
                if (g == 0) { atomicAdd((float*)(imp_row + j), gsum); atomicAdd((float*)(imp_row + j + 1), lv); }
            }
        } else {
            tmax = fmaxf(tmax, __shfl_xor(tmax, 16)); tmax = fmaxf(tmax, __shfl_xor(tmax, 32));
            const float mnew = fmaxf(A.m, tmax), msafe = fmaxf(mnew, -1e29f), alpha = __builtin_amdgcn_exp2f(A.m - msafe);
            float ps = 0.f;
#pragma unroll
            for (int mt = 0; mt < 4; ++mt)
#pragma unroll
                for (int r = 0; r < 4; ++r) { const float p = __builtin_amdgcn_exp2f(s[mt][r] - msafe); s[mt][r] = p; ps += p; }
            ps += __shfl_xor(ps, 16); ps += __shfl_xor(ps, 32);
            A.l = A.l * alpha + ps; A.m = mnew;
            if (MODE != TM_C1) {
#pragma unroll
                for (int t = 0; t < 4; ++t) A.O[t] = A.O[t] * alpha;
            }
        }
    }
    if (MODE != TM_C1) {
        bf16x8 pf[2];
#pragma unroll
        for (int k2 = 0; k2 < 2; ++k2) {
            u32x4 w; w.x = cvt_pk_bf16(s[2 * k2][0], s[2 * k2][1]); w.y = cvt_pk_bf16(s[2 * k2][2], s[2 * k2][3]); w.z = cvt_pk_bf16(s[2 * k2 + 1][0], s[2 * k2 + 1][1]); w.w = cvt_pk_bf16(s[2 * k2 + 1][2], s[2 * k2 + 1][3]);
            pf[k2] = __builtin_bit_cast(bf16x8, w);
        }
#pragma unroll
        for (int t = 0; t < 4; ++t) { A.O[t] = mfma16(fr[t][0], pf[0], A.O[t]); A.O[t] = mfma16(fr[t][1], pf[1], A.O[t]); }
    }
}

#define SGB(mask, n) __builtin_amdgcn_sched_group_barrier(mask, n, 0)
template <bool NEARB>
__device__ __forceinline__ void slot_pair_ss(const LAS unsigned char* tb0, const LAS unsigned char* tb1, const bf16x8 (&q0)[2], const bf16x8 (&q1)[2],
                                             int dbase0, int dbase1, const LAS float* rt, SlotState& A0, SlotState& A1, float mrow0, float mrow1) {
    f32x4 s0[4], s1[4];
    __builtin_amdgcn_sched_barrier(0);
    bf16x8 kf[4][2], vf[4][2];
#pragma unroll
    for (int mt = 0; mt < 4; ++mt) { kf[mt][0] = *(const LAS bf16x8*)(tb0 + mt * 2048); kf[mt][1] = *(const LAS bf16x8*)(tb1 + mt * 2048); }
#pragma unroll
    for (int mt = 0; mt < 4; ++mt) { s0[mt] = mfma16(kf[mt][0], q0[0], (f32x4){0.f, 0.f, 0.f, 0.f}); s0[mt] = mfma16(kf[mt][1], q0[1], s0[mt]); }
    __builtin_amdgcn_sched_barrier(0);
#pragma unroll
    for (int t = 0; t < 4; ++t) { vf[t][0] = *(const LAS bf16x8*)(tb0 + 8192 + t * 2048); vf[t][1] = *(const LAS bf16x8*)(tb1 + 8192 + t * 2048); }
    __builtin_amdgcn_sched_barrier(0);
#pragma unroll
    for (int mt = 0; mt < 4; ++mt) { s1[mt] = mfma16(kf[mt][0], q1[0], (f32x4){0.f, 0.f, 0.f, 0.f}); s1[mt] = mfma16(kf[mt][1], q1[1], s1[mt]); }
    float ps0 = 0.f, ps1 = 0.f;
    if (NEARB) {
        const LAS float* rp0 = rt + (RT_OFF - dbase0);
#pragma unroll
        for (int mt = 0; mt < 4; ++mt)
#pragma unroll
            for (int r = 0; r < 4; ++r) s0[mt][r] += rp0[16 * mt + r];
    }
#pragma unroll
    for (int mt = 0; mt < 4; ++mt)
#pragma unroll
        for (int r = 0; r < 4; ++r) { const float p0 = __builtin_amdgcn_exp2f(s0[mt][r] - mrow0); s0[mt][r] = p0; ps0 += p0; }
    bf16x8 pf0[2], pf1[2];
#pragma unroll
    for (int k2 = 0; k2 < 2; ++k2) {
        u32x4 w; w.x = cvt_pk_bf16(s0[2 * k2][0], s0[2 * k2][1]); w.y = cvt_pk_bf16(s0[2 * k2][2], s0[2 * k2][3]); w.z = cvt_pk_bf16(s0[2 * k2 + 1][0], s0[2 * k2 + 1][1]); w.w = cvt_pk_bf16(s0[2 * k2 + 1][2], s0[2 * k2 + 1][3]);
        pf0[k2] = __builtin_bit_cast(bf16x8, w);
    }
#pragma unroll
    for (int i = 0; i < 8; ++i) { SGB(0x8, 1); SGB(0x2, 5); SGB(0x400, 2); }
    __builtin_amdgcn_sched_barrier(0);
#pragma unroll
    for (int t = 0; t < 4; ++t) {
        A0.O[t] = mfma16(vf[t][0], pf0[0], A0.O[t]);
        A0.O[t] = mfma16(vf[t][1], pf0[1], A0.O[t]);
    }
    if (NEARB) {
        const LAS float* rp1 = rt + (RT_OFF - dbase1);
#pragma unroll
        for (int mt = 0; mt < 4; ++mt)
#pragma unroll
            for (int r = 0; r < 4; ++r) s1[mt][r] += rp1[16 * mt + r];
    }
#pragma unroll
    for (int mt = 0; mt < 4; ++mt)
#pragma unroll
        for (int r = 0; r < 4; ++r) { const float p1 = __builtin_amdgcn_exp2f(s1[mt][r] - mrow1); s1[mt][r] = p1; ps1 += p1; }
#pragma unroll
    for (int k2 = 0; k2 < 2; ++k2) {
        u32x4 v; v.x = cvt_pk_bf16(s1[2 * k2][0], s1[2 * k2][1]); v.y = cvt_pk_bf16(s1[2 * k2][2], s1[2 * k2][3]); v.z = cvt_pk_bf16(s1[2 * k2 + 1][0], s1[2 * k2 + 1][1]); v.w = cvt_pk_bf16(s1[2 * k2 + 1][2], s1[2 * k2 + 1][3]);
        pf1[k2] = __builtin_bit_cast(bf16x8, v);
    }
#pragma unroll
    for (int i = 0; i < 8; ++i) { SGB(0x8, 1); SGB(0x2, 5); SGB(0x400, 2); }
    __builtin_amdgcn_sched_barrier(0);
#pragma unroll
    for (int t = 0; t < 4; ++t) {
        A1.O[t] = mfma16(vf[t][0], pf1[0], A1.O[t]);
        A1.O[t] = mfma16(vf[t][1], pf1[1], A1.O[t]);
    }
    ps0 += __shfl_xor(ps0, 16); ps1 += __shfl_xor(ps1, 16); ps0 += __shfl_xor(ps0, 32); ps1 += __shfl_xor(ps1, 32);
    A0.l += ps0; A1.l += ps1;
}

__device__ __forceinline__ void nsa_item(const Frame& F, int item) {
    const int bhk = item & 7, cb = 127 - (item >> 3), b = bhk >> 1, hk = bhk & 1;
    int tid_ = F.tid, lane_ = F.lane; asm volatile("" : "+v"(tid_), "+v"(lane_));
    const int tid = tid_, lane = lane_, wave = F.wave, n = lane & 15, ts = n >> 2, g = n & 3, kg = lane >> 4;
    const bf16* nq = (const bf16*)(F.ws + WS_NQ); const bf16* nkv = (const bf16*)(F.ws + WS_NKV) + (size_t)b * SEQ * 768;
    const bf16* kcmp = (const bf16*)(F.ws + WS_KCMP) + (size_t)bhk * 512 * 64; const bf16* vcmpt = (const bf16*)(F.ws + WS_VCMPT) + (size_t)bhk * 64 * 512;
    const bf16* vst = (const bf16*)(F.ws + WS_VST) + (size_t)bhk * 64 * SEQ; const bf16* vwt = (const bf16*)(F.ws + WS_VWT) + (size_t)bhk * 64 * SEQ;
    const float* small = (const float*)(F.ws + WS_SMALL); const bf16* nz = (const bf16*)(F.ws + WS_NZ); bf16* mix = (bf16*)(F.ws + WS_MIX);
    LAS float* btl = (LAS float*)(F.lds + NL_BT); LAS float* imp = (LAS float*)(F.lds + NL_IMP);
    LAS unsigned* maskw = (LAS unsigned*)(F.lds + NL_MASK); LAS unsigned* smaskw = (LAS unsigned*)(F.lds + NL_SMASK);
    LAS unsigned char* kvb = F.lds + NL_KV;
    const LAS float* bt = btl + g * RT_LEN;
    for (int prb3 = 0; prb3 <= PRB_SETUP; ++prb3)
    { __syncthreads(); const float* btg = (const float*)(F.ws + WS_BT) + (size_t)(hk * 4) * 1025;
      for (int i = tid; i < 4 * RT_LEN; i += 512) { const int hh = i / RT_LEN, ii = i - hh * RT_LEN; const int d = RT_OFF - ii; btl[i] = d >= 0 ? btg[hh * 1025 + (d > 1024 ? 1024 : d)] : 0.f; }
      for (int i = lane; i < 8 * 130; i += 64) imp[wave * 8 * 130 + i] = 0.f; }
    const int tw0 = cb * 64 + wave * 8;
    int trow[2]; size_t tokg[2]; bf16x8 q[2][2];
    LAS float* totp = (LAS float*)(F.lds + NL_TOT) + ((wave * 8 + ts) * 4 + g) * 68 + 4 * kg;
#pragma unroll
    for (int sl = 0; sl < 2; ++sl) {
        trow[sl] = tw0 + 4 * sl + ts; tokg[sl] = (size_t)b * SEQ + trow[sl];
        const bf16* qp = nq + tokg[sl] * 512 + (hk * 4 + g) * 64 + 8 * kg;
        q[sl][0] = *(const bf16x8*)qp; q[sl][1] = *(const bf16x8*)(qp + 32);
    }
    SlotState A[2];
    const int fb0 = n * 128 + ((kg ^ (n & 7)) << 4), fb1 = n * 128 + (((4 + kg) ^ (n & 7)) << 4);
#define NS_LOADK(buf) do { _Pragma("unroll") for (int _mt = 0; _mt < 4; ++_mt) { kf[_mt][0] = *(const LAS bf16x8*)((buf) + fb0 + _mt * 2048); kf[_mt][1] = *(const LAS bf16x8*)((buf) + fb1 + _mt * 2048); } } while (0)
#define NS_LOADV(buf) do { _Pragma("unroll") for (int _t = 0; _t < 4; ++_t) _Pragma("unroll") for (int _ks = 0; _ks < 2; ++_ks) vf[_t][_ks] = tile_frag((buf) + 8192, 16 * _t + n, 4 * _ks + kg); } while (0)
#define NS_RESET() do { _Pragma("unroll") for (int _s = 0; _s < 2; ++_s) { A[_s].m = -1e30f; A[_s].l = 0.f; _Pragma("unroll") for (int _t = 0; _t < 4; ++_t) A[_s].O[_t] = (f32x4){0.f, 0.f, 0.f, 0.f}; } } while (0)
#define NS_BAR() do { asm volatile("s_waitcnt lgkmcnt(0)" ::: "memory"); __builtin_amdgcn_s_barrier(); asm volatile("" ::: "memory"); } while (0)
#define NS_PIPE(NT, KEY0, KB, KSTR, VTB, VLEN, NB, BUF, ...) do { \
        const int _nt = (NT); \
        for (int _p = 0; _p < (NB) - 1 && _p < _nt; ++_p) stage_dma(BUF(_p), KB, KSTR, VTB, VLEN, KEY0(_p), wave, lane); \
        wait_tiles((_nt - 1) < ((NB) - 2) ? (_nt - 1) : ((NB) - 2)); NS_BAR(); \
        for (int ti = 0; ti < _nt; ++ti) { \
            const LAS unsigned char* cbuf = BUF(ti & ((NB) - 1)); \
            if (ti + (NB) - 1 < _nt) stage_dma(BUF((ti + (NB) - 1) & ((NB) - 1)), KB, KSTR, VTB, VLEN, KEY0(ti + (NB) - 1), wave, lane); \
            __VA_ARGS__ \
            { const int _rem = _nt - 2 - ti; wait_tiles(_rem < 0 ? 0 : (_rem < (NB) - 2 ? _rem : (NB) - 2)); } \
            NS_BAR(); \
        } } while (0)
#define BUF2(i) (kvb + (i) * 16384)
#define BUF4(i) ((i) < 2 ? kvb + (i) * 16384 : (LAS unsigned char*)(F.lds + NL_IMP) + ((i) - 2) * 16384)
    __syncthreads();
    const float bfarv = bt[RT_OFF - 1024];
    const int ntc = ((4 * cb + 2) >> 6) + 1;
#define KEY0_LIN(i) (64 * (i))
    for (int prb = 0; prb <= PRB_C; ++prb) {
    NS_RESET();
    NS_PIPE(ntc, KEY0_LIN, kcmp, 64, vcmpt, 512, 2, BUF2, {

        const int db0 = trow[0] - 31 - 16 * (64 * ti + 4 * kg), db1 = trow[1] - 31 - 16 * (64 * ti + 4 * kg);
        if (64 * cb - 1024 * ti - 1039 >= 790) {
            slot_tile<TM_C1, false>(cbuf + fb0, cbuf + fb1, q[0], db0, bt, A[0], 0.f, 0.f, bfarv, nullptr, 64 * ti, lane);
            slot_tile<TM_C1, false>(cbuf + fb0, cbuf + fb1, q[1], db1, bt, A[1], 0.f, 0.f, bfarv, nullptr, 64 * ti, lane);
        } else {
            slot_tile<TM_C1, true>(cbuf + fb0, cbuf + fb1, q[0], db0, bt, A[0], 0.f, 0.f, bfarv, nullptr, 64 * ti, lane);
            slot_tile<TM_C1, true>(cbuf + fb0, cbuf + fb1, q[1], db1, bt, A[1], 0.f, 0.f, bfarv, nullptr, 64 * ti, lane);
        }
    });
    }
    {
        for (int prb2 = PRB_C2; prb2 >= 0; --prb2) {
        const float li0 = (prb2 == 0 && A[0].l > 0.f) ? 1.0f / A[0].l : 0.f, li1 = (prb2 == 0 && A[1].l > 0.f) ? 1.0f / A[1].l : 0.f;
        NS_PIPE(ntc, KEY0_LIN, kcmp, 64, vcmpt, 512, 2, BUF2, {

            const int db0 = trow[0] - 31 - 16 * (64 * ti + 4 * kg), db1 = trow[1] - 31 - 16 * (64 * ti + 4 * kg);
            if (64 * cb - 1024 * ti - 1039 >= 790) {
                slot_tile<TM_C2, false>(cbuf + fb0, cbuf + fb1, q[0], db0, bt, A[0], li0, 0.f, bfarv, imp + (wave * 8 + ts) * 130, 64 * ti, lane);
                slot_tile<TM_C2, false>(cbuf + fb0, cbuf + fb1, q[1], db1, bt, A[1], li1, 0.f, bfarv, imp + (wave * 8 + 4 + ts) * 130, 64 * ti, lane);
            } else {
                slot_tile<TM_C2, true>(cbuf + fb0, cbuf + fb1, q[0], db0, bt, A[0], li0, 0.f, bfarv, imp + (wave * 8 + ts) * 130, 64 * ti, lane);
                slot_tile<TM_C2, true>(cbuf + fb0, cbuf + fb1, q[1], db1, bt, A[1], li1, 0.f, bfarv, imp + (wave * 8 + 4 + ts) * 130, 64 * ti, lane);
            }
        });
        }
#pragma unroll
        for (int sl = 0; sl < 2; ++sl) { const float gate = small[tokg[sl] * 32 + 8 + hk * 4 + g];
#pragma unroll
            for (int t = 0; t < 4; ++t) *(LAS f32x4*)(totp + sl * 16 * 68 + 16 * t) = A[sl].O[t] * gate; }
    }
#pragma unroll
    for (int sl = 0; sl < 2; ++sl) {
        const int tsl = lane >> 4, i = lane & 15; const int tk = wave * 8 + 4 * sl + tsl;
        unsigned mw0 = 0u, mw1 = 0u, mw2 = 0u, mw3 = 0u;
#define NS_SETBIT(j) do { const unsigned _b = 1u << ((j) & 31); const int _w = (j) >> 5; mw0 |= _w == 0 ? _b : 0u; mw1 |= _w == 1 ? _b : 0u; mw2 |= _w == 2 ? _b : 0u; mw3 |= _w == 3 ? _b : 0u; } while (0)
        if (cb <= 15) { mw0 = (2u << cb) - 1u; }
        else {
            float val[8];
#pragma unroll
            for (int qq = 0; qq < 8; ++qq) { const int j = i + 16 * qq; val[qq] = (j >= 1 && j <= cb - 2) ? imp[tk * 130 + j] : -1.0f; }
            NS_SETBIT(0); NS_SETBIT(cb - 1); NS_SETBIT(cb);
            for (int round = 0; round < 13; ++round) {
                float bv = -2.0f; int bj = 1 << 20;
#pragma unroll
                for (int qq = 0; qq < 8; ++qq) if (val[qq] > bv) { bv = val[qq]; bj = i + 16 * qq; }
#define NS_DPP_STEP(CTRL) do { const float ov = __builtin_bit_cast(float, __builtin_amdgcn_update_dpp(0, __builtin_bit_cast(int, bv), CTRL, 0xf, 0xf, false)); \
                    const int oj = __builtin_amdgcn_update_dpp(0, bj, CTRL, 0xf, 0xf, false); if (ov > bv || (ov == bv && oj < bj)) { bv = ov; bj = oj; } } while (0)
                NS_DPP_STEP(0xB1); NS_DPP_STEP(0x4E); NS_DPP_STEP(0x141); NS_DPP_STEP(0x140);
#pragma unroll
                for (int qq = 0; qq < 8; ++qq) if (bj == i + 16 * qq) val[qq] = -3.0f;
                NS_SETBIT(bj);
            }
        }
        if (i == 0) { maskw[tk * 4 + 0] = mw0; maskw[tk * 4 + 1] = mw1; maskw[tk * 4 + 2] = mw2; maskw[tk * 4 + 3] = mw3; }
        mw0 |= __shfl_xor(mw0, 16); mw0 |= __shfl_xor(mw0, 32); mw1 |= __shfl_xor(mw1, 16); mw1 |= __shfl_xor(mw1, 32);
        mw2 |= __shfl_xor(mw2, 16); mw2 |= __shfl_xor(mw2, 32); mw3 |= __shfl_xor(mw3, 16); mw3 |= __shfl_xor(mw3, 32);
        if (lane == 0) { const int so = (wave * 2 + sl) * 4; smaskw[so] = mw0; smaskw[so + 1] = mw1; smaskw[so + 2] = mw2; smaskw[so + 3] = mw3; }
    }
    __syncthreads();
    {
#define KEY0_SEL(i) (64 * (cb == 0 ? 0 : (cb == 1 ? 1 - (i) : ((i) == 0 ? cb : ((i) == 1 ? cb - 1 : ((i) == 2 ? 0 : (i) - 2))))))
        const int tk0 = wave * 8 + ts;
        unsigned smk0[4], smk1[4], rmk0[4], rmk1[4];
#pragma unroll
        for (int w4 = 0; w4 < 4; ++w4) {
            smk0[w4] = __builtin_amdgcn_readfirstlane(smaskw[(wave * 2 + 0) * 4 + w4]); smk1[w4] = __builtin_amdgcn_readfirstlane(smaskw[(wave * 2 + 1) * 4 + w4]);
            rmk0[w4] = maskw[tk0 * 4 + w4]; rmk1[w4] = maskw[(tk0 + 4) * 4 + w4];
        }
        const LAS unsigned char* const Kb_ = nullptr; (void)Kb_;
        const bf16* ksl = nkv + 256 + hk * 64;
        for (int prb = 0; prb <= PRB_S; ++prb) {
        NS_RESET();
        const int nt = cb + 1, np = (nt + 1) >> 1;
        stage_dma(BUF4(0), ksl, 768, vst, SEQ, KEY0_SEL(0), wave, lane); if (nt > 1) stage_dma(BUF4(1), ksl, 768, vst, SEQ, KEY0_SEL(1), wave, lane);
        wait_tiles(0); NS_BAR();
        for (int p = 0; p < np; ++p) {
            const int sb = (p & 1) * 2;
            if (p + 1 < np) { stage_dma(BUF4(2 - sb), ksl, 768, vst, SEQ, KEY0_SEL(2 * p + 2), wave, lane); if (2 * p + 3 < nt) stage_dma(BUF4(3 - sb), ksl, 768, vst, SEQ, KEY0_SEL(2 * p + 3), wave, lane); }
#pragma unroll 1
            for (int hh = 0; hh < 2; ++hh) {
                const int ti = 2 * p + hh; if (ti >= nt) break;
                const LAS unsigned char* cbuf = BUF4(sb + hh);
                const int key0 = KEY0_SEL(ti); const int j = key0 >> 6;
                const bool dense = (cb < 2) || (ti < 3);
                const int db0 = trow[0] - key0 - 4 * kg, db1 = trow[1] - key0 - 4 * kg;
                const bool nearb = (cb - j) < 14;
                if (dense) {

                    if (nearb) {
                        slot_tile<TM_SD, true>(cbuf + fb0, cbuf + fb1, q[0], db0, bt, A[0], 0.f, 0.f, bfarv, nullptr, key0, lane);
                        slot_tile<TM_SD, true>(cbuf + fb0, cbuf + fb1, q[1], db1, bt, A[1], 0.f, 0.f, bfarv, nullptr, key0, lane);
                    } else {
                        slot_tile<TM_SD, false>(cbuf + fb0, cbuf + fb1, q[0], db0, bt, A[0], 0.f, 0.f, bfarv, nullptr, key0, lane);
                        slot_tile<TM_SD, false>(cbuf + fb0, cbuf + fb1, q[1], db1, bt, A[1], 0.f, 0.f, bfarv, nullptr, key0, lane);
                    }
                } else {
                    const int w4 = j >> 5, bit = j & 31;
                    const unsigned sm0 = w4 == 0 ? smk0[0] : (w4 == 1 ? smk0[1] : (w4 == 2 ? smk0[2] : smk0[3])), sm1 = w4 == 0 ? smk1[0] : (w4 == 1 ? smk1[1] : (w4 == 2 ? smk1[2] : smk1[3]));
                    const bool a0 = (sm0 >> bit) & 1u, a1 = (sm1 >> bit) & 1u;
                    if (a0 || a1) {

                        const unsigned rm0 = w4 == 0 ? rmk0[0] : (w4 == 1 ? rmk0[1] : (w4 == 2 ? rmk0[2] : rmk0[3])), rm1 = w4 == 0 ? rmk1[0] : (w4 == 1 ? rmk1[1] : (w4 == 2 ? rmk1[2] : rmk1[3]));
                        const float boff = nearb ? 0.f : bfarv;
                        const float mr0 = ((rm0 >> bit) & 1u) ? A[0].m - boff : 1e30f, mr1 = ((rm1 >> bit) & 1u) ? A[1].m - boff : 1e30f;
                        if (a0 && a1) {
                            if (nearb) slot_pair_ss<true>(cbuf + fb0, cbuf + fb1, q[0], q[1], db0, db1, bt, A[0], A[1], mr0, mr1);
                            else slot_pair_ss<false>(cbuf + fb0, cbuf + fb1, q[0], q[1], db0, db1, bt, A[0], A[1], mr0, mr1);
                        } else if (a0) {
                            if (nearb) slot_tile<TM_SS, true>(cbuf + fb0, cbuf + fb1, q[0], db0, bt, A[0], 0.f, mr0, 0.f, nullptr, key0, lane);
                            else slot_tile<TM_SS, false>(cbuf + fb0, cbuf + fb1, q[0], db0, bt, A[0], 0.f, mr0, 0.f, nullptr, key0, lane);
                        } else {
                            if (nearb) slot_tile<TM_SS, true>(cbuf + fb0, cbuf + fb1, q[1], db1, bt, A[1], 0.f, mr1, 0.f, nullptr, key0, lane);
                            else slot_tile<TM_SS, false>(cbuf + fb0, cbuf + fb1, q[1], db1, bt, A[1], 0.f, mr1, 0.f, nullptr, key0, lane);
                        }
                    }
                }
            }
            wait_tiles(0); NS_BAR();
        }
        }
#pragma unroll
        for (int sl = 0; sl < 2; ++sl) { const float gate = small[tokg[sl] * 32 + 16 + hk * 4 + g]; const float sc = A[sl].l > 0.f ? gate / A[sl].l : 0.f;
#pragma unroll
            for (int t = 0; t < 4; ++t) { LAS f32x4* tp = (LAS f32x4*)(totp + sl * 16 * 68 + 16 * t); *tp = *tp + A[sl].O[t] * sc; } }
    }
    {
        const int jw0 = cb >= 8 ? cb - 8 : 0;
#define KEY0_WIN(i) (64 * (jw0 + (i)))
        for (int prb = 0; prb <= PRB_W; ++prb) {
        NS_RESET();
        NS_PIPE(cb - jw0 + 1, KEY0_WIN, nkv + 512 + hk * 64, 768, vwt, SEQ, 4, BUF4, {

            slot_tile<TM_W, true>(cbuf + fb0, cbuf + fb1, q[0], trow[0] - KEY0_WIN(ti) - 4 * kg, bt, A[0], 0.f, 0.f, 0.f, nullptr, KEY0_WIN(ti), lane);
            slot_tile<TM_W, true>(cbuf + fb0, cbuf + fb1, q[1], trow[1] - KEY0_WIN(ti) - 4 * kg, bt, A[1], 0.f, 0.f, 0.f, nullptr, KEY0_WIN(ti), lane);
        });
        }
#pragma unroll
        for (int sl = 0; sl < 2; ++sl) { const float gate = small[tokg[sl] * 32 + 24 + hk * 4 + g]; const float sc = A[sl].l > 0.f ? gate / A[sl].l : 0.f;
#pragma unroll
            for (int t = 0; t < 4; ++t) { LAS f32x4* tp = (LAS f32x4*)(totp + sl * 16 * 68 + 16 * t); *tp = *tp + A[sl].O[t] * sc; } }
    }
    {
        int l2 = lane; asm volatile("" : "+v"(l2));
        const int n2 = l2 & 15, ts2 = n2 >> 2, g2 = n2 & 3, kg2 = l2 >> 4;
        const LAS float* tp2 = (const LAS float*)(F.lds + NL_TOT) + ((wave * 8 + ts2) * 4 + g2) * 68 + 4 * kg2;
#pragma unroll
        for (int sl = 0; sl < 2; ++sl) {
            const size_t tk = (size_t)b * SEQ + tw0 + 4 * sl + ts2;
#pragma unroll
            for (int t = 0; t < 4; ++t) {
                const u32x2 z = *(const u32x2*)(nz + tk * 512 + (hk * 4 + g2) * 64 + 16 * t + 4 * kg2);
                const f32x4 tv = *(const LAS f32x4*)(tp2 + sl * 16 * 68 + 16 * t);
                u32x2 d; d.x = cvt_pk_bf16(tv[0] * __uint_as_float(z.x << 16), tv[1] * __uint_as_float(z.x & 0xffff0000u));
                d.y = cvt_pk_bf16(tv[2] * __uint_as_float(z.y << 16), tv[3] * __uint_as_float(z.y & 0xffff0000u));
                *(u32x2*)(mix + tk * DM + 512 + (hk * 4 + g2) * 64 + 16 * t + 4 * kg2) = d;
            }
        }
    }
    __syncthreads();
#undef NS_LOADK
#undef NS_LOADV
#undef NS_RESET
#undef NS_PIPE
#undef NS_SETBIT
}
#ifndef PRB_SCANONLY
#define PRB_SCANONLY 0
#endif
#ifndef DUP_P1
#define DUP_P1 0
#endif
#ifndef DUP_P2
#define DUP_P2 0
#endif
#ifndef DUP_SCAN
#define DUP_SCAN 0
#endif
#ifndef DUP_NSA
#define DUP_NSA 0
#endif
__device__ __forceinline__ void p2_phase(const Frame& F) {
    for (int rep = 0; rep <= DUP_P2; ++rep)
    for (int task = blockIdx.x; task < 3072; task += gridDim.x) {
        if (task < 2048) gdn_prep_item(F, task);
        else if (task < 2560) compress_block(F, task - 2048);
        else vtranspose_task(F, task - 2560);
    }
}
__device__ __forceinline__ void p3_phase(const Frame& F) {
    for (int rep = 0; rep <= DUP_SCAN; ++rep)
        for (int bh = blockIdx.x; bh < 16; bh += gridDim.x) gdn_scan(F, bh);
    LAS int* nxt = (LAS int*)(F.lds + NL_NXT);
#if PRB_SCANONLY
    if (blockIdx.x < 16) return;
#endif
    for (int rep = 0; rep <= DUP_NSA; ++rep) {
        const int bhk = blockIdx.x & 7;
        unsigned* ctr = (unsigned*)(F.ws + WS_CTL) + 64 + 64 * bhk + 1024 * rep;
        for (;;) {
            __syncthreads();
            if (F.tid == 0) *nxt = (int)atomicAdd(ctr, 1u);
            __syncthreads();
            const int qi = *nxt;
            if (qi >= 128) break;
            nsa_item(F, qi * 8 + bhk);
        }
    }
}
typedef __attribute__((address_space(1))) unsigned gu32;
#define XB_TMO      128
#define XB_XCNT(j)  (256  + 64 * (j))
#define XB_XSUB(j)  (1280 + 64 * (j))
#define XB_XGEN(j)  (2304 + 64 * (j))
#define XB_TOP      3328
#define XB_TOPGEN   3392
#define XCD_BAR_WORDS 3456
#define XB_SPIN_CAP (1u << 18)

__device__ __forceinline__ unsigned xb_ld(unsigned* p)              { return __hip_atomic_load(p, __ATOMIC_RELAXED, __HIP_MEMORY_SCOPE_AGENT); }
__device__ __forceinline__ unsigned xb_add(unsigned* p, unsigned v) { return __hip_atomic_fetch_add(p, v, __ATOMIC_RELAXED, __HIP_MEMORY_SCOPE_AGENT); }
__device__ __forceinline__ unsigned xb_xcc_id() { return (unsigned)__builtin_amdgcn_s_getreg((3 << 11) | 20) & 0xFu; }
#define XB_SPIN(cond, bar) do { unsigned _sp = 0; while (cond) { __builtin_amdgcn_s_sleep(1); \
    if ((++_sp & 255u) == 0u) { if (xb_ld(&(bar)[XB_TMO])) break; if (_sp > XB_SPIN_CAP) { atomicAdd(&(bar)[XB_TMO], 1u); break; } } } } while (0)

struct XcdBarrier {
    unsigned* bar; unsigned x;
    volatile LAS unsigned* st;
};

__device__ __forceinline__ XcdBarrier xcd_barrier_post(unsigned* bar, volatile LAS unsigned* st) {
    XcdBarrier b; b.bar = bar; b.x = xb_xcc_id(); b.st = st;
    if (threadIdx.x == 0) (void)xb_add(&bar[XB_XCNT(b.x)], 1u);
    return b;
}
__device__ __forceinline__ void xcd_barrier_complete(unsigned* bar, unsigned x, unsigned& nloc, unsigned& nx) {
    const unsigned G = gridDim.x * gridDim.y * gridDim.z;
    unsigned sum, cnt, mine, sp = 0u;
    for (;;) {
        sum = 0u; cnt = 0u; mine = 0u;
#pragma unroll
        for (unsigned j = 0; j < 16; ++j) { const unsigned c = xb_ld(&bar[XB_XCNT(j)]); sum += c; cnt += (c > 0u) ? 1u : 0u; mine = (j == x) ? c : mine; }
        if (sum == G) break;
        __builtin_amdgcn_s_sleep(1);
        if ((++sp & 255u) == 0u) { if (xb_ld(&bar[XB_TMO])) break; if (sp > XB_SPIN_CAP) { atomicAdd(&bar[XB_TMO], 1u); break; } }
    }
    nloc = mine > 0u ? mine : 1u; nx = cnt > 0u ? cnt : 1u;
}

__device__ __forceinline__ void xcd_barrier(const XcdBarrier& b) {
    asm volatile("s_waitcnt vmcnt(0)" ::: "memory");
    __syncthreads();
    if (threadIdx.x == 0) {
        unsigned* bar = b.bar;
        __builtin_amdgcn_s_waitcnt(0);
        unsigned nloc = b.st[0], nx = b.st[1];
        if (nloc == 0u) { xcd_barrier_complete(bar, b.x, nloc, nx); b.st[0] = nloc; b.st[1] = nx; }
        const unsigned old = xb_add(&bar[XB_XSUB(b.x)], 1u);
        const unsigned gen = old / nloc;
        if (old + 1u == (gen + 1u) * nloc) {
            __builtin_amdgcn_fence(__ATOMIC_RELEASE, "agent");
            asm volatile("s_waitcnt vmcnt(0)" ::: "memory");
            const unsigned og = xb_add(&bar[XB_TOP], 1u);
            const unsigned tg = og / nx;
            if (og + 1u == (tg + 1u) * nx) xb_add(&bar[XB_TOPGEN], 1u);
            else XB_SPIN(xb_ld(&bar[XB_TOPGEN]) == tg, bar);
            __builtin_amdgcn_fence(__ATOMIC_ACQUIRE, "agent");
            xb_add(&bar[XB_XGEN(b.x)], 1u);
            asm volatile("s_waitcnt vmcnt(0)" ::: "memory");
        } else {
            XB_SPIN(xb_ld(&bar[XB_XGEN(b.x)]) == gen, bar);
            __builtin_amdgcn_fence(__ATOMIC_ACQUIRE, "agent");
            asm volatile("s_waitcnt vmcnt(0)" ::: "memory");
        }
    }
    __syncthreads();
}

constexpr int LDS_BARST = LDS_BYTES - 64;
struct Args { const float* in[16]; float* out; unsigned char* ws; int ph_lo, ph_hi, coop, pad; };
constexpr int N_PHASES = 6;

__global__ void __launch_bounds__(512, 2) hymba_fwd(Args a) {
    extern __shared__ __attribute__((aligned(16))) unsigned char lds_raw[];
    Frame F;
#pragma unroll
    for (int i = 0; i < 16; ++i) F.in[i] = a.in[i];
    F.out = a.out; F.ws = a.ws; F.lds = (LAS unsigned char*)lds_raw; F.ldsg = lds_raw;
    F.tid = threadIdx.x; F.lane = F.tid & 63; F.wave = __builtin_amdgcn_readfirstlane(F.tid >> 6);
    unsigned char* ws = a.ws;
    volatile LAS unsigned* barst = (volatile LAS unsigned*)(F.lds + LDS_BARST);
    if (F.tid < 2) barst[F.tid] = 0u;
    __syncthreads();
    XcdBarrier xbar; xbar.bar = (unsigned*)(ws + WS_CTL) + 4096; xbar.x = 0; xbar.st = nullptr;
    if (a.coop) xbar = xcd_barrier_post((unsigned*)(ws + WS_CTL) + 4096, barst);
    const int lo = a.ph_lo, hi = a.ph_hi;
#define IN(k) (lo <= (k) && (k) < hi)
#define SEAM(k) do { if (IN(k) && IN((k) + 1) && a.coop) { if ((k) == 0) cg::this_grid().sync(); else xcd_barrier(xbar); } __syncthreads(); } while (0)
#ifndef DUP_P0
#define DUP_P0 0
#endif
#ifndef DUP_P4
#define DUP_P4 0
#endif
    if (IN(0)) { _Pragma("unroll 1") for (int rep = 0; rep <= DUP_P0; ++rep) p0_prep(F); }
    SEAM(0);
    if (IN(1)) {
        pg8::Gemm g{(const bf16*)(ws + WS_XB), (const bf16*)(ws + WS_WTIN), T_TOK, NPROJ, DM};
        pg8::StaticOrder S; S.init(T_TOK, NPROJ, (int)gridDim.x, (int)blockIdx.x);
        EpiProj E{(bf16*)(ws + WS_GQKV), (bf16*)(ws + WS_GZ), (bf16*)(ws + WS_NQ), (bf16*)(ws + WS_NKV), (bf16*)(ws + WS_NZ), (const float*)(ws + WS_RS)};
        pg8::gemm_phase<EpiProj, pg8::StaticOrder, false>(F.lds, g, S, E, nullptr);
#if DUP_P1
        __syncthreads(); pg8::gemm_phase<EpiProj, pg8::StaticOrder, false>(F.lds, g, S, E, nullptr);
#endif
    }
    SEAM(1);
    if (IN(2)) p2_phase(F);
    SEAM(2);
    if (IN(3)) p3_phase(F);
    SEAM(3);
    if (IN(4)) {
        pg8::Gemm g{(const bf16*)(ws + WS_MIX), (const bf16*)(ws + WS_WTOUT), T_TOK, DM, DM};
        pg8::StaticOrder S; S.init(T_TOK, DM, (int)gridDim.x, (int)blockIdx.x);
        EpiOut E{F.in[0], F.out};
        pg8::gemm_phase<EpiOut, pg8::StaticOrder, false>(F.lds, g, S, E, nullptr);
#if DUP_P4
        __syncthreads(); pg8::gemm_phase<EpiOut, pg8::StaticOrder, false>(F.lds, g, S, E, nullptr);
#endif
    }
    SEAM(4);
    if (IN(5)) p5_final(F);
#undef IN
#undef SEAM
}

extern "C" void kernel_launch(void* const* d_in, const int* in_sizes, int n_in, void* d_out, int out_size, void* d_ws, size_t ws_size, hipStream_t stream) {
    static int grid = 0;
    if (grid == 0) {
        if (n_in != 16 || in_sizes[0] != T_TOK * DM || out_size != T_TOK * DM || ws_size < WS_END) { fprintf(stderr, "kernel_launch: unexpected shapes (n_in %d, ws %zu)\n", n_in, ws_size); grid = -1; return; }
        int dev = 0, cus = 0, per_cu = 0;
        if (hipGetDevice(&dev) != hipSuccess || hipDeviceGetAttribute(&cus, hipDeviceAttributeMultiprocessorCount, dev) != hipSuccess) { grid = -1; return; }
        if (hipFuncSetAttribute((const void*)hymba_fwd, hipFuncAttributeMaxDynamicSharedMemorySize, LDS_BYTES) != hipSuccess) { fprintf(stderr, "kernel_launch: hipFuncSetAttribute failed\n"); grid = -1; return; }
        if (hipOccupancyMaxActiveBlocksPerMultiprocessor(&per_cu, (const void*)hymba_fwd, 512, LDS_BYTES) != hipSuccess || per_cu < 1) { fprintf(stderr, "kernel_launch: occupancy query says %d\n", per_cu); per_cu = 1; }
        (void)hipGetLastError();
        grid = cus;
    }
    if (grid < 0) return;
    (void)hipMemsetAsync((char*)d_ws + WS_CTL, 0, 1 * MiB, stream);
    Args a{};
    for (int i = 0; i < 16; ++i) a.in[i] = (const float*)d_in[i];
    a.out = (float*)d_out; a.ws = (unsigned char*)d_ws;
#if MK_LAUNCHES == 1
    a.ph_lo = 0; a.ph_hi = N_PHASES; a.coop = 1;
    void* args[] = {&a};
    hipError_t e = hipLaunchCooperativeKernel((const void*)hymba_fwd, dim3(grid), dim3(512), args, LDS_BYTES, stream);
    if (e != hipSuccess) fprintf(stderr, "cooperative launch failed: %s (grid %d)\n", hipGetErrorString(e), grid);
#else
    for (int ph = 0; ph < N_PHASES; ++ph) {
        a.ph_lo = ph; a.ph_hi = ph + 1; a.coop = 0;
        hipLaunchKernelGGL(hymba_fwd, dim3(grid), dim3(512), LDS_BYTES, stream, a);
    }
#endif
}
```

```cpp
#include <hip/hip_runtime.h>
#include <hip/hip_cooperative_groups.h>
#include <cstdio>
#include <cstdint>
namespace cg = cooperative_groups;
#ifndef MK_LAUNCHES
#define MK_LAUNCHES 1
#endif

namespace pg8 {
#define PG8_LAS __attribute__((address_space(3)))
typedef unsigned short bf16_t;
typedef short bf16x8 __attribute__((ext_vector_type(8)));
typedef float f32x4 __attribute__((ext_vector_type(4)));
typedef unsigned u32x4 __attribute__((ext_vector_type(4)));
constexpr int BM = 256, BK = 64, HALF = 128, HTB = HALF * BK * 2  , STAGE_BYTES = 8 * HTB, NXCD = 8, WGM = 8;

__host__ __device__ __forceinline__ int lds_byte(int r, int c) { const int st = (r >> 4) * 2 + (c >> 5), rr = r & 15, cc = c & 31, ob = rr * 64 + cc * 2; return st * 1024 + (ob ^ (((ob >> 9) & 1) << 5)); }
__host__ __device__ __forceinline__ void stage_rc(int b, int& R, int& C) { const int st = b / 1024, sb = b % 1024, swz = sb ^ (((sb >> 9) & 1) << 5); R = (st >> 1) * 16 + swz / 64; C = (st & 1) * 32 + (swz % 64) / 2; }
__host__ __device__ __forceinline__ int perm32(int rho) { const int n = rho >> 4, i = rho & 15; return 8 * (i >> 2) + 4 * n + (i & 3); }

struct Unit { int pm, pn; };
struct Gemm { const bf16_t* A; const bf16_t* Bt; int M, N, K; };

struct StaticOrder {
    int nM, nN, nwg, G, c;
    __host__ __device__ void init(int M, int N, int G_, int c_) { nM = M / BM; nN = N / BM; nwg = nM * nN; G = G_; c = c_; }
    __host__ __device__ bool next(int i, Unit& u) const {
        const long L = (long)i * G + c; if (L >= nwg) return false;
        int wgid = (int)L; { const int q = nwg / NXCD, r = nwg % NXCD, xcd = wgid % NXCD, off = wgid / NXCD; wgid = (xcd < r ? xcd * (q + 1) : r * (q + 1) + (xcd - r) * q) + off; }
        const int nig = WGM * nN, gid = wgid / nig, fm = gid * WGM, gsz = (nM - fm) < WGM ? (nM - fm) : WGM;
        u.pm = fm + ((wgid % nig) % gsz); u.pn = (wgid % nig) / gsz; return true;
    }
    __device__ __forceinline__ void a_ready(const Unit&) const {}
    __device__ __forceinline__ void done(const Unit&) const {}
};
__device__ __forceinline__ unsigned cvt_pk_bf16(float lo, float hi) { unsigned r; asm volatile("v_cvt_pk_bf16_f32 %0, %1, %2" : "=v"(r) : "v"(lo), "v"(hi)); return r; }
typedef float f32x2 __attribute__((ext_vector_type(2)));
template <class Epi, class Sched, bool STAMP = false>
__device__ __forceinline__ void gemm_phase(PG8_LAS unsigned char* lds, const Gemm g, const Sched& S, const Epi& E, unsigned long long* stamps) {
    const int tid = threadIdx.x, wid = __builtin_amdgcn_readfirstlane(tid >> 6), lane = tid & 63, wr = wid >> 2, wc = wid & 3, fr = lane & 15, fq = lane >> 4;
    const int K = g.K, nt = K / BK;
    int ts_lo = 0, ts_hi = 0, nts = 0; const unsigned long long rt_entry = STAMP ? (unsigned long long)wall_clock64() : 0ull;
#define PG8_STAMP() do { if (STAMP && wid == 0 && nts < 64) { const unsigned long long _c = (unsigned long long)clock64(); \
        ts_lo = (lane == nts) ? (int)(unsigned)_c : ts_lo; ts_hi = (lane == nts) ? (int)(unsigned)(_c >> 32) : ts_hi; ++nts; } } while (0)
    PG8_STAMP();
    unsigned voffA[2], voffB[2];
#pragma unroll
    for (int i = 0; i < 2; ++i) { int R, C; stage_rc(tid * 16 + i * 8192, R, C); const int Rb = Epi::PERM ? ((R & ~31) + perm32(R & 31)) : R;
        voffA[i] = (unsigned)(R * K + C) * 2u; voffB[i] = (unsigned)(Rb * K + C) * 2u; }
    const size_t kstep = (size_t)(BK * 2);
    const size_t hstep = (size_t)HALF * K * 2;
    const size_t tstep = 2 * hstep;
    const unsigned ldsw = (unsigned)wid * 1024u;
    const int aoff = lds_byte(wr * 64 + fr, fq * 8), boff = lds_byte(wc * 32 + fr, fq * 8);
#define PG8_SA(b, h) (((b) * 2 + (h)) * HTB)
#define PG8_SB(b, h) ((4 + (b) * 2 + (h)) * HTB)
#define PG8_STAGE(bufoff, gbase, voff) do { _Pragma("unroll") for (int _i = 0; _i < 2; ++_i) \
        __builtin_amdgcn_global_load_lds((const unsigned*)((const char*)(gbase) + (voff)[_i]), (PG8_LAS unsigned*)(lds + (bufoff) + ldsw + _i * 8192), 16, 0, 0); } while (0)
#define PG8_LDA(dst, b, h) do { _Pragma("unroll") for (int m = 0; m < 4; ++m) _Pragma("unroll") for (int k = 0; k < 2; ++k) dst[m][k] = *(const PG8_LAS bf16x8*)(lds + PG8_SA(b, h) + aoff + m * 2048 + k * 1024); } while (0)
#define PG8_LDB(dst, b, h) do { _Pragma("unroll") for (int n = 0; n < 2; ++n) _Pragma("unroll") for (int k = 0; k < 2; ++k) dst[n][k] = *(const PG8_LAS bf16x8*)(lds + PG8_SB(b, h) + boff + n * 2048 + k * 1024); } while (0)
#define PG8_MMA(ai, bj, At, Bt) do { __builtin_amdgcn_s_setprio(1); _Pragma("unroll") for (int m = 0; m < 4; ++m) _Pragma("unroll") for (int n = 0; n < 2; ++n) _Pragma("unroll") for (int k = 0; k < 2; ++k) \
        acc[ai][bj][m][n] = __builtin_amdgcn_mfma_f32_16x16x32_bf16(Bt[n][k], At[m][k], acc[ai][bj][m][n], 0, 0, 0); __builtin_amdgcn_s_setprio(0); } while (0)
#define PG8_WAIT_V(n) asm volatile("s_waitcnt vmcnt(" #n ")" ::: "memory")
#define PG8_WAIT_L(n) asm volatile("s_waitcnt lgkmcnt(" #n ")" ::: "memory")
#define PG8_BAR __builtin_amdgcn_s_barrier()
#define PG8_SCHED __builtin_amdgcn_sched_barrier(0)
    Unit cur, nxt; int ui = 0;
    if (!S.next(0, cur)) return;
    f32x4 acc[2][2][4][2];
#pragma unroll
    for (int a = 0; a < 2; ++a)
#pragma unroll
        for (int b = 0; b < 2; ++b)
#pragma unroll
            for (int m = 0; m < 4; ++m)
#pragma unroll
                for (int n = 0; n < 2; ++n) acc[a][b][m][n] = (f32x4){0.f, 0.f, 0.f, 0.f};
    bf16x8 At[4][2], B0[2][2], B1[2][2];
    const char* cA = (const char*)g.A + (size_t)cur.pm * tstep; const char* cB = (const char*)g.Bt + (size_t)cur.pn * tstep;
    S.a_ready(cur);
    PG8_STAGE(PG8_SB(0, 0), cB, voffB); PG8_STAGE(PG8_SA(0, 0), cA, voffA); PG8_STAGE(PG8_SB(0, 1), cB + hstep, voffB); PG8_STAGE(PG8_SA(0, 1), cA + hstep, voffA);
    if (wr == 1) PG8_BAR;
    PG8_WAIT_V(4); PG8_BAR;
    PG8_STAGE(PG8_SB(1, 0), cB + kstep, voffB); PG8_STAGE(PG8_SA(1, 0), cA + kstep, voffA); PG8_STAGE(PG8_SB(1, 1), cB + hstep + kstep, voffB);
    PG8_WAIT_V(6); PG8_BAR;
    PG8_STAMP();
    for (;;) {
        const bool has_next = S.next(ui + 1, nxt);
        const char* nA = has_next ? (const char*)g.A + (size_t)nxt.pm * tstep : cA; const char* nB = has_next ? (const char*)g.Bt + (size_t)nxt.pn * tstep : cB;
        for (int t = 0; t < nt; t += 2) {
            const bool last = (t == nt - 2);
            const char* a1 = cA + (size_t)(t + 1) * kstep;
            const char* a2 = last ? nA : cA + (size_t)(t + 2) * kstep; const char* b2 = last ? nB : cB + (size_t)(t + 2) * kstep;
            const char* a3 = a2 + kstep; const char* b3 = b2 + kstep;
            if (last && has_next) S.a_ready(nxt);
            PG8_LDB(B0, 0, 0); PG8_SCHED; PG8_LDA(At, 0, 0); PG8_STAGE(PG8_SA(1, 1), a1 + hstep, voffA);
            PG8_WAIT_L(8); PG8_BAR; PG8_WAIT_L(0); PG8_MMA(0, 0, At, B0); PG8_BAR; PG8_SCHED;
            PG8_LDB(B1, 0, 1); PG8_STAGE(PG8_SB(0, 0), b2, voffB);
            PG8_BAR; PG8_WAIT_L(0); PG8_MMA(0, 1, At, B1); PG8_BAR;
            PG8_LDA(At, 0, 1); PG8_STAGE(PG8_SA(0, 0), a2, voffA);
            PG8_BAR; PG8_WAIT_L(0); PG8_MMA(1, 0, At, B0); PG8_BAR; PG8_SCHED;
            PG8_STAGE(PG8_SB(0, 1), b2 + hstep, voffB);
            PG8_WAIT_V(6); PG8_BAR; PG8_MMA(1, 1, At, B1); PG8_BAR;
            PG8_LDB(B0, 1, 0); PG8_SCHED; PG8_LDA(At, 1, 0); PG8_STAGE(PG8_SA(0, 1), a2 + hstep, voffA);
            PG8_WAIT_L(8); PG8_BAR; PG8_WAIT_L(0); PG8_MMA(0, 0, At, B0); PG8_BAR; PG8_SCHED;
            PG8_LDB(B1, 1, 1); PG8_STAGE(PG8_SB(1, 0), b3, voffB);
            PG8_BAR; PG8_WAIT_L(0); PG8_MMA(0, 1, At, B1); PG8_BAR;
            PG8_LDA(At, 1, 1); PG8_STAGE(PG8_SA(1, 0), a3, voffA);
            PG8_BAR; PG8_WAIT_L(0); PG8_MMA(1, 0, At, B0); PG8_BAR; PG8_SCHED;
            PG8_STAGE(PG8_SB(1, 1), b3 + hstep, voffB);
            PG8_WAIT_V(6); PG8_BAR; PG8_MMA(1, 1, At, B1); PG8_BAR;
        }
        PG8_STAMP();
        if constexpr (!Epi::AFTER_DRAIN) { E(acc, cur, wr, wc, fr, fq); S.done(cur); }
        PG8_STAMP();
        if (!has_next) break;
#pragma unroll
        for (int a = 0; a < 2; ++a)
#pragma unroll
            for (int b = 0; b < 2; ++b)
#pragma unroll
                for (int m = 0; m < 4; ++m)
#pragma unroll
                    for (int n = 0; n < 2; ++n) acc[a][b][m][n] = (f32x4){0.f, 0.f, 0.f, 0.f};
        cur = nxt; cA = nA; cB = nB; ++ui;
    }
    PG8_WAIT_V(0);
    if (wr == 0) PG8_BAR;
    PG8_BAR;
    if constexpr (Epi::AFTER_DRAIN) { E.fused(acc, cur, wr, wc, fr, fq, lds, wid, lane); S.done(cur); }
    PG8_STAMP();
    if (STAMP && wid == 0) { stamps[lane] = lane < nts ? (((unsigned long long)(unsigned)ts_hi << 32) | (unsigned)ts_lo) : 0ull;
        if (lane == 62) stamps[62] = rt_entry; if (lane == 63) stamps[63] = (unsigned long long)wall_clock64(); }
#undef PG8_STAMP
#undef PG8_SA
#undef PG8_SB
#undef PG8_STAGE
#undef PG8_LDA
#undef PG8_LDB
#undef PG8_MMA
#undef PG8_WAIT_V
#undef PG8_WAIT_L
#undef PG8_BAR
#undef PG8_SCHED
}
}
#define LAS __attribute__((address_space(3)))
typedef unsigned short bf16;
typedef short bf16x8 __attribute__((ext_vector_type(8)));
typedef short bf16x4 __attribute__((ext_vector_type(4)));
typedef float f32x4 __attribute__((ext_vector_type(4)));
typedef unsigned u32x4 __attribute__((ext_vector_type(4)));
typedef unsigned u32x2 __attribute__((ext_vector_type(2)));
typedef float f32x2_ __attribute__((ext_vector_type(2)));
typedef __bf16 bf16x2n __attribute__((ext_vector_type(2)));
__device__ __forceinline__ unsigned cvt_pk_bf16(float lo, float hi) { const f32x2_ v = {lo, hi}; const bf16x2n b = __builtin_convertvector(v, bf16x2n); return __builtin_bit_cast(unsigned, b); }

constexpr int T_TOK = 32768, SEQ = 8192, DM = 1024, NPROJ = 3840, PROJ_W = 3872;
constexpr float EPS = 1e-6f;
constexpr size_t MiB = 1u << 20;
constexpr size_t WS_CTL = 0;
constexpr size_t WS_WTIN = 1 * MiB;
constexpr size_t WS_WTOUT = 9 * MiB;
constexpr size_t WS_W1FK = 11 * MiB + 256 * 1024;
constexpr size_t WS_W1FV = 11 * MiB + 768 * 1024;
constexpr size_t WS_W2FK = 12 * MiB + 256 * 1024;
constexpr size_t WS_W2FV = 12 * MiB + 288 * 1024;
constexpr size_t WS_CPE = 12 * MiB + 320 * 1024;
constexpr size_t WS_BT = 12 * MiB + 384 * 1024;
constexpr size_t WS_RS = 13 * MiB;
constexpr size_t WS_SMALL = 14 * MiB;
constexpr size_t WS_XB = 32 * MiB;
constexpr size_t WS_MIX = 32 * MiB;
constexpr size_t WS_GQKV = 96 * MiB;
constexpr size_t WS_GZ = 192 * MiB;
constexpr size_t WS_NQ = 224 * MiB;
constexpr size_t WS_NKV = 256 * MiB;
constexpr size_t WS_NZ = 304 * MiB;
constexpr size_t WS_GREC = 336 * MiB;
constexpr size_t GREC_BYTES = 73728;
constexpr size_t WS_KCMP = 480 * MiB;
constexpr size_t WS_VCMPT = 480 * MiB + 512 * 1024;
constexpr size_t WS_VST = 482 * MiB;
constexpr size_t WS_VWT = 490 * MiB;
constexpr size_t WS_GLAST = 498 * MiB;
constexpr size_t WS_END = 499 * MiB;
constexpr int LDS_BYTES = 158720;

__device__ __forceinline__ float bf2f(unsigned short h) { return __uint_as_float((unsigned)h << 16); }
__device__ __forceinline__ unsigned short f2bf(float f) { return (unsigned short)(cvt_pk_bf16(f, 0.f) & 0xffffu); }
__device__ __forceinline__ float sigmoidf_(float v) { return 1.0f / (1.0f + __expf(-v)); }
__device__ __forceinline__ float siluf_(float v) { return v / (1.0f + __expf(-v)); }
__device__ __forceinline__ f32x4 mfma16(bf16x8 a, bf16x8 b, f32x4 c) { return __builtin_amdgcn_mfma_f32_16x16x32_bf16(a, b, c, 0, 0, 0); }
__device__ __forceinline__ int kperm(int g, int j) { return j < 4 ? 4 * g + j : 16 + 4 * g + (j - 4); }

struct Frame {
    const float* in[16]; float* out; unsigned char* ws; LAS unsigned char* lds; unsigned char* ldsg;
    int tid, lane, wave;
};

struct EpiProj {
    static constexpr bool PERM = true, AFTER_DRAIN = false;
    bf16* gqkv; bf16* gz; bf16* nq; bf16* nkv; bf16* nz; const float* rs;
    __device__ __forceinline__ void operator()(const f32x4 (&acc)[2][2][4][2], const pg8::Unit& u, int wr, int wc, int fr, int fq) const {
        const int pn = u.pn; bf16* base; int ldc, colt, act;
        if (pn < 6) { base = gqkv; ldc = 1536; colt = pn * 256; act = 0; }
        else if (pn < 8) { base = gz; ldc = 512; colt = (pn - 6) * 256; act = 1; }
        else if (pn < 10) { base = nq; ldc = 512; colt = (pn - 8) * 256; act = 2; }
        else if (pn < 13) { base = nkv; ldc = 768; colt = (pn - 10) * 256; act = 0; }
        else { base = nz; ldc = 512; colt = (pn - 13) * 256; act = 1; }
        const int row0 = u.pm * 256 + wr * 64 + fr, col0 = colt + wc * 32 + 8 * fq;
#pragma unroll
        for (int ai = 0; ai < 2; ++ai)
#pragma unroll
            for (int m = 0; m < 4; ++m) {
                const int row = row0 + ai * 128 + m * 16; const float r = rs[row];
                bf16* rowp = base + (size_t)row * ldc + col0;
#pragma unroll
                for (int bj = 0; bj < 2; ++bj) {
                    f32x4 v0 = acc[ai][bj][m][0] * r, v1 = acc[ai][bj][m][1] * r;
                    if (act == 1) {
#pragma unroll
                        for (int j = 0; j < 4; ++j) { v0[j] = siluf_(v0[j]); v1[j] = siluf_(v1[j]); }
                    } else if (act == 2) { v0 = v0 * 0.18033688011112042f; v1 = v1 * 0.18033688011112042f; }
                    u32x4 w; w.x = cvt_pk_bf16(v0[0], v0[1]); w.y = cvt_pk_bf16(v0[2], v0[3]); w.z = cvt_pk_bf16(v1[0], v1[1]); w.w = cvt_pk_bf16(v1[2], v1[3]);
                    *(u32x4*)(rowp + bj * 128) = w;
                }
            }
    }
};
struct EpiOut {
    static constexpr bool PERM = false, AFTER_DRAIN = false;
    const float* x; float* out;
    __device__ __forceinline__ void operator()(const f32x4 (&acc)[2][2][4][2], const pg8::Unit& u, int wr, int wc, int fr, int fq) const {
        const int row0 = u.pm * 256 + wr * 64 + fr, col0 = u.pn * 256 + wc * 32 + 4 * fq;
#pragma unroll
        for (int ai = 0; ai < 2; ++ai)
#pragma unroll
            for (int m = 0; m < 4; ++m) {
                const size_t ro = (size_t)(row0 + ai * 128 + m * 16) * DM + col0;
#pragma unroll
                for (int bj = 0; bj < 2; ++bj)
#pragma unroll
                    for (int n = 0; n < 2; ++n) {
                        const f32x4 xv = *(const f32x4*)(x + ro + bj * 128 + n * 16);
                        *(f32x4*)(out + ro + bj * 128 + n * 16) = acc[ai][bj][m][n] + xv;
                    }
            }
    }
};

__device__ __forceinline__ int orig_col(int n) {
    return n < 2048 ? n : (n < 2560 ? 2056 + (n - 2048) : (n < 3328 ? 2568 + (n - 2560) : 3360 + (n - 3328)));
}
__device__ __forceinline__ int orig_small(int sc) { return sc < 8 ? 2048 + sc : 3336 + (sc - 8); }
__device__ __forceinline__ int rel_bucket(int dist) {
    const int n = dist < 0 ? 0 : dist;
    if (n < 16) return n;
    int b = 16;
    b += (n >= 21); b += (n >= 27); b += (n >= 35); b += (n >= 46); b += (n >= 59); b += (n >= 77); b += (n >= 99); b += (n >= 128);
    b += (n >= 166); b += (n >= 216); b += (n >= 280); b += (n >= 363); b += (n >= 470); b += (n >= 609); b += (n >= 790);
    return b;
}
__device__ __forceinline__ void transpose_tile(const Frame& F, const float* src, int sld, int srccol0, int k0, const float* scale, bf16* dst, int dld, int n0) {
    LAS float* tile = (LAS float*)F.lds;
    const int kk = F.tid >> 6, nn = F.tid & 63;
#pragma unroll
    for (int i = 0; i < 8; ++i) { const int k = kk + 8 * i; float v = src[(size_t)(k0 + k) * sld + srccol0 + nn]; if (scale) v *= scale[k0 + k]; tile[k * 65 + nn] = v; }
    __syncthreads();
    const int n2 = F.tid >> 3, kc = F.tid & 7;
    float e[8];
#pragma unroll
    for (int j = 0; j < 8; ++j) e[j] = tile[(8 * kc + j) * 65 + n2];
    u32x4 w; w.x = cvt_pk_bf16(e[0], e[1]); w.y = cvt_pk_bf16(e[2], e[3]); w.z = cvt_pk_bf16(e[4], e[5]); w.w = cvt_pk_bf16(e[6], e[7]);
    *(u32x4*)(dst + (size_t)(n0 + n2) * dld + k0 + 8 * kc) = w;
    __syncthreads();
}

__device__ __forceinline__ void p0_prep(const Frame& F) {
    const float* x = F.in[0]; const float* nw = F.in[1]; const float* w_in = F.in[2];
    unsigned char* ws = F.ws;
    const int G = gridDim.x, bid = blockIdx.x;
    for (int task = bid; task < 1365; task += G) {
        if (task < 960) { const int nt = task / 16, kt = task % 16; transpose_tile(F, w_in, PROJ_W, orig_col(nt * 64), kt * 64, nw, (bf16*)(ws + WS_WTIN), DM, nt * 64); }
        else if (task < 1216) { const int t2 = task - 960, nt = t2 / 16, kt = t2 % 16; transpose_tile(F, F.in[13], DM, nt * 64, kt * 64, nullptr, (bf16*)(ws + WS_WTOUT), DM, nt * 64); }
        else if (task < 1344) {
            const int t2 = task - 1216, which = t2 >> 6, sub = t2 & 63;
            const float* w1 = F.in[which ? 11 : 9]; bf16* dst = (bf16*)(ws + (which ? WS_W1FV : WS_W1FK));
            const int mt = F.tid >> 6, l = F.tid & 63, m = l & 15, kg = l >> 4, ks = sub;
            float e[8];
#pragma unroll
            for (int j = 0; j < 8; ++j) e[j] = w1[(size_t)(32 * ks + 8 * kg + j) * 128 + 16 * mt + m];
            u32x4 w; w.x = cvt_pk_bf16(e[0], e[1]); w.y = cvt_pk_bf16(e[2], e[3]); w.z = cvt_pk_bf16(e[4], e[5]); w.w = cvt_pk_bf16(e[6], e[7]);
            *(u32x4*)(dst + ((size_t)(ks * 8 + mt) * 64 + l) * 8) = w;
        } else if (task < 1346) {
            const int which = task - 1344; const float* w2 = F.in[which ? 12 : 10]; bf16* dst = (bf16*)(ws + (which ? WS_W2FV : WS_W2FK));
            for (int i = F.tid; i < 1024; i += 512) {
                const int l = i & 63, ks = (i >> 6) & 3, mt = i >> 8, m = l & 15, kg = l >> 4;
                float e[8];
#pragma unroll
                for (int j = 0; j < 8; ++j) e[j] = w2[(size_t)(32 * ks + kperm(kg, j)) * 64 + 16 * mt + m];
                u32x4 w; w.x = cvt_pk_bf16(e[0], e[1]); w.y = cvt_pk_bf16(e[2], e[3]); w.z = cvt_pk_bf16(e[4], e[5]); w.w = cvt_pk_bf16(e[6], e[7]);
                *(u32x4*)(dst + (size_t)i * 8) = w;
            }
        } else if (task < 1348) {
            const int which = task - 1346; const float* pe = F.in[which ? 8 : 7]; const float* w1 = F.in[which ? 11 : 9];
            float* dst = (float*)(ws + WS_CPE) + which * 128;
            if (F.tid < 128) { float s = 0.f; for (int k = 0; k < 2048; ++k) s += pe[k] * w1[(size_t)k * 128 + F.tid]; dst[F.tid] = s; }
        } else {
            const int i = (task - 1348) * 512 + F.tid;
            if (i < 8 * 1025) { const int head = i / 1025, dist = i % 1025; ((float*)(ws + WS_BT))[i] = F.in[14][rel_bucket(dist) * 8 + head] * 1.4426950408889634f; }
        }
    }
    __syncthreads();
    {
        for (int i = F.tid; i < 32 * 2 * 64; i += 512) {
            const int l = i & 63, nt = (i >> 6) & 1, ks = i >> 7, kg = l >> 4, sc = 16 * nt + (l & 15), oc = orig_small(sc);
            float v[8], lo[8]; unsigned short hi[8];
#pragma unroll
            for (int j = 0; j < 8; ++j) { const int k = 32 * ks + 8 * kg + j; v[j] = w_in[(size_t)k * PROJ_W + oc] * nw[k]; hi[j] = f2bf(v[j]); lo[j] = v[j] - bf2f(hi[j]); }
            u32x4 wh, wl;
            wh.x = hi[0] | ((unsigned)hi[1] << 16); wh.y = hi[2] | ((unsigned)hi[3] << 16); wh.z = hi[4] | ((unsigned)hi[5] << 16); wh.w = hi[6] | ((unsigned)hi[7] << 16);
            wl.x = cvt_pk_bf16(lo[0], lo[1]); wl.y = cvt_pk_bf16(lo[2], lo[3]); wl.z = cvt_pk_bf16(lo[4], lo[5]); wl.w = cvt_pk_bf16(lo[6], lo[7]);
            *(LAS u32x4*)(F.lds + ((size_t)((ks * 2 + nt) * 2 + 0) * 64 + l) * 16) = wh;
            *(LAS u32x4*)(F.lds + ((size_t)((ks * 2 + nt) * 2 + 1) * 64 + l) * 16) = wl;
        }
    }
    __syncthreads();
    bf16* xb = (bf16*)(ws + WS_XB); float* rsv = (float*)(ws + WS_RS); float* small = (float*)(ws + WS_SMALL);
    const float* a_log = F.in[4]; const float* dt_bias = F.in[5];
    for (int tile = bid * 8 + F.wave; tile < T_TOK / 16; tile += G * 8) {
        const int l = F.lane, r = l & 15, kg = l >> 4; const int row = tile * 16 + r;
        const float* xr = x + (size_t)row * DM + 8 * kg;
        f32x4 acc0 = {0.f, 0.f, 0.f, 0.f}, acc1 = {0.f, 0.f, 0.f, 0.f};
        float ss = 0.f;
#pragma unroll 4
        for (int ks = 0; ks < 32; ++ks) {
            const f32x4 a0 = *(const f32x4*)(xr + 32 * ks), a1 = *(const f32x4*)(xr + 32 * ks + 4);
            ss += a0[0] * a0[0] + a0[1] * a0[1] + a0[2] * a0[2] + a0[3] * a0[3] + a1[0] * a1[0] + a1[1] * a1[1] + a1[2] * a1[2] + a1[3] * a1[3];
            u32x4 h; h.x = cvt_pk_bf16(a0[0], a0[1]); h.y = cvt_pk_bf16(a0[2], a0[3]); h.z = cvt_pk_bf16(a1[0], a1[1]); h.w = cvt_pk_bf16(a1[2], a1[3]);
            *(u32x4*)(xb + (size_t)row * DM + 32 * ks + 8 * kg) = h;
            u32x4 lo;
            lo.x = cvt_pk_bf16(a0[0] - __uint_as_float(h.x << 16), a0[1] - __uint_as_float(h.x & 0xffff0000u));
            lo.y = cvt_pk_bf16(a0[2] - __uint_as_float(h.y << 16), a0[3] - __uint_as_float(h.y & 0xffff0000u));
            lo.z = cvt_pk_bf16(a1[0] - __uint_as_float(h.z << 16), a1[1] - __uint_as_float(h.z & 0xffff0000u));
            lo.w = cvt_pk_bf16(a1[2] - __uint_as_float(h.w << 16), a1[3] - __uint_as_float(h.w & 0xffff0000u));
            const bf16x8 ah = __builtin_bit_cast(bf16x8, h), al = __builtin_bit_cast(bf16x8, lo);
            const LAS unsigned char* fb = F.lds + (size_t)(ks * 4) * 1024 + l * 16;
            const bf16x8 b0h = *(const LAS bf16x8*)(fb), b0l = *(const LAS bf16x8*)(fb + 1024), b1h = *(const LAS bf16x8*)(fb + 2048), b1l = *(const LAS bf16x8*)(fb + 3072);
            acc0 = mfma16(ah, b0h, acc0); acc0 = mfma16(al, b0h, acc0); acc0 = mfma16(ah, b0l, acc0);
            acc1 = mfma16(ah, b1h, acc1); acc1 = mfma16(al, b1h, acc1); acc1 = mfma16(ah, b1l, acc1);
        }
        ss += __shfl_xor(ss, 16); ss += __shfl_xor(ss, 32);
        const float rs = rsqrtf(ss * (1.0f / 1024.f) + EPS);
        if (kg == 0) rsv[row] = rs;
#pragma unroll
        for (int reg = 0; reg < 4; ++reg) {
            const int rr = 4 * kg + reg; const float rsr = __shfl(rs, rr);
            const int orow = tile * 16 + rr;
            {
                const float v = acc0[reg] * rsr; const int c = r; float o;
                if (c < 4) o = sigmoidf_(v);
                else if (c < 8) { const int h = c - 4; const float z = v + dt_bias[h]; const float sp = z > 20.f ? z : log1pf(expf(z)); o = -expf(a_log[h]) * sp; }
                else o = sigmoidf_(v);
                small[(size_t)orow * 32 + c] = o;
            }
            { const float v = acc1[reg] * rsr; small[(size_t)orow * 32 + 16 + r] = sigmoidf_(v); }
        }
    }
}

__device__ __forceinline__ void p5_final(const Frame& F) {
    const float* fw = F.in[15]; float* out = F.out;
    for (int r = blockIdx.x * 8 + F.wave; r < T_TOK; r += gridDim.x * 8) {
        f32x4* orow = (f32x4*)(out + (size_t)r * DM);
        f32x4 v[4]; float ss = 0.f;
#pragma unroll
        for (int i = 0; i < 4; ++i) { v[i] = orow[F.lane + 64 * i]; ss += v[i][0] * v[i][0] + v[i][1] * v[i][1] + v[i][2] * v[i][2] + v[i][3] * v[i][3]; }
#pragma unroll
        for (int o = 32; o > 0; o >>= 1) ss += __shfl_xor(ss, o);
        const float rs = rsqrtf(ss * (1.0f / 1024.f) + EPS);
#pragma unroll
        for (int i = 0; i < 4; ++i) { const f32x4 w = ((const f32x4*)fw)[F.lane + 64 * i]; orow[F.lane + 64 * i] = v[i] * rs * w; }
    }
}
#ifndef G_CONV
#define G_CONV 0
#endif
#ifndef G_MFMA
#define G_MFMA 0
#endif
#ifndef G_FRAG
#define G_FRAG 0
#endif
#ifndef G_OUT
#define G_OUT 0
#endif
__device__ __forceinline__ float dppf(float x, int ctrl_unused) { return x; }
#define DPP_F(x, CTRL, RM) __builtin_bit_cast(float, __builtin_amdgcn_update_dpp(0, __builtin_bit_cast(int, (x)), CTRL, RM, 0xf, true))
__device__ __forceinline__ float row16_sum(float x) {
    x += DPP_F(x, 0xB1, 0xf); x += DPP_F(x, 0x4E, 0xf); x += DPP_F(x, 0x141, 0xf); x += DPP_F(x, 0x140, 0xf); return x;
}
__device__ __forceinline__ float wave_prefix_sum(float v) {
    v += DPP_F(v, 0x111, 0xf); v += DPP_F(v, 0x112, 0xf); v += DPP_F(v, 0x114, 0xf); v += DPP_F(v, 0x118, 0xf);
    v += DPP_F(v, 0x142, 0xa); v += DPP_F(v, 0x143, 0xc); return v;
}
constexpr int GL_CW = 148224;
constexpr int REC_WNEG = 0, REC_QDEC = 16384, REC_ATTN = 32768, REC_KDT = 40960, REC_U = 57344, REC_LDS_BYTES = 57344;
__device__ __forceinline__ void gdn_prep_item(const Frame& F, int item) {
    int tid_ = F.tid; asm volatile("" : "+v"(tid_));
    const int tid = tid_;
    const int h = item & 3, n = (item >> 2) & 127, b = item >> 9;
    const int tok0 = b * SEQ + n * 64;
    LAS float* kf = (LAS float*)(F.lds); LAS float* vf = (LAS float*)(F.lds + 32768);
    LAS bf16* qb = (LAS bf16*)(F.lds + 65536); LAS bf16* kb = (LAS bf16*)(F.lds + 82944); LAS bf16* kbb = (LAS bf16*)(F.lds + 100352);
    LAS float* Lm = (LAS float*)(F.lds + 117760); LAS bf16* atb = (LAS bf16*)(F.lds + 134144); LAS float* gcs = (LAS float*)(F.lds + 143360);
    LAS float* tinv = (LAS float*)(F.lds + 144128);
    unsigned char* rec = F.ws + WS_GREC + (size_t)item * GREC_BYTES;
    const float* small = (const float*)(F.ws + WS_SMALL);
    {
        const int ln = tid & 63;
        const float beta = small[(size_t)(tok0 + ln) * 32 + h]; float c = small[(size_t)(tok0 + ln) * 32 + 4 + h];
        c = wave_prefix_sum(c);
        gcs[ln] = c; gcs[64 + ln] = beta; gcs[128 + ln] = expf(c);
        if (tid == 63) ((float*)(F.ws + WS_GLAST))[item] = expf(c);
    }
    for (int d1 = 0; d1 <= G_CONV; ++d1)
    {
        const bf16* gq = (const bf16*)(F.ws + WS_GQKV); const float* cw = F.in[3];
        const int grp = tid >> 4, li = tid & 15;
#pragma unroll
        for (int rr = 0; rr < 2; ++rr) {
            const int c = grp * 2 + rr, pos = n * 64 + c;
            const float betav = gcs[64 + c], egv = gcs[128 + c];
#pragma unroll
            for (int part = 0; part < 3; ++part) {
                const int ch = part * 512 + h * 128 + 8 * li;
                float y[8];
#pragma unroll
                for (int e = 0; e < 8; ++e) y[e] = 0.f;
#pragma unroll
                for (int j = 0; j < 4; ++j) {
                    const int p = pos - 3 + j;
                    if (p >= 0) {
                        const u32x4 xv = *(const u32x4*)(gq + (size_t)(b * SEQ + p) * 1536 + ch);
                        const LAS float* cwl = (const LAS float*)(F.lds + GL_CW) + (j * 3 + part) * 128 + 8 * li;
                        const f32x4 w0 = *(const LAS f32x4*)cwl, w1 = *(const LAS f32x4*)(cwl + 4);
                        y[0] += w0[0] * __uint_as_float(xv.x << 16); y[1] += w0[1] * __uint_as_float(xv.x & 0xffff0000u);
                        y[2] += w0[2] * __uint_as_float(xv.y << 16); y[3] += w0[3] * __uint_as_float(xv.y & 0xffff0000u);
                        y[4] += w1[0] * __uint_as_float(xv.z << 16); y[5] += w1[1] * __uint_as_float(xv.z & 0xffff0000u);
                        y[6] += w1[2] * __uint_as_float(xv.w << 16); y[7] += w1[3] * __uint_as_float(xv.w & 0xffff0000u);
                    }
                }
                float ss = 0.f;
#pragma unroll
                for (int e = 0; e < 8; ++e) { y[e] = siluf_(y[e]); ss += y[e] * y[e]; }
                if (part < 2) {
                    ss = row16_sum(ss);
                    const float sc = rsqrtf(ss + EPS) * (part == 0 ? 0.08838834764831845f : 1.0f);
#pragma unroll
                    for (int e = 0; e < 8; ++e) y[e] *= sc;
                }
                if (part == 0) {
                    u32x4 w; w.x = cvt_pk_bf16(y[0], y[1]); w.y = cvt_pk_bf16(y[2], y[3]); w.z = cvt_pk_bf16(y[4], y[5]); w.w = cvt_pk_bf16(y[6], y[7]);
                    *(LAS u32x4*)(qb + c * 136 + 8 * li) = w;
                    const int mt = c >> 4, m = c & 15, ks = li >> 2, a = (li & 3) >> 1, g0 = (2 * (li & 3)) & 3, g1 = (2 * (li & 3) + 1) & 3;
                    u32x2 d0, d1; d0.x = cvt_pk_bf16(y[0] * egv, y[1] * egv); d0.y = cvt_pk_bf16(y[2] * egv, y[3] * egv); d1.x = cvt_pk_bf16(y[4] * egv, y[5] * egv); d1.y = cvt_pk_bf16(y[6] * egv, y[7] * egv);
                    unsigned char* fb = rec + REC_QDEC + (size_t)(mt * 4 + ks) * 1024 + a * 8;
                    *(u32x2*)(fb + (g0 * 16 + m) * 16) = d0; *(u32x2*)(fb + (g1 * 16 + m) * 16) = d1;
                } else if (part == 1) {
                    *(LAS f32x4*)(kf + c * 128 + 8 * li) = (f32x4){y[0], y[1], y[2], y[3]}; *(LAS f32x4*)(kf + c * 128 + 8 * li + 4) = (f32x4){y[4], y[5], y[6], y[7]};
                    u32x4 w; w.x = cvt_pk_bf16(y[0], y[1]); w.y = cvt_pk_bf16(y[2], y[3]); w.z = cvt_pk_bf16(y[4], y[5]); w.w = cvt_pk_bf16(y[6], y[7]);
                    *(LAS u32x4*)(kb + c * 136 + 8 * li) = w;
                    w.x = cvt_pk_bf16(y[0] * betav, y[1] * betav); w.y = cvt_pk_bf16(y[2] * betav, y[3] * betav); w.z = cvt_pk_bf16(y[4] * betav, y[5] * betav); w.w = cvt_pk_bf16(y[6] * betav, y[7] * betav);
                    *(LAS u32x4*)(kbb + c * 136 + 8 * li) = w;
                } else {
                    *(LAS f32x4*)(vf + c * 128 + 8 * li) = (f32x4){y[0], y[1], y[2], y[3]}; *(LAS f32x4*)(vf + c * 128 + 8 * li + 4) = (f32x4){y[4], y[5], y[6], y[7]};
                }
            }
        }
    }
    __syncthreads();
    for (int d2 = 0; d2 <= G_MFMA; ++d2)
    {
        const int l = (tid & 63), m = l & 15, kg = l >> 4;
#pragma unroll
        for (int i = 0; i < 4; ++i) {
            const int tt = F.wave * 4 + i, which = tt >> 4, mi = (tt >> 2) & 3, ni = tt & 3;
            f32x4 acc = {0.f, 0.f, 0.f, 0.f};
            if (mi >= ni) {
                const LAS bf16* As = which ? qb : kbb;
#pragma unroll
                for (int ks = 0; ks < 4; ++ks) {
                    const bf16x8 a = *(const LAS bf16x8*)(As + (16 * mi + m) * 136 + 32 * ks + 8 * kg);
                    const bf16x8 bb = *(const LAS bf16x8*)(kb + (16 * ni + m) * 136 + 32 * ks + 8 * kg);
                    acc = mfma16(a, bb, acc);
                }
            }
#pragma unroll
            for (int r = 0; r < 4; ++r) {
                const int irow = 16 * mi + 4 * kg + r, jcol = 16 * ni + m;
                const float dec = (irow >= jcol) ? expf(gcs[irow] - gcs[jcol]) : 0.f;
                if (which == 0) Lm[jcol * 64 + irow] = (irow > jcol) ? acc[r] * dec : 0.f;
                else atb[irow * 72 + jcol] = f2bf((irow >= jcol) ? acc[r] * dec : 0.f);
            }
        }
    }
    __syncthreads();
    for (int d3 = 0; d3 <= G_FRAG; ++d3) {
    if (tid < 64) {
        const int ib = tid >> 4, c = tid & 15;
        float x[16];
#pragma unroll
        for (int i = 0; i < 16; ++i) x[i] = (i == c) ? 1.0f : 0.0f;
#pragma unroll
        for (int j = 0; j < 15; ++j) {
            const LAS f32x4* lp = (const LAS f32x4*)(Lm + (16 * ib + j) * 64 + 16 * ib);
#pragma unroll
            for (int q4 = 0; q4 < 4; ++q4) {
                if (4 * q4 + 3 > j) {
                    const f32x4 lv = lp[q4];
#pragma unroll
                    for (int e = 0; e < 4; ++e) if (4 * q4 + e > j) x[4 * q4 + e] -= lv[e] * x[j];
                }
            }
            asm volatile("" ::: "memory");
        }
#pragma unroll
        for (int i = 0; i < 16; ++i) tinv[(ib * 16 + c) * 16 + i] = x[i];
    }
    {
        const float gl = gcs[63];
#pragma unroll
        for (int q = 0; q < 2; ++q) {
            const int idx = tid + 512 * q, l = idx & 63, ks = (idx >> 6) & 1, mt = idx >> 7, m = l & 15, g = l >> 4;
            float e[8];
#pragma unroll
            for (int j = 0; j < 8; ++j) { const int cr = 32 * ks + kperm(g, j); e[j] = kf[cr * 128 + 16 * mt + m] * expf(gl - gcs[cr]); }
            u32x4 w; w.x = cvt_pk_bf16(e[0], e[1]); w.y = cvt_pk_bf16(e[2], e[3]); w.z = cvt_pk_bf16(e[4], e[5]); w.w = cvt_pk_bf16(e[6], e[7]);
            *(u32x4*)(rec + REC_KDT + (size_t)idx * 16) = w;
        }
        {
            const int idx = tid, l = idx & 63, ks = (idx >> 6) & 1, mt = idx >> 7, m = l & 15, g = l >> 4;
            const u32x2 a0 = *(const LAS u32x2*)(atb + (16 * mt + m) * 72 + 32 * ks + 4 * g), a1 = *(const LAS u32x2*)(atb + (16 * mt + m) * 72 + 32 * ks + 16 + 4 * g);
            *(u32x4*)(rec + REC_ATTN + (size_t)idx * 16) = (u32x4){a0.x, a0.y, a1.x, a1.y};
        }
    }
    }
    __syncthreads();
    {
        const int l = (tid & 63), li = l & 15, lk = l >> 4, w = F.wave; const bool isw = w >= 4;
        LAS float* base = isw ? (kf + 32 * (w - 4)) : (vf + 32 * w);
#pragma unroll
        for (int ib = 0; ib < 4; ++ib) {
            f32x4 acc[2];
#pragma unroll
            for (int nt = 0; nt < 2; ++nt)
#pragma unroll
                for (int r = 0; r < 4; ++r) { const int i = 16 * ib + 4 * lk + r; acc[nt][r] = base[i * 128 + 16 * nt + li] * gcs[64 + i] * (isw ? gcs[128 + i] : 1.0f); }
#pragma unroll
            for (int kk = 0; kk < 4 * ib; ++kk) {
                const float av = -Lm[(4 * kk + lk) * 64 + 16 * ib + li];
                acc[0] = __builtin_amdgcn_mfma_f32_16x16x4f32(av, base[(4 * kk + lk) * 128 + li], acc[0], 0, 0, 0);
                acc[1] = __builtin_amdgcn_mfma_f32_16x16x4f32(av, base[(4 * kk + lk) * 128 + 16 + li], acc[1], 0, 0, 0);
            }
#pragma unroll
            for (int nt = 0; nt < 2; ++nt)
#pragma unroll
                for (int r = 0; r < 4; ++r) base[(16 * ib + 4 * lk + r) * 128 + 16 * nt + li] = acc[nt][r];
            f32x4 y[2] = {(f32x4){0.f, 0.f, 0.f, 0.f}, (f32x4){0.f, 0.f, 0.f, 0.f}};
#pragma unroll
            for (int kk = 0; kk < 4; ++kk) {
                const float av = tinv[(ib * 16 + 4 * kk + lk) * 16 + li];
                y[0] = __builtin_amdgcn_mfma_f32_16x16x4f32(av, base[(16 * ib + 4 * kk + lk) * 128 + li], y[0], 0, 0, 0);
                y[1] = __builtin_amdgcn_mfma_f32_16x16x4f32(av, base[(16 * ib + 4 * kk + lk) * 128 + 16 + li], y[1], 0, 0, 0);
            }
#pragma unroll
            for (int nt = 0; nt < 2; ++nt)
#pragma unroll
                for (int r = 0; r < 4; ++r) base[(16 * ib + 4 * lk + r) * 128 + 16 * nt + li] = y[nt][r];
        }
    }
    __syncthreads();
    for (int d4 = 0; d4 <= G_OUT; ++d4)
    {
#pragma unroll
        for (int q = 0; q < 4; ++q) {
            const int idx = tid + 512 * q, l = idx & 63, mt = (idx >> 6) & 3, sl = idx >> 8, g4 = l >> 4, nn = l & 15;
            const LAS float* up = vf + (16 * mt + 4 * g4) * 128 + 16 * sl + nn;
            u32x2 d; d.x = cvt_pk_bf16(up[0], up[128]); d.y = cvt_pk_bf16(up[256], up[384]);
            *(u32x2*)(rec + REC_U + (size_t)idx * 8) = d;
        }
#pragma unroll
        for (int q = 0; q < 2; ++q) {
            const int idx = tid + 512 * q, l = idx & 63, ks = (idx >> 6) & 3, mt = idx >> 8, m = l & 15, g = l >> 4;
            const f32x4 a0 = *(const LAS f32x4*)(kf + (16 * mt + m) * 128 + 32 * ks + 4 * g), a1 = *(const LAS f32x4*)(kf + (16 * mt + m) * 128 + 32 * ks + 16 + 4 * g);
            u32x4 w; w.x = cvt_pk_bf16(-a0[0], -a0[1]); w.y = cvt_pk_bf16(-a0[2], -a0[3]); w.z = cvt_pk_bf16(-a1[0], -a1[1]); w.w = cvt_pk_bf16(-a1[2], -a1[3]);
            *(u32x4*)(rec + REC_WNEG + (size_t)idx * 16) = w;
        }
    }
    __syncthreads();
}

__device__ __forceinline__ bf16x8 acc2frag(const f32x4& lo, const f32x4& hi) {
    u32x4 w; w.x = cvt_pk_bf16(lo[0], lo[1]); w.y = cvt_pk_bf16(lo[2], lo[3]); w.z = cvt_pk_bf16(hi[0], hi[1]); w.w = cvt_pk_bf16(hi[2], hi[3]);
    return __builtin_bit_cast(bf16x8, w);
}
__device__ __forceinline__ void gdn_scan(const Frame& F, int bh) {
    const int tid = F.tid, lane = F.lane, s = F.wave;
    const int b = bh >> 2, h = bh & 3;
    LAS unsigned char* buf0 = F.lds; LAS float* ox = (LAS float*)(F.lds + 2 * REC_LDS_BYTES);
    const float* glast = (const float*)(F.ws + WS_GLAST);
    const bf16* gz = (const bf16*)(F.ws + WS_GZ); const float* gnw = F.in[6]; bf16* mix = (bf16*)(F.ws + WS_MIX);
    f32x4 S[8];
#pragma unroll
    for (int t = 0; t < 8; ++t) S[t] = (f32x4){0.f, 0.f, 0.f, 0.f};
    const unsigned char* const recbase = F.ws + WS_GREC + (size_t)(b * 512 + h) * GREC_BYTES;
#define recp(n) (recbase + (size_t)(n) * 4 * GREC_BYTES)
#define GS_STAGE(n, bufsel) do { const unsigned char* _r = recp(n); _Pragma("unroll") for (int _i = 0; _i < 7; ++_i) \
        __builtin_amdgcn_global_load_lds((const unsigned*)(_r + (size_t)(_i * 512 + tid) * 16), (LAS unsigned*)(buf0 + (bufsel) * REC_LDS_BYTES + (_i * 8 + s) * 1024), 16, 0, 0); } while (0)
    GS_STAGE(0, 0);
    u32x2 un[4];
#pragma unroll
    for (int mt = 0; mt < 4; ++mt) un[mt] = *(const u32x2*)(recp(0) + REC_U + (size_t)((s * 4 + mt) * 64 + lane) * 8);
    float egn = glast[(b * 128 + 0) * 4 + h];
    for (int n = 0; n < 128; ++n) {
        const int cur = n & 1;
        asm volatile("s_waitcnt vmcnt(0)" ::: "memory");
        __syncthreads();
        u32x2 uc[4];
#pragma unroll
        for (int mt = 0; mt < 4; ++mt) uc[mt] = un[mt];
        const float egl = egn;
        if (n + 1 < 128) {
            GS_STAGE(n + 1, cur ^ 1);
#pragma unroll
            for (int mt = 0; mt < 4; ++mt) un[mt] = *(const u32x2*)(recp(n + 1) + REC_U + (size_t)((s * 4 + mt) * 64 + lane) * 8);
            egn = glast[(b * 128 + n + 1) * 4 + h];
        }
        const LAS unsigned char* bp = buf0 + cur * REC_LDS_BYTES + lane * 16;
        bf16x8 Sb[4];
#pragma unroll
        for (int ks = 0; ks < 4; ++ks) Sb[ks] = acc2frag(S[2 * ks], S[2 * ks + 1]);
        f32x4 vn[4], o[4];
#pragma unroll
        for (int mt = 0; mt < 4; ++mt) {
            vn[mt] = (f32x4){__uint_as_float(uc[mt].x << 16), __uint_as_float(uc[mt].x & 0xffff0000u), __uint_as_float(uc[mt].y << 16), __uint_as_float(uc[mt].y & 0xffff0000u)};
#pragma unroll
            for (int ks = 0; ks < 4; ++ks) vn[mt] = mfma16(*(const LAS bf16x8*)(bp + REC_WNEG + (mt * 4 + ks) * 1024), Sb[ks], vn[mt]);
        }
        bf16x8 Vb[2];
#pragma unroll
        for (int ks = 0; ks < 2; ++ks) Vb[ks] = acc2frag(vn[2 * ks], vn[2 * ks + 1]);
#pragma unroll
        for (int mt = 0; mt < 4; ++mt) {
            o[mt] = (f32x4){0.f, 0.f, 0.f, 0.f};
#pragma unroll
            for (int ks = 0; ks < 4; ++ks) o[mt] = mfma16(*(const LAS bf16x8*)(bp + REC_QDEC + (mt * 4 + ks) * 1024), Sb[ks], o[mt]);
#pragma unroll
            for (int ks = 0; ks < 2; ++ks) o[mt] = mfma16(*(const LAS bf16x8*)(bp + REC_ATTN + (mt * 2 + ks) * 1024), Vb[ks], o[mt]);
        }
#pragma unroll
        for (int t = 0; t < 8; ++t) {
            S[t] = S[t] * egl;
#pragma unroll
            for (int ks = 0; ks < 2; ++ks) S[t] = mfma16(*(const LAS bf16x8*)(bp + REC_KDT + (t * 2 + ks) * 1024), Vb[ks], S[t]);
        }
        {
            const int g4 = lane >> 4, nn = lane & 15;
#pragma unroll
            for (int mt = 0; mt < 4; ++mt)
#pragma unroll
                for (int r = 0; r < 4; ++r) ox[(16 * mt + 4 * g4 + r) * 132 + 16 * s + nn] = o[mt][r];
        }
        __syncthreads();
        {
            const int row = tid >> 3, part = tid & 7; const int tok = b * SEQ + n * 64 + row;
            float v[16]; float ss = 0.f;
#pragma unroll
            for (int q = 0; q < 4; ++q) { const f32x4 t4 = *(const LAS f32x4*)(ox + row * 132 + 16 * part + 4 * q); v[4 * q] = t4[0]; v[4 * q + 1] = t4[1]; v[4 * q + 2] = t4[2]; v[4 * q + 3] = t4[3]; }
#pragma unroll
            for (int e = 0; e < 16; ++e) ss += v[e] * v[e];
            ss += __shfl_xor(ss, 1); ss += __shfl_xor(ss, 2); ss += __shfl_xor(ss, 4);
            const float rs = rsqrtf(ss * (1.0f / 128.f) + EPS);
            const u32x4 z0 = *(const u32x4*)(gz + (size_t)tok * 512 + h * 128 + 16 * part), z1 = *(const u32x4*)(gz + (size_t)tok * 512 + h * 128 + 16 * part + 8);
            const unsigned zz[8] = {z0.x, z0.y, z0.z, z0.w, z1.x, z1.y, z1.z, z1.w};
            unsigned ow[8];
#pragma unroll
            for (int e = 0; e < 8; ++e) {
                const float w0 = gnw[16 * part + 2 * e], w1 = gnw[16 * part + 2 * e + 1];
                ow[e] = cvt_pk_bf16(v[2 * e] * rs * w0 * __uint_as_float(zz[e] << 16), v[2 * e + 1] * rs * w1 * __uint_as_float(zz[e] & 0xffff0000u));
            }
            bf16* mp = mix + (size_t)tok * DM + h * 128 + 16 * part;
            *(u32x4*)mp = (u32x4){ow[0], ow[1], ow[2], ow[3]}; *(u32x4*)(mp + 8) = (u32x4){ow[4], ow[5], ow[6], ow[7]};
        }
    }
#undef GS_STAGE
#undef recp
    asm volatile("s_waitcnt vmcnt(0)" ::: "memory");
    __syncthreads();
}
__device__ __forceinline__ int pos32(int key) { return (key & ~31) | (8 * ((key >> 2) & 3) + 4 * ((key >> 4) & 1) + (key & 3)); }
__device__ __forceinline__ void compress_block(const Frame& F, int task) {
    const int which = task >> 8, bhk = (task >> 5) & 7, rt = task & 31, b = bhk >> 1, hk = bhk & 1;
    int l_ = F.lane; asm volatile("" : "+v"(l_));
    const int l = l_, n = l & 15, kg = l >> 4, w = F.wave;
    const bf16* nkv = (const bf16*)(F.ws + WS_NKV);
    const bf16* w1f = (const bf16*)(F.ws + (which ? WS_W1FV : WS_W1FK)); const bf16* w2f = (const bf16*)(F.ws + (which ? WS_W2FV : WS_W2FK));
    const float* cpe = (const float*)(F.ws + WS_CPE) + which * 128;
    const int nc = 16 * rt + n;
    f32x4 acc[8];
#pragma unroll
    for (int t = 0; t < 8; ++t) acc[t] = (f32x4){0.f, 0.f, 0.f, 0.f};
#pragma unroll 4
    for (int k8 = 0; k8 < 8; ++k8) {
        const int ks = 8 * w + k8;
        int tok = 16 * nc + (ks >> 1); tok = tok < SEQ ? tok : SEQ - 1;
        const bf16x8 bfrag = *(const bf16x8*)(nkv + (size_t)(b * SEQ + tok) * 768 + which * 128 + hk * 64 + (ks & 1) * 32 + 8 * kg);
#pragma unroll
        for (int mt = 0; mt < 8; ++mt) acc[mt] = mfma16(*(const bf16x8*)(w1f + ((size_t)(ks * 8 + mt) * 64 + l) * 8), bfrag, acc[mt]);
    }
    LAS f32x4* part = (LAS f32x4*)F.lds;
    LAS unsigned char* hfrag = F.lds + 65536;
#pragma unroll
    for (int mt = 0; mt < 8; ++mt) part[(w * 8 + mt) * 64 + l] = acc[mt];
    __syncthreads();
    {
        f32x4 h = part[w * 64 + l];
#pragma unroll
        for (int p = 1; p < 8; ++p) h = h + part[(p * 8 + w) * 64 + l];
#pragma unroll
        for (int r = 0; r < 4; ++r) h[r] = siluf_(h[r] + cpe[16 * w + 4 * kg + r]);
        u32x2 d; d.x = cvt_pk_bf16(h[0], h[1]); d.y = cvt_pk_bf16(h[2], h[3]);
        *(LAS u32x2*)(hfrag + ((w >> 1) * 64 + l) * 16 + (w & 1) * 8) = d;
    }
    __syncthreads();
    if (w < 4) {
        f32x4 o = {0.f, 0.f, 0.f, 0.f};
#pragma unroll
        for (int ks = 0; ks < 4; ++ks) o = mfma16(*(const bf16x8*)(w2f + ((size_t)(w * 4 + ks) * 64 + l) * 8), *(const LAS bf16x8*)(hfrag + (ks * 64 + l) * 16), o);
        const bool valid = nc < 511;
        if (which == 0) {
            bf16* kc = (bf16*)(F.ws + WS_KCMP) + ((size_t)bhk * 512 + nc) * 64;
            u32x2 d; d.x = valid ? cvt_pk_bf16(o[0], o[1]) : 0u; d.y = valid ? cvt_pk_bf16(o[2], o[3]) : 0u; *(u32x2*)(kc + 16 * w + 4 * kg) = d;
        } else {
            bf16* vt = (bf16*)(F.ws + WS_VCMPT) + (size_t)bhk * 64 * 512 + pos32(nc);
#pragma unroll
            for (int r = 0; r < 4; ++r) vt[(size_t)(16 * w + 4 * kg + r) * 512] = valid ? f2bf(o[r]) : (unsigned short)0;
        }
    }
    __syncthreads();
}
__device__ __forceinline__ void vtranspose_task(const Frame& F, int task) {
    const int which = task >> 8, bhk = (task >> 5) & 7, tg = task & 31, b = bhk >> 1, hk = bhk & 1;
    const bf16* nkv = (const bf16*)(F.ws + WS_NKV); bf16* dst = (bf16*)(F.ws + (which ? WS_VWT : WS_VST)) + (size_t)bhk * 64 * SEQ;
    LAS bf16* tile = (LAS bf16*)F.lds;
    const int t0 = tg * 256;
#pragma unroll
    for (int sub = 0; sub < 4; ++sub) {
        const int tk = sub * 64 + (F.tid >> 3), dc = F.tid & 7;
        const u32x4 v = *(const u32x4*)(nkv + (size_t)(b * SEQ + t0 + tk) * 768 + 384 + which * 256 + hk * 64 + 8 * dc);
        const unsigned vv[4] = {v.x, v.y, v.z, v.w};
#pragma unroll
        for (int e = 0; e < 4; ++e) { tile[(8 * dc + 2 * e) * 264 + pos32(tk)] = (unsigned short)(vv[e] & 0xffffu); tile[(8 * dc + 2 * e + 1) * 264 + pos32(tk)] = (unsigned short)(vv[e] >> 16); }
    }
    __syncthreads();
#pragma unroll
    for (int sub = 0; sub < 4; ++sub) {
        const int i = sub * 512 + F.tid, d = i >> 5, tc = i & 31;
        *(u32x4*)(dst + (size_t)d * SEQ + t0 + 8 * tc) = *(const LAS u32x4*)(tile + d * 264 + 8 * tc);
    }
    __syncthreads();
}
constexpr int NL_BT = 0, NL_IMP = 18496, NL_MASK = 51776, NL_SMASK = 52800, NL_KV = 53248, NL_NXT = 86016, NL_TOT = 86528;
#ifndef PRB_X1
#define PRB_X1 0
#endif
#ifndef PRB_C2
#define PRB_C2 0
#endif
#ifndef PRB_SETUP
#define PRB_SETUP 0
#endif
#ifndef PRB_S
#define PRB_S 0
#endif
#ifndef PRB_W
#define PRB_W 0
#endif
#ifndef PRB_C
#define PRB_C 0
#endif
constexpr int TM_C1 = 0, TM_C2 = 1, TM_SD = 2, TM_SS = 3, TM_W = 4;
#ifndef PRB_DMA
#define PRB_DMA 0
#endif
__device__ __forceinline__ void stage_dma(LAS unsigned char* buf, const bf16* Kb, int kstride, const bf16* VT, int vlen, int key0, int wave, int lane) {
    const int row = wave * 8 + (lane >> 3), ch = (lane & 7) ^ ((lane >> 3) & 7);
#if PRB_DMA
    __builtin_amdgcn_global_load_lds((const unsigned*)(Kb + (size_t)(key0 + row) * kstride + 8 * ch), (LAS unsigned*)(buf + wave * 1024), 16, 0, 0);
    __builtin_amdgcn_global_load_lds((const unsigned*)(VT + (size_t)row * vlen + key0 + 8 * ch), (LAS unsigned*)(buf + 8192 + wave * 1024), 16, 0, 0);
#endif
    __builtin_amdgcn_global_load_lds((const unsigned*)(Kb + (size_t)(key0 + row) * kstride + 8 * ch), (LAS unsigned*)(buf + wave * 1024), 16, 0, 0);
    __builtin_amdgcn_global_load_lds((const unsigned*)(VT + (size_t)row * vlen + key0 + 8 * ch), (LAS unsigned*)(buf + 8192 + wave * 1024), 16, 0, 0);
}
__device__ __forceinline__ void wait_tiles(int newer) {
#if PRB_DMA
    if (newer >= 2) asm volatile("s_waitcnt vmcnt(8)" ::: "memory"); else if (newer == 1) asm volatile("s_waitcnt vmcnt(4)" ::: "memory"); else asm volatile("s_waitcnt vmcnt(0)" ::: "memory");
#else
    if (newer >= 2) asm volatile("s_waitcnt vmcnt(4)" ::: "memory"); else if (newer == 1) asm volatile("s_waitcnt vmcnt(2)" ::: "memory"); else asm volatile("s_waitcnt vmcnt(0)" ::: "memory");
#endif
}
__device__ __forceinline__ bf16x8 tile_frag(const LAS unsigned char* buf, int row, int chunk) { return *(const LAS bf16x8*)(buf + row * 128 + ((chunk ^ (row & 7)) << 4)); }

struct SlotState { f32x4 O[4]; float m, l; };
__device__ __forceinline__ void lds_add_f32(LAS float* p, float v) { asm volatile("ds_add_f32 %0, %1" :: "v"((unsigned)(size_t)p), "v"(v) : "memory"); }
__device__ __forceinline__ float quad_sum(float x) {
    x += __builtin_bit_cast(float, __builtin_amdgcn_update_dpp(0, __builtin_bit_cast(int, x), 0xB1, 0xf, 0xf, false));
    x += __builtin_bit_cast(float, __builtin_amdgcn_update_dpp(0, __builtin_bit_cast(int, x), 0x4E, 0xf, 0xf, false));
    return x;
}
constexpr int RT_LEN = 1156, RT_OFF = 1088;
template <int MODE, bool NEARB>
__device__ __forceinline__ void slot_tile(const LAS unsigned char* tb0, const LAS unsigned char* tb1, const bf16x8 (&q)[2], int dbase, const LAS float* rt, SlotState& A,
                                          float linv, float mrow, float bfar, LAS float* imp_row, int key0, int lane, float* carry = nullptr) {
    const int kg = lane >> 4;
    __builtin_amdgcn_sched_barrier(0);
    bf16x8 fr[4][2];
#pragma unroll
    for (int mt = 0; mt < 4; ++mt) { fr[mt][0] = *(const LAS bf16x8*)(tb0 + mt * 2048); fr[mt][1] = *(const LAS bf16x8*)(tb1 + mt * 2048); }
    f32x4 s[4];
#pragma unroll
    for (int mt = 0; mt < 4; ++mt) { s[mt] = mfma16(fr[mt][0], q[0], (f32x4){0.f, 0.f, 0.f, 0.f}); s[mt] = mfma16(fr[mt][1], q[1], s[mt]); }
    if (MODE != TM_C1) {
        __builtin_amdgcn_sched_barrier(0);
#pragma unroll
        for (int t = 0; t < 4; ++t) { fr[t][0] = *(const LAS bf16x8*)(tb0 + 8192 + t * 2048); fr[t][1] = *(const LAS bf16x8*)(tb1 + 8192 + t * 2048); }
        __builtin_amdgcn_sched_barrier(0);
    }
    constexpr bool CMP = (MODE == TM_C1 || MODE == TM_C2);
    if (MODE == TM_SS) {
        if (NEARB) {
            const LAS float* rp = rt + (RT_OFF - dbase);
#pragma unroll
            for (int mt = 0; mt < 4; ++mt)
#pragma unroll
                for (int r = 0; r < 4; ++r) s[mt][r] += rp[16 * mt + r];
        }
        float ps = 0.f;
#pragma unroll
        for (int mt = 0; mt < 4; ++mt)
#pragma unroll
            for (int r = 0; r < 4; ++r) { const float p = __builtin_amdgcn_exp2f(s[mt][r] - mrow); s[mt][r] = p; ps += p; }
        ps += __shfl_xor(ps, 16); ps += __shfl_xor(ps, 32);
        A.l += ps;
    } else {
        float tmax = -1e30f;
        if (NEARB) {
            const LAS float* rp = rt + (RT_OFF - dbase);
#pragma unroll
            for (int mt = 0; mt < 4; ++mt)
#pragma unroll
                for (int r = 0; r < 4; ++r) {
                    const int c = 16 * mt + r;
                    if (CMP) {
                        const int dist = dbase - 16 * c; const int di = dist < 0 ? 0 : (dist > RT_OFF ? RT_OFF : dist);
                        float bv = rt[RT_OFF - di]; asm volatile("" : "+v"(bv));
                        s[mt][r] = dist >= 0 ? s[mt][r] + bv : -1e30f;
                    } else {
                        const int dist = dbase - c; const bool ok = (MODE == TM_W) ? (dist >= 0 && dist < 512) : (dist >= 0);
                        float bv = rp[c]; asm volatile("" : "+v"(bv));
                        s[mt][r] = ok ? s[mt][r] + bv : -1e30f;
                    }
                    tmax = fmaxf(tmax, s[mt][r]);
                }
        } else {
#pragma unroll
            for (int mt = 0; mt < 4; ++mt)
#pragma unroll
                for (int r = 0; r < 4; ++r) { s[mt][r] += bfar; tmax = fmaxf(tmax, s[mt][r]); }
        }
        if (MODE == TM_C2) {
#pragma unroll
            for (int mt = 0; mt < 4; ++mt)
#pragma unroll
                for (int r = 0; r < 4; ++r) s[mt][r] = __builtin_amdgcn_exp2f(s[mt][r] - A.m) * linv;
            const int g = lane & 3;
            float gsum[4], lv[4];
#pragma unroll
            for (int mt = 0; mt < 4; ++mt) { gsum[mt] = quad_sum(s[mt][0] + s[mt][1] + s[mt][2] + s[mt][3]); lv[mt] = quad_sum(s[mt][3]); }
#pragma unroll
            for (int mt = 0; mt < 4; ++mt) {
                const float up = __shfl_up(lv[mt], 16);
                const float wrap = mt > 0 ? __shfl(lv[mt - 1], (lane & 15) + 48) : *carry;
                const float prev = kg > 0 ? up : wrap;
                const int j = (key0 >> 2) + 4 * mt + kg;
                if (g == 0) asm volatile("ds_write_b32 %0, %1" :: "v"((unsigned)(size_t)(imp_row + j)), "v"(gsum[mt] + prev) : "memory");
            }
            *carry = __shfl(lv[3], (lane & 15) + 48);
        } else {
            tmax = fmaxf(tmax, __shfl_xor(tmax, 16)); tmax = fmaxf(tmax, __shfl_xor(tmax, 32));
            const float mnew = fmaxf(A.m, tmax), msafe = fmaxf(mnew, -1e29f), alpha = __builtin_amdgcn_exp2f(A.m - msafe);
            float ps = 0.f;
#pragma unroll
            for (int mt = 0; mt < 4; ++mt)
#pragma unroll
                for (int r = 0; r < 4; ++r) { const float p = __builtin_amdgcn_exp2f(s[mt][r] - msafe); s[mt][r] = p; ps += p; }
            ps += __shfl_xor(ps, 16); ps += __shfl_xor(ps, 32);
            A.l = A.l * alpha + ps; A.m = mnew;
            if (MODE != TM_C1) {
#pragma unroll
                for (int t = 0; t < 4; ++t) A.O[t] = A.O[t] * alpha;
            }
        }
    }
    if (MODE != TM_C1) {
        bf16x8 pf[2];
#pragma unroll
        for (int k2 = 0; k2 < 2; ++k2) {
            u32x4 w; w.x = cvt_pk_bf16(s[2 * k2][0], s[2 * k2][1]); w.y = cvt_pk_bf16(s[2 * k2][2], s[2 * k2][3]); w.z = cvt_pk_bf16(s[2 * k2 + 1][0], s[2 * k2 + 1][1]); w.w = cvt_pk_bf16(s[2 * k2 + 1][2], s[2 * k2 + 1][3]);
            pf[k2] = __builtin_bit_cast(bf16x8, w);
        }
#pragma unroll
        for (int t = 0; t < 4; ++t) { A.O[t] = mfma16(fr[t][0], pf[0], A.O[t]); A.O[t] = mfma16(fr[t][1], pf[1], A.O[t]); }
    }
}

#define SGB(mask, n) __builtin_amdgcn_sched_group_barrier(mask, n, 0)
template <bool NEARB>
__device__ __forceinline__ void slot_pair_ss(const LAS unsigned char* tb0, const LAS unsigned char* tb1, const bf16x8 (&q0)[2], const bf16x8 (&q1)[2],
                                             int dbase0, int dbase1, const LAS float* rt, SlotState& A0, SlotState& A1, float mrow0, float mrow1) {
    f32x4 s0[4], s1[4];
    __builtin_amdgcn_sched_barrier(0);
    bf16x8 kf[4][2], vf[4][2];
#pragma unroll
    for (int mt = 0; mt < 4; ++mt) { kf[mt][0] = *(const LAS bf16x8*)(tb0 + mt * 2048); kf[mt][1] = *(const LAS bf16x8*)(tb1 + mt * 2048); }
#pragma unroll
    for (int mt = 0; mt < 4; ++mt) { s0[mt] = mfma16(kf[mt][0], q0[0], (f32x4){0.f, 0.f, 0.f, 0.f}); s0[mt] = mfma16(kf[mt][1], q0[1], s0[mt]); }
    __builtin_amdgcn_sched_barrier(0);
#pragma unroll
    for (int t = 0; t < 4; ++t) { vf[t][0] = *(const LAS bf16x8*)(tb0 + 8192 + t * 2048); vf[t][1] = *(const LAS bf16x8*)(tb1 + 8192 + t * 2048); }
    __builtin_amdgcn_sched_barrier(0);
#pragma unroll
    for (int mt = 0; mt < 4; ++mt) { s1[mt] = mfma16(kf[mt][0], q1[0], (f32x4){0.f, 0.f, 0.f, 0.f}); s1[mt] = mfma16(kf[mt][1], q1[1], s1[mt]); }
    float ps0 = 0.f, ps1 = 0.f;
    if (NEARB) {
        const LAS float* rp0 = rt + (RT_OFF - dbase0);
#pragma unroll
        for (int mt = 0; mt < 4; ++mt)
#pragma unroll
            for (int r = 0; r < 4; ++r) s0[mt][r] += rp0[16 * mt + r];
    }
#pragma unroll
    for (int mt = 0; mt < 4; ++mt)
#pragma unroll
        for (int r = 0; r < 4; ++r) { const float p0 = __builtin_amdgcn_exp2f(s0[mt][r] - mrow0); s0[mt][r] = p0; ps0 += p0; }
    bf16x8 pf0[2], pf1[2];
#pragma unroll
    for (int k2 = 0; k2 < 2; ++k2) {
        u32x4 w; w.x = cvt_pk_bf16(s0[2 * k2][0], s0[2 * k2][1]); w.y = cvt_pk_bf16(s0[2 * k2][2], s0[2 * k2][3]); w.z = cvt_pk_bf16(s0[2 * k2 + 1][0], s0[2 * k2 + 1][1]); w.w = cvt_pk_bf16(s0[2 * k2 + 1][2], s0[2 * k2 + 1][3]);
        pf0[k2] = __builtin_bit_cast(bf16x8, w);
    }
#pragma unroll
    for (int i = 0; i < 8; ++i) { SGB(0x8, 1); SGB(0x2, 5); SGB(0x400, 2); }
    __builtin_amdgcn_sched_barrier(0);
#pragma unroll
    for (int t = 0; t < 4; ++t) {
        A0.O[t] = mfma16(vf[t][0], pf0[0], A0.O[t]);
        A0.O[t] = mfma16(vf[t][1], pf0[1], A0.O[t]);
    }
    if (NEARB) {
        const LAS float* rp1 = rt + (RT_OFF - dbase1);
#pragma unroll
        for (int mt = 0; mt < 4; ++mt)
#pragma unroll
            for (int r = 0; r < 4; ++r) s1[mt][r] += rp1[16 * mt + r];
    }
#pragma unroll
    for (int mt = 0; mt < 4; ++mt)
#pragma unroll
        for (int r = 0; r < 4; ++r) { const float p1 = __builtin_amdgcn_exp2f(s1[mt][r] - mrow1); s1[mt][r] = p1; ps1 += p1; }
#pragma unroll
    for (int k2 = 0; k2 < 2; ++k2) {
        u32x4 v; v.x = cvt_pk_bf16(s1[2 * k2][0], s1[2 * k2][1]); v.y = cvt_pk_bf16(s1[2 * k2][2], s1[2 * k2][3]); v.z = cvt_pk_bf16(s1[2 * k2 + 1][0], s1[2 * k2 + 1][1]); v.w = cvt_pk_bf16(s1[2 * k2 + 1][2], s1[2 * k2 + 1][3]);
        pf1[k2] = __builtin_bit_cast(bf16x8, v);
    }
#pragma unroll
    for (int i = 0; i < 8; ++i) { SGB(0x8, 1); SGB(0x2, 5); SGB(0x400, 2); }
    __builtin_amdgcn_sched_barrier(0);
#pragma unroll
    for (int t = 0; t < 4; ++t) {
        A1.O[t] = mfma16(vf[t][0], pf1[0], A1.O[t]);
        A1.O[t] = mfma16(vf[t][1], pf1[1], A1.O[t]);
    }
    ps0 += __shfl_xor(ps0, 16); ps1 += __shfl_xor(ps1, 16); ps0 += __shfl_xor(ps0, 32); ps1 += __shfl_xor(ps1, 32);
    A0.l += ps0; A1.l += ps1;
}

__device__ __forceinline__ void nsa_item(const Frame& F, int item) {
    const int bhk = item & 7, cb = 127 - (item >> 3), b = bhk >> 1, hk = bhk & 1;
    int tid_ = F.tid, lane_ = F.lane; asm volatile("" : "+v"(tid_), "+v"(lane_));
    const int tid = tid_, lane = lane_, wave = F.wave, n = lane & 15, ts = n >> 2, g = n & 3, kg = lane >> 4;
    const bf16* nq = (const bf16*)(F.ws + WS_NQ); const bf16* nkv = (const bf16*)(F.ws + WS_NKV) + (size_t)b * SEQ * 768;
    const bf16* kcmp = (const bf16*)(F.ws + WS_KCMP) + (size_t)bhk * 512 * 64; const bf16* vcmpt = (const bf16*)(F.ws + WS_VCMPT) + (size_t)bhk * 64 * 512;
    const bf16* vst = (const bf16*)(F.ws + WS_VST) + (size_t)bhk * 64 * SEQ; const bf16* vwt = (const bf16*)(F.ws + WS_VWT) + (size_t)bhk * 64 * SEQ;
    const float* small = (const float*)(F.ws + WS_SMALL); const bf16* nz = (const bf16*)(F.ws + WS_NZ); bf16* mix = (bf16*)(F.ws + WS_MIX);
    LAS float* btl = (LAS float*)(F.lds + NL_BT); LAS float* imp = (LAS float*)(F.lds + NL_IMP);
    LAS unsigned* maskw = (LAS unsigned*)(F.lds + NL_MASK); LAS unsigned* smaskw = (LAS unsigned*)(F.lds + NL_SMASK);
    LAS unsigned char* kvb = F.lds + NL_KV;
    const LAS float* bt = btl + g * RT_LEN;
    for (int prb3 = 0; prb3 <= PRB_SETUP; ++prb3)
    { __syncthreads(); const float* btg = (const float*)(F.ws + WS_BT) + (size_t)(hk * 4) * 1025;
      for (int i = tid; i < 4 * RT_LEN; i += 512) { const int hh = i / RT_LEN, ii = i - hh * RT_LEN; const int d = RT_OFF - ii; btl[i] = d >= 0 ? btg[hh * 1025 + (d > 1024 ? 1024 : d)] : 0.f; }
      for (int i = lane; i < 8 * 130; i += 64) imp[wave * 8 * 130 + i] = 0.f; }
    const int tw0 = cb * 64 + wave * 8;
    int trow[2]; size_t tokg[2]; bf16x8 q[2][2];
    LAS float* totp = (LAS float*)(F.lds + NL_TOT) + ((wave * 8 + ts) * 4 + g) * 68 + 4 * kg;
#pragma unroll
    for (int sl = 0; sl < 2; ++sl) {
        trow[sl] = tw0 + 4 * sl + ts; tokg[sl] = (size_t)b * SEQ + trow[sl];
        const bf16* qp = nq + tokg[sl] * 512 + (hk * 4 + g) * 64 + 8 * kg;
        q[sl][0] = *(const bf16x8*)qp; q[sl][1] = *(const bf16x8*)(qp + 32);
    }
    SlotState A[2];
    const int fb0 = n * 128 + ((kg ^ (n & 7)) << 4), fb1 = n * 128 + (((4 + kg) ^ (n & 7)) << 4);
#define NS_LOADK(buf) do { _Pragma("unroll") for (int _mt = 0; _mt < 4; ++_mt) { kf[_mt][0] = *(const LAS bf16x8*)((buf) + fb0 + _mt * 2048); kf[_mt][1] = *(const LAS bf16x8*)((buf) + fb1 + _mt * 2048); } } while (0)
#define NS_LOADV(buf) do { _Pragma("unroll") for (int _t = 0; _t < 4; ++_t) _Pragma("unroll") for (int _ks = 0; _ks < 2; ++_ks) vf[_t][_ks] = tile_frag((buf) + 8192, 16 * _t + n, 4 * _ks + kg); } while (0)
#define NS_RESET() do { _Pragma("unroll") for (int _s = 0; _s < 2; ++_s) { A[_s].m = -1e30f; A[_s].l = 0.f; _Pragma("unroll") for (int _t = 0; _t < 4; ++_t) A[_s].O[_t] = (f32x4){0.f, 0.f, 0.f, 0.f}; } } while (0)
#define NS_BAR() do { asm volatile("s_waitcnt lgkmcnt(0)" ::: "memory"); __builtin_amdgcn_s_barrier(); asm volatile("" ::: "memory"); } while (0)
#define NS_PIPE(NT, KEY0, KB, KSTR, VTB, VLEN, NB, BUF, ...) do { \
        const int _nt = (NT); \
        for (int _p = 0; _p < (NB) - 1 && _p < _nt; ++_p) stage_dma(BUF(_p), KB, KSTR, VTB, VLEN, KEY0(_p), wave, lane); \
        wait_tiles((_nt - 1) < ((NB) - 2) ? (_nt - 1) : ((NB) - 2)); NS_BAR(); \
        for (int ti = 0; ti < _nt; ++ti) { \
            const LAS unsigned char* cbuf = BUF(ti & ((NB) - 1)); \
            if (ti + (NB) - 1 < _nt) stage_dma(BUF((ti + (NB) - 1) & ((NB) - 1)), KB, KSTR, VTB, VLEN, KEY0(ti + (NB) - 1), wave, lane); \
            __VA_ARGS__ \
            { const int _rem = _nt - 2 - ti; wait_tiles(_rem < 0 ? 0 : (_rem < (NB) - 2 ? _rem : (NB) - 2)); } \
            NS_BAR(); \
        } } while (0)
#define BUF2(i) (kvb + (i) * 16384)
#define BUF4(i) ((i) < 2 ? kvb + (i) * 16384 : (LAS unsigned char*)(F.lds + NL_IMP) + ((i) - 2) * 16384)
    __syncthreads();
    const float bfarv = bt[RT_OFF - 1024];
    const int ntc = ((4 * cb + 2) >> 6) + 1;
#define KEY0_LIN(i) (64 * (i))
    for (int prb = 0; prb <= PRB_C; ++prb) {
    NS_RESET();
    NS_PIPE(ntc, KEY0_LIN, kcmp, 64, vcmpt, 512, 2, BUF2, {

        const int db0 = trow[0] - 31 - 16 * (64 * ti + 4 * kg), db1 = trow[1] - 31 - 16 * (64 * ti + 4 * kg);
        if (64 * cb - 1024 * ti - 1039 >= 790) {
            slot_tile<TM_C1, false>(cbuf + fb0, cbuf + fb1, q[0], db0, bt, A[0], 0.f, 0.f, bfarv, nullptr, 64 * ti, lane);
            slot_tile<TM_C1, false>(cbuf + fb0, cbuf + fb1, q[1], db1, bt, A[1], 0.f, 0.f, bfarv, nullptr, 64 * ti, lane);
        } else {
            slot_tile<TM_C1, true>(cbuf + fb0, cbuf + fb1, q[0], db0, bt, A[0], 0.f, 0.f, bfarv, nullptr, 64 * ti, lane);
            slot_tile<TM_C1, true>(cbuf + fb0, cbuf + fb1, q[1], db1, bt, A[1], 0.f, 0.f, bfarv, nullptr, 64 * ti, lane);
        }
    });
    }
    {
        for (int prb2 = PRB_C2; prb2 >= 0; --prb2) {
        const float li0 = (prb2 == 0 && A[0].l > 0.f) ? 1.0f / A[0].l : 0.f, li1 = (prb2 == 0 && A[1].l > 0.f) ? 1.0f / A[1].l : 0.f;
        float cry0 = 0.f, cry1 = 0.f;
        NS_PIPE(ntc, KEY0_LIN, kcmp, 64, vcmpt, 512, 2, BUF2, {

            const int db0 = trow[0] - 31 - 16 * (64 * ti + 4 * kg), db1 = trow[1] - 31 - 16 * (64 * ti + 4 * kg);
            if (64 * cb - 1024 * ti - 1039 >= 790) {
                slot_tile<TM_C2, false>(cbuf + fb0, cbuf + fb1, q[0], db0, bt, A[0], li0, 0.f, bfarv, imp + (wave * 8 + ts) * 130, 64 * ti, lane, &cry0);
                slot_tile<TM_C2, false>(cbuf + fb0, cbuf + fb1, q[1], db1, bt, A[1], li1, 0.f, bfarv, imp + (wave * 8 + 4 + ts) * 130, 64 * ti, lane, &cry1);
            } else {
                slot_tile<TM_C2, true>(cbuf + fb0, cbuf + fb1, q[0], db0, bt, A[0], li0, 0.f, bfarv, imp + (wave * 8 + ts) * 130, 64 * ti, lane, &cry0);
                slot_tile<TM_C2, true>(cbuf + fb0, cbuf + fb1, q[1], db1, bt, A[1], li1, 0.f, bfarv, imp + (wave * 8 + 4 + ts) * 130, 64 * ti, lane, &cry1);
            }
        });
        }
#pragma unroll
        for (int sl = 0; sl < 2; ++sl) { const float gate = small[tokg[sl] * 32 + 8 + hk * 4 + g];
#pragma unroll
            for (int t = 0; t < 4; ++t) *(LAS f32x4*)(totp + sl * 16 * 68 + 16 * t) = A[sl].O[t] * gate; }
    }
#pragma unroll
    for (int sl = 0; sl < 2; ++sl) {
        const int tsl = lane >> 4, i = lane & 15; const int tk = wave * 8 + 4 * sl + tsl;
        unsigned mw0 = 0u, mw1 = 0u, mw2 = 0u, mw3 = 0u;
#define NS_SETBIT(j) do { const unsigned _b = 1u << ((j) & 31); const int _w = (j) >> 5; mw0 |= _w == 0 ? _b : 0u; mw1 |= _w == 1 ? _b : 0u; mw2 |= _w == 2 ? _b : 0u; mw3 |= _w == 3 ? _b : 0u; } while (0)
        if (cb <= 15) { mw0 = (2u << cb) - 1u; }
        else {
            float val[8];
#pragma unroll
            for (int qq = 0; qq < 8; ++qq) { const int j = i + 16 * qq; val[qq] = (j >= 1 && j <= cb - 2) ? imp[tk * 130 + j] : -1.0f; }
            NS_SETBIT(0); NS_SETBIT(cb - 1); NS_SETBIT(cb);
            for (int round = 0; round < 13; ++round) {
                float bv = -2.0f; int bj = 1 << 20;
#pragma unroll
                for (int qq = 0; qq < 8; ++qq) if (val[qq] > bv) { bv = val[qq]; bj = i + 16 * qq; }
#define NS_DPP_STEP(CTRL) do { const float ov = __builtin_bit_cast(float, __builtin_amdgcn_update_dpp(0, __builtin_bit_cast(int, bv), CTRL, 0xf, 0xf, false)); \
                    const int oj = __builtin_amdgcn_update_dpp(0, bj, CTRL, 0xf, 0xf, false); if (ov > bv || (ov == bv && oj < bj)) { bv = ov; bj = oj; } } while (0)
                NS_DPP_STEP(0xB1); NS_DPP_STEP(0x4E); NS_DPP_STEP(0x141); NS_DPP_STEP(0x140);
#pragma unroll
                for (int qq = 0; qq < 8; ++qq) if (bj == i + 16 * qq) val[qq] = -3.0f;
                NS_SETBIT(bj);
            }
        }
        if (i == 0) { maskw[tk * 4 + 0] = mw0; maskw[tk * 4 + 1] = mw1; maskw[tk * 4 + 2] = mw2; maskw[tk * 4 + 3] = mw3; }
        mw0 |= __shfl_xor(mw0, 16); mw0 |= __shfl_xor(mw0, 32); mw1 |= __shfl_xor(mw1, 16); mw1 |= __shfl_xor(mw1, 32);
        mw2 |= __shfl_xor(mw2, 16); mw2 |= __shfl_xor(mw2, 32); mw3 |= __shfl_xor(mw3, 16); mw3 |= __shfl_xor(mw3, 32);
        if (lane == 0) { const int so = (wave * 2 + sl) * 4; smaskw[so] = mw0; smaskw[so + 1] = mw1; smaskw[so + 2] = mw2; smaskw[so + 3] = mw3; }
    }
    __syncthreads();
    {
#define KEY0_SEL(i) (64 * (cb == 0 ? 0 : (cb == 1 ? 1 - (i) : ((i) == 0 ? cb : ((i) == 1 ? cb - 1 : ((i) == 2 ? 0 : (i) - 2))))))
        const int tk0 = wave * 8 + ts;
        unsigned smk0[4], smk1[4], rmk0[4], rmk1[4];
#pragma unroll
        for (int w4 = 0; w4 < 4; ++w4) {
            smk0[w4] = __builtin_amdgcn_readfirstlane(smaskw[(wave * 2 + 0) * 4 + w4]); smk1[w4] = __builtin_amdgcn_readfirstlane(smaskw[(wave * 2 + 1) * 4 + w4]);
            rmk0[w4] = maskw[tk0 * 4 + w4]; rmk1[w4] = maskw[(tk0 + 4) * 4 + w4];
        }
        const LAS unsigned char* const Kb_ = nullptr; (void)Kb_;
        const bf16* ksl = nkv + 256 + hk * 64;
        for (int prb = 0; prb <= PRB_S; ++prb) {
        NS_RESET();
        const int nt = cb + 1, np = (nt + 1) >> 1;
        stage_dma(BUF4(0), ksl, 768, vst, SEQ, KEY0_SEL(0), wave, lane); if (nt > 1) stage_dma(BUF4(1), ksl, 768, vst, SEQ, KEY0_SEL(1), wave, lane);
        wait_tiles(0); NS_BAR();
        for (int p = 0; p < np; ++p) {
            const int sb = (p & 1) * 2;
            if (p + 1 < np) { stage_dma(BUF4(2 - sb), ksl, 768, vst, SEQ, KEY0_SEL(2 * p + 2), wave, lane); if (2 * p + 3 < nt) stage_dma(BUF4(3 - sb), ksl, 768, vst, SEQ, KEY0_SEL(2 * p + 3), wave, lane); }
#pragma unroll 1
            for (int hh = 0; hh < 2; ++hh) {
                const int ti = 2 * p + hh; if (ti >= nt) break;
                const LAS unsigned char* cbuf = BUF4(sb + hh);
                const int key0 = KEY0_SEL(ti); const int j = key0 >> 6;
                const bool dense = (cb < 2) || (ti < 3);
                const int db0 = trow[0] - key0 - 4 * kg, db1 = trow[1] - key0 - 4 * kg;
                const bool nearb = (cb - j) < 14;
                if (dense) {

                    if (nearb) {
                        slot_tile<TM_SD, true>(cbuf + fb0, cbuf + fb1, q[0], db0, bt, A[0], 0.f, 0.f, bfarv, nullptr, key0, lane);
                        slot_tile<TM_SD, true>(cbuf + fb0, cbuf + fb1, q[1], db1, bt, A[1], 0.f, 0.f, bfarv, nullptr, key0, lane);
                    } else {
                        slot_tile<TM_SD, false>(cbuf + fb0, cbuf + fb1, q[0], db0, bt, A[0], 0.f, 0.f, bfarv, nullptr, key0, lane);
                        slot_tile<TM_SD, false>(cbuf + fb0, cbuf + fb1, q[1], db1, bt, A[1], 0.f, 0.f, bfarv, nullptr, key0, lane);
                    }
                } else {
                    const int w4 = j >> 5, bit = j & 31;
                    const unsigned sm0 = w4 == 0 ? smk0[0] : (w4 == 1 ? smk0[1] : (w4 == 2 ? smk0[2] : smk0[3])), sm1 = w4 == 0 ? smk1[0] : (w4 == 1 ? smk1[1] : (w4 == 2 ? smk1[2] : smk1[3]));
                    const bool a0 = (sm0 >> bit) & 1u, a1 = (sm1 >> bit) & 1u;
                    if (a0 || a1) {

                        const unsigned rm0 = w4 == 0 ? rmk0[0] : (w4 == 1 ? rmk0[1] : (w4 == 2 ? rmk0[2] : rmk0[3])), rm1 = w4 == 0 ? rmk1[0] : (w4 == 1 ? rmk1[1] : (w4 == 2 ? rmk1[2] : rmk1[3]));
                        const float boff = nearb ? 0.f : bfarv;
                        const float mr0 = ((rm0 >> bit) & 1u) ? A[0].m - boff : 1e30f, mr1 = ((rm1 >> bit) & 1u) ? A[1].m - boff : 1e30f;
                        if (a0 && a1) {
                            if (nearb) slot_pair_ss<true>(cbuf + fb0, cbuf + fb1, q[0], q[1], db0, db1, bt, A[0], A[1], mr0, mr1);
                            else slot_pair_ss<false>(cbuf + fb0, cbuf + fb1, q[0], q[1], db0, db1, bt, A[0], A[1], mr0, mr1);
                        } else if (a0) {
                            if (nearb) slot_tile<TM_SS, true>(cbuf + fb0, cbuf + fb1, q[0], db0, bt, A[0], 0.f, mr0, 0.f, nullptr, key0, lane);
                            else slot_tile<TM_SS, false>(cbuf + fb0, cbuf + fb1, q[0], db0, bt, A[0], 0.f, mr0, 0.f, nullptr, key0, lane);
                        } else {
                            if (nearb) slot_tile<TM_SS, true>(cbuf + fb0, cbuf + fb1, q[1], db1, bt, A[1], 0.f, mr1, 0.f, nullptr, key0, lane);
                            else slot_tile<TM_SS, false>(cbuf + fb0, cbuf + fb1, q[1], db1, bt, A[1], 0.f, mr1, 0.f, nullptr, key0, lane);
                        }
                    }
                }
            }
            wait_tiles(0); NS_BAR();
        }
        }
#pragma unroll
        for (int sl = 0; sl < 2; ++sl) { const float gate = small[tokg[sl] * 32 + 16 + hk * 4 + g]; const float sc = A[sl].l > 0.f ? gate / A[sl].l : 0.f;
#pragma unroll
            for (int t = 0; t < 4; ++t) { LAS f32x4* tp = (LAS f32x4*)(totp + sl * 16 * 68 + 16 * t); *tp = *tp + A[sl].O[t] * sc; } }
    }
    {
        const int jw0 = cb >= 8 ? cb - 8 : 0;
#define KEY0_WIN(i) (64 * (jw0 + (i)))
        for (int prb = 0; prb <= PRB_W; ++prb) {
        NS_RESET();
        NS_PIPE(cb - jw0 + 1, KEY0_WIN, nkv + 512 + hk * 64, 768, vwt, SEQ, 4, BUF4, {

            slot_tile<TM_W, true>(cbuf + fb0, cbuf + fb1, q[0], trow[0] - KEY0_WIN(ti) - 4 * kg, bt, A[0], 0.f, 0.f, 0.f, nullptr, KEY0_WIN(ti), lane);
            slot_tile<TM_W, true>(cbuf + fb0, cbuf + fb1, q[1], trow[1] - KEY0_WIN(ti) - 4 * kg, bt, A[1], 0.f, 0.f, 0.f, nullptr, KEY0_WIN(ti), lane);
        });
        }
#pragma unroll
        for (int sl = 0; sl < 2; ++sl) { const float gate = small[tokg[sl] * 32 + 24 + hk * 4 + g]; const float sc = A[sl].l > 0.f ? gate / A[sl].l : 0.f;
#pragma unroll
            for (int t = 0; t < 4; ++t) { LAS f32x4* tp = (LAS f32x4*)(totp + sl * 16 * 68 + 16 * t); *tp = *tp + A[sl].O[t] * sc; } }
    }
    {
        int l2 = lane; asm volatile("" : "+v"(l2));
        const int n2 = l2 & 15, ts2 = n2 >> 2, g2 = n2 & 3, kg2 = l2 >> 4;
        const LAS float* tp2 = (const LAS float*)(F.lds + NL_TOT) + ((wave * 8 + ts2) * 4 + g2) * 68 + 4 * kg2;
#pragma unroll
        for (int sl = 0; sl < 2; ++sl) {
            const size_t tk = (size_t)b * SEQ + tw0 + 4 * sl + ts2;
#pragma unroll
            for (int t = 0; t < 4; ++t) {
                const u32x2 z = *(const u32x2*)(nz + tk * 512 + (hk * 4 + g2) * 64 + 16 * t + 4 * kg2);
                const f32x4 tv = *(const LAS f32x4*)(tp2 + sl * 16 * 68 + 16 * t);
                u32x2 d; d.x = cvt_pk_bf16(tv[0] * __uint_as_float(z.x << 16), tv[1] * __uint_as_float(z.x & 0xffff0000u));
                d.y = cvt_pk_bf16(tv[2] * __uint_as_float(z.y << 16), tv[3] * __uint_as_float(z.y & 0xffff0000u));
                *(u32x2*)(mix + tk * DM + 512 + (hk * 4 + g2) * 64 + 16 * t + 4 * kg2) = d;
            }
        }
    }
    __syncthreads();
#undef NS_LOADK
#undef NS_LOADV
#undef NS_RESET
#undef NS_PIPE
#undef NS_SETBIT
}
#ifndef PRB_SCANONLY
#define PRB_SCANONLY 0
#endif
#ifndef DUP_P1
#define DUP_P1 0
#endif
#ifndef DUP_P2G
#define DUP_P2G 0
#endif
#ifndef DUP_P2
#define DUP_P2 0
#endif
#ifndef DUP_SCAN
#define DUP_SCAN 0
#endif
#ifndef DUP_NSA
#define DUP_NSA 0
#endif
__device__ __forceinline__ void p2_phase(const Frame& F) {
    int cw_head = -1;
#define P2_CW_LOAD(h_) do { if ((h_) != cw_head) { __syncthreads(); const float* cw = F.in[3]; \
        for (int i = F.tid; i < 4 * 3 * 128; i += 512) { const int j = i / 384, r = i - j * 384, part = r >> 7, c = r & 127; ((LAS float*)(F.lds + GL_CW))[i] = cw[j * 1536 + part * 512 + (h_) * 128 + c]; } \
        cw_head = (h_); __syncthreads(); } } while (0)
    for (int rep = 0; rep <= DUP_P2; ++rep)
    for (int task = blockIdx.x; task < 3072; task += gridDim.x) {
        if (task < 2048) { P2_CW_LOAD(task & 3); for (int r2 = 0; r2 <= DUP_P2G; ++r2) gdn_prep_item(F, task); }
        else if (task < 2560) compress_block(F, task - 2048);
        else vtranspose_task(F, task - 2560);
    }
}
__device__ __forceinline__ void p3_phase(const Frame& F) {
    for (int rep = 0; rep <= DUP_SCAN; ++rep)
        for (int bh = blockIdx.x; bh < 16; bh += gridDim.x) gdn_scan(F, bh);
    LAS int* nxt = (LAS int*)(F.lds + NL_NXT);
#if PRB_SCANONLY
    if (blockIdx.x < 16) return;
#endif
    for (int rep = 0; rep <= DUP_NSA; ++rep) {
        const int bhk = blockIdx.x & 7;
        unsigned* ctr = (unsigned*)(F.ws + WS_CTL) + 64 + 64 * bhk + 1024 * rep;
        for (;;) {
            __syncthreads();
            if (F.tid == 0) *nxt = (int)atomicAdd(ctr, 1u);
            __syncthreads();
            const int qi = *nxt;
            if (qi >= 128) break;
            nsa_item(F, qi * 8 + bhk);
        }
    }
}
typedef __attribute__((address_space(1))) unsigned gu32;
#define XB_TMO      128
#define XB_XCNT(j)  (256  + 64 * (j))
#define XB_XSUB(j)  (1280 + 64 * (j))
#define XB_XGEN(j)  (2304 + 64 * (j))
#define XB_TOP      3328
#define XB_TOPGEN   3392
#define XCD_BAR_WORDS 3456
#define XB_SPIN_CAP (1u << 18)

__device__ __forceinline__ unsigned xb_ld(unsigned* p)              { return __hip_atomic_load(p, __ATOMIC_RELAXED, __HIP_MEMORY_SCOPE_AGENT); }
__device__ __forceinline__ unsigned xb_add(unsigned* p, unsigned v) { return __hip_atomic_fetch_add(p, v, __ATOMIC_RELAXED, __HIP_MEMORY_SCOPE_AGENT); }
__device__ __forceinline__ unsigned xb_xcc_id() { return (unsigned)__builtin_amdgcn_s_getreg((3 << 11) | 20) & 0xFu; }
#define XB_SPIN(cond, bar) do { unsigned _sp = 0; while (cond) { __builtin_amdgcn_s_sleep(1); \
    if ((++_sp & 255u) == 0u) { if (xb_ld(&(bar)[XB_TMO])) break; if (_sp > XB_SPIN_CAP) { atomicAdd(&(bar)[XB_TMO], 1u); break; } } } } while (0)

struct XcdBarrier {
    unsigned* bar; unsigned x;
    volatile LAS unsigned* st;
};

__device__ __forceinline__ XcdBarrier xcd_barrier_post(unsigned* bar, volatile LAS unsigned* st) {
    XcdBarrier b; b.bar = bar; b.x = xb_xcc_id(); b.st = st;
    if (threadIdx.x == 0) (void)xb_add(&bar[XB_XCNT(b.x)], 1u);
    return b;
}
__device__ __forceinline__ void xcd_barrier_complete(unsigned* bar, unsigned x, unsigned& nloc, unsigned& nx) {
    const unsigned G = gridDim.x * gridDim.y * gridDim.z;
    unsigned sum, cnt, mine, sp = 0u;
    for (;;) {
        sum = 0u; cnt = 0u; mine = 0u;
#pragma unroll
        for (unsigned j = 0; j < 16; ++j) { const unsigned c = xb_ld(&bar[XB_XCNT(j)]); sum += c; cnt += (c > 0u) ? 1u : 0u; mine = (j == x) ? c : mine; }
        if (sum == G) break;
        __builtin_amdgcn_s_sleep(1);
        if ((++sp & 255u) == 0u) { if (xb_ld(&bar[XB_TMO])) break; if (sp > XB_SPIN_CAP) { atomicAdd(&bar[XB_TMO], 1u); break; } }
    }
    nloc = mine > 0u ? mine : 1u; nx = cnt > 0u ? cnt : 1u;
}

__device__ __forceinline__ void xcd_barrier(const XcdBarrier& b) {
    asm volatile("s_waitcnt vmcnt(0)" ::: "memory");
    __syncthreads();
    if (threadIdx.x == 0) {
        unsigned* bar = b.bar;
        __builtin_amdgcn_s_waitcnt(0);
        unsigned nloc = b.st[0], nx = b.st[1];
        if (nloc == 0u) { xcd_barrier_complete(bar, b.x, nloc, nx); b.st[0] = nloc; b.st[1] = nx; }
        const unsigned old = xb_add(&bar[XB_XSUB(b.x)], 1u);
        const unsigned gen = old / nloc;
        if (old + 1u == (gen + 1u) * nloc) {
            __builtin_amdgcn_fence(__ATOMIC_RELEASE, "agent");
            asm volatile("s_waitcnt vmcnt(0)" ::: "memory");
            const unsigned og = xb_add(&bar[XB_TOP], 1u);
            const unsigned tg = og / nx;
            if (og + 1u == (tg + 1u) * nx) xb_add(&bar[XB_TOPGEN], 1u);
            else XB_SPIN(xb_ld(&bar[XB_TOPGEN]) == tg, bar);
            __builtin_amdgcn_fence(__ATOMIC_ACQUIRE, "agent");
            xb_add(&bar[XB_XGEN(b.x)], 1u);
            asm volatile("s_waitcnt vmcnt(0)" ::: "memory");
        } else {
            XB_SPIN(xb_ld(&bar[XB_XGEN(b.x)]) == gen, bar);
            __builtin_amdgcn_fence(__ATOMIC_ACQUIRE, "agent");
            asm volatile("s_waitcnt vmcnt(0)" ::: "memory");
        }
    }
    __syncthreads();
}

constexpr int LDS_BARST = LDS_BYTES - 64;
struct Args { const float* in[16]; float* out; unsigned char* ws; int ph_lo, ph_hi, coop, pad; };
constexpr int N_PHASES = 6;

__global__ void __launch_bounds__(512, 2) hymba_fwd(Args a) {
    extern __shared__ __attribute__((aligned(16))) unsigned char lds_raw[];
    Frame F;
#pragma unroll
    for (int i = 0; i < 16; ++i) F.in[i] = a.in[i];
    F.out = a.out; F.ws = a.ws; F.lds = (LAS unsigned char*)lds_raw; F.ldsg = lds_raw;
    F.tid = threadIdx.x; F.lane = F.tid & 63; F.wave = __builtin_amdgcn_readfirstlane(F.tid >> 6);
    unsigned char* ws = a.ws;
    volatile LAS unsigned* barst = (volatile LAS unsigned*)(F.lds + LDS_BARST);
    if (F.tid < 2) barst[F.tid] = 0u;
    __syncthreads();
    XcdBarrier xbar; xbar.bar = (unsigned*)(ws + WS_CTL) + 4096; xbar.x = 0; xbar.st = nullptr;
    if (a.coop) xbar = xcd_barrier_post((unsigned*)(ws + WS_CTL) + 4096, barst);
    const int lo = a.ph_lo, hi = a.ph_hi;
#define IN(k) (lo <= (k) && (k) < hi)
#define SEAM(k) do { if (IN(k) && IN((k) + 1) && a.coop) { xcd_barrier(xbar); } __syncthreads(); } while (0)
#ifndef DUP_P0
#define DUP_P0 0
#endif
#ifndef DUP_P4
#define DUP_P4 0
#endif
    if (IN(0)) { _Pragma("unroll 1") for (int rep = 0; rep <= DUP_P0; ++rep) p0_prep(F); }
    SEAM(0);
    if (IN(1)) {
        pg8::Gemm g{(const bf16*)(ws + WS_XB), (const bf16*)(ws + WS_WTIN), T_TOK, NPROJ, DM};
        pg8::StaticOrder S; S.init(T_TOK, NPROJ, (int)gridDim.x, (int)blockIdx.x);
        EpiProj E{(bf16*)(ws + WS_GQKV), (bf16*)(ws + WS_GZ), (bf16*)(ws + WS_NQ), (bf16*)(ws + WS_NKV), (bf16*)(ws + WS_NZ), (const float*)(ws + WS_RS)};
        pg8::gemm_phase<EpiProj, pg8::StaticOrder, false>(F.lds, g, S, E, nullptr);
#if DUP_P1
        __syncthreads(); pg8::gemm_phase<EpiProj, pg8::StaticOrder, false>(F.lds, g, S, E, nullptr);
#endif
    }
    SEAM(1);
    if (IN(2)) p2_phase(F);
    SEAM(2);
    if (IN(3)) p3_phase(F);
    SEAM(3);
    if (IN(4)) {
        pg8::Gemm g{(const bf16*)(ws + WS_MIX), (const bf16*)(ws + WS_WTOUT), T_TOK, DM, DM};
        pg8::StaticOrder S; S.init(T_TOK, DM, (int)gridDim.x, (int)blockIdx.x);
        EpiOut E{F.in[0], F.out};
        pg8::gemm_phase<EpiOut, pg8::StaticOrder, false>(F.lds, g, S, E, nullptr);
#if DUP_P4
        __syncthreads(); pg8::gemm_phase<EpiOut, pg8::StaticOrder, false>(F.lds, g, S, E, nullptr);
#endif
    }
    SEAM(4);
    if (IN(5)) p5_final(F);
#undef IN
#undef SEAM
}

extern "C" void kernel_launch(void* const* d_in, const int* in_sizes, int n_in, void* d_out, int out_size, void* d_ws, size_t ws_size, hipStream_t stream) {
    static int grid = 0;
    if (grid == 0) {
        if (n_in != 16 || in_sizes[0] != T_TOK * DM || out_size != T_TOK * DM || ws_size < WS_END) { fprintf(stderr, "kernel_launch: unexpected shapes (n_in %d, ws %zu)\n", n_in, ws_size); grid = -1; return; }
        int dev = 0, cus = 0, per_cu = 0;
        if (hipGetDevice(&dev) != hipSuccess || hipDeviceGetAttribute(&cus, hipDeviceAttributeMultiprocessorCount, dev) != hipSuccess) { grid = -1; return; }
        if (hipFuncSetAttribute((const void*)hymba_fwd, hipFuncAttributeMaxDynamicSharedMemorySize, LDS_BYTES) != hipSuccess) { fprintf(stderr, "kernel_launch: hipFuncSetAttribute failed\n"); grid = -1; return; }
        if (hipOccupancyMaxActiveBlocksPerMultiprocessor(&per_cu, (const void*)hymba_fwd, 512, LDS_BYTES) != hipSuccess || per_cu < 1) { fprintf(stderr, "kernel_launch: occupancy query says %d\n", per_cu); per_cu = 1; }
        (void)hipGetLastError();
        grid = cus;
    }
    if (grid < 0) return;
    (void)hipMemsetAsync((char*)d_ws + WS_CTL, 0, 1 * MiB, stream);
    Args a{};
    for (int i = 0; i < 16; ++i) a.in[i] = (const float*)d_in[i];
    a.out = (float*)d_out; a.ws = (unsigned char*)d_ws;
#if MK_LAUNCHES == 1
    a.ph_lo = 0; a.ph_hi = N_PHASES; a.coop = 1;
    void* args[] = {&a};
    hipError_t e = hipLaunchCooperativeKernel((const void*)hymba_fwd, dim3(grid), dim3(512), args, LDS_BYTES, stream);
    if (e != hipSuccess) fprintf(stderr, "cooperative launch failed: %s (grid %d)\n", hipGetErrorString(e), grid);
#else
    for (int ph = 0; ph < N_PHASES; ++ph) {
        a.ph_lo = ph; a.ph_hi = ph + 1; a.coop = 0;
        hipLaunchKernelGGL(hymba_fwd, dim3(grid), dim3(512), LDS_BYTES, stream, a);
    }
#endif
}
```

```cpp
#include <hip/hip_runtime.h>
#include <hip/hip_cooperative_groups.h>
#include <cstdio>
#include <cstdint>
namespace cg = cooperative_groups;
#ifndef MK_LAUNCHES
#define MK_LAUNCHES 1
#endif

namespace pg8 {
#define PG8_LAS __attribute__((address_space(3)))
typedef unsigned short bf16_t;
typedef short bf16x8 __attribute__((ext_vector_type(8)));
typedef float f32x4 __attribute__((ext_vector_type(4)));
typedef unsigned u32x4 __attribute__((ext_vector_type(4)));
constexpr int BM = 256, BK = 64, HALF = 128, HTB = HALF * BK * 2  , STAGE_BYTES = 8 * HTB, NXCD = 8, WGM = 8;

__host__ __device__ __forceinline__ int lds_byte(int r, int c) { const int st = (r >> 4) * 2 + (c >> 5), rr = r & 15, cc = c & 31, ob = rr * 64 + cc * 2; return st * 1024 + (ob ^ (((ob >> 9) & 1) << 5)); }
__host__ __device__ __forceinline__ void stage_rc(int b, int& R, int& C) { const int st = b / 1024, sb = b % 1024, swz = sb ^ (((sb >> 9) & 1) << 5); R = (st >> 1) * 16 + swz / 64; C = (st & 1) * 32 + (swz % 64) / 2; }
__host__ __device__ __forceinline__ int perm32(int rho) { const int n = rho >> 4, i = rho & 15; return 8 * (i >> 2) + 4 * n + (i & 3); }

struct Unit { int pm, pn; };
struct Gemm { const bf16_t* A; const bf16_t* Bt; int M, N, K; };

struct StaticOrder {
    int nM, nN, nwg, G, c;
    __host__ __device__ void init(int M, int N, int G_, int c_) { nM = M / BM; nN = N / BM; nwg = nM * nN; G = G_; c = c_; }
    __host__ __device__ bool next(int i, Unit& u) const {
        const long L = (long)i * G + c; if (L >= nwg) return false;
        int wgid = (int)L; { const int q = nwg / NXCD, r = nwg % NXCD, xcd = wgid % NXCD, off = wgid / NXCD; wgid = (xcd < r ? xcd * (q + 1) : r * (q + 1) + (xcd - r) * q) + off; }
        const int nig = WGM * nN, gid = wgid / nig, fm = gid * WGM, gsz = (nM - fm) < WGM ? (nM - fm) : WGM;
        u.pm = fm + ((wgid % nig) % gsz); u.pn = (wgid % nig) / gsz; return true;
    }
    __device__ __forceinline__ void a_ready(const Unit&) const {}
    __device__ __forceinline__ void done(const Unit&) const {}
};
__device__ __forceinline__ unsigned cvt_pk_bf16(float lo, float hi) { unsigned r; asm volatile("v_cvt_pk_bf16_f32 %0, %1, %2" : "=v"(r) : "v"(lo), "v"(hi)); return r; }
typedef float f32x2 __attribute__((ext_vector_type(2)));
template <class Epi, class Sched, bool STAMP = false>
__device__ __forceinline__ void gemm_phase(PG8_LAS unsigned char* lds, const Gemm g, const Sched& S, const Epi& E, unsigned long long* stamps) {
    const int tid = threadIdx.x, wid = __builtin_amdgcn_readfirstlane(tid >> 6), lane = tid & 63, wr = wid >> 2, wc = wid & 3, fr = lane & 15, fq = lane >> 4;
    const int K = g.K, nt = K / BK;
    int ts_lo = 0, ts_hi = 0, nts = 0; const unsigned long long rt_entry = STAMP ? (unsigned long long)wall_clock64() : 0ull;
#define PG8_STAMP() do { if (STAMP && wid == 0 && nts < 64) { const unsigned long long _c = (unsigned long long)clock64(); \
        ts_lo = (lane == nts) ? (int)(unsigned)_c : ts_lo; ts_hi = (lane == nts) ? (int)(unsigned)(_c >> 32) : ts_hi; ++nts; } } while (0)
    PG8_STAMP();
    unsigned voffA[2], voffB[2];
#pragma unroll
    for (int i = 0; i < 2; ++i) { int R, C; stage_rc(tid * 16 + i * 8192, R, C); const int Rb = Epi::PERM ? ((R & ~31) + perm32(R & 31)) : R;
        voffA[i] = (unsigned)(R * K + C) * 2u; voffB[i] = (unsigned)(Rb * K + C) * 2u; }
    const size_t kstep = (size_t)(BK * 2);
    const size_t hstep = (size_t)HALF * K * 2;
    const size_t tstep = 2 * hstep;
    const unsigned ldsw = (unsigned)wid * 1024u;
    const int aoff = lds_byte(wr * 64 + fr, fq * 8), boff = lds_byte(wc * 32 + fr, fq * 8);
#define PG8_SA(b, h) (((b) * 2 + (h)) * HTB)
#define PG8_SB(b, h) ((4 + (b) * 2 + (h)) * HTB)
#define PG8_STAGE(bufoff, gbase, voff) do { _Pragma("unroll") for (int _i = 0; _i < 2; ++_i) \
        __builtin_amdgcn_global_load_lds((const unsigned*)((const char*)(gbase) + (voff)[_i]), (PG8_LAS unsigned*)(lds + (bufoff) + ldsw + _i * 8192), 16, 0, 0); } while (0)
#define PG8_LDA(dst, b, h) do { _Pragma("unroll") for (int m = 0; m < 4; ++m) _Pragma("unroll") for (int k = 0; k < 2; ++k) dst[m][k] = *(const PG8_LAS bf16x8*)(lds + PG8_SA(b, h) + aoff + m * 2048 + k * 1024); } while (0)
#define PG8_LDB(dst, b, h) do { _Pragma("unroll") for (int n = 0; n < 2; ++n) _Pragma("unroll") for (int k = 0; k < 2; ++k) dst[n][k] = *(const PG8_LAS bf16x8*)(lds + PG8_SB(b, h) + boff + n * 2048 + k * 1024); } while (0)
#define PG8_MMA(ai, bj, At, Bt) do { __builtin_amdgcn_s_setprio(1); _Pragma("unroll") for (int m = 0; m < 4; ++m) _Pragma("unroll") for (int n = 0; n < 2; ++n) _Pragma("unroll") for (int k = 0; k < 2; ++k) \
        acc[ai][bj][m][n] = __builtin_amdgcn_mfma_f32_16x16x32_bf16(Bt[n][k], At[m][k], acc[ai][bj][m][n], 0, 0, 0); __builtin_amdgcn_s_setprio(0); } while (0)
#define PG8_WAIT_V(n) asm volatile("s_waitcnt vmcnt(" #n ")" ::: "memory")
#define PG8_WAIT_L(n) asm volatile("s_waitcnt lgkmcnt(" #n ")" ::: "memory")
#define PG8_BAR __builtin_amdgcn_s_barrier()
#define PG8_SCHED __builtin_amdgcn_sched_barrier(0)
    Unit cur, nxt; int ui = 0;
    if (!S.next(0, cur)) return;
    f32x4 acc[2][2][4][2];
#pragma unroll
    for (int a = 0; a < 2; ++a)
#pragma unroll
        for (int b = 0; b < 2; ++b)
#pragma unroll
            for (int m = 0; m < 4; ++m)
#pragma unroll
                for (int n = 0; n < 2; ++n) acc[a][b][m][n] = (f32x4){0.f, 0.f, 0.f, 0.f};
    bf16x8 At[4][2], B0[2][2], B1[2][2];
    const char* cA = (const char*)g.A + (size_t)cur.pm * tstep; const char* cB = (const char*)g.Bt + (size_t)cur.pn * tstep;
    S.a_ready(cur);
    PG8_STAGE(PG8_SB(0, 0), cB, voffB); PG8_STAGE(PG8_SA(0, 0), cA, voffA); PG8_STAGE(PG8_SB(0, 1), cB + hstep, voffB); PG8_STAGE(PG8_SA(0, 1), cA + hstep, voffA);
    if (wr == 1) PG8_BAR;
    PG8_WAIT_V(4); PG8_BAR;
    PG8_STAGE(PG8_SB(1, 0), cB + kstep, voffB); PG8_STAGE(PG8_SA(1, 0), cA + kstep, voffA); PG8_STAGE(PG8_SB(1, 1), cB + hstep + kstep, voffB);
    PG8_WAIT_V(6); PG8_BAR;
    PG8_STAMP();
    for (;;) {
        const bool has_next = S.next(ui + 1, nxt);
        const char* nA = has_next ? (const char*)g.A + (size_t)nxt.pm * tstep : cA; const char* nB = has_next ? (const char*)g.Bt + (size_t)nxt.pn * tstep : cB;
        for (int t = 0; t < nt; t += 2) {
            const bool last = (t == nt - 2);
            const char* a1 = cA + (size_t)(t + 1) * kstep;
            const char* a2 = last ? nA : cA + (size_t)(t + 2) * kstep; const char* b2 = last ? nB : cB + (size_t)(t + 2) * kstep;
            const char* a3 = a2 + kstep; const char* b3 = b2 + kstep;
            if (last && has_next) S.a_ready(nxt);
            PG8_LDB(B0, 0, 0); PG8_SCHED; PG8_LDA(At, 0, 0); PG8_STAGE(PG8_SA(1, 1), a1 + hstep, voffA);
            PG8_WAIT_L(8); PG8_BAR; PG8_WAIT_L(0); PG8_MMA(0, 0, At, B0); PG8_BAR; PG8_SCHED;
            PG8_LDB(B1, 0, 1); PG8_STAGE(PG8_SB(0, 0), b2, voffB);
            PG8_BAR; PG8_WAIT_L(0); PG8_MMA(0, 1, At, B1); PG8_BAR;
            PG8_LDA(At, 0, 1); PG8_STAGE(PG8_SA(0, 0), a2, voffA);
            PG8_BAR; PG8_WAIT_L(0); PG8_MMA(1, 0, At, B0); PG8_BAR; PG8_SCHED;
            PG8_STAGE(PG8_SB(0, 1), b2 + hstep, voffB);
            PG8_WAIT_V(6); PG8_BAR; PG8_MMA(1, 1, At, B1); PG8_BAR;
            PG8_LDB(B0, 1, 0); PG8_SCHED; PG8_LDA(At, 1, 0); PG8_STAGE(PG8_SA(0, 1), a2 + hstep, voffA);
            PG8_WAIT_L(8); PG8_BAR; PG8_WAIT_L(0); PG8_MMA(0, 0, At, B0); PG8_BAR; PG8_SCHED;
            PG8_LDB(B1, 1, 1); PG8_STAGE(PG8_SB(1, 0), b3, voffB);
            PG8_BAR; PG8_WAIT_L(0); PG8_MMA(0, 1, At, B1); PG8_BAR;
            PG8_LDA(At, 1, 1); PG8_STAGE(PG8_SA(1, 0), a3, voffA);
            PG8_BAR; PG8_WAIT_L(0); PG8_MMA(1, 0, At, B0); PG8_BAR; PG8_SCHED;
            PG8_STAGE(PG8_SB(1, 1), b3 + hstep, voffB);
            PG8_WAIT_V(6); PG8_BAR; PG8_MMA(1, 1, At, B1); PG8_BAR;
        }
        PG8_STAMP();
        if constexpr (!Epi::AFTER_DRAIN) { E(acc, cur, wr, wc, fr, fq); S.done(cur); }
        PG8_STAMP();
        if (!has_next) break;
#pragma unroll
        for (int a = 0; a < 2; ++a)
#pragma unroll
            for (int b = 0; b < 2; ++b)
#pragma unroll
                for (int m = 0; m < 4; ++m)
#pragma unroll
                    for (int n = 0; n < 2; ++n) acc[a][b][m][n] = (f32x4){0.f, 0.f, 0.f, 0.f};
        cur = nxt; cA = nA; cB = nB; ++ui;
    }
    PG8_WAIT_V(0);
    if (wr == 0) PG8_BAR;
    PG8_BAR;
    if constexpr (Epi::AFTER_DRAIN) { E.fused(acc, cur, wr, wc, fr, fq, lds, wid, lane); S.done(cur); }
    PG8_STAMP();
    if (STAMP && wid == 0) { stamps[lane] = lane < nts ? (((unsigned long long)(unsigned)ts_hi << 32) | (unsigned)ts_lo) : 0ull;
        if (lane == 62) stamps[62] = rt_entry; if (lane == 63) stamps[63] = (unsigned long long)wall_clock64(); }
#undef PG8_STAMP
#undef PG8_SA
#undef PG8_SB
#undef PG8_STAGE
#undef PG8_LDA
#undef PG8_LDB
#undef PG8_MMA
#undef PG8_WAIT_V
#undef PG8_WAIT_L
#undef PG8_BAR
#undef PG8_SCHED
}
}
#define LAS __attribute__((address_space(3)))
typedef unsigned short bf16;
typedef short bf16x8 __attribute__((ext_vector_type(8)));
typedef short bf16x4 __attribute__((ext_vector_type(4)));
typedef float f32x4 __attribute__((ext_vector_type(4)));
typedef unsigned u32x4 __attribute__((ext_vector_type(4)));
typedef unsigned u32x2 __attribute__((ext_vector_type(2)));
typedef float f32x2_ __attribute__((ext_vector_type(2)));
typedef __bf16 bf16x2n __attribute__((ext_vector_type(2)));
__device__ __forceinline__ unsigned cvt_pk_bf16(float lo, float hi) { const f32x2_ v = {lo, hi}; const bf16x2n b = __builtin_convertvector(v, bf16x2n); return __builtin_bit_cast(unsigned, b); }

constexpr int T_TOK = 32768, SEQ = 8192, DM = 1024, NPROJ = 3840, PROJ_W = 3872;
constexpr float EPS = 1e-6f;
constexpr size_t MiB = 1u << 20;
constexpr size_t WS_CTL = 0;
constexpr size_t WS_WTIN = 1 * MiB;
constexpr size_t WS_WTOUT = 9 * MiB;
constexpr size_t WS_W1FK = 11 * MiB + 256 * 1024;
constexpr size_t WS_W1FV = 11 * MiB + 768 * 1024;
constexpr size_t WS_W2FK = 12 * MiB + 256 * 1024;
constexpr size_t WS_W2FV = 12 * MiB + 288 * 1024;
constexpr size_t WS_CPE = 12 * MiB + 320 * 1024;
constexpr size_t WS_BT = 12 * MiB + 384 * 1024;
constexpr size_t WS_RS = 13 * MiB;
constexpr size_t WS_SMALL = 14 * MiB;
constexpr size_t WS_XB = 32 * MiB;
constexpr size_t WS_MIX = 32 * MiB;
constexpr size_t WS_GQKV = 96 * MiB;
constexpr size_t WS_GZ = 192 * MiB;
constexpr size_t WS_NQ = 224 * MiB;
constexpr size_t WS_NKV = 256 * MiB;
constexpr size_t WS_NZ = 304 * MiB;
constexpr size_t WS_GREC = 336 * MiB;
constexpr size_t GREC_BYTES = 73728;
constexpr size_t WS_KCMP = 480 * MiB;
constexpr size_t WS_VCMPT = 480 * MiB + 512 * 1024;
constexpr size_t WS_VST = 482 * MiB;
constexpr size_t WS_VWT = 490 * MiB;
constexpr size_t WS_GLAST = 498 * MiB;
constexpr size_t WS_END = 499 * MiB;
constexpr int LDS_BYTES = 158720;

__device__ __forceinline__ float bf2f(unsigned short h) { return __uint_as_float((unsigned)h << 16); }
__device__ __forceinline__ unsigned short f2bf(float f) { return (unsigned short)(cvt_pk_bf16(f, 0.f) & 0xffffu); }
__device__ __forceinline__ float sigmoidf_(float v) { return 1.0f / (1.0f + __expf(-v)); }
__device__ __forceinline__ float siluf_(float v) { return v / (1.0f + __expf(-v)); }
__device__ __forceinline__ f32x4 mfma16(bf16x8 a, bf16x8 b, f32x4 c) { return __builtin_amdgcn_mfma_f32_16x16x32_bf16(a, b, c, 0, 0, 0); }
__device__ __forceinline__ int kperm(int g, int j) { return j < 4 ? 4 * g + j : 16 + 4 * g + (j - 4); }

struct Frame {
    const float* in[16]; float* out; unsigned char* ws; LAS unsigned char* lds; unsigned char* ldsg;
    int tid, lane, wave;
};

struct EpiProj {
    static constexpr bool PERM = true, AFTER_DRAIN = false;
    bf16* gqkv; bf16* gz; bf16* nq; bf16* nkv; bf16* nz; const float* rs;
    __device__ __forceinline__ void operator()(const f32x4 (&acc)[2][2][4][2], const pg8::Unit& u, int wr, int wc, int fr, int fq) const {
        const int pn = u.pn; bf16* base; int ldc, colt, act;
        if (pn < 6) { base = gqkv; ldc = 1536; colt = pn * 256; act = 0; }
        else if (pn < 8) { base = gz; ldc = 512; colt = (pn - 6) * 256; act = 1; }
        else if (pn < 10) { base = nq; ldc = 512; colt = (pn - 8) * 256; act = 2; }
        else if (pn < 13) { base = nkv; ldc = 768; colt = (pn - 10) * 256; act = 0; }
        else { base = nz; ldc = 512; colt = (pn - 13) * 256; act = 1; }
        const int row0 = u.pm * 256 + wr * 64 + fr, col0 = colt + wc * 32 + 8 * fq;
#pragma unroll
        for (int ai = 0; ai < 2; ++ai)
#pragma unroll
            for (int m = 0; m < 4; ++m) {
                const int row = row0 + ai * 128 + m * 16; const float r = rs[row];
                bf16* rowp = base + (size_t)row * ldc + col0;
#pragma unroll
                for (int bj = 0; bj < 2; ++bj) {
                    f32x4 v0 = acc[ai][bj][m][0] * r, v1 = acc[ai][bj][m][1] * r;
                    if (act == 1) {
#pragma unroll
                        for (int j = 0; j < 4; ++j) { v0[j] = siluf_(v0[j]); v1[j] = siluf_(v1[j]); }
                    } else if (act == 2) { v0 = v0 * 0.18033688011112042f; v1 = v1 * 0.18033688011112042f; }
                    u32x4 w; w.x = cvt_pk_bf16(v0[0], v0[1]); w.y = cvt_pk_bf16(v0[2], v0[3]); w.z = cvt_pk_bf16(v1[0], v1[1]); w.w = cvt_pk_bf16(v1[2], v1[3]);
                    *(u32x4*)(rowp + bj * 128) = w;
                }
            }
    }
};
struct EpiOut {
    static constexpr bool PERM = false, AFTER_DRAIN = false;
    const float* x; float* out;
    __device__ __forceinline__ void operator()(const f32x4 (&acc)[2][2][4][2], const pg8::Unit& u, int wr, int wc, int fr, int fq) const {
        const int row0 = u.pm * 256 + wr * 64 + fr, col0 = u.pn * 256 + wc * 32 + 4 * fq;
#pragma unroll
        for (int ai = 0; ai < 2; ++ai)
#pragma unroll
            for (int m = 0; m < 4; ++m) {
                const size_t ro = (size_t)(row0 + ai * 128 + m * 16) * DM + col0;
#pragma unroll
                for (int bj = 0; bj < 2; ++bj)
#pragma unroll
                    for (int n = 0; n < 2; ++n) {
                        const f32x4 xv = *(const f32x4*)(x + ro + bj * 128 + n * 16);
                        *(f32x4*)(out + ro + bj * 128 + n * 16) = acc[ai][bj][m][n] + xv;
                    }
            }
    }
};

__device__ __forceinline__ int orig_col(int n) {
    return n < 2048 ? n : (n < 2560 ? 2056 + (n - 2048) : (n < 3328 ? 2568 + (n - 2560) : 3360 + (n - 3328)));
}
__device__ __forceinline__ int orig_small(int sc) { return sc < 8 ? 2048 + sc : 3336 + (sc - 8); }
__device__ __forceinline__ int rel_bucket(int dist) {
    const int n = dist < 0 ? 0 : dist;
    if (n < 16) return n;
    int b = 16;
    b += (n >= 21); b += (n >= 27); b += (n >= 35); b += (n >= 46); b += (n >= 59); b += (n >= 77); b += (n >= 99); b += (n >= 128);
    b += (n >= 166); b += (n >= 216); b += (n >= 280); b += (n >= 363); b += (n >= 470); b += (n >= 609); b += (n >= 790);
    return b;
}
__device__ __forceinline__ void transpose_tile(const Frame& F, const float* src, int sld, int srccol0, int k0, const float* scale, bf16* dst, int dld, int n0) {
    LAS float* tile = (LAS float*)F.lds;
    const int kk = F.tid >> 6, nn = F.tid & 63;
#pragma unroll
    for (int i = 0; i < 8; ++i) { const int k = kk + 8 * i; float v = src[(size_t)(k0 + k) * sld + srccol0 + nn]; if (scale) v *= scale[k0 + k]; tile[k * 65 + nn] = v; }
    __syncthreads();
    const int n2 = F.tid >> 3, kc = F.tid & 7;
    float e[8];
#pragma unroll
    for (int j = 0; j < 8; ++j) e[j] = tile[(8 * kc + j) * 65 + n2];
    u32x4 w; w.x = cvt_pk_bf16(e[0], e[1]); w.y = cvt_pk_bf16(e[2], e[3]); w.z = cvt_pk_bf16(e[4], e[5]); w.w = cvt_pk_bf16(e[6], e[7]);
    *(u32x4*)(dst + (size_t)(n0 + n2) * dld + k0 + 8 * kc) = w;
    __syncthreads();
}

__device__ __forceinline__ void p0_prep(const Frame& F) {
    const float* x = F.in[0]; const float* nw = F.in[1]; const float* w_in = F.in[2];
    unsigned char* ws = F.ws;
    const int G = gridDim.x, bid = blockIdx.x;
    for (int task = bid; task < 1365; task += G) {
        if (task < 960) { const int nt = task / 16, kt = task % 16; transpose_tile(F, w_in, PROJ_W, orig_col(nt * 64), kt * 64, nw, (bf16*)(ws + WS_WTIN), DM, nt * 64); }
        else if (task < 1216) { const int t2 = task - 960, nt = t2 / 16, kt = t2 % 16; transpose_tile(F, F.in[13], DM, nt * 64, kt * 64, nullptr, (bf16*)(ws + WS_WTOUT), DM, nt * 64); }
        else if (task < 1344) {
            const int t2 = task - 1216, which = t2 >> 6, sub = t2 & 63;
            const float* w1 = F.in[which ? 11 : 9]; bf16* dst = (bf16*)(ws + (which ? WS_W1FV : WS_W1FK));
            const int mt = F.tid >> 6, l = F.tid & 63, m = l & 15, kg = l >> 4, ks = sub;
            float e[8];
#pragma unroll
            for (int j = 0; j < 8; ++j) e[j] = w1[(size_t)(32 * ks + 8 * kg + j) * 128 + 16 * mt + m];
            u32x4 w; w.x = cvt_pk_bf16(e[0], e[1]); w.y = cvt_pk_bf16(e[2], e[3]); w.z = cvt_pk_bf16(e[4], e[5]); w.w = cvt_pk_bf16(e[6], e[7]);
            *(u32x4*)(dst + ((size_t)(ks * 8 + mt) * 64 + l) * 8) = w;
        } else if (task < 1346) {
            const int which = task - 1344; const float* w2 = F.in[which ? 12 : 10]; bf16* dst = (bf16*)(ws + (which ? WS_W2FV : WS_W2FK));
            for (int i = F.tid; i < 1024; i += 512) {
                const int l = i & 63, ks = (i >> 6) & 3, mt = i >> 8, m = l & 15, kg = l >> 4;
                float e[8];
#pragma unroll
                for (int j = 0; j < 8; ++j) e[j] = w2[(size_t)(32 * ks + kperm(kg, j)) * 64 + 16 * mt + m];
                u32x4 w; w.x = cvt_pk_bf16(e[0], e[1]); w.y = cvt_pk_bf16(e[2], e[3]); w.z = cvt_pk_bf16(e[4], e[5]); w.w = cvt_pk_bf16(e[6], e[7]);
                *(u32x4*)(dst + (size_t)i * 8) = w;
            }
        } else if (task < 1348) {
            const int which = task - 1346; const float* pe = F.in[which ? 8 : 7]; const float* w1 = F.in[which ? 11 : 9];
            float* dst = (float*)(ws + WS_CPE) + which * 128;
            if (F.tid < 128) { float s = 0.f; for (int k = 0; k < 2048; ++k) s += pe[k] * w1[(size_t)k * 128 + F.tid]; dst[F.tid] = s; }
        } else {
            const int i = (task - 1348) * 512 + F.tid;
            if (i < 8 * 1025) { const int head = i / 1025, dist = i % 1025; ((float*)(ws + WS_BT))[i] = F.in[14][rel_bucket(dist) * 8 + head] * 1.4426950408889634f; }
        }
    }
    __syncthreads();
    {
        for (int i = F.tid; i < 32 * 2 * 64; i += 512) {
            const int l = i & 63, nt = (i >> 6) & 1, ks = i >> 7, kg = l >> 4, sc = 16 * nt + (l & 15), oc = orig_small(sc);
            float v[8], lo[8]; unsigned short hi[8];
#pragma unroll
            for (int j = 0; j < 8; ++j) { const int k = 32 * ks + 8 * kg + j; v[j] = w_in[(size_t)k * PROJ_W + oc] * nw[k]; hi[j] = f2bf(v[j]); lo[j] = v[j] - bf2f(hi[j]); }
            u32x4 wh, wl;
            wh.x = hi[0] | ((unsigned)hi[1] << 16); wh.y = hi[2] | ((unsigned)hi[3] << 16); wh.z = hi[4] | ((unsigned)hi[5] << 16); wh.w = hi[6] | ((unsigned)hi[7] << 16);
            wl.x = cvt_pk_bf16(lo[0], lo[1]); wl.y = cvt_pk_bf16(lo[2], lo[3]); wl.z = cvt_pk_bf16(lo[4], lo[5]); wl.w = cvt_pk_bf16(lo[6], lo[7]);
            *(LAS u32x4*)(F.lds + ((size_t)((ks * 2 + nt) * 2 + 0) * 64 + l) * 16) = wh;
            *(LAS u32x4*)(F.lds + ((size_t)((ks * 2 + nt) * 2 + 1) * 64 + l) * 16) = wl;
        }
    }
    __syncthreads();
    bf16* xb = (bf16*)(ws + WS_XB); float* rsv = (float*)(ws + WS_RS); float* small = (float*)(ws + WS_SMALL);
    const float* a_log = F.in[4]; const float* dt_bias = F.in[5];
    for (int tile = bid * 8 + F.wave; tile < T_TOK / 16; tile += G * 8) {
        const int l = F.lane, r = l & 15, kg = l >> 4; const int row = tile * 16 + r;
        const float* xr = x + (size_t)row * DM + 8 * kg;
        f32x4 acc0 = {0.f, 0.f, 0.f, 0.f}, acc1 = {0.f, 0.f, 0.f, 0.f};
        float ss = 0.f;
#pragma unroll 4
        for (int ks = 0; ks < 32; ++ks) {
            const f32x4 a0 = *(const f32x4*)(xr + 32 * ks), a1 = *(const f32x4*)(xr + 32 * ks + 4);
            ss += a0[0] * a0[0] + a0[1] * a0[1] + a0[2] * a0[2] + a0[3] * a0[3] + a1[0] * a1[0] + a1[1] * a1[1] + a1[2] * a1[2] + a1[3] * a1[3];
            u32x4 h; h.x = cvt_pk_bf16(a0[0], a0[1]); h.y = cvt_pk_bf16(a0[2], a0[3]); h.z = cvt_pk_bf16(a1[0], a1[1]); h.w = cvt_pk_bf16(a1[2], a1[3]);
            *(u32x4*)(xb + (size_t)row * DM + 32 * ks + 8 * kg) = h;
            u32x4 lo;
            lo.x = cvt_pk_bf16(a0[0] - __uint_as_float(h.x << 16), a0[1] - __uint_as_float(h.x & 0xffff0000u));
            lo.y = cvt_pk_bf16(a0[2] - __uint_as_float(h.y << 16), a0[3] - __uint_as_float(h.y & 0xffff0000u));
            lo.z = cvt_pk_bf16(a1[0] - __uint_as_float(h.z << 16), a1[1] - __uint_as_float(h.z & 0xffff0000u));
            lo.w = cvt_pk_bf16(a1[2] - __uint_as_float(h.w << 16), a1[3] - __uint_as_float(h.w & 0xffff0000u));
            const bf16x8 ah = __builtin_bit_cast(bf16x8, h), al = __builtin_bit_cast(bf16x8, lo);
            const LAS unsigned char* fb = F.lds + (size_t)(ks * 4) * 1024 + l * 16;
            const bf16x8 b0h = *(const LAS bf16x8*)(fb), b0l = *(const LAS bf16x8*)(fb + 1024), b1h = *(const LAS bf16x8*)(fb + 2048), b1l = *(const LAS bf16x8*)(fb + 3072);
            acc0 = mfma16(ah, b0h, acc0); acc0 = mfma16(al, b0h, acc0); acc0 = mfma16(ah, b0l, acc0);
            acc1 = mfma16(ah, b1h, acc1); acc1 = mfma16(al, b1h, acc1); acc1 = mfma16(ah, b1l, acc1);
        }
        ss += __shfl_xor(ss, 16); ss += __shfl_xor(ss, 32);
        const float rs = rsqrtf(ss * (1.0f / 1024.f) + EPS);
        if (kg == 0) rsv[row] = rs;
#pragma unroll
        for (int reg = 0; reg < 4; ++reg) {
            const int rr = 4 * kg + reg; const float rsr = __shfl(rs, rr);
            const int orow = tile * 16 + rr;
            {
                const float v = acc0[reg] * rsr; const int c = r; float o;
                if (c < 4) o = sigmoidf_(v);
                else if (c < 8) { const int h = c - 4; const float z = v + dt_bias[h]; const float sp = z > 20.f ? z : log1pf(expf(z)); o = -expf(a_log[h]) * sp; }
                else o = sigmoidf_(v);
                small[(size_t)orow * 32 + c] = o;
            }
            { const float v = acc1[reg] * rsr; small[(size_t)orow * 32 + 16 + r] = sigmoidf_(v); }
        }
    }
}

__device__ __forceinline__ void p5_final(const Frame& F) {
    const float* fw = F.in[15]; float* out = F.out;
    for (int r = blockIdx.x * 8 + F.wave; r < T_TOK; r += gridDim.x * 8) {
        f32x4* orow = (f32x4*)(out + (size_t)r * DM);
        f32x4 v[4]; float ss = 0.f;
#pragma unroll
        for (int i = 0; i < 4; ++i) { v[i] = orow[F.lane + 64 * i]; ss += v[i][0] * v[i][0] + v[i][1] * v[i][1] + v[i][2] * v[i][2] + v[i][3] * v[i][3]; }
#pragma unroll
        for (int o = 32; o > 0; o >>= 1) ss += __shfl_xor(ss, o);
        const float rs = rsqrtf(ss * (1.0f / 1024.f) + EPS);
#pragma unroll
        for (int i = 0; i < 4; ++i) { const f32x4 w = ((const f32x4*)fw)[F.lane + 64 * i]; orow[F.lane + 64 * i] = v[i] * rs * w; }
    }
}
#ifndef G_CONV
#define G_CONV 0
#endif
#ifndef G_MFMA
#define G_MFMA 0
#endif
#ifndef G_FRAG
#define G_FRAG 0
#endif
#ifndef G_OUT
#define G_OUT 0
#endif
__device__ __forceinline__ float dppf(float x, int ctrl_unused) { return x; }
#define DPP_F(x, CTRL, RM) __builtin_bit_cast(float, __builtin_amdgcn_update_dpp(0, __builtin_bit_cast(int, (x)), CTRL, RM, 0xf, true))
__device__ __forceinline__ float row16_sum(float x) {
    x += DPP_F(x, 0xB1, 0xf); x += DPP_F(x, 0x4E, 0xf); x += DPP_F(x, 0x141, 0xf); x += DPP_F(x, 0x140, 0xf); return x;
}
__device__ __forceinline__ float wave_prefix_sum(float v) {
    v += DPP_F(v, 0x111, 0xf); v += DPP_F(v, 0x112, 0xf); v += DPP_F(v, 0x114, 0xf); v += DPP_F(v, 0x118, 0xf);
    v += DPP_F(v, 0x142, 0xa); v += DPP_F(v, 0x143, 0xc); return v;
}
constexpr int GL_CW = 148224;
constexpr int REC_WNEG = 0, REC_QDEC = 16384, REC_ATTN = 32768, REC_KDT = 40960, REC_U = 57344, REC_LDS_BYTES = 57344;
__device__ __forceinline__ void gdn_prep_item(const Frame& F, int item) {
    int tid_ = F.tid; asm volatile("" : "+v"(tid_));
    const int tid = tid_;
    const int h = item & 3, n = (item >> 2) & 127, b = item >> 9;
    const int tok0 = b * SEQ + n * 64;
    LAS float* kf = (LAS float*)(F.lds); LAS float* vf = (LAS float*)(F.lds + 32768);
    LAS bf16* qb = (LAS bf16*)(F.lds + 65536); LAS bf16* kb = (LAS bf16*)(F.lds + 82944); LAS bf16* kbb = (LAS bf16*)(F.lds + 100352);
    LAS float* Lm = (LAS float*)(F.lds + 117760); LAS bf16* atb = (LAS bf16*)(F.lds + 134144); LAS float* gcs = (LAS float*)(F.lds + 143360);
    LAS float* tinv = (LAS float*)(F.lds + 144128);
    unsigned char* rec = F.ws + WS_GREC + (size_t)item * GREC_BYTES;
    const float* small = (const float*)(F.ws + WS_SMALL);
    {
        const int ln = tid & 63;
        const float beta = small[(size_t)(tok0 + ln) * 32 + h]; float c = small[(size_t)(tok0 + ln) * 32 + 4 + h];
        c = wave_prefix_sum(c);
        gcs[ln] = c; gcs[64 + ln] = beta; gcs[128 + ln] = expf(c);
        if (tid == 63) ((float*)(F.ws + WS_GLAST))[item] = expf(c);
    }
    for (int d1 = 0; d1 <= G_CONV; ++d1)
    {
        const bf16* gq = (const bf16*)(F.ws + WS_GQKV); const float* cw = F.in[3];
        const int grp = tid >> 4, li = tid & 15;
#pragma unroll
        for (int rr = 0; rr < 2; ++rr) {
            const int c = grp * 2 + rr, pos = n * 64 + c;
            const float betav = gcs[64 + c], egv = gcs[128 + c];
#pragma unroll
            for (int part = 0; part < 3; ++part) {
                const int ch = part * 512 + h * 128 + 8 * li;
                float y[8];
#pragma unroll
                for (int e = 0; e < 8; ++e) y[e] = 0.f;
#pragma unroll
                for (int j = 0; j < 4; ++j) {
                    const int p = pos - 3 + j;
                    if (p >= 0) {
                        const u32x4 xv = *(const u32x4*)(gq + (size_t)(b * SEQ + p) * 1536 + ch);
                        const LAS float* cwl = (const LAS float*)(F.lds + GL_CW) + (j * 3 + part) * 128 + 8 * li;
                        const f32x4 w0 = *(const LAS f32x4*)cwl, w1 = *(const LAS f32x4*)(cwl + 4);
                        y[0] += w0[0] * __uint_as_float(xv.x << 16); y[1] += w0[1] * __uint_as_float(xv.x & 0xffff0000u);
                        y[2] += w0[2] * __uint_as_float(xv.y << 16); y[3] += w0[3] * __uint_as_float(xv.y & 0xffff0000u);
                        y[4] += w1[0] * __uint_as_float(xv.z << 16); y[5] += w1[1] * __uint_as_float(xv.z & 0xffff0000u);
                        y[6] += w1[2] * __uint_as_float(xv.w << 16); y[7] += w1[3] * __uint_as_float(xv.w & 0xffff0000u);
                    }
                }
                float ss = 0.f;
#pragma unroll
                for (int e = 0; e < 8; ++e) { y[e] = siluf_(y[e]); ss += y[e] * y[e]; }
                if (part < 2) {
                    ss = row16_sum(ss);
                    const float sc = rsqrtf(ss + EPS) * (part == 0 ? 0.08838834764831845f : 1.0f);
#pragma unroll
                    for (int e = 0; e < 8; ++e) y[e] *= sc;
                }
                if (part == 0) {
                    u32x4 w; w.x = cvt_pk_bf16(y[0], y[1]); w.y = cvt_pk_bf16(y[2], y[3]); w.z = cvt_pk_bf16(y[4], y[5]); w.w = cvt_pk_bf16(y[6], y[7]);
                    *(LAS u32x4*)(qb + c * 136 + 8 * li) = w;
                    const int mt = c >> 4, m = c & 15, ks = li >> 2, a = (li & 3) >> 1, g0 = (2 * (li & 3)) & 3, g1 = (2 * (li & 3) + 1) & 3;
                    u32x2 d0, d1; d0.x = cvt_pk_bf16(y[0] * egv, y[1] * egv); d0.y = cvt_pk_bf16(y[2] * egv, y[3] * egv); d1.x = cvt_pk_bf16(y[4] * egv, y[5] * egv); d1.y = cvt_pk_bf16(y[6] * egv, y[7] * egv);
                    unsigned char* fb = rec + REC_QDEC + (size_t)(mt * 4 + ks) * 1024 + a * 8;
                    *(u32x2*)(fb + (g0 * 16 + m) * 16) = d0; *(u32x2*)(fb + (g1 * 16 + m) * 16) = d1;
                } else if (part == 1) {
                    *(LAS f32x4*)(kf + c * 128 + 8 * li) = (f32x4){y[0], y[1], y[2], y[3]}; *(LAS f32x4*)(kf + c * 128 + 8 * li + 4) = (f32x4){y[4], y[5], y[6], y[7]};
                    u32x4 w; w.x = cvt_pk_bf16(y[0], y[1]); w.y = cvt_pk_bf16(y[2], y[3]); w.z = cvt_pk_bf16(y[4], y[5]); w.w = cvt_pk_bf16(y[6], y[7]);
                    *(LAS u32x4*)(kb + c * 136 + 8 * li) = w;
                    w.x = cvt_pk_bf16(y[0] * betav, y[1] * betav); w.y = cvt_pk_bf16(y[2] * betav, y[3] * betav); w.z = cvt_pk_bf16(y[4] * betav, y[5] * betav); w.w = cvt_pk_bf16(y[6] * betav, y[7] * betav);
                    *(LAS u32x4*)(kbb + c * 136 + 8 * li) = w;
                } else {
                    *(LAS f32x4*)(vf + c * 128 + 8 * li) = (f32x4){y[0], y[1], y[2], y[3]}; *(LAS f32x4*)(vf + c * 128 + 8 * li + 4) = (f32x4){y[4], y[5], y[6], y[7]};
                }
            }
        }
    }
    __syncthreads();
    for (int d2 = 0; d2 <= G_MFMA; ++d2)
    {
        const int l = (tid & 63), m = l & 15, kg = l >> 4;
#pragma unroll
        for (int i = 0; i < 4; ++i) {
            const int tt = F.wave * 4 + i, which = tt >> 4, mi = (tt >> 2) & 3, ni = tt & 3;
            f32x4 acc = {0.f, 0.f, 0.f, 0.f};
            if (mi >= ni) {
                const LAS bf16* As = which ? qb : kbb;
#pragma unroll
                for (int ks = 0; ks < 4; ++ks) {
                    const bf16x8 a = *(const LAS bf16x8*)(As + (16 * mi + m) * 136 + 32 * ks + 8 * kg);
                    const bf16x8 bb = *(const LAS bf16x8*)(kb + (16 * ni + m) * 136 + 32 * ks + 8 * kg);
                    acc = mfma16(a, bb, acc);
                }
            }
#pragma unroll
            for (int r = 0; r < 4; ++r) {
                const int irow = 16 * mi + 4 * kg + r, jcol = 16 * ni + m;
                const float dec = (irow >= jcol) ? expf(gcs[irow] - gcs[jcol]) : 0.f;
                if (which == 0) Lm[jcol * 64 + irow] = (irow > jcol) ? acc[r] * dec : 0.f;
                else atb[irow * 72 + jcol] = f2bf((irow >= jcol) ? acc[r] * dec : 0.f);
            }
        }
    }
    __syncthreads();
    for (int d3 = 0; d3 <= G_FRAG; ++d3) {
    if (tid < 64) {
        const int ib = tid >> 4, c = tid & 15;
        float x[16];
#pragma unroll
        for (int i = 0; i < 16; ++i) x[i] = (i == c) ? 1.0f : 0.0f;
#pragma unroll
        for (int j = 0; j < 15; ++j) {
            const LAS f32x4* lp = (const LAS f32x4*)(Lm + (16 * ib + j) * 64 + 16 * ib);
#pragma unroll
            for (int q4 = 0; q4 < 4; ++q4) {
                if (4 * q4 + 3 > j) {
                    const f32x4 lv = lp[q4];
#pragma unroll
                    for (int e = 0; e < 4; ++e) if (4 * q4 + e > j) x[4 * q4 + e] -= lv[e] * x[j];
                }
            }
            asm volatile("" ::: "memory");
        }
#pragma unroll
        for (int i = 0; i < 16; ++i) tinv[(ib * 16 + c) * 16 + i] = x[i];
    }
    {
        const float gl = gcs[63];
#pragma unroll
        for (int q = 0; q < 2; ++q) {
            const int idx = tid + 512 * q, l = idx & 63, ks = (idx >> 6) & 1, mt = idx >> 7, m = l & 15, g = l >> 4;
            float e[8];
#pragma unroll
            for (int j = 0; j < 8; ++j) { const int cr = 32 * ks + kperm(g, j); e[j] = kf[cr * 128 + 16 * mt + m] * expf(gl - gcs[cr]); }
            u32x4 w; w.x = cvt_pk_bf16(e[0], e[1]); w.y = cvt_pk_bf16(e[2], e[3]); w.z = cvt_pk_bf16(e[4], e[5]); w.w = cvt_pk_bf16(e[6], e[7]);
            *(u32x4*)(rec + REC_KDT + (size_t)idx * 16) = w;
        }
        {
            const int idx = tid, l = idx & 63, ks = (idx >> 6) & 1, mt = idx >> 7, m = l & 15, g = l >> 4;
            const u32x2 a0 = *(const LAS u32x2*)(atb + (16 * mt + m) * 72 + 32 * ks + 4 * g), a1 = *(const LAS u32x2*)(atb + (16 * mt + m) * 72 + 32 * ks + 16 + 4 * g);
            *(u32x4*)(rec + REC_ATTN + (size_t)idx * 16) = (u32x4){a0.x, a0.y, a1.x, a1.y};
        }
    }
    }
    __syncthreads();
    {
        const int l = (tid & 63), li = l & 15, lk = l >> 4, w = F.wave; const bool isw = w >= 4;
        LAS float* base = isw ? (kf + 32 * (w - 4)) : (vf + 32 * w);
#pragma unroll
        for (int ib = 0; ib < 4; ++ib) {
            f32x4 acc[2];
#pragma unroll
            for (int nt = 0; nt < 2; ++nt)
#pragma unroll
                for (int r = 0; r < 4; ++r) { const int i = 16 * ib + 4 * lk + r; acc[nt][r] = base[i * 128 + 16 * nt + li] * gcs[64 + i] * (isw ? gcs[128 + i] : 1.0f); }
#pragma unroll
            for (int kk = 0; kk < 4 * ib; ++kk) {
                const float av = -Lm[(4 * kk + lk) * 64 + 16 * ib + li];
                acc[0] = __builtin_amdgcn_mfma_f32_16x16x4f32(av, base[(4 * kk + lk) * 128 + li], acc[0], 0, 0, 0);
                acc[1] = __builtin_amdgcn_mfma_f32_16x16x4f32(av, base[(4 * kk + lk) * 128 + 16 + li], acc[1], 0, 0, 0);
            }
#pragma unroll
            for (int nt = 0; nt < 2; ++nt)
#pragma unroll
                for (int r = 0; r < 4; ++r) base[(16 * ib + 4 * lk + r) * 128 + 16 * nt + li] = acc[nt][r];
            f32x4 y[2] = {(f32x4){0.f, 0.f, 0.f, 0.f}, (f32x4){0.f, 0.f, 0.f, 0.f}};
#pragma unroll
            for (int kk = 0; kk < 4; ++kk) {
                const float av = tinv[(ib * 16 + 4 * kk + lk) * 16 + li];
                y[0] = __builtin_amdgcn_mfma_f32_16x16x4f32(av, base[(16 * ib + 4 * kk + lk) * 128 + li], y[0], 0, 0, 0);
                y[1] = __builtin_amdgcn_mfma_f32_16x16x4f32(av, base[(16 * ib + 4 * kk + lk) * 128 + 16 + li], y[1], 0, 0, 0);
            }
#pragma unroll
            for (int nt = 0; nt < 2; ++nt)
#pragma unroll
                for (int r = 0; r < 4; ++r) base[(16 * ib + 4 * lk + r) * 128 + 16 * nt + li] = y[nt][r];
        }
    }
    __syncthreads();
    for (int d4 = 0; d4 <= G_OUT; ++d4)
    {
#pragma unroll
        for (int q = 0; q < 4; ++q) {
            const int idx = tid + 512 * q, l = idx & 63, mt = (idx >> 6) & 3, sl = idx >> 8, g4 = l >> 4, nn = l & 15;
            const LAS float* up = vf + (16 * mt + 4 * g4) * 128 + 16 * sl + nn;
            u32x2 d; d.x = cvt_pk_bf16(up[0], up[128]); d.y = cvt_pk_bf16(up[256], up[384]);
            *(u32x2*)(rec + REC_U + (size_t)idx * 8) = d;
        }
#pragma unroll
        for (int q = 0; q < 2; ++q) {
            const int idx = tid + 512 * q, l = idx & 63, ks = (idx >> 6) & 3, mt = idx >> 8, m = l & 15, g = l >> 4;
            const f32x4 a0 = *(const LAS f32x4*)(kf + (16 * mt + m) * 128 + 32 * ks + 4 * g), a1 = *(const LAS f32x4*)(kf + (16 * mt + m) * 128 + 32 * ks + 16 + 4 * g);
            u32x4 w; w.x = cvt_pk_bf16(-a0[0], -a0[1]); w.y = cvt_pk_bf16(-a0[2], -a0[3]); w.z = cvt_pk_bf16(-a1[0], -a1[1]); w.w = cvt_pk_bf16(-a1[2], -a1[3]);
            *(u32x4*)(rec + REC_WNEG + (size_t)idx * 16) = w;
        }
    }
    __syncthreads();
}

__device__ __forceinline__ bf16x8 acc2frag(const f32x4& lo, const f32x4& hi) {
    u32x4 w; w.x = cvt_pk_bf16(lo[0], lo[1]); w.y = cvt_pk_bf16(lo[2], lo[3]); w.z = cvt_pk_bf16(hi[0], hi[1]); w.w = cvt_pk_bf16(hi[2], hi[3]);
    return __builtin_bit_cast(bf16x8, w);
}
__device__ __forceinline__ void gdn_scan(const Frame& F, int bh) {
    const int tid = F.tid, lane = F.lane, s = F.wave;
    const int b = bh >> 2, h = bh & 3;
    LAS unsigned char* buf0 = F.lds; LAS float* ox = (LAS float*)(F.lds + 2 * REC_LDS_BYTES);
    const float* glast = (const float*)(F.ws + WS_GLAST);
    const bf16* gz = (const bf16*)(F.ws + WS_GZ); const float* gnw = F.in[6]; bf16* mix = (bf16*)(F.ws + WS_MIX);
    f32x4 S[8];
#pragma unroll
    for (int t = 0; t < 8; ++t) S[t] = (f32x4){0.f, 0.f, 0.f, 0.f};
    const unsigned char* const recbase = F.ws + WS_GREC + (size_t)(b * 512 + h) * GREC_BYTES;
#define recp(n) (recbase + (size_t)(n) * 4 * GREC_BYTES)
#define GS_STAGE(n, bufsel) do { const unsigned char* _r = recp(n); _Pragma("unroll") for (int _i = 0; _i < 7; ++_i) \
        __builtin_amdgcn_global_load_lds((const unsigned*)(_r + (size_t)(_i * 512 + tid) * 16), (LAS unsigned*)(buf0 + (bufsel) * REC_LDS_BYTES + (_i * 8 + s) * 1024), 16, 0, 0); } while (0)
    GS_STAGE(0, 0);
    u32x2 un[4];
#pragma unroll
    for (int mt = 0; mt < 4; ++mt) un[mt] = *(const u32x2*)(recp(0) + REC_U + (size_t)((s * 4 + mt) * 64 + lane) * 8);
    float egn = glast[(b * 128 + 0) * 4 + h];
    for (int n = 0; n < 128; ++n) {
        const int cur = n & 1;
        asm volatile("s_waitcnt vmcnt(0)" ::: "memory");
        __syncthreads();
        u32x2 uc[4];
#pragma unroll
        for (int mt = 0; mt < 4; ++mt) uc[mt] = un[mt];
        const float egl = egn;
        if (n + 1 < 128) {
            GS_STAGE(n + 1, cur ^ 1);
#pragma unroll
            for (int mt = 0; mt < 4; ++mt) un[mt] = *(const u32x2*)(recp(n + 1) + REC_U + (size_t)((s * 4 + mt) * 64 + lane) * 8);
            egn = glast[(b * 128 + n + 1) * 4 + h];
        }
        const LAS unsigned char* bp = buf0 + cur * REC_LDS_BYTES + lane * 16;
        bf16x8 Sb[4];
#pragma unroll
        for (int ks = 0; ks < 4; ++ks) Sb[ks] = acc2frag(S[2 * ks], S[2 * ks + 1]);
        f32x4 vn[4], o[4];
#pragma unroll
        for (int mt = 0; mt < 4; ++mt) {
            vn[mt] = (f32x4){__uint_as_float(uc[mt].x << 16), __uint_as_float(uc[mt].x & 0xffff0000u), __uint_as_float(uc[mt].y << 16), __uint_as_float(uc[mt].y & 0xffff0000u)};
#pragma unroll
            for (int ks = 0; ks < 4; ++ks) vn[mt] = mfma16(*(const LAS bf16x8*)(bp + REC_WNEG + (mt * 4 + ks) * 1024), Sb[ks], vn[mt]);
        }
        bf16x8 Vb[2];
#pragma unroll
        for (int ks = 0; ks < 2; ++ks) Vb[ks] = acc2frag(vn[2 * ks], vn[2 * ks + 1]);
#pragma unroll
        for (int mt = 0; mt < 4; ++mt) {
            o[mt] = (f32x4){0.f, 0.f, 0.f, 0.f};
#pragma unroll
            for (int ks = 0; ks < 4; ++ks) o[mt] = mfma16(*(const LAS bf16x8*)(bp + REC_QDEC + (mt * 4 + ks) * 1024), Sb[ks], o[mt]);
#pragma unroll
            for (int ks = 0; ks < 2; ++ks) o[mt] = mfma16(*(const LAS bf16x8*)(bp + REC_ATTN + (mt * 2 + ks) * 1024), Vb[ks], o[mt]);
        }
#pragma unroll
        for (int t = 0; t < 8; ++t) {
            S[t] = S[t] * egl;
#pragma unroll
            for (int ks = 0; ks < 2; ++ks) S[t] = mfma16(*(const LAS bf16x8*)(bp + REC_KDT + (t * 2 + ks) * 1024), Vb[ks], S[t]);
        }
        {
            const int g4 = lane >> 4, nn = lane & 15;
#pragma unroll
            for (int mt = 0; mt < 4; ++mt)
#pragma unroll
                for (int r = 0; r < 4; ++r) ox[(16 * mt + 4 * g4 + r) * 132 + 16 * s + nn] = o[mt][r];
        }
        __syncthreads();
        {
            const int row = tid >> 3, part = tid & 7; const int tok = b * SEQ + n * 64 + row;
            float v[16]; float ss = 0.f;
#pragma unroll
            for (int q = 0; q < 4; ++q) { const f32x4 t4 = *(const LAS f32x4*)(ox + row * 132 + 16 * part + 4 * q); v[4 * q] = t4[0]; v[4 * q + 1] = t4[1]; v[4 * q + 2] = t4[2]; v[4 * q + 3] = t4[3]; }
#pragma unroll
            for (int e = 0; e < 16; ++e) ss += v[e] * v[e];
            ss += __shfl_xor(ss, 1); ss += __shfl_xor(ss, 2); ss += __shfl_xor(ss, 4);
            const float rs = rsqrtf(ss * (1.0f / 128.f) + EPS);
            const u32x4 z0 = *(const u32x4*)(gz + (size_t)tok * 512 + h * 128 + 16 * part), z1 = *(const u32x4*)(gz + (size_t)tok * 512 + h * 128 + 16 * part + 8);
            const unsigned zz[8] = {z0.x, z0.y, z0.z, z0.w, z1.x, z1.y, z1.z, z1.w};
            unsigned ow[8];
#pragma unroll
            for (int e = 0; e < 8; ++e) {
                const float w0 = gnw[16 * part + 2 * e], w1 = gnw[16 * part + 2 * e + 1];
                ow[e] = cvt_pk_bf16(v[2 * e] * rs * w0 * __uint_as_float(zz[e] << 16), v[2 * e + 1] * rs * w1 * __uint_as_float(zz[e] & 0xffff0000u));
            }
            bf16* mp = mix + (size_t)tok * DM + h * 128 + 16 * part;
            *(u32x4*)mp = (u32x4){ow[0], ow[1], ow[2], ow[3]}; *(u32x4*)(mp + 8) = (u32x4){ow[4], ow[5], ow[6], ow[7]};
        }
    }
#undef GS_STAGE
#undef recp
    asm volatile("s_waitcnt vmcnt(0)" ::: "memory");
    __syncthreads();
}
__device__ __forceinline__ int pos32(int key) { return (key & ~31) | (8 * ((key >> 2) & 3) + 4 * ((key >> 4) & 1) + (key & 3)); }
__device__ __forceinline__ void compress_block(const Frame& F, int task) {
    const int which = task >> 8, bhk = (task >> 5) & 7, rt = task & 31, b = bhk >> 1, hk = bhk & 1;
    int l_ = F.lane; asm volatile("" : "+v"(l_));
    const int l = l_, n = l & 15, kg = l >> 4, w = F.wave;
    const bf16* nkv = (const bf16*)(F.ws + WS_NKV);
    const bf16* w1f = (const bf16*)(F.ws + (which ? WS_W1FV : WS_W1FK)); const bf16* w2f = (const bf16*)(F.ws + (which ? WS_W2FV : WS_W2FK));
    const float* cpe = (const float*)(F.ws + WS_CPE) + which * 128;
    const int nc = 16 * rt + n;
    f32x4 acc[8];
#pragma unroll
    for (int t = 0; t < 8; ++t) acc[t] = (f32x4){0.f, 0.f, 0.f, 0.f};
#pragma unroll 4
    for (int k8 = 0; k8 < 8; ++k8) {
        const int ks = 8 * w + k8;
        int tok = 16 * nc + (ks >> 1); tok = tok < SEQ ? tok : SEQ - 1;
        const bf16x8 bfrag = *(const bf16x8*)(nkv + (size_t)(b * SEQ + tok) * 768 + which * 128 + hk * 64 + (ks & 1) * 32 + 8 * kg);
#pragma unroll
        for (int mt = 0; mt < 8; ++mt) acc[mt] = mfma16(*(const bf16x8*)(w1f + ((size_t)(ks * 8 + mt) * 64 + l) * 8), bfrag, acc[mt]);
    }
    LAS f32x4* part = (LAS f32x4*)F.lds;
    LAS unsigned char* hfrag = F.lds + 65536;
#pragma unroll
    for (int mt = 0; mt < 8; ++mt) part[(w * 8 + mt) * 64 + l] = acc[mt];
    __syncthreads();
    {
        f32x4 h = part[w * 64 + l];
#pragma unroll
        for (int p = 1; p < 8; ++p) h = h + part[(p * 8 + w) * 64 + l];
#pragma unroll
        for (int r = 0; r < 4; ++r) h[r] = siluf_(h[r] + cpe[16 * w + 4 * kg + r]);
        u32x2 d; d.x = cvt_pk_bf16(h[0], h[1]); d.y = cvt_pk_bf16(h[2], h[3]);
        *(LAS u32x2*)(hfrag + ((w >> 1) * 64 + l) * 16 + (w & 1) * 8) = d;
    }
    __syncthreads();
    if (w < 4) {
        f32x4 o = {0.f, 0.f, 0.f, 0.f};
#pragma unroll
        for (int ks = 0; ks < 4; ++ks) o = mfma16(*(const bf16x8*)(w2f + ((size_t)(w * 4 + ks) * 64 + l) * 8), *(const LAS bf16x8*)(hfrag + (ks * 64 + l) * 16), o);
        const bool valid = nc < 511;
        if (which == 0) {
            bf16* kc = (bf16*)(F.ws + WS_KCMP) + ((size_t)bhk * 512 + nc) * 64;
            u32x2 d; d.x = valid ? cvt_pk_bf16(o[0], o[1]) : 0u; d.y = valid ? cvt_pk_bf16(o[2], o[3]) : 0u; *(u32x2*)(kc + 16 * w + 4 * kg) = d;
        } else {
            bf16* vt = (bf16*)(F.ws + WS_VCMPT) + (size_t)bhk * 64 * 512 + pos32(nc);
#pragma unroll
            for (int r = 0; r < 4; ++r) vt[(size_t)(16 * w + 4 * kg + r) * 512] = valid ? f2bf(o[r]) : (unsigned short)0;
        }
    }
    __syncthreads();
}
__device__ __forceinline__ void vtranspose_task(const Frame& F, int task) {
    const int which = task >> 8, bhk = (task >> 5) & 7, tg = task & 31, b = bhk >> 1, hk = bhk & 1;
    const bf16* nkv = (const bf16*)(F.ws + WS_NKV); bf16* dst = (bf16*)(F.ws + (which ? WS_VWT : WS_VST)) + (size_t)bhk * 64 * SEQ;
    LAS bf16* tile = (LAS bf16*)F.lds;
    const int t0 = tg * 256;
#pragma unroll
    for (int sub = 0; sub < 4; ++sub) {
        const int tk = sub * 64 + (F.tid >> 3), dc = F.tid & 7;
        const u32x4 v = *(const u32x4*)(nkv + (size_t)(b * SEQ + t0 + tk) * 768 + 384 + which * 256 + hk * 64 + 8 * dc);
        const unsigned vv[4] = {v.x, v.y, v.z, v.w};
#pragma unroll
        for (int e = 0; e < 4; ++e) { tile[(8 * dc + 2 * e) * 264 + pos32(tk)] = (unsigned short)(vv[e] & 0xffffu); tile[(8 * dc + 2 * e + 1) * 264 + pos32(tk)] = (unsigned short)(vv[e] >> 16); }
    }
    __syncthreads();
#pragma unroll
    for (int sub = 0; sub < 4; ++sub) {
        const int i = sub * 512 + F.tid, d = i >> 5, tc = i & 31;
        *(u32x4*)(dst + (size_t)d * SEQ + t0 + 8 * tc) = *(const LAS u32x4*)(tile + d * 264 + 8 * tc);
    }
    __syncthreads();
}
constexpr int NL_BT = 0, NL_IMP = 18496, NL_MASK = 51776, NL_SMASK = 52800, NL_KV = 53248, NL_NXT = 86016, NL_TOT = 86528;
#ifndef PRB_X1
#define PRB_X1 0
#endif
#ifndef PRB_C2
#define PRB_C2 0
#endif
#ifndef PRB_SETUP
#define PRB_SETUP 0
#endif
#ifndef PRB_SEL
#define PRB_SEL 0
#endif
#ifndef PRB_ALLACT
#define PRB_ALLACT 0
#endif
#ifndef PRB_S
#define PRB_S 0
#endif
#ifndef PRB_W
#define PRB_W 0
#endif
#ifndef PRB_C
#define PRB_C 0
#endif
constexpr int TM_C1 = 0, TM_C2 = 1, TM_SD = 2, TM_SS = 3, TM_W = 4;
#ifndef PRB_DMA
#define PRB_DMA 0
#endif
__device__ __forceinline__ void stage_dma(LAS unsigned char* buf, const bf16* Kb, int kstride, const bf16* VT, int vlen, int key0, int wave, int lane) {
    const int row = wave * 8 + (lane >> 3), ch = (lane & 7) ^ ((lane >> 3) & 7);
#if PRB_DMA
    __builtin_amdgcn_global_load_lds((const unsigned*)(Kb + (size_t)(key0 + row) * kstride + 8 * ch), (LAS unsigned*)(buf + wave * 1024), 16, 0, 0);
    __builtin_amdgcn_global_load_lds((const unsigned*)(VT + (size_t)row * vlen + key0 + 8 * ch), (LAS unsigned*)(buf + 8192 + wave * 1024), 16, 0, 0);
#endif
    __builtin_amdgcn_global_load_lds((const unsigned*)(Kb + (size_t)(key0 + row) * kstride + 8 * ch), (LAS unsigned*)(buf + wave * 1024), 16, 0, 0);
    __builtin_amdgcn_global_load_lds((const unsigned*)(VT + (size_t)row * vlen + key0 + 8 * ch), (LAS unsigned*)(buf + 8192 + wave * 1024), 16, 0, 0);
}
__device__ __forceinline__ void wait_tiles(int newer) {
#if PRB_DMA
    if (newer >= 2) asm volatile("s_waitcnt vmcnt(8)" ::: "memory"); else if (newer == 1) asm volatile("s_waitcnt vmcnt(4)" ::: "memory"); else asm volatile("s_waitcnt vmcnt(0)" ::: "memory");
#else
    if (newer >= 2) asm volatile("s_waitcnt vmcnt(4)" ::: "memory"); else if (newer == 1) asm volatile("s_waitcnt vmcnt(2)" ::: "memory"); else asm volatile("s_waitcnt vmcnt(0)" ::: "memory");
#endif
}
__device__ __forceinline__ bf16x8 tile_frag(const LAS unsigned char* buf, int row, int chunk) { return *(const LAS bf16x8*)(buf + row * 128 + ((chunk ^ (row & 7)) << 4)); }

struct SlotState { f32x4 O[4]; float m, l; };
__device__ __forceinline__ float kg_sum(float x) {
    const unsigned u = __builtin_bit_cast(unsigned, x); const auto r = __builtin_amdgcn_permlane16_swap(u, u, false, false);
    const float y = __builtin_bit_cast(float, (unsigned)r[0]) + __builtin_bit_cast(float, (unsigned)r[1]);
    const unsigned v = __builtin_bit_cast(unsigned, y); const auto q = __builtin_amdgcn_permlane32_swap(v, v, false, false);
    return __builtin_bit_cast(float, (unsigned)q[0]) + __builtin_bit_cast(float, (unsigned)q[1]);
}
__device__ __forceinline__ float kg_max(float x) {
    const unsigned u = __builtin_bit_cast(unsigned, x); const auto r = __builtin_amdgcn_permlane16_swap(u, u, false, false);
    const float y = fmaxf(__builtin_bit_cast(float, (unsigned)r[0]), __builtin_bit_cast(float, (unsigned)r[1]));
    const unsigned v = __builtin_bit_cast(unsigned, y); const auto q = __builtin_amdgcn_permlane32_swap(v, v, false, false);
    return fmaxf(__builtin_bit_cast(float, (unsigned)q[0]), __builtin_bit_cast(float, (unsigned)q[1]));
}

__device__ __forceinline__ void lds_add_f32(LAS float* p, float v) { asm volatile("ds_add_f32 %0, %1" :: "v"((unsigned)(size_t)p), "v"(v) : "memory"); }
__device__ __forceinline__ float quad_sum(float x) {
    x += __builtin_bit_cast(float, __builtin_amdgcn_update_dpp(0, __builtin_bit_cast(int, x), 0xB1, 0xf, 0xf, false));
    x += __builtin_bit_cast(float, __builtin_amdgcn_update_dpp(0, __builtin_bit_cast(int, x), 0x4E, 0xf, 0xf, false));
    return x;
}
constexpr int RT_LEN = 1156, RT_OFF = 1088;
template <int MODE, bool NEARB>
__device__ __forceinline__ void slot_tile(const LAS unsigned char* tb0, const LAS unsigned char* tb1, const bf16x8 (&q)[2], int dbase, const LAS float* rt, SlotState& A,
                                          float linv, float mrow, float bfar, LAS float* imp_row, int key0, int lane, float* carry = nullptr) {
    const int kg = lane >> 4;
    __builtin_amdgcn_sched_barrier(0);
    bf16x8 fr[4][2];
#pragma unroll
    for (int mt = 0; mt < 4; ++mt) { fr[mt][0] = *(const LAS bf16x8*)(tb0 + mt * 2048); fr[mt][1] = *(const LAS bf16x8*)(tb1 + mt * 2048); }
    asm volatile("" : "+v"(fr[0][0]), "+v"(fr[0][1]), "+v"(fr[1][0]), "+v"(fr[1][1]), "+v"(fr[2][0]), "+v"(fr[2][1]), "+v"(fr[3][0]), "+v"(fr[3][1]));
    f32x4 s[4];
#pragma unroll
    for (int mt = 0; mt < 4; ++mt) { s[mt] = mfma16(fr[mt][0], q[0], (f32x4){0.f, 0.f, 0.f, 0.f}); s[mt] = mfma16(fr[mt][1], q[1], s[mt]); }
    if (MODE != TM_C1) {
        __builtin_amdgcn_sched_barrier(0);
#pragma unroll
        for (int t = 0; t < 4; ++t) { fr[t][0] = *(const LAS bf16x8*)(tb0 + 8192 + t * 2048); fr[t][1] = *(const LAS bf16x8*)(tb1 + 8192 + t * 2048); }
        __builtin_amdgcn_sched_barrier(0);
    }
    constexpr bool CMP = (MODE == TM_C1 || MODE == TM_C2);
    if (MODE == TM_SS) {
        if (NEARB) {
            const LAS float* rp = rt + (RT_OFF - dbase);
            f32x4 bv[4];
#pragma unroll
            for (int mt = 0; mt < 4; ++mt)
#pragma unroll
                for (int r = 0; r < 4; ++r) bv[mt][r] = rp[16 * mt + r];
            asm volatile("" : "+v"(bv[0]), "+v"(bv[1]), "+v"(bv[2]), "+v"(bv[3]));
#pragma unroll
            for (int mt = 0; mt < 4; ++mt) s[mt] = s[mt] + bv[mt];
        }
        float ps = 0.f;
#pragma unroll
        for (int mt = 0; mt < 4; ++mt)
#pragma unroll
            for (int r = 0; r < 4; ++r) { const float p = __builtin_amdgcn_exp2f(s[mt][r] - mrow); s[mt][r] = p; ps += p; }
        ps = kg_sum(ps);
        A.l += ps;
    } else {
        float tmax = -1e30f;
        if (NEARB) {
            const LAS float* rp = rt + (RT_OFF - dbase);
            f32x4 bv[4];
#pragma unroll
            for (int mt = 0; mt < 4; ++mt)
#pragma unroll
                for (int r = 0; r < 4; ++r) {
                    const int c = 16 * mt + r;
                    if (CMP) { const int dist = dbase - 16 * c; const int di = dist < 0 ? 0 : (dist > RT_OFF ? RT_OFF : dist); bv[mt][r] = rt[RT_OFF - di]; }
                    else bv[mt][r] = rp[c];
                }
            asm volatile("" : "+v"(bv[0]), "+v"(bv[1]), "+v"(bv[2]), "+v"(bv[3]));
#pragma unroll
            for (int mt = 0; mt < 4; ++mt)
#pragma unroll
                for (int r = 0; r < 4; ++r) {
                    const int c = 16 * mt + r;
                    const int dist = CMP ? dbase - 16 * c : dbase - c;
                    const bool ok = (MODE == TM_W) ? (dist >= 0 && dist < 512) : (dist >= 0);
                    s[mt][r] = ok ? s[mt][r] + bv[mt][r] : -1e30f;
                    tmax = fmaxf(tmax, s[mt][r]);
                }
        } else {
#pragma unroll
            for (int mt = 0; mt < 4; ++mt)
#pragma unroll
                for (int r = 0; r < 4; ++r) { s[mt][r] += bfar; tmax = fmaxf(tmax, s[mt][r]); }
        }
        if (MODE == TM_C2) {
#pragma unroll
            for (int mt = 0; mt < 4; ++mt)
#pragma unroll
                for (int r = 0; r < 4; ++r) s[mt][r] = __builtin_amdgcn_exp2f(s[mt][r] - A.m) * linv;
            const int g = lane & 3;
            float gsum[4], lv[4];
#pragma unroll
            for (int mt = 0; mt < 4; ++mt) { gsum[mt] = quad_sum(s[mt][0] + s[mt][1] + s[mt][2] + s[mt][3]); lv[mt] = quad_sum(s[mt][3]); }
#pragma unroll
            for (int mt = 0; mt < 4; ++mt) {
                const float up = __shfl_up(lv[mt], 16);
                const float wrap = mt > 0 ? __shfl(lv[mt - 1], (lane & 15) + 48) : *carry;
                const float prev = kg > 0 ? up : wrap;
                const int j = (key0 >> 2) + 4 * mt + kg;
                if (g == 0) asm volatile("ds_write_b32 %0, %1" :: "v"((unsigned)(size_t)(imp_row + j)), "v"(gsum[mt] + prev) : "memory");
            }
            *carry = __shfl(lv[3], (lane & 15) + 48);
        } else {
            tmax = kg_max(tmax);
            const float mnew = fmaxf(A.m, tmax), msafe = fmaxf(mnew, -1e29f), alpha = __builtin_amdgcn_exp2f(A.m - msafe);
            float ps = 0.f;
#pragma unroll
            for (int mt = 0; mt < 4; ++mt)
#pragma unroll
                for (int r = 0; r < 4; ++r) { const float p = __builtin_amdgcn_exp2f(s[mt][r] - msafe); s[mt][r] = p; ps += p; }
            ps = kg_sum(ps);
            A.l = A.l * alpha + ps; A.m = mnew;
            if (MODE != TM_C1) {
#pragma unroll
                for (int t = 0; t < 4; ++t) A.O[t] = A.O[t] * alpha;
            }
        }
    }
    if (MODE != TM_C1) {
        bf16x8 pf[2];
#pragma unroll
        for (int k2 = 0; k2 < 2; ++k2) {
            u32x4 w; w.x = cvt_pk_bf16(s[2 * k2][0], s[2 * k2][1]); w.y = cvt_pk_bf16(s[2 * k2][2], s[2 * k2][3]); w.z = cvt_pk_bf16(s[2 * k2 + 1][0], s[2 * k2 + 1][1]); w.w = cvt_pk_bf16(s[2 * k2 + 1][2], s[2 * k2 + 1][3]);
            pf[k2] = __builtin_bit_cast(bf16x8, w);
        }
#pragma unroll
        for (int t = 0; t < 4; ++t) { A.O[t] = mfma16(fr[t][0], pf[0], A.O[t]); A.O[t] = mfma16(fr[t][1], pf[1], A.O[t]); }
    }
}

#define SGB(mask, n) __builtin_amdgcn_sched_group_barrier(mask, n, 0)
template <bool NEARB>
__device__ __forceinline__ void slot_pair_ss(const LAS unsigned char* tb0, const LAS unsigned char* tb1, const bf16x8 (&q0)[2], const bf16x8 (&q1)[2],
                                             int dbase0, int dbase1, const LAS float* rt, SlotState& A0, SlotState& A1, float mrow0, float mrow1) {
    f32x4 s0[4], s1[4];
    __builtin_amdgcn_sched_barrier(0);
    bf16x8 kf[4][2], vf[4][2];
#pragma unroll
    for (int mt = 0; mt < 4; ++mt) { kf[mt][0] = *(const LAS bf16x8*)(tb0 + mt * 2048); kf[mt][1] = *(const LAS bf16x8*)(tb1 + mt * 2048); }
    asm volatile("" : "+v"(kf[0][0]), "+v"(kf[0][1]), "+v"(kf[1][0]), "+v"(kf[1][1]), "+v"(kf[2][0]), "+v"(kf[2][1]), "+v"(kf[3][0]), "+v"(kf[3][1]));
#pragma unroll
    for (int mt = 0; mt < 4; ++mt) { s0[mt] = mfma16(kf[mt][0], q0[0], (f32x4){0.f, 0.f, 0.f, 0.f}); s0[mt] = mfma16(kf[mt][1], q0[1], s0[mt]); }
    __builtin_amdgcn_sched_barrier(0);
#pragma unroll
    for (int t = 0; t < 4; ++t) { vf[t][0] = *(const LAS bf16x8*)(tb0 + 8192 + t * 2048); vf[t][1] = *(const LAS bf16x8*)(tb1 + 8192 + t * 2048); }
    __builtin_amdgcn_sched_barrier(0);
#pragma unroll
    for (int mt = 0; mt < 4; ++mt) { s1[mt] = mfma16(kf[mt][0], q1[0], (f32x4){0.f, 0.f, 0.f, 0.f}); s1[mt] = mfma16(kf[mt][1], q1[1], s1[mt]); }
    float ps0 = 0.f, ps1 = 0.f;
    if (NEARB) {
        const LAS float* rp0 = rt + (RT_OFF - dbase0);
        f32x4 bv[4];
#pragma unroll
        for (int mt = 0; mt < 4; ++mt)
#pragma unroll
            for (int r = 0; r < 4; ++r) bv[mt][r] = rp0[16 * mt + r];
        asm volatile("" : "+v"(bv[0]), "+v"(bv[1]), "+v"(bv[2]), "+v"(bv[3]));
#pragma unroll
        for (int mt = 0; mt < 4; ++mt) s0[mt] = s0[mt] + bv[mt];
    }
#pragma unroll
    for (int mt = 0; mt < 4; ++mt)
#pragma unroll
        for (int r = 0; r < 4; ++r) { const float p0 = __builtin_amdgcn_exp2f(s0[mt][r] - mrow0); s0[mt][r] = p0; ps0 += p0; }
    bf16x8 pf0[2], pf1[2];
#pragma unroll
    for (int k2 = 0; k2 < 2; ++k2) {
        u32x4 w; w.x = cvt_pk_bf16(s0[2 * k2][0], s0[2 * k2][1]); w.y = cvt_pk_bf16(s0[2 * k2][2], s0[2 * k2][3]); w.z = cvt_pk_bf16(s0[2 * k2 + 1][0], s0[2 * k2 + 1][1]); w.w = cvt_pk_bf16(s0[2 * k2 + 1][2], s0[2 * k2 + 1][3]);
        pf0[k2] = __builtin_bit_cast(bf16x8, w);
    }
#pragma unroll
    for (int i = 0; i < 8; ++i) { SGB(0x8, 1); SGB(0x2, 5); SGB(0x400, 2); }
    __builtin_amdgcn_sched_barrier(0);
#pragma unroll
    for (int t = 0; t < 4; ++t) {
        A0.O[t] = mfma16(vf[t][0], pf0[0], A0.O[t]);
        A0.O[t] = mfma16(vf[t][1], pf0[1], A0.O[t]);
    }
    if (NEARB) {
        const LAS float* rp1 = rt + (RT_OFF - dbase1);
        f32x4 bv[4];
#pragma unroll
        for (int mt = 0; mt < 4; ++mt)
#pragma unroll
            for (int r = 0; r < 4; ++r) bv[mt][r] = rp1[16 * mt + r];
        asm volatile("" : "+v"(bv[0]), "+v"(bv[1]), "+v"(bv[2]), "+v"(bv[3]));
#pragma unroll
        for (int mt = 0; mt < 4; ++mt) s1[mt] = s1[mt] + bv[mt];
    }
#pragma unroll
    for (int mt = 0; mt < 4; ++mt)
#pragma unroll
        for (int r = 0; r < 4; ++r) { const float p1 = __builtin_amdgcn_exp2f(s1[mt][r] - mrow1); s1[mt][r] = p1; ps1 += p1; }
#pragma unroll
    for (int k2 = 0; k2 < 2; ++k2) {
        u32x4 v; v.x = cvt_pk_bf16(s1[2 * k2][0], s1[2 * k2][1]); v.y = cvt_pk_bf16(s1[2 * k2][2], s1[2 * k2][3]); v.z = cvt_pk_bf16(s1[2 * k2 + 1][0], s1[2 * k2 + 1][1]); v.w = cvt_pk_bf16(s1[2 * k2 + 1][2], s1[2 * k2 + 1][3]);
        pf1[k2] = __builtin_bit_cast(bf16x8, v);
    }
#pragma unroll
    for (int i = 0; i < 8; ++i) { SGB(0x8, 1); SGB(0x2, 5); SGB(0x400, 2); }
    __builtin_amdgcn_sched_barrier(0);
#pragma unroll
    for (int t = 0; t < 4; ++t) {
        A1.O[t] = mfma16(vf[t][0], pf1[0], A1.O[t]);
        A1.O[t] = mfma16(vf[t][1], pf1[1], A1.O[t]);
    }
    ps0 = kg_sum(ps0); ps1 = kg_sum(ps1);
    A0.l += ps0; A1.l += ps1;
}

__device__ __forceinline__ void nsa_item(const Frame& F, int item) {
    const int bhk = item & 7, cb = 127 - (item >> 3), b = bhk >> 1, hk = bhk & 1;
    int tid_ = F.tid, lane_ = F.lane; asm volatile("" : "+v"(tid_), "+v"(lane_));
    const int tid = tid_, lane = lane_, wave = F.wave, n = lane & 15, ts = n >> 2, g = n & 3, kg = lane >> 4;
    const bf16* nq = (const bf16*)(F.ws + WS_NQ); const bf16* nkv = (const bf16*)(F.ws + WS_NKV) + (size_t)b * SEQ * 768;
    const bf16* kcmp = (const bf16*)(F.ws + WS_KCMP) + (size_t)bhk * 512 * 64; const bf16* vcmpt = (const bf16*)(F.ws + WS_VCMPT) + (size_t)bhk * 64 * 512;
    const bf16* vst = (const bf16*)(F.ws + WS_VST) + (size_t)bhk * 64 * SEQ; const bf16* vwt = (const bf16*)(F.ws + WS_VWT) + (size_t)bhk * 64 * SEQ;
    const float* small = (const float*)(F.ws + WS_SMALL); const bf16* nz = (const bf16*)(F.ws + WS_NZ); bf16* mix = (bf16*)(F.ws + WS_MIX);
    LAS float* btl = (LAS float*)(F.lds + NL_BT); LAS float* imp = (LAS float*)(F.lds + NL_IMP);
    LAS unsigned* maskw = (LAS unsigned*)(F.lds + NL_MASK); LAS unsigned* smaskw = (LAS unsigned*)(F.lds + NL_SMASK);
    LAS unsigned char* kvb = F.lds + NL_KV;
    const LAS float* bt = btl + g * RT_LEN;
    for (int prb3 = 0; prb3 <= PRB_SETUP; ++prb3)
    { __syncthreads(); const float* btg = (const float*)(F.ws + WS_BT) + (size_t)(hk * 4) * 1025;
      for (int i = tid; i < 4 * RT_LEN; i += 512) { const int hh = i / RT_LEN, ii = i - hh * RT_LEN; const int d = RT_OFF - ii; btl[i] = d >= 0 ? btg[hh * 1025 + (d > 1024 ? 1024 : d)] : 0.f; }
      for (int i = lane; i < 8 * 130; i += 64) imp[wave * 8 * 130 + i] = 0.f; }
    const int tw0 = cb * 64 + wave * 8;
    int trow[2]; size_t tokg[2]; bf16x8 q[2][2];
    LAS float* totp = (LAS float*)(F.lds + NL_TOT) + ((wave * 8 + ts) * 4 + g) * 68 + 4 * kg;
#pragma unroll
    for (int sl = 0; sl < 2; ++sl) {
        trow[sl] = tw0 + 4 * sl + ts; tokg[sl] = (size_t)b * SEQ + trow[sl];
        const bf16* qp = nq + tokg[sl] * 512 + (hk * 4 + g) * 64 + 8 * kg;
        q[sl][0] = *(const bf16x8*)qp; q[sl][1] = *(const bf16x8*)(qp + 32);
    }
    SlotState A[2];
    const int fb0 = n * 128 + ((kg ^ (n & 7)) << 4), fb1 = n * 128 + (((4 + kg) ^ (n & 7)) << 4);
#define NS_LOADK(buf) do { _Pragma("unroll") for (int _mt = 0; _mt < 4; ++_mt) { kf[_mt][0] = *(const LAS bf16x8*)((buf) + fb0 + _mt * 2048); kf[_mt][1] = *(const LAS bf16x8*)((buf) + fb1 + _mt * 2048); } } while (0)
#define NS_LOADV(buf) do { _Pragma("unroll") for (int _t = 0; _t < 4; ++_t) _Pragma("unroll") for (int _ks = 0; _ks < 2; ++_ks) vf[_t][_ks] = tile_frag((buf) + 8192, 16 * _t + n, 4 * _ks + kg); } while (0)
#define NS_RESET() do { _Pragma("unroll") for (int _s = 0; _s < 2; ++_s) { A[_s].m = -1e30f; A[_s].l = 0.f; _Pragma("unroll") for (int _t = 0; _t < 4; ++_t) A[_s].O[_t] = (f32x4){0.f, 0.f, 0.f, 0.f}; } } while (0)
#define NS_BAR() do { asm volatile("s_waitcnt lgkmcnt(0)" ::: "memory"); __builtin_amdgcn_s_barrier(); asm volatile("" ::: "memory"); } while (0)
#define NS_PIPE(NT, KEY0, KB, KSTR, VTB, VLEN, NB, BUF, ...) do { \
        const int _nt = (NT); \
        for (int _p = 0; _p < (NB) - 1 && _p < _nt; ++_p) stage_dma(BUF(_p), KB, KSTR, VTB, VLEN, KEY0(_p), wave, lane); \
        wait_tiles((_nt - 1) < ((NB) - 2) ? (_nt - 1) : ((NB) - 2)); NS_BAR(); \
        for (int ti = 0; ti < _nt; ++ti) { \
            const LAS unsigned char* cbuf = BUF(ti & ((NB) - 1)); \
            if (ti + (NB) - 1 < _nt) stage_dma(BUF((ti + (NB) - 1) & ((NB) - 1)), KB, KSTR, VTB, VLEN, KEY0(ti + (NB) - 1), wave, lane); \
            __VA_ARGS__ \
            { const int _rem = _nt - 2 - ti; wait_tiles(_rem < 0 ? 0 : (_rem < (NB) - 2 ? _rem : (NB) - 2)); } \
            NS_BAR(); \
        } } while (0)
#define BUF2(i) (kvb + (i) * 16384)
#define BUF4(i) ((i) < 2 ? kvb + (i) * 16384 : (LAS unsigned char*)(F.lds + NL_IMP) + ((i) - 2) * 16384)
    __syncthreads();
    const float bfarv = bt[RT_OFF - 1024];
    const int ntc = ((4 * cb + 2) >> 6) + 1;
#define KEY0_LIN(i) (64 * (i))
    for (int prb = 0; prb <= PRB_C; ++prb) {
    NS_RESET();
    NS_PIPE(ntc, KEY0_LIN, kcmp, 64, vcmpt, 512, 2, BUF2, {

        const int db0 = trow[0] - 31 - 16 * (64 * ti + 4 * kg), db1 = trow[1] - 31 - 16 * (64 * ti + 4 * kg);
        if (64 * cb - 1024 * ti - 1039 >= 790) {
            slot_tile<TM_C1, false>(cbuf + fb0, cbuf + fb1, q[0], db0, bt, A[0], 0.f, 0.f, bfarv, nullptr, 64 * ti, lane);
            slot_tile<TM_C1, false>(cbuf + fb0, cbuf + fb1, q[1], db1, bt, A[1], 0.f, 0.f, bfarv, nullptr, 64 * ti, lane);
        } else {
            slot_tile<TM_C1, true>(cbuf + fb0, cbuf + fb1, q[0], db0, bt, A[0], 0.f, 0.f, bfarv, nullptr, 64 * ti, lane);
            slot_tile<TM_C1, true>(cbuf + fb0, cbuf + fb1, q[1], db1, bt, A[1], 0.f, 0.f, bfarv, nullptr, 64 * ti, lane);
        }
    });
    }
    {
        for (int prb2 = PRB_C2; prb2 >= 0; --prb2) {
        const float li0 = (prb2 == 0 && A[0].l > 0.f) ? 1.0f / A[0].l : 0.f, li1 = (prb2 == 0 && A[1].l > 0.f) ? 1.0f / A[1].l : 0.f;
        float cry0 = 0.f, cry1 = 0.f;
        NS_PIPE(ntc, KEY0_LIN, kcmp, 64, vcmpt, 512, 2, BUF2, {

            const int db0 = trow[0] - 31 - 16 * (64 * ti + 4 * kg), db1 = trow[1] - 31 - 16 * (64 * ti + 4 * kg);
            if (64 * cb - 1024 * ti - 1039 >= 790) {
                slot_tile<TM_C2, false>(cbuf + fb0, cbuf + fb1, q[0], db0, bt, A[0], li0, 0.f, bfarv, imp + (wave * 8 + ts) * 130, 64 * ti, lane, &cry0);
                slot_tile<TM_C2, false>(cbuf + fb0, cbuf + fb1, q[1], db1, bt, A[1], li1, 0.f, bfarv, imp + (wave * 8 + 4 + ts) * 130, 64 * ti, lane, &cry1);
            } else {
                slot_tile<TM_C2, true>(cbuf + fb0, cbuf + fb1, q[0], db0, bt, A[0], li0, 0.f, bfarv, imp + (wave * 8 + ts) * 130, 64 * ti, lane, &cry0);
                slot_tile<TM_C2, true>(cbuf + fb0, cbuf + fb1, q[1], db1, bt, A[1], li1, 0.f, bfarv, imp + (wave * 8 + 4 + ts) * 130, 64 * ti, lane, &cry1);
            }
        });
        }
#pragma unroll
        for (int sl = 0; sl < 2; ++sl) { const float gate = small[tokg[sl] * 32 + 8 + hk * 4 + g];
#pragma unroll
            for (int t = 0; t < 4; ++t) *(LAS f32x4*)(totp + sl * 16 * 68 + 16 * t) = A[sl].O[t] * gate; }
    }
    for (int prs = 0; prs <= PRB_SEL; ++prs)
    {
        const int tsl = lane >> 3, i = lane & 7; const int tk = wave * 8 + tsl;
        unsigned mw0 = 0u, mw1 = 0u, mw2 = 0u, mw3 = 0u;
#define NS_SETBIT(j) do { const unsigned _b = 1u << ((j) & 31); const int _w = (j) >> 5; mw0 |= _w == 0 ? _b : 0u; mw1 |= _w == 1 ? _b : 0u; mw2 |= _w == 2 ? _b : 0u; mw3 |= _w == 3 ? _b : 0u; } while (0)
        if (cb <= 15) { mw0 = (2u << cb) - 1u; }
        else {
            float val[16];
#pragma unroll
            for (int qq = 0; qq < 16; ++qq) { const int j = i + 8 * qq; val[qq] = (j >= 1 && j <= cb - 2) ? imp[tk * 130 + j] : -1.0f; }
            NS_SETBIT(0); NS_SETBIT(cb - 1); NS_SETBIT(cb);
            for (int round = 0; round < 13; ++round) {
                float bv = -2.0f; int bj = 1 << 20;
#pragma unroll
                for (int qq = 0; qq < 16; ++qq) if (val[qq] > bv) { bv = val[qq]; bj = i + 8 * qq; }
#define NS_DPP_STEP(CTRL) do { const float ov = __builtin_bit_cast(float, __builtin_amdgcn_update_dpp(0, __builtin_bit_cast(int, bv), CTRL, 0xf, 0xf, false)); \
                    const int oj = __builtin_amdgcn_update_dpp(0, bj, CTRL, 0xf, 0xf, false); if (ov > bv || (ov == bv && oj < bj)) { bv = ov; bj = oj; } } while (0)
                NS_DPP_STEP(0xB1); NS_DPP_STEP(0x4E); NS_DPP_STEP(0x141);
#pragma unroll
                for (int qq = 0; qq < 16; ++qq) if (bj == i + 8 * qq) val[qq] = -3.0f;
                NS_SETBIT(bj);
            }
        }
        if (i == 0) { maskw[tk * 4 + 0] = mw0; maskw[tk * 4 + 1] = mw1; maskw[tk * 4 + 2] = mw2; maskw[tk * 4 + 3] = mw3; }
        mw0 |= __shfl_xor(mw0, 8); mw0 |= __shfl_xor(mw0, 16); mw1 |= __shfl_xor(mw1, 8); mw1 |= __shfl_xor(mw1, 16);
        mw2 |= __shfl_xor(mw2, 8); mw2 |= __shfl_xor(mw2, 16); mw3 |= __shfl_xor(mw3, 8); mw3 |= __shfl_xor(mw3, 16);
        if ((lane & 31) == 0) { const int so = (wave * 2 + (lane >> 5)) * 4; smaskw[so] = mw0; smaskw[so + 1] = mw1; smaskw[so + 2] = mw2; smaskw[so + 3] = mw3; }
    }
    __syncthreads();
    {
#define KEY0_SEL(i) (64 * (cb == 0 ? 0 : (cb == 1 ? 1 - (i) : ((i) == 0 ? cb : ((i) == 1 ? cb - 1 : ((i) == 2 ? 0 : (i) - 2))))))
        const int tk0 = wave * 8 + ts;
        unsigned smk0[4], smk1[4], rmk0[4], rmk1[4];
#pragma unroll
        for (int w4 = 0; w4 < 4; ++w4) {
            smk0[w4] = __builtin_amdgcn_readfirstlane(smaskw[(wave * 2 + 0) * 4 + w4]); smk1[w4] = __builtin_amdgcn_readfirstlane(smaskw[(wave * 2 + 1) * 4 + w4]);
            rmk0[w4] = maskw[tk0 * 4 + w4]; rmk1[w4] = maskw[(tk0 + 4) * 4 + w4];
        }
        const LAS unsigned char* const Kb_ = nullptr; (void)Kb_;
        const bf16* ksl = nkv + 256 + hk * 64;
        for (int prb = 0; prb <= PRB_S; ++prb) {
        NS_RESET();
        const int nt = cb + 1, np = (nt + 1) >> 1;
        stage_dma(BUF4(0), ksl, 768, vst, SEQ, KEY0_SEL(0), wave, lane); if (nt > 1) stage_dma(BUF4(1), ksl, 768, vst, SEQ, KEY0_SEL(1), wave, lane);
        wait_tiles(0); NS_BAR();
        for (int p = 0; p < np; ++p) {
            const int sb = (p & 1) * 2;
            if (p + 1 < np) { stage_dma(BUF4(2 - sb), ksl, 768, vst, SEQ, KEY0_SEL(2 * p + 2), wave, lane); if (2 * p + 3 < nt) stage_dma(BUF4(3 - sb), ksl, 768, vst, SEQ, KEY0_SEL(2 * p + 3), wave, lane); }
#pragma unroll 1
            for (int hh = 0; hh < 2; ++hh) {
                const int ti = 2 * p + hh; if (ti >= nt) break;
                const LAS unsigned char* cbuf = BUF4(sb + hh);
                const int key0 = KEY0_SEL(ti); const int j = key0 >> 6;
                const bool dense = (cb < 2) || (ti < 3);
                const int db0 = trow[0] - key0 - 4 * kg, db1 = trow[1] - key0 - 4 * kg;
                const bool nearb = (cb - j) < 14;
                if (dense) {

                    if (nearb) {
                        slot_tile<TM_SD, true>(cbuf + fb0, cbuf + fb1, q[0], db0, bt, A[0], 0.f, 0.f, bfarv, nullptr, key0, lane);
                        slot_tile<TM_SD, true>(cbuf + fb0, cbuf + fb1, q[1], db1, bt, A[1], 0.f, 0.f, bfarv, nullptr, key0, lane);
                    } else {
                        slot_tile<TM_SD, false>(cbuf + fb0, cbuf + fb1, q[0], db0, bt, A[0], 0.f, 0.f, bfarv, nullptr, key0, lane);
                        slot_tile<TM_SD, false>(cbuf + fb0, cbuf + fb1, q[1], db1, bt, A[1], 0.f, 0.f, bfarv, nullptr, key0, lane);
                    }
                } else {
                    const int w4 = j >> 5, bit = j & 31;
                    const unsigned sm0 = w4 == 0 ? smk0[0] : (w4 == 1 ? smk0[1] : (w4 == 2 ? smk0[2] : smk0[3])), sm1 = w4 == 0 ? smk1[0] : (w4 == 1 ? smk1[1] : (w4 == 2 ? smk1[2] : smk1[3]));
                    const bool a0 = PRB_ALLACT ? true : ((sm0 >> bit) & 1u), a1 = PRB_ALLACT ? true : ((sm1 >> bit) & 1u);
                    if (a0 || a1) {

                        const unsigned rm0 = w4 == 0 ? rmk0[0] : (w4 == 1 ? rmk0[1] : (w4 == 2 ? rmk0[2] : rmk0[3])), rm1 = w4 == 0 ? rmk1[0] : (w4 == 1 ? rmk1[1] : (w4 == 2 ? rmk1[2] : rmk1[3]));
                        const float boff = nearb ? 0.f : bfarv;
                        const float mr0 = ((rm0 >> bit) & 1u) ? A[0].m - boff : 1e30f, mr1 = ((rm1 >> bit) & 1u) ? A[1].m - boff : 1e30f;
                        if (a0 && a1) {
                            if (nearb) slot_pair_ss<true>(cbuf + fb0, cbuf + fb1, q[0], q[1], db0, db1, bt, A[0], A[1], mr0, mr1);
                            else slot_pair_ss<false>(cbuf + fb0, cbuf + fb1, q[0], q[1], db0, db1, bt, A[0], A[1], mr0, mr1);
                        } else if (a0) {
                            if (nearb) slot_tile<TM_SS, true>(cbuf + fb0, cbuf + fb1, q[0], db0, bt, A[0], 0.f, mr0, 0.f, nullptr, key0, lane);
                            else slot_tile<TM_SS, false>(cbuf + fb0, cbuf + fb1, q[0], db0, bt, A[0], 0.f, mr0, 0.f, nullptr, key0, lane);
                        } else {
                            if (nearb) slot_tile<TM_SS, true>(cbuf + fb0, cbuf + fb1, q[1], db1, bt, A[1], 0.f, mr1, 0.f, nullptr, key0, lane);
                            else slot_tile<TM_SS, false>(cbuf + fb0, cbuf + fb1, q[1], db1, bt, A[1], 0.f, mr1, 0.f, nullptr, key0, lane);
                        }
                    }
                }
            }
            wait_tiles(0); NS_BAR();
        }
        }
#pragma unroll
        for (int sl = 0; sl < 2; ++sl) { const float gate = small[tokg[sl] * 32 + 16 + hk * 4 + g]; const float sc = A[sl].l > 0.f ? gate / A[sl].l : 0.f;
#pragma unroll
            for (int t = 0; t < 4; ++t) { LAS f32x4* tp = (LAS f32x4*)(totp + sl * 16 * 68 + 16 * t); *tp = *tp + A[sl].O[t] * sc; } }
    }
    {
        const int jw0 = cb >= 8 ? cb - 8 : 0;
#define KEY0_WIN(i) (64 * (jw0 + (i)))
        for (int prb = 0; prb <= PRB_W; ++prb) {
        NS_RESET();
        NS_PIPE(cb - jw0 + 1, KEY0_WIN, nkv + 512 + hk * 64, 768, vwt, SEQ, 4, BUF4, {

            slot_tile<TM_W, true>(cbuf + fb0, cbuf + fb1, q[0], trow[0] - KEY0_WIN(ti) - 4 * kg, bt, A[0], 0.f, 0.f, 0.f, nullptr, KEY0_WIN(ti), lane);
            slot_tile<TM_W, true>(cbuf + fb0, cbuf + fb1, q[1], trow[1] - KEY0_WIN(ti) - 4 * kg, bt, A[1], 0.f, 0.f, 0.f, nullptr, KEY0_WIN(ti), lane);
        });
        }
#pragma unroll
        for (int sl = 0; sl < 2; ++sl) { const float gate = small[tokg[sl] * 32 + 24 + hk * 4 + g]; const float sc = A[sl].l > 0.f ? gate / A[sl].l : 0.f;
#pragma unroll
            for (int t = 0; t < 4; ++t) { LAS f32x4* tp = (LAS f32x4*)(totp + sl * 16 * 68 + 16 * t); *tp = *tp + A[sl].O[t] * sc; } }
    }
    {
        int l2 = lane; asm volatile("" : "+v"(l2));
        const int n2 = l2 & 15, ts2 = n2 >> 2, g2 = n2 & 3, kg2 = l2 >> 4;
        const LAS float* tp2 = (const LAS float*)(F.lds + NL_TOT) + ((wave * 8 + ts2) * 4 + g2) * 68 + 4 * kg2;
#pragma unroll
        for (int sl = 0; sl < 2; ++sl) {
            const size_t tk = (size_t)b * SEQ + tw0 + 4 * sl + ts2;
#pragma unroll
            for (int t = 0; t < 4; ++t) {
                const u32x2 z = *(const u32x2*)(nz + tk * 512 + (hk * 4 + g2) * 64 + 16 * t + 4 * kg2);
                const f32x4 tv = *(const LAS f32x4*)(tp2 + sl * 16 * 68 + 16 * t);
                u32x2 d; d.x = cvt_pk_bf16(tv[0] * __uint_as_float(z.x << 16), tv[1] * __uint_as_float(z.x & 0xffff0000u));
                d.y = cvt_pk_bf16(tv[2] * __uint_as_float(z.y << 16), tv[3] * __uint_as_float(z.y & 0xffff0000u));
                *(u32x2*)(mix + tk * DM + 512 + (hk * 4 + g2) * 64 + 16 * t + 4 * kg2) = d;
            }
        }
    }
    __syncthreads();
#undef NS_LOADK
#undef NS_LOADV
#undef NS_RESET
#undef NS_PIPE
#undef NS_SETBIT
}
#ifndef PRB_SCANONLY
#define PRB_SCANONLY 0
#endif
#ifndef DUP_P1
#define DUP_P1 0
#endif
#ifndef DUP_P2G
#define DUP_P2G 0
#endif
#ifndef DUP_P2
#define DUP_P2 0
#endif
#ifndef DUP_SCAN
#define DUP_SCAN 0
#endif
#ifndef DUP_NSA
#define DUP_NSA 0
#endif
__device__ __forceinline__ void p2_phase(const Frame& F) {
    int cw_head = -1;
#define P2_CW_LOAD(h_) do { if ((h_) != cw_head) { __syncthreads(); const float* cw = F.in[3]; \
        for (int i = F.tid; i < 4 * 3 * 128; i += 512) { const int j = i / 384, r = i - j * 384, part = r >> 7, c = r & 127; ((LAS float*)(F.lds + GL_CW))[i] = cw[j * 1536 + part * 512 + (h_) * 128 + c]; } \
        cw_head = (h_); __syncthreads(); } } while (0)
    for (int rep = 0; rep <= DUP_P2; ++rep)
    for (int task = blockIdx.x; task < 3072; task += gridDim.x) {
        if (task < 2048) { P2_CW_LOAD(task & 3); for (int r2 = 0; r2 <= DUP_P2G; ++r2) gdn_prep_item(F, task); }
        else if (task < 2560) compress_block(F, task - 2048);
        else vtranspose_task(F, task - 2560);
    }
}
__device__ __forceinline__ void p3_phase(const Frame& F) {
    for (int rep = 0; rep <= DUP_SCAN; ++rep)
        for (int bh = blockIdx.x; bh < 16; bh += gridDim.x) gdn_scan(F, bh);
    LAS int* nxt = (LAS int*)(F.lds + NL_NXT);
#if PRB_SCANONLY
    if (blockIdx.x < 16) return;
#endif
    for (int rep = 0; rep <= DUP_NSA; ++rep) {
        const int bhk = blockIdx.x & 7;
        unsigned* ctr = (unsigned*)(F.ws + WS_CTL) + 64 + 64 * bhk + 1024 * rep;
        for (;;) {
            __syncthreads();
            if (F.tid == 0) *nxt = (int)atomicAdd(ctr, 1u);
            __syncthreads();
            const int qi = *nxt;
            if (qi >= 128) break;
            nsa_item(F, qi * 8 + bhk);
        }
    }
}
typedef __attribute__((address_space(1))) unsigned gu32;
#define XB_TMO      128
#define XB_XCNT(j)  (256  + 64 * (j))
#define XB_XSUB(j)  (1280 + 64 * (j))
#define XB_XGEN(j)  (2304 + 64 * (j))
#define XB_TOP      3328
#define XB_TOPGEN   3392
#define XCD_BAR_WORDS 3456
#define XB_SPIN_CAP (1u << 18)

__device__ __forceinline__ unsigned xb_ld(unsigned* p)              { return __hip_atomic_load(p, __ATOMIC_RELAXED, __HIP_MEMORY_SCOPE_AGENT); }
__device__ __forceinline__ unsigned xb_add(unsigned* p, unsigned v) { return __hip_atomic_fetch_add(p, v, __ATOMIC_RELAXED, __HIP_MEMORY_SCOPE_AGENT); }
__device__ __forceinline__ unsigned xb_xcc_id() { return (unsigned)__builtin_amdgcn_s_getreg((3 << 11) | 20) & 0xFu; }
#define XB_SPIN(cond, bar) do { unsigned _sp = 0; while (cond) { __builtin_amdgcn_s_sleep(1); \
    if ((++_sp & 255u) == 0u) { if (xb_ld(&(bar)[XB_TMO])) break; if (_sp > XB_SPIN_CAP) { atomicAdd(&(bar)[XB_TMO], 1u); break; } } } } while (0)

struct XcdBarrier {
    unsigned* bar; unsigned x;
    volatile LAS unsigned* st;
};

__device__ __forceinline__ XcdBarrier xcd_barrier_post(unsigned* bar, volatile LAS unsigned* st) {
    XcdBarrier b; b.bar = bar; b.x = xb_xcc_id(); b.st = st;
    if (threadIdx.x == 0) (void)xb_add(&bar[XB_XCNT(b.x)], 1u);
    return b;
}
__device__ __forceinline__ void xcd_barrier_complete(unsigned* bar, unsigned x, unsigned& nloc, unsigned& nx) {
    const unsigned G = gridDim.x * gridDim.y * gridDim.z;
    unsigned sum, cnt, mine, sp = 0u;
    for (;;) {
        sum = 0u; cnt = 0u; mine = 0u;
#pragma unroll
        for (unsigned j = 0; j < 16; ++j) { const unsigned c = xb_ld(&bar[XB_XCNT(j)]); sum += c; cnt += (c > 0u) ? 1u : 0u; mine = (j == x) ? c : mine; }
        if (sum == G) break;
        __builtin_amdgcn_s_sleep(1);
        if ((++sp & 255u) == 0u) { if (xb_ld(&bar[XB_TMO])) break; if (sp > XB_SPIN_CAP) { atomicAdd(&bar[XB_TMO], 1u); break; } }
    }
    nloc = mine > 0u ? mine : 1u; nx = cnt > 0u ? cnt : 1u;
}

__device__ __forceinline__ void xcd_barrier(const XcdBarrier& b) {
    asm volatile("s_waitcnt vmcnt(0)" ::: "memory");
    __syncthreads();
    if (threadIdx.x == 0) {
        unsigned* bar = b.bar;
        __builtin_amdgcn_s_waitcnt(0);
        unsigned nloc = b.st[0], nx = b.st[1];
        if (nloc == 0u) { xcd_barrier_complete(bar, b.x, nloc, nx); b.st[0] = nloc; b.st[1] = nx; }
        const unsigned old = xb_add(&bar[XB_XSUB(b.x)], 1u);
        const unsigned gen = old / nloc;
        if (old + 1u == (gen + 1u) * nloc) {
            __builtin_amdgcn_fence(__ATOMIC_RELEASE, "agent");
            asm volatile("s_waitcnt vmcnt(0)" ::: "memory");
            const unsigned og = xb_add(&bar[XB_TOP], 1u);
            const unsigned tg = og / nx;
            if (og + 1u == (tg + 1u) * nx) xb_add(&bar[XB_TOPGEN], 1u);
            else XB_SPIN(xb_ld(&bar[XB_TOPGEN]) == tg, bar);
            __builtin_amdgcn_fence(__ATOMIC_ACQUIRE, "agent");
            xb_add(&bar[XB_XGEN(b.x)], 1u);
            asm volatile("s_waitcnt vmcnt(0)" ::: "memory");
        } else {
            XB_SPIN(xb_ld(&bar[XB_XGEN(b.x)]) == gen, bar);
            __builtin_amdgcn_fence(__ATOMIC_ACQUIRE, "agent");
            asm volatile("s_waitcnt vmcnt(0)" ::: "memory");
        }
    }
    __syncthreads();
}

constexpr int LDS_BARST = LDS_BYTES - 64;
struct Args { const float* in[16]; float* out; unsigned char* ws; int ph_lo, ph_hi, coop, pad; };
constexpr int N_PHASES = 6;

__global__ void __launch_bounds__(512, 2) hymba_fwd(Args a) {
    extern __shared__ __attribute__((aligned(16))) unsigned char lds_raw[];
    Frame F;
#pragma unroll
    for (int i = 0; i < 16; ++i) F.in[i] = a.in[i];
    F.out = a.out; F.ws = a.ws; F.lds = (LAS unsigned char*)lds_raw; F.ldsg = lds_raw;
    F.tid = threadIdx.x; F.lane = F.tid & 63; F.wave = __builtin_amdgcn_readfirstlane(F.tid >> 6);
    unsigned char* ws = a.ws;
    volatile LAS unsigned* barst = (volatile LAS unsigned*)(F.lds + LDS_BARST);
    if (F.tid < 2) barst[F.tid] = 0u;
    __syncthreads();
    XcdBarrier xbar; xbar.bar = (unsigned*)(ws + WS_CTL) + 4096; xbar.x = 0; xbar.st = nullptr;
    if (a.coop) xbar = xcd_barrier_post((unsigned*)(ws + WS_CTL) + 4096, barst);
    const int lo = a.ph_lo, hi = a.ph_hi;
#define IN(k) (lo <= (k) && (k) < hi)
#define SEAM(k) do { if (IN(k) && IN((k) + 1) && a.coop) { xcd_barrier(xbar); } __syncthreads(); } while (0)
#ifndef DUP_P0
#define DUP_P0 0
#endif
#ifndef DUP_P4
#define DUP_P4 0
#endif
    if (IN(0)) { _Pragma("unroll 1") for (int rep = 0; rep <= DUP_P0; ++rep) p0_prep(F); }
    SEAM(0);
    if (IN(1)) {
        pg8::Gemm g{(const bf16*)(ws + WS_XB), (const bf16*)(ws + WS_WTIN), T_TOK, NPROJ, DM};
        pg8::StaticOrder S; S.init(T_TOK, NPROJ, (int)gridDim.x, (int)blockIdx.x);
        EpiProj E{(bf16*)(ws + WS_GQKV), (bf16*)(ws + WS_GZ), (bf16*)(ws + WS_NQ), (bf16*)(ws + WS_NKV), (bf16*)(ws + WS_NZ), (const float*)(ws + WS_RS)};
        pg8::gemm_phase<EpiProj, pg8::StaticOrder, false>(F.lds, g, S, E, nullptr);
#if DUP_P1
        __syncthreads(); pg8::gemm_phase<EpiProj, pg8::StaticOrder, false>(F.lds, g, S, E, nullptr);
#endif
    }
    SEAM(1);
    if (IN(2)) p2_phase(F);
    SEAM(2);
    if (IN(3)) p3_phase(F);
    SEAM(3);
    if (IN(4)) {
        pg8::Gemm g{(const bf16*)(ws + WS_MIX), (const bf16*)(ws + WS_WTOUT), T_TOK, DM, DM};
        pg8::StaticOrder S; S.init(T_TOK, DM, (int)gridDim.x, (int)blockIdx.x);
        EpiOut E{F.in[0], F.out};
        pg8::gemm_phase<EpiOut, pg8::StaticOrder, false>(F.lds, g, S, E, nullptr);
#if DUP_P4
        __syncthreads(); pg8::gemm_phase<EpiOut, pg8::StaticOrder, false>(F.lds, g, S, E, nullptr);
#endif
    }
    SEAM(4);
    if (IN(5)) p5_final(F);
#undef IN
#undef SEAM
}

extern "C" void kernel_launch(void* const* d_in, const int* in_sizes, int n_in, void* d_out, int out_size, void* d_ws, size_t ws_size, hipStream_t stream) {
    static int grid = 0;
    if (grid == 0) {
        if (n_in != 16 || in_sizes[0] != T_TOK * DM || out_size != T_TOK * DM || ws_size < WS_END) { fprintf(stderr, "kernel_launch: unexpected shapes (n_in %d, ws %zu)\n", n_in, ws_size); grid = -1; return; }
        int dev = 0, cus = 0, per_cu = 0;
        if (hipGetDevice(&dev) != hipSuccess || hipDeviceGetAttribute(&cus, hipDeviceAttributeMultiprocessorCount, dev) != hipSuccess) { grid = -1; return; }
        if (hipFuncSetAttribute((const void*)hymba_fwd, hipFuncAttributeMaxDynamicSharedMemorySize, LDS_BYTES) != hipSuccess) { fprintf(stderr, "kernel_launch: hipFuncSetAttribute failed\n"); grid = -1; return; }
        if (hipOccupancyMaxActiveBlocksPerMultiprocessor(&per_cu, (const void*)hymba_fwd, 512, LDS_BYTES) != hipSuccess || per_cu < 1) { fprintf(stderr, "kernel_launch: occupancy query says %d\n", per_cu); per_cu = 1; }
        (void)hipGetLastError();
        grid = cus;
    }
    if (grid < 0) return;
    (void)hipMemsetAsync((char*)d_ws + WS_CTL, 0, 64 * 1024, stream);
    Args a{};
    for (int i = 0; i < 16; ++i) a.in[i] = (const float*)d_in[i];
    a.out = (float*)d_out; a.ws = (unsigned char*)d_ws;
#if MK_LAUNCHES == 1
    a.ph_lo = 0; a.ph_hi = N_PHASES; a.coop = 1;
    void* args[] = {&a};
    hipError_t e = hipLaunchCooperativeKernel((const void*)hymba_fwd, dim3(grid), dim3(512), args, LDS_BYTES, stream);
    if (e != hipSuccess) fprintf(stderr, "cooperative launch failed: %s (grid %d)\n", hipGetErrorString(e), grid);
#else
    for (int ph = 0; ph < N_PHASES; ++ph) {
        a.ph_lo = ph; a.ph_hi = ph + 1; a.coop = 0;
        hipLaunchKernelGGL(hymba_fwd, dim3(grid), dim3(512), LDS_BYTES, stream, a);
    }
#endif
}
```

```cpp
#include <hip/hip_runtime.h>
#include <hip/hip_cooperative_groups.h>
#include <cstdio>
#include <cstdint>
namespace cg = cooperative_groups;
#ifndef MK_LAUNCHES
#define MK_LAUNCHES 1
#endif

namespace pg8 {
#define PG8_LAS __attribute__((address_space(3)))
typedef unsigned short bf16_t;
typedef short bf16x8 __attribute__((ext_vector_type(8)));
typedef float f32x4 __attribute__((ext_vector_type(4)));
typedef unsigned u32x4 __attribute__((ext_vector_type(4)));
constexpr int BM = 256, BK = 64, HALF = 128, HTB = HALF * BK * 2  , STAGE_BYTES = 8 * HTB, NXCD = 8, WGM = 8;

__host__ __device__ __forceinline__ int lds_byte(int r, int c) { const int st = (r >> 4) * 2 + (c >> 5), rr = r & 15, cc = c & 31, ob = rr * 64 + cc * 2; return st * 1024 + (ob ^ (((ob >> 9) & 1) << 5)); }
__host__ __device__ __forceinline__ void stage_rc(int b, int& R, int& C) { const int st = b / 1024, sb = b % 1024, swz = sb ^ (((sb >> 9) & 1) << 5); R = (st >> 1) * 16 + swz / 64; C = (st & 1) * 32 + (swz % 64) / 2; }
__host__ __device__ __forceinline__ int perm32(int rho) { const int n = rho >> 4, i = rho & 15; return 8 * (i >> 2) + 4 * n + (i & 3); }

struct Unit { int pm, pn; };
struct Gemm { const bf16_t* A; const bf16_t* Bt; int M, N, K; };

struct StaticOrder {
    int nM, nN, nwg, G, c;
    __host__ __device__ void init(int M, int N, int G_, int c_) { nM = M / BM; nN = N / BM; nwg = nM * nN; G = G_; c = c_; }
    __host__ __device__ bool next(int i, Unit& u) const {
        const long L = (long)i * G + c; if (L >= nwg) return false;
        int wgid = (int)L; { const int q = nwg / NXCD, r = nwg % NXCD, xcd = wgid % NXCD, off = wgid / NXCD; wgid = (xcd < r ? xcd * (q + 1) : r * (q + 1) + (xcd - r) * q) + off; }
        const int nig = WGM * nN, gid = wgid / nig, fm = gid * WGM, gsz = (nM - fm) < WGM ? (nM - fm) : WGM;
        u.pm = fm + ((wgid % nig) % gsz); u.pn = (wgid % nig) / gsz; return true;
    }
    __device__ __forceinline__ void a_ready(const Unit&) const {}
    __device__ __forceinline__ void done(const Unit&) const {}
};
__device__ __forceinline__ unsigned cvt_pk_bf16(float lo, float hi) { unsigned r; asm volatile("v_cvt_pk_bf16_f32 %0, %1, %2" : "=v"(r) : "v"(lo), "v"(hi)); return r; }
typedef float f32x2 __attribute__((ext_vector_type(2)));
template <class Epi, class Sched, bool STAMP = false>
__device__ __forceinline__ void gemm_phase(PG8_LAS unsigned char* lds, const Gemm g, const Sched& S, const Epi& E, unsigned long long* stamps) {
    const int tid = threadIdx.x, wid = __builtin_amdgcn_readfirstlane(tid >> 6), lane = tid & 63, wr = wid >> 2, wc = wid & 3, fr = lane & 15, fq = lane >> 4;
    const int K = g.K, nt = K / BK;
    int ts_lo = 0, ts_hi = 0, nts = 0; const unsigned long long rt_entry = STAMP ? (unsigned long long)wall_clock64() : 0ull;
#define PG8_STAMP() do { if (STAMP && wid == 0 && nts < 64) { const unsigned long long _c = (unsigned long long)clock64(); \
        ts_lo = (lane == nts) ? (int)(unsigned)_c : ts_lo; ts_hi = (lane == nts) ? (int)(unsigned)(_c >> 32) : ts_hi; ++nts; } } while (0)
    PG8_STAMP();
    unsigned voffA[2], voffB[2];
#pragma unroll
    for (int i = 0; i < 2; ++i) { int R, C; stage_rc(tid * 16 + i * 8192, R, C); const int Rb = Epi::PERM ? ((R & ~31) + perm32(R & 31)) : R;
        voffA[i] = (unsigned)(R * K + C) * 2u; voffB[i] = (unsigned)(Rb * K + C) * 2u; }
    const size_t kstep = (size_t)(BK * 2);
    const size_t hstep = (size_t)HALF * K * 2;
    const size_t tstep = 2 * hstep;
    const unsigned ldsw = (unsigned)wid * 1024u;
    const int aoff = lds_byte(wr * 64 + fr, fq * 8), boff = lds_byte(wc * 32 + fr, fq * 8);
#define PG8_SA(b, h) (((b) * 2 + (h)) * HTB)
#define PG8_SB(b, h) ((4 + (b) * 2 + (h)) * HTB)
#define PG8_STAGE(bufoff, gbase, voff) do { _Pragma("unroll") for (int _i = 0; _i < 2; ++_i) \
        __builtin_amdgcn_global_load_lds((const unsigned*)((const char*)(gbase) + (voff)[_i]), (PG8_LAS unsigned*)(lds + (bufoff) + ldsw + _i * 8192), 16, 0, 0); } while (0)
#define PG8_LDA(dst, b, h) do { _Pragma("unroll") for (int m = 0; m < 4; ++m) _Pragma("unroll") for (int k = 0; k < 2; ++k) dst[m][k] = *(const PG8_LAS bf16x8*)(lds + PG8_SA(b, h) + aoff + m * 2048 + k * 1024); } while (0)
#define PG8_LDB(dst, b, h) do { _Pragma("unroll") for (int n = 0; n < 2; ++n) _Pragma("unroll") for (int k = 0; k < 2; ++k) dst[n][k] = *(const PG8_LAS bf16x8*)(lds + PG8_SB(b, h) + boff + n * 2048 + k * 1024); } while (0)
#define PG8_MMA(ai, bj, At, Bt) do { __builtin_amdgcn_s_setprio(1); _Pragma("unroll") for (int m = 0; m < 4; ++m) _Pragma("unroll") for (int n = 0; n < 2; ++n) _Pragma("unroll") for (int k = 0; k < 2; ++k) \
        acc[ai][bj][m][n] = __builtin_amdgcn_mfma_f32_16x16x32_bf16(Bt[n][k], At[m][k], acc[ai][bj][m][n], 0, 0, 0); __builtin_amdgcn_s_setprio(0); } while (0)
#define PG8_WAIT_V(n) asm volatile("s_waitcnt vmcnt(" #n ")" ::: "memory")
#define PG8_WAIT_L(n) asm volatile("s_waitcnt lgkmcnt(" #n ")" ::: "memory")
#define PG8_BAR __builtin_amdgcn_s_barrier()
#define PG8_SCHED __builtin_amdgcn_sched_barrier(0)
    Unit cur, nxt; int ui = 0;
    if (!S.next(0, cur)) return;
    f32x4 acc[2][2][4][2];
#pragma unroll
    for (int a = 0; a < 2; ++a)
#pragma unroll
        for (int b = 0; b < 2; ++b)
#pragma unroll
            for (int m = 0; m < 4; ++m)
#pragma unroll
                for (int n = 0; n < 2; ++n) acc[a][b][m][n] = (f32x4){0.f, 0.f, 0.f, 0.f};
    bf16x8 At[4][2], B0[2][2], B1[2][2];
    const char* cA = (const char*)g.A + (size_t)cur.pm * tstep; const char* cB = (const char*)g.Bt + (size_t)cur.pn * tstep;
    S.a_ready(cur);
    PG8_STAGE(PG8_SB(0, 0), cB, voffB); PG8_STAGE(PG8_SA(0, 0), cA, voffA); PG8_STAGE(PG8_SB(0, 1), cB + hstep, voffB); PG8_STAGE(PG8_SA(0, 1), cA + hstep, voffA);
    if (wr == 1) PG8_BAR;
    PG8_WAIT_V(4); PG8_BAR;
    PG8_STAGE(PG8_SB(1, 0), cB + kstep, voffB); PG8_STAGE(PG8_SA(1, 0), cA + kstep, voffA); PG8_STAGE(PG8_SB(1, 1), cB + hstep + kstep, voffB);
    PG8_WAIT_V(6); PG8_BAR;
    PG8_STAMP();
    for (;;) {
        const bool has_next = S.next(ui + 1, nxt);
        const char* nA = has_next ? (const char*)g.A + (size_t)nxt.pm * tstep : cA; const char* nB = has_next ? (const char*)g.Bt + (size_t)nxt.pn * tstep : cB;
        for (int t = 0; t < nt; t += 2) {
            const bool last = (t == nt - 2);
            const char* a1 = cA + (size_t)(t + 1) * kstep;
            const char* a2 = last ? nA : cA + (size_t)(t + 2) * kstep; const char* b2 = last ? nB : cB + (size_t)(t + 2) * kstep;
            const char* a3 = a2 + kstep; const char* b3 = b2 + kstep;
            if (last && has_next) S.a_ready(nxt);
            PG8_LDB(B0, 0, 0); PG8_SCHED; PG8_LDA(At, 0, 0); PG8_STAGE(PG8_SA(1, 1), a1 + hstep, voffA);
            PG8_WAIT_L(8); PG8_BAR; PG8_WAIT_L(0); PG8_MMA(0, 0, At, B0); PG8_BAR; PG8_SCHED;
            PG8_LDB(B1, 0, 1); PG8_STAGE(PG8_SB(0, 0), b2, voffB);
            PG8_BAR; PG8_WAIT_L(0); PG8_MMA(0, 1, At, B1); PG8_BAR;
            PG8_LDA(At, 0, 1); PG8_STAGE(PG8_SA(0, 0), a2, voffA);
            PG8_BAR; PG8_WAIT_L(0); PG8_MMA(1, 0, At, B0); PG8_BAR; PG8_SCHED;
            PG8_STAGE(PG8_SB(0, 1), b2 + hstep, voffB);
            PG8_WAIT_V(6); PG8_BAR; PG8_MMA(1, 1, At, B1); PG8_BAR;
            PG8_LDB(B0, 1, 0); PG8_SCHED; PG8_LDA(At, 1, 0); PG8_STAGE(PG8_SA(0, 1), a2 + hstep, voffA);
            PG8_WAIT_L(8); PG8_BAR; PG8_WAIT_L(0); PG8_MMA(0, 0, At, B0); PG8_BAR; PG8_SCHED;
            PG8_LDB(B1, 1, 1); PG8_STAGE(PG8_SB(1, 0), b3, voffB);
            PG8_BAR; PG8_WAIT_L(0); PG8_MMA(0, 1, At, B1); PG8_BAR;
            PG8_LDA(At, 1, 1); PG8_STAGE(PG8_SA(1, 0), a3, voffA);
            PG8_BAR; PG8_WAIT_L(0); PG8_MMA(1, 0, At, B0); PG8_BAR; PG8_SCHED;
            PG8_STAGE(PG8_SB(1, 1), b3 + hstep, voffB);
            PG8_WAIT_V(6); PG8_BAR; PG8_MMA(1, 1, At, B1); PG8_BAR;
        }
        PG8_STAMP();
        if constexpr (!Epi::AFTER_DRAIN) { E(acc, cur, wr, wc, fr, fq); S.done(cur); }
        PG8_STAMP();
        if (!has_next) break;
#pragma unroll
        for (int a = 0; a < 2; ++a)
#pragma unroll
            for (int b = 0; b < 2; ++b)
#pragma unroll
                for (int m = 0; m < 4; ++m)
#pragma unroll
                    for (int n = 0; n < 2; ++n) acc[a][b][m][n] = (f32x4){0.f, 0.f, 0.f, 0.f};
        cur = nxt; cA = nA; cB = nB; ++ui;
    }
    PG8_WAIT_V(0);
    if (wr == 0) PG8_BAR;
    PG8_BAR;
    if constexpr (Epi::AFTER_DRAIN) { E.fused(acc, cur, wr, wc, fr, fq, lds, wid, lane); S.done(cur); }
    PG8_STAMP();
    if (STAMP && wid == 0) { stamps[lane] = lane < nts ? (((unsigned long long)(unsigned)ts_hi << 32) | (unsigned)ts_lo) : 0ull;
        if (lane == 62) stamps[62] = rt_entry; if (lane == 63) stamps[63] = (unsigned long long)wall_clock64(); }
#undef PG8_STAMP
#undef PG8_SA
#undef PG8_SB
#undef PG8_STAGE
#undef PG8_LDA
#undef PG8_LDB
#undef PG8_MMA
#undef PG8_WAIT_V
#undef PG8_WAIT_L
#undef PG8_BAR
#undef PG8_SCHED
}
}
#define LAS __attribute__((address_space(3)))
typedef unsigned short bf16;
typedef short bf16x8 __attribute__((ext_vector_type(8)));
typedef short bf16x4 __attribute__((ext_vector_type(4)));
typedef float f32x4 __attribute__((ext_vector_type(4)));
typedef unsigned u32x4 __attribute__((ext_vector_type(4)));
typedef unsigned u32x2 __attribute__((ext_vector_type(2)));
typedef float f32x2_ __attribute__((ext_vector_type(2)));
typedef __bf16 bf16x2n __attribute__((ext_vector_type(2)));
__device__ __forceinline__ unsigned cvt_pk_bf16(float lo, float hi) { const f32x2_ v = {lo, hi}; const bf16x2n b = __builtin_convertvector(v, bf16x2n); return __builtin_bit_cast(unsigned, b); }

constexpr int T_TOK = 32768, SEQ = 8192, DM = 1024, NPROJ = 3840, PROJ_W = 3872;
constexpr float EPS = 1e-6f;
constexpr size_t MiB = 1u << 20;
constexpr size_t WS_CTL = 0;
constexpr size_t WS_WTIN = 1 * MiB;
constexpr size_t WS_WTOUT = 9 * MiB;
constexpr size_t WS_W1FK = 11 * MiB + 256 * 1024;
constexpr size_t WS_W1FV = 11 * MiB + 768 * 1024;
constexpr size_t WS_W2FK = 12 * MiB + 256 * 1024;
constexpr size_t WS_W2FV = 12 * MiB + 288 * 1024;
constexpr size_t WS_CPE = 12 * MiB + 320 * 1024;
constexpr size_t WS_BT = 12 * MiB + 384 * 1024;
constexpr size_t WS_RS = 13 * MiB;
constexpr size_t WS_SMALL = 14 * MiB;
constexpr size_t WS_XB = 32 * MiB;
constexpr size_t WS_MIX = 32 * MiB;
constexpr size_t WS_GQKV = 96 * MiB;
constexpr size_t WS_GZ = 192 * MiB;
constexpr size_t WS_NQ = 224 * MiB;
constexpr size_t WS_NKV = 256 * MiB;
constexpr size_t WS_NZ = 304 * MiB;
constexpr size_t WS_GREC = 336 * MiB;
constexpr size_t GREC_BYTES = 73728;
constexpr size_t WS_KCMP = 480 * MiB;
constexpr size_t WS_VCMPT = 480 * MiB + 512 * 1024;
constexpr size_t WS_VST = 482 * MiB;
constexpr size_t WS_VWT = 490 * MiB;
constexpr size_t WS_GLAST = 498 * MiB;
constexpr size_t WS_END = 499 * MiB;
constexpr int LDS_BYTES = 158720;

__device__ __forceinline__ float bf2f(unsigned short h) { return __uint_as_float((unsigned)h << 16); }
__device__ __forceinline__ unsigned short f2bf(float f) { return (unsigned short)(cvt_pk_bf16(f, 0.f) & 0xffffu); }
__device__ __forceinline__ float sigmoidf_(float v) { return 1.0f / (1.0f + __expf(-v)); }
__device__ __forceinline__ float siluf_(float v) { return v / (1.0f + __expf(-v)); }
__device__ __forceinline__ f32x4 mfma16(bf16x8 a, bf16x8 b, f32x4 c) { return __builtin_amdgcn_mfma_f32_16x16x32_bf16(a, b, c, 0, 0, 0); }
__device__ __forceinline__ int kperm(int g, int j) { return j < 4 ? 4 * g + j : 16 + 4 * g + (j - 4); }

struct Frame {
    const float* in[16]; float* out; unsigned char* ws; LAS unsigned char* lds; unsigned char* ldsg;
    int tid, lane, wave;
};

struct EpiProj {
    static constexpr bool PERM = true, AFTER_DRAIN = false;
    bf16* gqkv; bf16* gz; bf16* nq; bf16* nkv; bf16* nz; const float* rs;
    __device__ __forceinline__ void operator()(const f32x4 (&acc)[2][2][4][2], const pg8::Unit& u, int wr, int wc, int fr, int fq) const {
        const int pn = u.pn; bf16* base; int ldc, colt, act;
        if (pn < 6) { base = gqkv; ldc = 1536; colt = pn * 256; act = 0; }
        else if (pn < 8) { base = gz; ldc = 512; colt = (pn - 6) * 256; act = 1; }
        else if (pn < 10) { base = nq; ldc = 512; colt = (pn - 8) * 256; act = 2; }
        else if (pn < 13) { base = nkv; ldc = 768; colt = (pn - 10) * 256; act = 0; }
        else { base = nz; ldc = 512; colt = (pn - 13) * 256; act = 1; }
        const int row0 = u.pm * 256 + wr * 64 + fr, col0 = colt + wc * 32 + 8 * fq;
        float rsv[2][4];
#pragma unroll
        for (int ai = 0; ai < 2; ++ai)
#pragma unroll
            for (int m = 0; m < 4; ++m) rsv[ai][m] = rs[row0 + ai * 128 + m * 16];
#pragma unroll
        for (int ai = 0; ai < 2; ++ai)
#pragma unroll
            for (int m = 0; m < 4; ++m) {
                const int row = row0 + ai * 128 + m * 16; const float r = rsv[ai][m];
                bf16* rowp = base + (size_t)row * ldc + col0;
#pragma unroll
                for (int bj = 0; bj < 2; ++bj) {
                    f32x4 v0 = acc[ai][bj][m][0] * r, v1 = acc[ai][bj][m][1] * r;
                    if (act == 1) {
#pragma unroll
                        for (int j = 0; j < 4; ++j) { v0[j] = siluf_(v0[j]); v1[j] = siluf_(v1[j]); }
                    } else if (act == 2) { v0 = v0 * 0.18033688011112042f; v1 = v1 * 0.18033688011112042f; }
                    u32x4 w; w.x = cvt_pk_bf16(v0[0], v0[1]); w.y = cvt_pk_bf16(v0[2], v0[3]); w.z = cvt_pk_bf16(v1[0], v1[1]); w.w = cvt_pk_bf16(v1[2], v1[3]);
                    *(u32x4*)(rowp + bj * 128) = w;
                }
            }
    }
};
struct EpiOut {
    static constexpr bool PERM = false, AFTER_DRAIN = false;
    const float* __restrict__ x; float* __restrict__ out;
    __device__ __forceinline__ void operator()(const f32x4 (&acc)[2][2][4][2], const pg8::Unit& u, int wr, int wc, int fr, int fq) const {
        const int row0 = u.pm * 256 + wr * 64 + fr, col0 = u.pn * 256 + wc * 32 + 4 * fq;
        f32x4 xa[8], xb[8];
#define EO_LOAD(X_, AI, MH) do { _Pragma("unroll") for (int _m = 0; _m < 2; ++_m) _Pragma("unroll") for (int _bj = 0; _bj < 2; ++_bj) _Pragma("unroll") for (int _n = 0; _n < 2; ++_n) \
            X_[_m * 4 + _bj * 2 + _n] = *(const f32x4*)(x + (size_t)(row0 + (AI) * 128 + ((MH) * 2 + _m) * 16) * DM + col0 + _bj * 128 + _n * 16); } while (0)
#define EO_STORE(X_, AI, MH) do { asm volatile("" : "+v"(X_[0]), "+v"(X_[1]), "+v"(X_[2]), "+v"(X_[3]), "+v"(X_[4]), "+v"(X_[5]), "+v"(X_[6]), "+v"(X_[7])); \
            _Pragma("unroll") for (int _m = 0; _m < 2; ++_m) _Pragma("unroll") for (int _bj = 0; _bj < 2; ++_bj) _Pragma("unroll") for (int _n = 0; _n < 2; ++_n) \
            *(f32x4*)(out + (size_t)(row0 + (AI) * 128 + ((MH) * 2 + _m) * 16) * DM + col0 + _bj * 128 + _n * 16) = acc[AI][_bj][(MH) * 2 + _m][_n] + X_[_m * 4 + _bj * 2 + _n]; } while (0)
        EO_LOAD(xa, 0, 0); EO_LOAD(xb, 0, 1); EO_STORE(xa, 0, 0); EO_LOAD(xa, 1, 0); EO_STORE(xb, 0, 1); EO_LOAD(xb, 1, 1); EO_STORE(xa, 1, 0); EO_STORE(xb, 1, 1);
#undef EO_LOAD
#undef EO_STORE
    }
};

__device__ __forceinline__ int orig_col(int n) {
    return n < 2048 ? n : (n < 2560 ? 2056 + (n - 2048) : (n < 3328 ? 2568 + (n - 2560) : 3360 + (n - 3328)));
}
__device__ __forceinline__ int orig_small(int sc) { return sc < 8 ? 2048 + sc : 3336 + (sc - 8); }
__device__ __forceinline__ int rel_bucket(int dist) {
    const int n = dist < 0 ? 0 : dist;
    if (n < 16) return n;
    int b = 16;
    b += (n >= 21); b += (n >= 27); b += (n >= 35); b += (n >= 46); b += (n >= 59); b += (n >= 77); b += (n >= 99); b += (n >= 128);
    b += (n >= 166); b += (n >= 216); b += (n >= 280); b += (n >= 363); b += (n >= 470); b += (n >= 609); b += (n >= 790);
    return b;
}
__device__ __forceinline__ void transpose_tile(const Frame& F, const float* src, int sld, int srccol0, int k0, const float* scale, bf16* dst, int dld, int n0) {
    LAS float* tile = (LAS float*)F.lds;
    const int kk = F.tid >> 6, nn = F.tid & 63;
    float tv[8], tsc[8];
#pragma unroll
    for (int i = 0; i < 8; ++i) { const int k = kk + 8 * i; tv[i] = src[(size_t)(k0 + k) * sld + srccol0 + nn]; tsc[i] = scale ? scale[k0 + k] : 1.0f; }
#pragma unroll
    for (int i = 0; i < 8; ++i) { const int k = kk + 8 * i; tile[k * 65 + nn] = tv[i] * tsc[i]; }
    __syncthreads();
    const int n2 = F.tid >> 3, kc = F.tid & 7;
    float e[8];
#pragma unroll
    for (int j = 0; j < 8; ++j) e[j] = tile[(8 * kc + j) * 65 + n2];
    u32x4 w; w.x = cvt_pk_bf16(e[0], e[1]); w.y = cvt_pk_bf16(e[2], e[3]); w.z = cvt_pk_bf16(e[4], e[5]); w.w = cvt_pk_bf16(e[6], e[7]);
    *(u32x4*)(dst + (size_t)(n0 + n2) * dld + k0 + 8 * kc) = w;
    __syncthreads();
}

__device__ __forceinline__ void p0_prep(const Frame& F) {
    const float* x = F.in[0]; const float* nw = F.in[1]; const float* w_in = F.in[2];
    unsigned char* ws = F.ws;
    const int G = gridDim.x, bid = blockIdx.x;
    for (int task = bid; task < 1365; task += G) {
        if (task < 960) { const int nt = task / 16, kt = task % 16; transpose_tile(F, w_in, PROJ_W, orig_col(nt * 64), kt * 64, nw, (bf16*)(ws + WS_WTIN), DM, nt * 64); }
        else if (task < 1216) { const int t2 = task - 960, nt = t2 / 16, kt = t2 % 16; transpose_tile(F, F.in[13], DM, nt * 64, kt * 64, nullptr, (bf16*)(ws + WS_WTOUT), DM, nt * 64); }
        else if (task < 1344) {
            const int t2 = task - 1216, which = t2 >> 6, sub = t2 & 63;
            const float* w1 = F.in[which ? 11 : 9]; bf16* dst = (bf16*)(ws + (which ? WS_W1FV : WS_W1FK));
            const int mt = F.tid >> 6, l = F.tid & 63, m = l & 15, kg = l >> 4, ks = sub;
            float e[8];
#pragma unroll
            for (int j = 0; j < 8; ++j) e[j] = w1[(size_t)(32 * ks + 8 * kg + j) * 128 + 16 * mt + m];
            u32x4 w; w.x = cvt_pk_bf16(e[0], e[1]); w.y = cvt_pk_bf16(e[2], e[3]); w.z = cvt_pk_bf16(e[4], e[5]); w.w = cvt_pk_bf16(e[6], e[7]);
            *(u32x4*)(dst + ((size_t)(ks * 8 + mt) * 64 + l) * 8) = w;
        } else if (task < 1346) {
            const int which = task - 1344; const float* w2 = F.in[which ? 12 : 10]; bf16* dst = (bf16*)(ws + (which ? WS_W2FV : WS_W2FK));
            for (int i = F.tid; i < 1024; i += 512) {
                const int l = i & 63, ks = (i >> 6) & 3, mt = i >> 8, m = l & 15, kg = l >> 4;
                float e[8];
#pragma unroll
                for (int j = 0; j < 8; ++j) e[j] = w2[(size_t)(32 * ks + kperm(kg, j)) * 64 + 16 * mt + m];
                u32x4 w; w.x = cvt_pk_bf16(e[0], e[1]); w.y = cvt_pk_bf16(e[2], e[3]); w.z = cvt_pk_bf16(e[4], e[5]); w.w = cvt_pk_bf16(e[6], e[7]);
                *(u32x4*)(dst + (size_t)i * 8) = w;
            }
        } else if (task < 1348) {
            const int which = task - 1346; const float* pe = F.in[which ? 8 : 7]; const float* w1 = F.in[which ? 11 : 9];
            float* dst = (float*)(ws + WS_CPE) + which * 128;
            if (F.tid < 128) { float s = 0.f; for (int k = 0; k < 2048; ++k) s += pe[k] * w1[(size_t)k * 128 + F.tid]; dst[F.tid] = s; }
        } else {
            const int i = (task - 1348) * 512 + F.tid;
            if (i < 8 * 1025) { const int head = i / 1025, dist = i % 1025; ((float*)(ws + WS_BT))[i] = F.in[14][rel_bucket(dist) * 8 + head] * 1.4426950408889634f; }
        }
    }
    __syncthreads();
    {
        for (int i = F.tid; i < 32 * 2 * 64; i += 512) {
            const int l = i & 63, nt = (i >> 6) & 1, ks = i >> 7, kg = l >> 4, sc = 16 * nt + (l & 15), oc = orig_small(sc);
            float v[8], lo[8]; unsigned short hi[8];
#pragma unroll
            for (int j = 0; j < 8; ++j) { const int k = 32 * ks + 8 * kg + j; v[j] = w_in[(size_t)k * PROJ_W + oc] * nw[k]; hi[j] = f2bf(v[j]); lo[j] = v[j] - bf2f(hi[j]); }
            u32x4 wh, wl;
            wh.x = hi[0] | ((unsigned)hi[1] << 16); wh.y = hi[2] | ((unsigned)hi[3] << 16); wh.z = hi[4] | ((unsigned)hi[5] << 16); wh.w = hi[6] | ((unsigned)hi[7] << 16);
            wl.x = cvt_pk_bf16(lo[0], lo[1]); wl.y = cvt_pk_bf16(lo[2], lo[3]); wl.z = cvt_pk_bf16(lo[4], lo[5]); wl.w = cvt_pk_bf16(lo[6], lo[7]);
            *(LAS u32x4*)(F.lds + ((size_t)((ks * 2 + nt) * 2 + 0) * 64 + l) * 16) = wh;
            *(LAS u32x4*)(F.lds + ((size_t)((ks * 2 + nt) * 2 + 1) * 64 + l) * 16) = wl;
        }
    }
    __syncthreads();
    bf16* xb = (bf16*)(ws + WS_XB); float* rsv = (float*)(ws + WS_RS); float* small = (float*)(ws + WS_SMALL);
    const float* a_log = F.in[4]; const float* dt_bias = F.in[5];
    for (int tile = bid * 8 + F.wave; tile < T_TOK / 16; tile += G * 8) {
        const int l = F.lane, r = l & 15, kg = l >> 4; const int row = tile * 16 + r;
        const float* xr = x + (size_t)row * DM + 8 * kg;
        f32x4 acc0 = {0.f, 0.f, 0.f, 0.f}, acc1 = {0.f, 0.f, 0.f, 0.f};
        float ss = 0.f;
        f32x4 xc[8], xn[8];
#define P0_LOADG(X_, G_) do { _Pragma("unroll") for (int _q = 0; _q < 4; ++_q) { X_[2 * _q] = *(const f32x4*)(xr + 32 * (4 * (G_) + _q)); X_[2 * _q + 1] = *(const f32x4*)(xr + 32 * (4 * (G_) + _q) + 4); } } while (0)
#define P0_STEP(X_, G_) do { _Pragma("unroll") for (int _q = 0; _q < 4; ++_q) { const int ks = 4 * (G_) + _q; const f32x4 a0 = X_[2 * _q], a1 = X_[2 * _q + 1]; \
            ss += a0[0] * a0[0] + a0[1] * a0[1] + a0[2] * a0[2] + a0[3] * a0[3] + a1[0] * a1[0] + a1[1] * a1[1] + a1[2] * a1[2] + a1[3] * a1[3]; \
            u32x4 h; h.x = cvt_pk_bf16(a0[0], a0[1]); h.y = cvt_pk_bf16(a0[2], a0[3]); h.z = cvt_pk_bf16(a1[0], a1[1]); h.w = cvt_pk_bf16(a1[2], a1[3]); \
            *(u32x4*)(xb + (size_t)row * DM + 32 * ks + 8 * kg) = h; \
            u32x4 lo; \
            lo.x = cvt_pk_bf16(a0[0] - __uint_as_float(h.x << 16), a0[1] - __uint_as_float(h.x & 0xffff0000u)); \
            lo.y = cvt_pk_bf16(a0[2] - __uint_as_float(h.y << 16), a0[3] - __uint_as_float(h.y & 0xffff0000u)); \
            lo.z = cvt_pk_bf16(a1[0] - __uint_as_float(h.z << 16), a1[1] - __uint_as_float(h.z & 0xffff0000u)); \
            lo.w = cvt_pk_bf16(a1[2] - __uint_as_float(h.w << 16), a1[3] - __uint_as_float(h.w & 0xffff0000u)); \
            const bf16x8 ah = __builtin_bit_cast(bf16x8, h), al = __builtin_bit_cast(bf16x8, lo); \
            const LAS unsigned char* fb = F.lds + (size_t)(ks * 4) * 1024 + l * 16; \
            const bf16x8 b0h = *(const LAS bf16x8*)(fb), b0l = *(const LAS bf16x8*)(fb + 1024), b1h = *(const LAS bf16x8*)(fb + 2048), b1l = *(const LAS bf16x8*)(fb + 3072); \
            acc0 = mfma16(ah, b0h, acc0); acc0 = mfma16(al, b0h, acc0); acc0 = mfma16(ah, b0l, acc0); \
            acc1 = mfma16(ah, b1h, acc1); acc1 = mfma16(al, b1h, acc1); acc1 = mfma16(ah, b1l, acc1); } } while (0)
#define P0_PIN(X_) asm volatile("" : "+v"(X_[0]), "+v"(X_[1]), "+v"(X_[2]), "+v"(X_[3]), "+v"(X_[4]), "+v"(X_[5]), "+v"(X_[6]), "+v"(X_[7]))
        P0_LOADG(xc, 0);
#pragma unroll
        for (int gq = 0; gq < 8; gq += 2) {
            P0_LOADG(xn, gq + 1); P0_PIN(xc); P0_STEP(xc, gq);
            if (gq + 2 < 8) P0_LOADG(xc, gq + 2);
            P0_PIN(xn); P0_STEP(xn, gq + 1);
        }
#undef P0_LOADG
#undef P0_STEP
#undef P0_PIN
        const float dtb = dt_bias[r & 3], alg = a_log[r & 3];
        ss += __shfl_xor(ss, 16); ss += __shfl_xor(ss, 32);
        const float rs = rsqrtf(ss * (1.0f / 1024.f) + EPS);
        if (kg == 0) rsv[row] = rs;
#pragma unroll
        for (int reg = 0; reg < 4; ++reg) {
            const int rr = 4 * kg + reg; const float rsr = __shfl(rs, rr);
            const int orow = tile * 16 + rr;
            {
                const float v = acc0[reg] * rsr; const int c = r; float o;
                if (c < 4) o = sigmoidf_(v);
                else if (c < 8) { const float z = v + dtb; const float sp = z > 20.f ? z : log1pf(expf(z)); o = -expf(alg) * sp; }
                else o = sigmoidf_(v);
                small[(size_t)orow * 32 + c] = o;
            }
            { const float v = acc1[reg] * rsr; small[(size_t)orow * 32 + 16 + r] = sigmoidf_(v); }
        }
    }
}

__device__ __forceinline__ void p5_final(const Frame& F) {
    const float* fw = F.in[15]; float* out = F.out;
    f32x4 wv[4];
#pragma unroll
    for (int i = 0; i < 4; ++i) wv[i] = ((const f32x4*)fw)[F.lane + 64 * i];
    const int stride = gridDim.x * 8;
    int r = blockIdx.x * 8 + F.wave;
    f32x4 v[4], vn[4];
    if (r < T_TOK) {
#pragma unroll
        for (int i = 0; i < 4; ++i) v[i] = ((const f32x4*)(out + (size_t)r * DM))[F.lane + 64 * i];
    }
    for (; r < T_TOK; r += stride) {
        const int rn = r + stride;
        if (rn < T_TOK) {
#pragma unroll
            for (int i = 0; i < 4; ++i) vn[i] = ((const f32x4*)(out + (size_t)rn * DM))[F.lane + 64 * i];
        }
        asm volatile("" : "+v"(v[0]), "+v"(v[1]), "+v"(v[2]), "+v"(v[3]));
        float ss = 0.f;
#pragma unroll
        for (int i = 0; i < 4; ++i) ss += v[i][0] * v[i][0] + v[i][1] * v[i][1] + v[i][2] * v[i][2] + v[i][3] * v[i][3];
#pragma unroll
        for (int o = 32; o > 0; o >>= 1) ss += __shfl_xor(ss, o);
        const float rs = rsqrtf(ss * (1.0f / 1024.f) + EPS);
        f32x4* orow = (f32x4*)(out + (size_t)r * DM);
#pragma unroll
        for (int i = 0; i < 4; ++i) orow[F.lane + 64 * i] = v[i] * rs * wv[i];
#pragma unroll
        for (int i = 0; i < 4; ++i) v[i] = vn[i];
    }
}

#ifndef G_CONV
#define G_CONV 0
#endif
#ifndef G_MFMA
#define G_MFMA 0
#endif
#ifndef G_FRAG
#define G_FRAG 0
#endif
#ifndef G_OUT
#define G_OUT 0
#endif
__device__ __forceinline__ float dppf(float x, int ctrl_unused) { return x; }
#define DPP_F(x, CTRL, RM) __builtin_bit_cast(float, __builtin_amdgcn_update_dpp(0, __builtin_bit_cast(int, (x)), CTRL, RM, 0xf, true))
__device__ __forceinline__ float row16_sum(float x) {
    x += DPP_F(x, 0xB1, 0xf); x += DPP_F(x, 0x4E, 0xf); x += DPP_F(x, 0x141, 0xf); x += DPP_F(x, 0x140, 0xf); return x;
}
__device__ __forceinline__ float wave_prefix_sum(float v) {
    v += DPP_F(v, 0x111, 0xf); v += DPP_F(v, 0x112, 0xf); v += DPP_F(v, 0x114, 0xf); v += DPP_F(v, 0x118, 0xf);
    v += DPP_F(v, 0x142, 0xa); v += DPP_F(v, 0x143, 0xc); return v;
}
constexpr int GL_CW = 148224;
constexpr int REC_WNEG = 0, REC_QDEC = 16384, REC_ATTN = 32768, REC_KDT = 40960, REC_U = 57344, REC_LDS_BYTES = 57344;
__device__ __forceinline__ void gdn_prep_item(const Frame& F, int item) {
    int tid_ = F.tid; asm volatile("" : "+v"(tid_));
    const int tid = tid_;
    const int h = item & 3, n = (item >> 2) & 127, b = item >> 9;
    const int tok0 = b * SEQ + n * 64;
    LAS float* kf = (LAS float*)(F.lds); LAS float* vf = (LAS float*)(F.lds + 32768);
    LAS bf16* qb = (LAS bf16*)(F.lds + 65536); LAS bf16* kb = (LAS bf16*)(F.lds + 82944); LAS bf16* kbb = (LAS bf16*)(F.lds + 100352);
    LAS float* Lm = (LAS float*)(F.lds + 117760); LAS bf16* atb = (LAS bf16*)(F.lds + 134144); LAS float* gcs = (LAS float*)(F.lds + 143360);
    LAS float* tinv = (LAS float*)(F.lds + 144128);
    unsigned char* rec = F.ws + WS_GREC + (size_t)item * GREC_BYTES;
    const float* small = (const float*)(F.ws + WS_SMALL);
    {
        const int ln = tid & 63;
        const float beta = small[(size_t)(tok0 + ln) * 32 + h]; float c = small[(size_t)(tok0 + ln) * 32 + 4 + h];
        c = wave_prefix_sum(c);
        gcs[ln] = c; gcs[64 + ln] = beta; gcs[128 + ln] = expf(c);
        if (tid == 63) ((float*)(F.ws + WS_GLAST))[item] = expf(c);
    }
    for (int d1 = 0; d1 <= G_CONV; ++d1)
    {
        const bf16* gq = (const bf16*)(F.ws + WS_GQKV); const float* cw = F.in[3];
        const int grp = tid >> 4, li = tid & 15;
        u32x4 xin[3][5]; float pzv[5];
        {
            const int pos0 = n * 64 + grp * 2;
#pragma unroll
            for (int q5 = 0; q5 < 5; ++q5) {
                const int p = pos0 - 3 + q5; const int pc = p < 0 ? 0 : p; pzv[q5] = p < 0 ? 0.f : 1.f;
#pragma unroll
                for (int part = 0; part < 3; ++part) xin[part][q5] = *(const u32x4*)(gq + (size_t)(b * SEQ + pc) * 1536 + part * 512 + h * 128 + 8 * li);
            }
#pragma unroll
            for (int part = 0; part < 3; ++part) asm volatile("" : "+v"(xin[part][0]), "+v"(xin[part][1]), "+v"(xin[part][2]), "+v"(xin[part][3]), "+v"(xin[part][4]));
        }
#pragma unroll
        for (int rr = 0; rr < 2; ++rr) {
            const int c = grp * 2 + rr;
            const float betav = gcs[64 + c], egv = gcs[128 + c];
#pragma unroll
            for (int part = 0; part < 3; ++part) {
                float y[8];
#pragma unroll
                for (int e = 0; e < 8; ++e) y[e] = 0.f;
#pragma unroll
                for (int j = 0; j < 4; ++j) {
                    const float pz = pzv[rr + j];
                    {
                        const u32x4 xv = xin[part][rr + j];
                        const LAS float* cwl = (const LAS float*)(F.lds + GL_CW) + (j * 3 + part) * 128 + 8 * li;
                        const f32x4 w0 = *(const LAS f32x4*)cwl * pz, w1 = *(const LAS f32x4*)(cwl + 4) * pz;
                        y[0] += w0[0] * __uint_as_float(xv.x << 16); y[1] += w0[1] * __uint_as_float(xv.x & 0xffff0000u);
                        y[2] += w0[2] * __uint_as_float(xv.y << 16); y[3] += w0[3] * __uint_as_float(xv.y & 0xffff0000u);
                        y[4] += w1[0] * __uint_as_float(xv.z << 16); y[5] += w1[1] * __uint_as_float(xv.z & 0xffff0000u);
                        y[6] += w1[2] * __uint_as_float(xv.w << 16); y[7] += w1[3] * __uint_as_float(xv.w & 0xffff0000u);
                    }
                }
                float ss = 0.f;
#pragma unroll
                for (int e = 0; e < 8; ++e) { y[e] = siluf_(y[e]); ss += y[e] * y[e]; }
                if (part < 2) {
                    ss = row16_sum(ss);
                    const float sc = rsqrtf(ss + EPS) * (part == 0 ? 0.08838834764831845f : 1.0f);
#pragma unroll
                    for (int e = 0; e < 8; ++e) y[e] *= sc;
                }
                if (part == 0) {
                    u32x4 w; w.x = cvt_pk_bf16(y[0], y[1]); w.y = cvt_pk_bf16(y[2], y[3]); w.z = cvt_pk_bf16(y[4], y[5]); w.w = cvt_pk_bf16(y[6], y[7]);
                    *(LAS u32x4*)(qb + c * 136 + 8 * li) = w;
                    const int mt = c >> 4, m = c & 15, ks = li >> 2, a = (li & 3) >> 1, g0 = (2 * (li & 3)) & 3, g1 = (2 * (li & 3) + 1) & 3;
                    u32x2 d0, d1; d0.x = cvt_pk_bf16(y[0] * egv, y[1] * egv); d0.y = cvt_pk_bf16(y[2] * egv, y[3] * egv); d1.x = cvt_pk_bf16(y[4] * egv, y[5] * egv); d1.y = cvt_pk_bf16(y[6] * egv, y[7] * egv);
                    unsigned char* fb = rec + REC_QDEC + (size_t)(mt * 4 + ks) * 1024 + a * 8;
                    *(u32x2*)(fb + (g0 * 16 + m) * 16) = d0; *(u32x2*)(fb + (g1 * 16 + m) * 16) = d1;
                } else if (part == 1) {
                    *(LAS f32x4*)(kf + c * 128 + 8 * li) = (f32x4){y[0], y[1], y[2], y[3]}; *(LAS f32x4*)(kf + c * 128 + 8 * li + 4) = (f32x4){y[4], y[5], y[6], y[7]};
                    u32x4 w; w.x = cvt_pk_bf16(y[0], y[1]); w.y = cvt_pk_bf16(y[2], y[3]); w.z = cvt_pk_bf16(y[4], y[5]); w.w = cvt_pk_bf16(y[6], y[7]);
                    *(LAS u32x4*)(kb + c * 136 + 8 * li) = w;
                    w.x = cvt_pk_bf16(y[0] * betav, y[1] * betav); w.y = cvt_pk_bf16(y[2] * betav, y[3] * betav); w.z = cvt_pk_bf16(y[4] * betav, y[5] * betav); w.w = cvt_pk_bf16(y[6] * betav, y[7] * betav);
                    *(LAS u32x4*)(kbb + c * 136 + 8 * li) = w;
                } else {
                    *(LAS f32x4*)(vf + c * 128 + 8 * li) = (f32x4){y[0], y[1], y[2], y[3]}; *(LAS f32x4*)(vf + c * 128 + 8 * li + 4) = (f32x4){y[4], y[5], y[6], y[7]};
                }
            }
        }
    }
    __syncthreads();
    for (int d2 = 0; d2 <= G_MFMA; ++d2)
    {
        const int l = (tid & 63), m = l & 15, kg = l >> 4;
#pragma unroll
        for (int i = 0; i < 4; ++i) {
            const int tt = F.wave * 4 + i, which = tt >> 4, mi = (tt >> 2) & 3, ni = tt & 3;
            f32x4 acc = {0.f, 0.f, 0.f, 0.f};
            if (mi >= ni) {
                const LAS bf16* As = which ? qb : kbb;
#pragma unroll
                for (int ks = 0; ks < 4; ++ks) {
                    const bf16x8 a = *(const LAS bf16x8*)(As + (16 * mi + m) * 136 + 32 * ks + 8 * kg);
                    const bf16x8 bb = *(const LAS bf16x8*)(kb + (16 * ni + m) * 136 + 32 * ks + 8 * kg);
                    acc = mfma16(a, bb, acc);
                }
            }
            {
                const int jcol = 16 * ni + m; const float gj = gcs[jcol];
                const f32x4 gi = *(const LAS f32x4*)(gcs + 16 * mi + 4 * kg);
#pragma unroll
                for (int r = 0; r < 4; ++r) {
                    const int irow = 16 * mi + 4 * kg + r;
                    const float d = gi[r] - gj; const float dec = __expf(d < 0.f ? d : 0.f);
                    const float v = acc[r] * dec;
                    if (which == 0) Lm[jcol * 64 + irow] = (irow > jcol) ? v : 0.f;
                    else atb[irow * 72 + jcol] = f2bf((irow >= jcol) ? v : 0.f);
                }
            }
        }
    }
    __syncthreads();
    for (int d3 = 0; d3 <= G_FRAG; ++d3) {
    if (tid < 64) {
        const int ib = tid >> 4, c = tid & 15;
        float x[16];
#pragma unroll
        for (int i = 0; i < 16; ++i) x[i] = (i == c) ? 1.0f : 0.0f;
#pragma unroll
        for (int j = 0; j < 15; ++j) {
            const LAS f32x4* lp = (const LAS f32x4*)(Lm + (16 * ib + j) * 64 + 16 * ib);
#pragma unroll
            for (int q4 = 0; q4 < 4; ++q4) {
                if (4 * q4 + 3 > j) {
                    const f32x4 lv = lp[q4];
#pragma unroll
                    for (int e = 0; e < 4; ++e) if (4 * q4 + e > j) x[4 * q4 + e] -= lv[e] * x[j];
                }
            }
            asm volatile("" ::: "memory");
        }
#pragma unroll
        for (int i = 0; i < 16; ++i) tinv[(ib * 16 + c) * 16 + i] = x[i];
    }
    {
        const float gl = gcs[63];
#pragma unroll
        for (int q = 0; q < 2; ++q) {
            const int idx = tid + 512 * q, l = idx & 63, ks = (idx >> 6) & 1, mt = idx >> 7, m = l & 15, g = l >> 4;
            float e[8];
#pragma unroll
            for (int j = 0; j < 8; ++j) { const int cr = 32 * ks + kperm(g, j); e[j] = kf[cr * 128 + 16 * mt + m] * expf(gl - gcs[cr]); }
            u32x4 w; w.x = cvt_pk_bf16(e[0], e[1]); w.y = cvt_pk_bf16(e[2], e[3]); w.z = cvt_pk_bf16(e[4], e[5]); w.w = cvt_pk_bf16(e[6], e[7]);
            *(u32x4*)(rec + REC_KDT + (size_t)idx * 16) = w;
        }
        {
            const int idx = tid, l = idx & 63, ks = (idx >> 6) & 1, mt = idx >> 7, m = l & 15, g = l >> 4;
            const u32x2 a0 = *(const LAS u32x2*)(atb + (16 * mt + m) * 72 + 32 * ks + 4 * g), a1 = *(const LAS u32x2*)(atb + (16 * mt + m) * 72 + 32 * ks + 16 + 4 * g);
            *(u32x4*)(rec + REC_ATTN + (size_t)idx * 16) = (u32x4){a0.x, a0.y, a1.x, a1.y};
        }
    }
    }
    __syncthreads();
    {
        const int l = (tid & 63), li = l & 15, lk = l >> 4, w = F.wave; const bool isw = w >= 4;
        LAS float* base = isw ? (kf + 32 * (w - 4)) : (vf + 32 * w);
#pragma unroll
        for (int ib = 0; ib < 4; ++ib) {
            f32x4 acc[2];
#pragma unroll
            for (int nt = 0; nt < 2; ++nt)
#pragma unroll
                for (int r = 0; r < 4; ++r) { const int i = 16 * ib + 4 * lk + r; acc[nt][r] = base[i * 128 + 16 * nt + li] * gcs[64 + i] * (isw ? gcs[128 + i] : 1.0f); }
            if (ib > 0) {
                float av[12], b0[12], b1[12];
#pragma unroll
                for (int kk = 0; kk < 4 * ib; ++kk) { av[kk] = -Lm[(4 * kk + lk) * 64 + 16 * ib + li]; b0[kk] = base[(4 * kk + lk) * 128 + li]; b1[kk] = base[(4 * kk + lk) * 128 + 16 + li]; }
#pragma unroll
                for (int kk = 0; kk < 4 * ib; ++kk) asm volatile("" : "+v"(av[kk]), "+v"(b0[kk]), "+v"(b1[kk]));
#pragma unroll
                for (int kk = 0; kk < 4 * ib; ++kk) {
                    acc[0] = __builtin_amdgcn_mfma_f32_16x16x4f32(av[kk], b0[kk], acc[0], 0, 0, 0);
                    acc[1] = __builtin_amdgcn_mfma_f32_16x16x4f32(av[kk], b1[kk], acc[1], 0, 0, 0);
                }
            }
#pragma unroll
            for (int nt = 0; nt < 2; ++nt)
#pragma unroll
                for (int r = 0; r < 4; ++r) base[(16 * ib + 4 * lk + r) * 128 + 16 * nt + li] = acc[nt][r];
            f32x4 y[2] = {(f32x4){0.f, 0.f, 0.f, 0.f}, (f32x4){0.f, 0.f, 0.f, 0.f}};
            {
                float av[4], b0[4], b1[4];
#pragma unroll
                for (int kk = 0; kk < 4; ++kk) { av[kk] = tinv[(ib * 16 + 4 * kk + lk) * 16 + li]; b0[kk] = base[(16 * ib + 4 * kk + lk) * 128 + li]; b1[kk] = base[(16 * ib + 4 * kk + lk) * 128 + 16 + li]; }
#pragma unroll
                for (int kk = 0; kk < 4; ++kk) asm volatile("" : "+v"(av[kk]), "+v"(b0[kk]), "+v"(b1[kk]));
#pragma unroll
                for (int kk = 0; kk < 4; ++kk) {
                    y[0] = __builtin_amdgcn_mfma_f32_16x16x4f32(av[kk], b0[kk], y[0], 0, 0, 0);
                    y[1] = __builtin_amdgcn_mfma_f32_16x16x4f32(av[kk], b1[kk], y[1], 0, 0, 0);
                }
            }
#pragma unroll
            for (int nt = 0; nt < 2; ++nt)
#pragma unroll
                for (int r = 0; r < 4; ++r) base[(16 * ib + 4 * lk + r) * 128 + 16 * nt + li] = y[nt][r];
        }
    }
    __syncthreads();
    for (int d4 = 0; d4 <= G_OUT; ++d4)
    {
#pragma unroll
        for (int q = 0; q < 4; ++q) {
            const int idx = tid + 512 * q, l = idx & 63, mt = (idx >> 6) & 3, sl = idx >> 8, g4 = l >> 4, nn = l & 15;
            const LAS float* up = vf + (16 * mt + 4 * g4) * 128 + 16 * sl + nn;
            u32x2 d; d.x = cvt_pk_bf16(up[0], up[128]); d.y = cvt_pk_bf16(up[256], up[384]);
            *(u32x2*)(rec + REC_U + (size_t)idx * 8) = d;
        }
#pragma unroll
        for (int q = 0; q < 2; ++q) {
            const int idx = tid + 512 * q, l = idx & 63, ks = (idx >> 6) & 3, mt = idx >> 8, m = l & 15, g = l >> 4;
            const f32x4 a0 = *(const LAS f32x4*)(kf + (16 * mt + m) * 128 + 32 * ks + 4 * g), a1 = *(const LAS f32x4*)(kf + (16 * mt + m) * 128 + 32 * ks + 16 + 4 * g);
            u32x4 w; w.x = cvt_pk_bf16(-a0[0], -a0[1]); w.y = cvt_pk_bf16(-a0[2], -a0[3]); w.z = cvt_pk_bf16(-a1[0], -a1[1]); w.w = cvt_pk_bf16(-a1[2], -a1[3]);
            *(u32x4*)(rec + REC_WNEG + (size_t)idx * 16) = w;
        }
    }
    __syncthreads();
}

__device__ __forceinline__ bf16x8 acc2frag(const f32x4& lo, const f32x4& hi) {
    u32x4 w; w.x = cvt_pk_bf16(lo[0], lo[1]); w.y = cvt_pk_bf16(lo[2], lo[3]); w.z = cvt_pk_bf16(hi[0], hi[1]); w.w = cvt_pk_bf16(hi[2], hi[3]);
    return __builtin_bit_cast(bf16x8, w);
}
__device__ __forceinline__ void gdn_scan(const Frame& F, int bh) {
    const int tid = F.tid, lane = F.lane, s = F.wave;
    const int b = bh >> 2, h = bh & 3;
    LAS unsigned char* buf0 = F.lds; LAS float* ox = (LAS float*)(F.lds + 2 * REC_LDS_BYTES);
    const float* glast = (const float*)(F.ws + WS_GLAST);
    const bf16* gz = (const bf16*)(F.ws + WS_GZ); const float* gnw = F.in[6]; bf16* mix = (bf16*)(F.ws + WS_MIX);
    f32x4 S[8];
#pragma unroll
    for (int t = 0; t < 8; ++t) S[t] = (f32x4){0.f, 0.f, 0.f, 0.f};
    const unsigned char* const recbase = F.ws + WS_GREC + (size_t)(b * 512 + h) * GREC_BYTES;
#define recp(n) (recbase + (size_t)(n) * 4 * GREC_BYTES)
#define GS_STAGE(n, bufsel) do { const unsigned char* _r = recp(n); _Pragma("unroll") for (int _i = 0; _i < 7; ++_i) \
        __builtin_amdgcn_global_load_lds((const unsigned*)(_r + (size_t)(_i * 512 + tid) * 16), (LAS unsigned*)(buf0 + (bufsel) * REC_LDS_BYTES + (_i * 8 + s) * 1024), 16, 0, 0); } while (0)
    GS_STAGE(0, 0);
    u32x2 un[4];
#pragma unroll
    for (int mt = 0; mt < 4; ++mt) un[mt] = *(const u32x2*)(recp(0) + REC_U + (size_t)((s * 4 + mt) * 64 + lane) * 8);
    float egn = glast[(b * 128 + 0) * 4 + h];
    for (int n = 0; n < 128; ++n) {
        const int cur = n & 1;
        asm volatile("s_waitcnt vmcnt(0)" ::: "memory");
        __syncthreads();
        u32x2 uc[4];
#pragma unroll
        for (int mt = 0; mt < 4; ++mt) uc[mt] = un[mt];
        const float egl = egn;
        if (n + 1 < 128) {
            GS_STAGE(n + 1, cur ^ 1);
#pragma unroll
            for (int mt = 0; mt < 4; ++mt) un[mt] = *(const u32x2*)(recp(n + 1) + REC_U + (size_t)((s * 4 + mt) * 64 + lane) * 8);
            egn = glast[(b * 128 + n + 1) * 4 + h];
        }
        const LAS unsigned char* bp = buf0 + cur * REC_LDS_BYTES + lane * 16;
        const bf16* gzr = gz + (size_t)(b * SEQ + n * 64 + (tid >> 3)) * 512 + h * 128 + 16 * (tid & 7);
        const u32x4 gzp0 = *(const u32x4*)gzr, gzp1 = *(const u32x4*)(gzr + 8);
        bf16x8 Sb[4];
#pragma unroll
        for (int ks = 0; ks < 4; ++ks) Sb[ks] = acc2frag(S[2 * ks], S[2 * ks + 1]);
        f32x4 vn[4], o[4];
#pragma unroll
        for (int mt = 0; mt < 4; ++mt) {
            vn[mt] = (f32x4){__uint_as_float(uc[mt].x << 16), __uint_as_float(uc[mt].x & 0xffff0000u), __uint_as_float(uc[mt].y << 16), __uint_as_float(uc[mt].y & 0xffff0000u)};
#pragma unroll
            for (int ks = 0; ks < 4; ++ks) vn[mt] = mfma16(*(const LAS bf16x8*)(bp + REC_WNEG + (mt * 4 + ks) * 1024), Sb[ks], vn[mt]);
        }
        bf16x8 Vb[2];
#pragma unroll
        for (int ks = 0; ks < 2; ++ks) Vb[ks] = acc2frag(vn[2 * ks], vn[2 * ks + 1]);
#pragma unroll
        for (int mt = 0; mt < 4; ++mt) {
            o[mt] = (f32x4){0.f, 0.f, 0.f, 0.f};
#pragma unroll
            for (int ks = 0; ks < 4; ++ks) o[mt] = mfma16(*(const LAS bf16x8*)(bp + REC_QDEC + (mt * 4 + ks) * 1024), Sb[ks], o[mt]);
#pragma unroll
            for (int ks = 0; ks < 2; ++ks) o[mt] = mfma16(*(const LAS bf16x8*)(bp + REC_ATTN + (mt * 2 + ks) * 1024), Vb[ks], o[mt]);
        }
#pragma unroll
        for (int t = 0; t < 8; ++t) {
            S[t] = S[t] * egl;
#pragma unroll
            for (int ks = 0; ks < 2; ++ks) S[t] = mfma16(*(const LAS bf16x8*)(bp + REC_KDT + (t * 2 + ks) * 1024), Vb[ks], S[t]);
        }
        {
            const int g4 = lane >> 4, nn = lane & 15;
#pragma unroll
            for (int mt = 0; mt < 4; ++mt)
#pragma unroll
                for (int r = 0; r < 4; ++r) ox[(16 * mt + 4 * g4 + r) * 132 + 16 * s + nn] = o[mt][r];
        }
        __syncthreads();
        {
            const int row = tid >> 3, part = tid & 7; const int tok = b * SEQ + n * 64 + row;
            float v[16]; float ss = 0.f;
#pragma unroll
            for (int q = 0; q < 4; ++q) { const f32x4 t4 = *(const LAS f32x4*)(ox + row * 132 + 16 * part + 4 * q); v[4 * q] = t4[0]; v[4 * q + 1] = t4[1]; v[4 * q + 2] = t4[2]; v[4 * q + 3] = t4[3]; }
#pragma unroll
            for (int e = 0; e < 16; ++e) ss += v[e] * v[e];
            ss += __shfl_xor(ss, 1); ss += __shfl_xor(ss, 2); ss += __shfl_xor(ss, 4);
            const float rs = rsqrtf(ss * (1.0f / 128.f) + EPS);
            const u32x4 z0 = gzp0, z1 = gzp1;
            const unsigned zz[8] = {z0.x, z0.y, z0.z, z0.w, z1.x, z1.y, z1.z, z1.w};
            unsigned ow[8];
#pragma unroll
            for (int e = 0; e < 8; ++e) {
                const float w0 = gnw[16 * part + 2 * e], w1 = gnw[16 * part + 2 * e + 1];
                ow[e] = cvt_pk_bf16(v[2 * e] * rs * w0 * __uint_as_float(zz[e] << 16), v[2 * e + 1] * rs * w1 * __uint_as_float(zz[e] & 0xffff0000u));
            }
            bf16* mp = mix + (size_t)tok * DM + h * 128 + 16 * part;
            *(u32x4*)mp = (u32x4){ow[0], ow[1], ow[2], ow[3]}; *(u32x4*)(mp + 8) = (u32x4){ow[4], ow[5], ow[6], ow[7]};
        }
    }
#undef GS_STAGE
#undef recp
    asm volatile("s_waitcnt vmcnt(0)" ::: "memory");
    __syncthreads();
}
__device__ __forceinline__ int pos32(int key) { return (key & ~31) | (8 * ((key >> 2) & 3) + 4 * ((key >> 4) & 1) + (key & 3)); }
__device__ __forceinline__ void compress_block(const Frame& F, int task) {
    const int which = task >> 8, bhk = (task >> 5) & 7, rt = task & 31, b = bhk >> 1, hk = bhk & 1;
    int l_ = F.lane; asm volatile("" : "+v"(l_));
    const int l = l_, n = l & 15, kg = l >> 4, w = F.wave;
    const bf16* nkv = (const bf16*)(F.ws + WS_NKV);
    const bf16* w1f = (const bf16*)(F.ws + (which ? WS_W1FV : WS_W1FK)); const bf16* w2f = (const bf16*)(F.ws + (which ? WS_W2FV : WS_W2FK));
    const float* cpe = (const float*)(F.ws + WS_CPE) + which * 128;
    const int nc = 16 * rt + n;
    f32x4 acc[8];
#pragma unroll
    for (int t = 0; t < 8; ++t) acc[t] = (f32x4){0.f, 0.f, 0.f, 0.f};
    {
        bf16x8 ac[8], an[8], bc, bn;
#define CMP_LOAD(A_, B_, K8) do { const int _ks = 8 * w + (K8); int _tok = 16 * nc + (_ks >> 1); _tok = _tok < SEQ ? _tok : SEQ - 1; \
            B_ = *(const bf16x8*)(nkv + (size_t)(b * SEQ + _tok) * 768 + which * 128 + hk * 64 + (_ks & 1) * 32 + 8 * kg); \
            _Pragma("unroll") for (int _mt = 0; _mt < 8; ++_mt) A_[_mt] = *(const bf16x8*)(w1f + ((size_t)(_ks * 8 + _mt) * 64 + l) * 8); } while (0)
#define CMP_PIN(A_, B_) asm volatile("" : "+v"(A_[0]), "+v"(A_[1]), "+v"(A_[2]), "+v"(A_[3]), "+v"(A_[4]), "+v"(A_[5]), "+v"(A_[6]), "+v"(A_[7]), "+v"(B_))
        CMP_LOAD(ac, bc, 0);
#pragma unroll
        for (int k8 = 0; k8 < 8; k8 += 2) {
            CMP_LOAD(an, bn, k8 + 1);
            CMP_PIN(ac, bc);
#pragma unroll
            for (int mt = 0; mt < 8; ++mt) acc[mt] = mfma16(ac[mt], bc, acc[mt]);
            if (k8 + 2 < 8) CMP_LOAD(ac, bc, k8 + 2);
            CMP_PIN(an, bn);
#pragma unroll
            for (int mt = 0; mt < 8; ++mt) acc[mt] = mfma16(an[mt], bn, acc[mt]);
        }
#undef CMP_LOAD
#undef CMP_PIN
    }
    LAS f32x4* part = (LAS f32x4*)F.lds;
    LAS unsigned char* hfrag = F.lds + 65536;
#pragma unroll
    for (int mt = 0; mt < 8; ++mt) part[(w * 8 + mt) * 64 + l] = acc[mt];
    __syncthreads();
    {
        f32x4 h = part[w * 64 + l];
#pragma unroll
        for (int p = 1; p < 8; ++p) h = h + part[(p * 8 + w) * 64 + l];
#pragma unroll
        for (int r = 0; r < 4; ++r) h[r] = siluf_(h[r] + cpe[16 * w + 4 * kg + r]);
        u32x2 d; d.x = cvt_pk_bf16(h[0], h[1]); d.y = cvt_pk_bf16(h[2], h[3]);
        *(LAS u32x2*)(hfrag + ((w >> 1) * 64 + l) * 16 + (w & 1) * 8) = d;
    }
    __syncthreads();
    if (w < 4) {
        f32x4 o = {0.f, 0.f, 0.f, 0.f};
#pragma unroll
        for (int ks = 0; ks < 4; ++ks) o = mfma16(*(const bf16x8*)(w2f + ((size_t)(w * 4 + ks) * 64 + l) * 8), *(const LAS bf16x8*)(hfrag + (ks * 64 + l) * 16), o);
        const bool valid = nc < 511;
        if (which == 0) {
            bf16* kc = (bf16*)(F.ws + WS_KCMP) + ((size_t)bhk * 512 + nc) * 64;
            u32x2 d; d.x = valid ? cvt_pk_bf16(o[0], o[1]) : 0u; d.y = valid ? cvt_pk_bf16(o[2], o[3]) : 0u; *(u32x2*)(kc + 16 * w + 4 * kg) = d;
        } else {
            bf16* vt = (bf16*)(F.ws + WS_VCMPT) + (size_t)bhk * 64 * 512 + pos32(nc);
#pragma unroll
            for (int r = 0; r < 4; ++r) vt[(size_t)(16 * w + 4 * kg + r) * 512] = valid ? f2bf(o[r]) : (unsigned short)0;
        }
    }
    __syncthreads();
}
__device__ __forceinline__ void vtranspose_task(const Frame& F, int task) {
    const int which = task >> 8, bhk = (task >> 5) & 7, tg = task & 31, b = bhk >> 1, hk = bhk & 1;
    const bf16* nkv = (const bf16*)(F.ws + WS_NKV); bf16* dst = (bf16*)(F.ws + (which ? WS_VWT : WS_VST)) + (size_t)bhk * 64 * SEQ;
    LAS bf16* tile = (LAS bf16*)F.lds;
    const int t0 = tg * 256;
#pragma unroll
    for (int sub = 0; sub < 4; ++sub) {
        const int tk = sub * 64 + (F.tid >> 3), dc = F.tid & 7;
        const u32x4 v = *(const u32x4*)(nkv + (size_t)(b * SEQ + t0 + tk) * 768 + 384 + which * 256 + hk * 64 + 8 * dc);
        const unsigned vv[4] = {v.x, v.y, v.z, v.w};
#pragma unroll
        for (int e = 0; e < 4; ++e) { tile[(8 * dc + 2 * e) * 264 + pos32(tk)] = (unsigned short)(vv[e] & 0xffffu); tile[(8 * dc + 2 * e + 1) * 264 + pos32(tk)] = (unsigned short)(vv[e] >> 16); }
    }
    __syncthreads();
#pragma unroll
    for (int sub = 0; sub < 4; ++sub) {
        const int i = sub * 512 + F.tid, d = i >> 5, tc = i & 31;
        *(u32x4*)(dst + (size_t)d * SEQ + t0 + 8 * tc) = *(const LAS u32x4*)(tile + d * 264 + 8 * tc);
    }
    __syncthreads();
}
constexpr int NL_BT = 0, NL_IMP = 18496, NL_MASK = 51776, NL_SMASK = 52800, NL_KV = 53248, NL_NXT = 86016, NL_TOT = 86528;
#ifndef PRB_X1
#define PRB_X1 0
#endif
#ifndef PRB_C2
#define PRB_C2 0
#endif
#ifndef PRB_SETUP
#define PRB_SETUP 0
#endif
#ifndef PRB_SEL
#define PRB_SEL 0
#endif
#ifndef PRB_ALLACT
#define PRB_ALLACT 0
#endif
#ifndef PRB_S
#define PRB_S 0
#endif
#ifndef PRB_W
#define PRB_W 0
#endif
#ifndef PRB_C
#define PRB_C 0
#endif
constexpr int TM_C1 = 0, TM_C2 = 1, TM_SD = 2, TM_SS = 3, TM_W = 4;
#ifndef PRB_DMA
#define PRB_DMA 0
#endif
__device__ __forceinline__ void stage_dma(LAS unsigned char* buf, const bf16* Kb, int kstride, const bf16* VT, int vlen, int key0, int wave, int lane) {
    const int row = wave * 8 + (lane >> 3), ch = (lane & 7) ^ ((lane >> 3) & 7);
#if PRB_DMA
    __builtin_amdgcn_global_load_lds((const unsigned*)(Kb + (size_t)(key0 + row) * kstride + 8 * ch), (LAS unsigned*)(buf + wave * 1024), 16, 0, 0);
    __builtin_amdgcn_global_load_lds((const unsigned*)(VT + (size_t)row * vlen + key0 + 8 * ch), (LAS unsigned*)(buf + 8192 + wave * 1024), 16, 0, 0);
#endif
    __builtin_amdgcn_global_load_lds((const unsigned*)(Kb + (size_t)(key0 + row) * kstride + 8 * ch), (LAS unsigned*)(buf + wave * 1024), 16, 0, 0);
    __builtin_amdgcn_global_load_lds((const unsigned*)(VT + (size_t)row * vlen + key0 + 8 * ch), (LAS unsigned*)(buf + 8192 + wave * 1024), 16, 0, 0);
}
__device__ __forceinline__ void wait_tiles(int newer) {
#if PRB_DMA
    if (newer >= 2) asm volatile("s_waitcnt vmcnt(8)" ::: "memory"); else if (newer == 1) asm volatile("s_waitcnt vmcnt(4)" ::: "memory"); else asm volatile("s_waitcnt vmcnt(0)" ::: "memory");
#else
    if (newer >= 2) asm volatile("s_waitcnt vmcnt(4)" ::: "memory"); else if (newer == 1) asm volatile("s_waitcnt vmcnt(2)" ::: "memory"); else asm volatile("s_waitcnt vmcnt(0)" ::: "memory");
#endif
}
__device__ __forceinline__ bf16x8 tile_frag(const LAS unsigned char* buf, int row, int chunk) { return *(const LAS bf16x8*)(buf + row * 128 + ((chunk ^ (row & 7)) << 4)); }

struct SlotState { f32x4 O[4]; float m, l; };
__device__ __forceinline__ float kg_sum(float x) {
    const unsigned u = __builtin_bit_cast(unsigned, x); const auto r = __builtin_amdgcn_permlane16_swap(u, u, false, false);
    const float y = __builtin_bit_cast(float, (unsigned)r[0]) + __builtin_bit_cast(float, (unsigned)r[1]);
    const unsigned v = __builtin_bit_cast(unsigned, y); const auto q = __builtin_amdgcn_permlane32_swap(v, v, false, false);
    return __builtin_bit_cast(float, (unsigned)q[0]) + __builtin_bit_cast(float, (unsigned)q[1]);
}
__device__ __forceinline__ float kg_max(float x) {
    const unsigned u = __builtin_bit_cast(unsigned, x); const auto r = __builtin_amdgcn_permlane16_swap(u, u, false, false);
    const float y = fmaxf(__builtin_bit_cast(float, (unsigned)r[0]), __builtin_bit_cast(float, (unsigned)r[1]));
    const unsigned v = __builtin_bit_cast(unsigned, y); const auto q = __builtin_amdgcn_permlane32_swap(v, v, false, false);
    return fmaxf(__builtin_bit_cast(float, (unsigned)q[0]), __builtin_bit_cast(float, (unsigned)q[1]));
}

__device__ __forceinline__ void lds_add_f32(LAS float* p, float v) { asm volatile("ds_add_f32 %0, %1" :: "v"((unsigned)(size_t)p), "v"(v) : "memory"); }
__device__ __forceinline__ float quad_sum(float x) {
    x += __builtin_bit_cast(float, __builtin_amdgcn_update_dpp(0, __builtin_bit_cast(int, x), 0xB1, 0xf, 0xf, false));
    x += __builtin_bit_cast(float, __builtin_amdgcn_update_dpp(0, __builtin_bit_cast(int, x), 0x4E, 0xf, 0xf, false));
    return x;
}
constexpr int RT_LEN = 1156, RT_OFF = 1088;
template <int MODE, bool NEARB>
__device__ __forceinline__ void slot_tile(const LAS unsigned char* tb0, const LAS unsigned char* tb1, const bf16x8 (&q)[2], int dbase, const LAS float* rt, SlotState& A,
                                          float linv, float mrow, float bfar, LAS float* imp_row, int key0, int lane, float* carry = nullptr) {
    const int kg = lane >> 4;
    __builtin_amdgcn_sched_barrier(0);
    bf16x8 fr[4][2];
#pragma unroll
    for (int mt = 0; mt < 4; ++mt) { fr[mt][0] = *(const LAS bf16x8*)(tb0 + mt * 2048); fr[mt][1] = *(const LAS bf16x8*)(tb1 + mt * 2048); }
    asm volatile("" : "+v"(fr[0][0]), "+v"(fr[0][1]), "+v"(fr[1][0]), "+v"(fr[1][1]), "+v"(fr[2][0]), "+v"(fr[2][1]), "+v"(fr[3][0]), "+v"(fr[3][1]));
    f32x4 s[4];
    const float ini = (MODE == TM_SS) ? -mrow : 0.f;
#pragma unroll
    for (int mt = 0; mt < 4; ++mt) { s[mt] = mfma16(fr[mt][0], q[0], (f32x4){ini, ini, ini, ini}); s[mt] = mfma16(fr[mt][1], q[1], s[mt]); }
    if (MODE != TM_C1) {
        __builtin_amdgcn_sched_barrier(0);
#pragma unroll
        for (int t = 0; t < 4; ++t) { fr[t][0] = *(const LAS bf16x8*)(tb0 + 8192 + t * 2048); fr[t][1] = *(const LAS bf16x8*)(tb1 + 8192 + t * 2048); }
        __builtin_amdgcn_sched_barrier(0);
    }
    constexpr bool CMP = (MODE == TM_C1 || MODE == TM_C2);
    if (MODE == TM_SS) {
        if (NEARB) {
            const LAS float* rp = rt + (RT_OFF - dbase);
            f32x4 bv[4];
#pragma unroll
            for (int mt = 0; mt < 4; ++mt)
#pragma unroll
                for (int r = 0; r < 4; ++r) bv[mt][r] = rp[16 * mt + r];
            asm volatile("" : "+v"(bv[0]), "+v"(bv[1]), "+v"(bv[2]), "+v"(bv[3]));
#pragma unroll
            for (int mt = 0; mt < 4; ++mt) s[mt] = s[mt] + bv[mt];
        }
        float ps = 0.f;
#pragma unroll
        for (int mt = 0; mt < 4; ++mt)
#pragma unroll
            for (int r = 0; r < 4; ++r) { const float p = __builtin_amdgcn_exp2f(s[mt][r]); s[mt][r] = p; ps += p; }
        ps = kg_sum(ps);
        A.l += ps;
    } else {
        float tmax = -1e30f;
        if (NEARB) {
            const LAS float* rp = rt + (RT_OFF - dbase);
            f32x4 bv[4];
#pragma unroll
            for (int mt = 0; mt < 4; ++mt)
#pragma unroll
                for (int r = 0; r < 4; ++r) {
                    const int c = 16 * mt + r;
                    if (CMP) { const int dist = dbase - 16 * c; const int di = dist < 0 ? 0 : (dist > RT_OFF ? RT_OFF : dist); bv[mt][r] = rt[RT_OFF - di]; }
                    else bv[mt][r] = rp[c];
                }
            asm volatile("" : "+v"(bv[0]), "+v"(bv[1]), "+v"(bv[2]), "+v"(bv[3]));
#pragma unroll
            for (int mt = 0; mt < 4; ++mt)
#pragma unroll
                for (int r = 0; r < 4; ++r) {
                    const int c = 16 * mt + r;
                    const int dist = CMP ? dbase - 16 * c : dbase - c;
                    const bool ok = (MODE == TM_W) ? (dist >= 0 && dist < 512) : (dist >= 0);
                    s[mt][r] = ok ? s[mt][r] + bv[mt][r] : -1e30f;
                    tmax = fmaxf(tmax, s[mt][r]);
                }
        } else {
#pragma unroll
            for (int mt = 0; mt < 4; ++mt)
#pragma unroll
                for (int r = 0; r < 4; ++r) { s[mt][r] += bfar; tmax = fmaxf(tmax, s[mt][r]); }
        }
        if (MODE == TM_C2) {
#pragma unroll
            for (int mt = 0; mt < 4; ++mt)
#pragma unroll
                for (int r = 0; r < 4; ++r) s[mt][r] = __builtin_amdgcn_exp2f(s[mt][r] - A.m) * linv;
            const int g = lane & 3;
            float gsum[4], lv[4];
#pragma unroll
            for (int mt = 0; mt < 4; ++mt) { gsum[mt] = quad_sum(s[mt][0] + s[mt][1] + s[mt][2] + s[mt][3]); lv[mt] = quad_sum(s[mt][3]); }
#pragma unroll
            for (int mt = 0; mt < 4; ++mt) {
                const float up = __shfl_up(lv[mt], 16);
                const float wrap = mt > 0 ? __shfl(lv[mt - 1], (lane & 15) + 48) : *carry;
                const float prev = kg > 0 ? up : wrap;
                const int j = (key0 >> 2) + 4 * mt + kg;
                if (g == 0) asm volatile("ds_write_b32 %0, %1" :: "v"((unsigned)(size_t)(imp_row + j)), "v"(gsum[mt] + prev) : "memory");
            }
            *carry = __shfl(lv[3], (lane & 15) + 48);
        } else {
            tmax = kg_max(tmax);
            const float mnew = fmaxf(A.m, tmax), msafe = fmaxf(mnew, -1e29f), alpha = __builtin_amdgcn_exp2f(A.m - msafe);
            float ps = 0.f;
#pragma unroll
            for (int mt = 0; mt < 4; ++mt)
#pragma unroll
                for (int r = 0; r < 4; ++r) { const float p = __builtin_amdgcn_exp2f(s[mt][r] - msafe); s[mt][r] = p; ps += p; }
            ps = kg_sum(ps);
            A.l = A.l * alpha + ps; A.m = mnew;
            if (MODE != TM_C1) {
#pragma unroll
                for (int t = 0; t < 4; ++t) A.O[t] = A.O[t] * alpha;
            }
        }
    }
    if (MODE != TM_C1) {
        bf16x8 pf[2];
#pragma unroll
        for (int k2 = 0; k2 < 2; ++k2) {
            u32x4 w; w.x = cvt_pk_bf16(s[2 * k2][0], s[2 * k2][1]); w.y = cvt_pk_bf16(s[2 * k2][2], s[2 * k2][3]); w.z = cvt_pk_bf16(s[2 * k2 + 1][0], s[2 * k2 + 1][1]); w.w = cvt_pk_bf16(s[2 * k2 + 1][2], s[2 * k2 + 1][3]);
            pf[k2] = __builtin_bit_cast(bf16x8, w);
        }
#pragma unroll
        for (int t = 0; t < 4; ++t) { A.O[t] = mfma16(fr[t][0], pf[0], A.O[t]); A.O[t] = mfma16(fr[t][1], pf[1], A.O[t]); }
    }
}

#define SGB(mask, n) __builtin_amdgcn_sched_group_barrier(mask, n, 0)
template <bool NEARB>
__device__ __forceinline__ void slot_pair_ss(const LAS unsigned char* tb0, const LAS unsigned char* tb1, const bf16x8 (&q0)[2], const bf16x8 (&q1)[2],
                                             int dbase0, int dbase1, const LAS float* rt, SlotState& A0, SlotState& A1, float mrow0, float mrow1) {
    f32x4 s0[4], s1[4];
    __builtin_amdgcn_sched_barrier(0);
    bf16x8 kf[4][2], vf[4][2];
#pragma unroll
    for (int mt = 0; mt < 4; ++mt) { kf[mt][0] = *(const LAS bf16x8*)(tb0 + mt * 2048); kf[mt][1] = *(const LAS bf16x8*)(tb1 + mt * 2048); }
    asm volatile("" : "+v"(kf[0][0]), "+v"(kf[0][1]), "+v"(kf[1][0]), "+v"(kf[1][1]), "+v"(kf[2][0]), "+v"(kf[2][1]), "+v"(kf[3][0]), "+v"(kf[3][1]));
#pragma unroll
    for (int mt = 0; mt < 4; ++mt) { s0[mt] = mfma16(kf[mt][0], q0[0], (f32x4){-mrow0, -mrow0, -mrow0, -mrow0}); s0[mt] = mfma16(kf[mt][1], q0[1], s0[mt]); }
    __builtin_amdgcn_sched_barrier(0);
#pragma unroll
    for (int t = 0; t < 4; ++t) { vf[t][0] = *(const LAS bf16x8*)(tb0 + 8192 + t * 2048); vf[t][1] = *(const LAS bf16x8*)(tb1 + 8192 + t * 2048); }
    __builtin_amdgcn_sched_barrier(0);
#pragma unroll
    for (int mt = 0; mt < 4; ++mt) { s1[mt] = mfma16(kf[mt][0], q1[0], (f32x4){-mrow1, -mrow1, -mrow1, -mrow1}); s1[mt] = mfma16(kf[mt][1], q1[1], s1[mt]); }
    float ps0 = 0.f, ps1 = 0.f;
    if (NEARB) {
        const LAS float* rp0 = rt + (RT_OFF - dbase0);
        f32x4 bv[4];
#pragma unroll
        for (int mt = 0; mt < 4; ++mt)
#pragma unroll
            for (int r = 0; r < 4; ++r) bv[mt][r] = rp0[16 * mt + r];
        asm volatile("" : "+v"(bv[0]), "+v"(bv[1]), "+v"(bv[2]), "+v"(bv[3]));
#pragma unroll
        for (int mt = 0; mt < 4; ++mt) s0[mt] = s0[mt] + bv[mt];
    }
#pragma unroll
    for (int mt = 0; mt < 4; ++mt)
#pragma unroll
        for (int r = 0; r < 4; ++r) { const float p0 = __builtin_amdgcn_exp2f(s0[mt][r]); s0[mt][r] = p0; ps0 += p0; }
    bf16x8 pf0[2], pf1[2];
#pragma unroll
    for (int k2 = 0; k2 < 2; ++k2) {
        u32x4 w; w.x = cvt_pk_bf16(s0[2 * k2][0], s0[2 * k2][1]); w.y = cvt_pk_bf16(s0[2 * k2][2], s0[2 * k2][3]); w.z = cvt_pk_bf16(s0[2 * k2 + 1][0], s0[2 * k2 + 1][1]); w.w = cvt_pk_bf16(s0[2 * k2 + 1][2], s0[2 * k2 + 1][3]);
        pf0[k2] = __builtin_bit_cast(bf16x8, w);
    }
#pragma unroll
    for (int i = 0; i < 8; ++i) { SGB(0x8, 1); SGB(0x2, 5); SGB(0x400, 2); }
    __builtin_amdgcn_sched_barrier(0);
#pragma unroll
    for (int t = 0; t < 4; ++t) {
        A0.O[t] = mfma16(vf[t][0], pf0[0], A0.O[t]);
        A0.O[t] = mfma16(vf[t][1], pf0[1], A0.O[t]);
    }
    if (NEARB) {
        const LAS float* rp1 = rt + (RT_OFF - dbase1);
        f32x4 bv[4];
#pragma unroll
        for (int mt = 0; mt < 4; ++mt)
#pragma unroll
            for (int r = 0; r < 4; ++r) bv[mt][r] = rp1[16 * mt + r];
        asm volatile("" : "+v"(bv[0]), "+v"(bv[1]), "+v"(bv[2]), "+v"(bv[3]));
#pragma unroll
        for (int mt = 0; mt < 4; ++mt) s1[mt] = s1[mt] + bv[mt];
    }
#pragma unroll
    for (int mt = 0; mt < 4; ++mt)
#pragma unroll
        for (int r = 0; r < 4; ++r) { const float p1 = __builtin_amdgcn_exp2f(s1[mt][r]); s1[mt][r] = p1; ps1 += p1; }
#pragma unroll
    for (int k2 = 0; k2 < 2; ++k2) {
        u32x4 v; v.x = cvt_pk_bf16(s1[2 * k2][0], s1[2 * k2][1]); v.y = cvt_pk_bf16(s1[2 * k2][2], s1[2 * k2][3]); v.z = cvt_pk_bf16(s1[2 * k2 + 1][0], s1[2 * k2 + 1][1]); v.w = cvt_pk_bf16(s1[2 * k2 + 1][2], s1[2 * k2 + 1][3]);
        pf1[k2] = __builtin_bit_cast(bf16x8, v);
    }
#pragma unroll
    for (int i = 0; i < 8; ++i) { SGB(0x8, 1); SGB(0x2, 5); SGB(0x400, 2); }
    __builtin_amdgcn_sched_barrier(0);
#pragma unroll
    for (int t = 0; t < 4; ++t) {
        A1.O[t] = mfma16(vf[t][0], pf1[0], A1.O[t]);
        A1.O[t] = mfma16(vf[t][1], pf1[1], A1.O[t]);
    }
    ps0 = kg_sum(ps0); ps1 = kg_sum(ps1);
    A0.l += ps0; A1.l += ps1;
}

__device__ __forceinline__ void nsa_item(const Frame& F, int item) {
    const int bhk = item & 7, cb = 127 - (item >> 3), b = bhk >> 1, hk = bhk & 1;
    int tid_ = F.tid, lane_ = F.lane; asm volatile("" : "+v"(tid_), "+v"(lane_));
    const int tid = tid_, lane = lane_, wave = F.wave, n = lane & 15, ts = n >> 2, g = n & 3, kg = lane >> 4;
    const bf16* nq = (const bf16*)(F.ws + WS_NQ); const bf16* nkv = (const bf16*)(F.ws + WS_NKV) + (size_t)b * SEQ * 768;
    const bf16* kcmp = (const bf16*)(F.ws + WS_KCMP) + (size_t)bhk * 512 * 64; const bf16* vcmpt = (const bf16*)(F.ws + WS_VCMPT) + (size_t)bhk * 64 * 512;
    const bf16* vst = (const bf16*)(F.ws + WS_VST) + (size_t)bhk * 64 * SEQ; const bf16* vwt = (const bf16*)(F.ws + WS_VWT) + (size_t)bhk * 64 * SEQ;
    const float* small = (const float*)(F.ws + WS_SMALL); const bf16* nz = (const bf16*)(F.ws + WS_NZ); bf16* mix = (bf16*)(F.ws + WS_MIX);
    LAS float* btl = (LAS float*)(F.lds + NL_BT); LAS float* imp = (LAS float*)(F.lds + NL_IMP);
    LAS unsigned* maskw = (LAS unsigned*)(F.lds + NL_MASK); LAS unsigned* smaskw = (LAS unsigned*)(F.lds + NL_SMASK);
    LAS unsigned char* kvb = F.lds + NL_KV;
    const LAS float* bt = btl + g * RT_LEN;
    for (int prb3 = 0; prb3 <= PRB_SETUP; ++prb3)
    { __syncthreads(); const float* btg = (const float*)(F.ws + WS_BT) + (size_t)(hk * 4) * 1025;
      for (int i = tid; i < 4 * RT_LEN; i += 512) { const int hh = i / RT_LEN, ii = i - hh * RT_LEN; const int d = RT_OFF - ii; btl[i] = d >= 0 ? btg[hh * 1025 + (d > 1024 ? 1024 : d)] : 0.f; }
      for (int i = lane; i < 8 * 130; i += 64) imp[wave * 8 * 130 + i] = 0.f; }
    const int tw0 = cb * 64 + wave * 8;
    int trow[2]; size_t tokg[2]; bf16x8 q[2][2];
    LAS float* totp = (LAS float*)(F.lds + NL_TOT) + ((wave * 8 + ts) * 4 + g) * 68 + 4 * kg;
#pragma unroll
    for (int sl = 0; sl < 2; ++sl) {
        trow[sl] = tw0 + 4 * sl + ts; tokg[sl] = (size_t)b * SEQ + trow[sl];
        const bf16* qp = nq + tokg[sl] * 512 + (hk * 4 + g) * 64 + 8 * kg;
        q[sl][0] = *(const bf16x8*)qp; q[sl][1] = *(const bf16x8*)(qp + 32);
    }
    float gts[2][3];
#pragma unroll
    for (int sl = 0; sl < 2; ++sl)
#pragma unroll
        for (int br = 0; br < 3; ++br) gts[sl][br] = small[tokg[sl] * 32 + 8 + 8 * br + hk * 4 + g];
    SlotState A[2];
    const int fb0 = n * 128 + ((kg ^ (n & 7)) << 4), fb1 = n * 128 + (((4 + kg) ^ (n & 7)) << 4);
#define NS_LOADK(buf) do { _Pragma("unroll") for (int _mt = 0; _mt < 4; ++_mt) { kf[_mt][0] = *(const LAS bf16x8*)((buf) + fb0 + _mt * 2048); kf[_mt][1] = *(const LAS bf16x8*)((buf) + fb1 + _mt * 2048); } } while (0)
#define NS_LOADV(buf) do { _Pragma("unroll") for (int _t = 0; _t < 4; ++_t) _Pragma("unroll") for (int _ks = 0; _ks < 2; ++_ks) vf[_t][_ks] = tile_frag((buf) + 8192, 16 * _t + n, 4 * _ks + kg); } while (0)
#define NS_RESET() do { _Pragma("unroll") for (int _s = 0; _s < 2; ++_s) { A[_s].m = -1e30f; A[_s].l = 0.f; _Pragma("unroll") for (int _t = 0; _t < 4; ++_t) A[_s].O[_t] = (f32x4){0.f, 0.f, 0.f, 0.f}; } } while (0)
#define NS_BAR() do { asm volatile("s_waitcnt lgkmcnt(0)" ::: "memory"); __builtin_amdgcn_s_barrier(); asm volatile("" ::: "memory"); } while (0)
#define NS_PIPE(NT, KEY0, KB, KSTR, VTB, VLEN, NB, BUF, ...) do { \
        const int _nt = (NT); \
        for (int _p = 0; _p < (NB) - 1 && _p < _nt; ++_p) stage_dma(BUF(_p), KB, KSTR, VTB, VLEN, KEY0(_p), wave, lane); \
        wait_tiles((_nt - 1) < ((NB) - 2) ? (_nt - 1) : ((NB) - 2)); NS_BAR(); \
        for (int ti = 0; ti < _nt; ++ti) { \
            const LAS unsigned char* cbuf = BUF(ti & ((NB) - 1)); \
            if (ti + (NB) - 1 < _nt) stage_dma(BUF((ti + (NB) - 1) & ((NB) - 1)), KB, KSTR, VTB, VLEN, KEY0(ti + (NB) - 1), wave, lane); \
            __VA_ARGS__ \
            { const int _rem = _nt - 2 - ti; wait_tiles(_rem < 0 ? 0 : (_rem < (NB) - 2 ? _rem : (NB) - 2)); } \
            NS_BAR(); \
        } } while (0)
#define BUF2(i) (kvb + (i) * 16384)
#define BUF4(i) ((i) < 2 ? kvb + (i) * 16384 : (LAS unsigned char*)(F.lds + NL_IMP) + ((i) - 2) * 16384)
    __syncthreads();
    const float bfarv = bt[RT_OFF - 1024];
    const int ntc = ((4 * cb + 2) >> 6) + 1;
#define KEY0_LIN(i) (64 * (i))
    for (int prb = 0; prb <= PRB_C; ++prb) {
    NS_RESET();
    NS_PIPE(ntc, KEY0_LIN, kcmp, 64, vcmpt, 512, 2, BUF2, {

        const int db0 = trow[0] - 31 - 16 * (64 * ti + 4 * kg), db1 = trow[1] - 31 - 16 * (64 * ti + 4 * kg);
        if (64 * cb - 1024 * ti - 1039 >= 790) {
            slot_tile<TM_C1, false>(cbuf + fb0, cbuf + fb1, q[0], db0, bt, A[0], 0.f, 0.f, bfarv, nullptr, 64 * ti, lane);
            slot_tile<TM_C1, false>(cbuf + fb0, cbuf + fb1, q[1], db1, bt, A[1], 0.f, 0.f, bfarv, nullptr, 64 * ti, lane);
        } else {
            slot_tile<TM_C1, true>(cbuf + fb0, cbuf + fb1, q[0], db0, bt, A[0], 0.f, 0.f, bfarv, nullptr, 64 * ti, lane);
            slot_tile<TM_C1, true>(cbuf + fb0, cbuf + fb1, q[1], db1, bt, A[1], 0.f, 0.f, bfarv, nullptr, 64 * ti, lane);
        }
    });
    }
    {
        for (int prb2 = PRB_C2; prb2 >= 0; --prb2) {
        const float li0 = (prb2 == 0 && A[0].l > 0.f) ? __builtin_amdgcn_rcpf(A[0].l) : 0.f, li1 = (prb2 == 0 && A[1].l > 0.f) ? __builtin_amdgcn_rcpf(A[1].l) : 0.f;
        float cry0 = 0.f, cry1 = 0.f;
        NS_PIPE(ntc, KEY0_LIN, kcmp, 64, vcmpt, 512, 2, BUF2, {

            const int db0 = trow[0] - 31 - 16 * (64 * ti + 4 * kg), db1 = trow[1] - 31 - 16 * (64 * ti + 4 * kg);
            if (64 * cb - 1024 * ti - 1039 >= 790) {
                slot_tile<TM_C2, false>(cbuf + fb0, cbuf + fb1, q[0], db0, bt, A[0], li0, 0.f, bfarv, imp + (wave * 8 + ts) * 130, 64 * ti, lane, &cry0);
                slot_tile<TM_C2, false>(cbuf + fb0, cbuf + fb1, q[1], db1, bt, A[1], li1, 0.f, bfarv, imp + (wave * 8 + 4 + ts) * 130, 64 * ti, lane, &cry1);
            } else {
                slot_tile<TM_C2, true>(cbuf + fb0, cbuf + fb1, q[0], db0, bt, A[0], li0, 0.f, bfarv, imp + (wave * 8 + ts) * 130, 64 * ti, lane, &cry0);
                slot_tile<TM_C2, true>(cbuf + fb0, cbuf + fb1, q[1], db1, bt, A[1], li1, 0.f, bfarv, imp + (wave * 8 + 4 + ts) * 130, 64 * ti, lane, &cry1);
            }
        });
        }
#pragma unroll
        for (int sl = 0; sl < 2; ++sl) { const float gate = gts[sl][0];
#pragma unroll
            for (int t = 0; t < 4; ++t) *(LAS f32x4*)(totp + sl * 16 * 68 + 16 * t) = A[sl].O[t] * gate; }
    }
    for (int prs = 0; prs <= PRB_SEL; ++prs)
    {
        const int tsl = lane >> 3, i = lane & 7; const int tk = wave * 8 + tsl;
        unsigned mw0 = 0u, mw1 = 0u, mw2 = 0u, mw3 = 0u;
#define NS_SETBIT(j) do { const unsigned _b = 1u << ((j) & 31); const int _w = (j) >> 5; mw0 |= _w == 0 ? _b : 0u; mw1 |= _w == 1 ? _b : 0u; mw2 |= _w == 2 ? _b : 0u; mw3 |= _w == 3 ? _b : 0u; } while (0)
        if (cb <= 15) { mw0 = (2u << cb) - 1u; }
        else {
            float val[16];
#pragma unroll
            for (int qq = 0; qq < 16; ++qq) { const int j = i + 8 * qq; val[qq] = (j >= 1 && j <= cb - 2) ? imp[tk * 130 + j] : -1.0f; }
            NS_SETBIT(0); NS_SETBIT(cb - 1); NS_SETBIT(cb);
            for (int round = 0; round < 13; ++round) {
                float bv = -2.0f; int bj = 1 << 20;
#pragma unroll
                for (int qq = 0; qq < 16; ++qq) if (val[qq] > bv) { bv = val[qq]; bj = i + 8 * qq; }
#define NS_DPP_STEP(CTRL) do { const float ov = __builtin_bit_cast(float, __builtin_amdgcn_update_dpp(0, __builtin_bit_cast(int, bv), CTRL, 0xf, 0xf, false)); \
                    const int oj = __builtin_amdgcn_update_dpp(0, bj, CTRL, 0xf, 0xf, false); if (ov > bv || (ov == bv && oj < bj)) { bv = ov; bj = oj; } } while (0)
                NS_DPP_STEP(0xB1); NS_DPP_STEP(0x4E); NS_DPP_STEP(0x141);
#pragma unroll
                for (int qq = 0; qq < 16; ++qq) if (bj == i + 8 * qq) val[qq] = -3.0f;
                NS_SETBIT(bj);
            }
        }
        if (i == 0) { maskw[tk * 4 + 0] = mw0; maskw[tk * 4 + 1] = mw1; maskw[tk * 4 + 2] = mw2; maskw[tk * 4 + 3] = mw3; }
        mw0 |= __shfl_xor(mw0, 8); mw0 |= __shfl_xor(mw0, 16); mw1 |= __shfl_xor(mw1, 8); mw1 |= __shfl_xor(mw1, 16);
        mw2 |= __shfl_xor(mw2, 8); mw2 |= __shfl_xor(mw2, 16); mw3 |= __shfl_xor(mw3, 8); mw3 |= __shfl_xor(mw3, 16);
        if ((lane & 31) == 0) { const int so = (wave * 2 + (lane >> 5)) * 4; smaskw[so] = mw0; smaskw[so + 1] = mw1; smaskw[so + 2] = mw2; smaskw[so + 3] = mw3; }
    }
    __syncthreads();
    {
        const int tk0 = wave * 8 + ts;
        unsigned smk0[4], smk1[4], rmk0[4], rmk1[4];
#pragma unroll
        for (int w4 = 0; w4 < 4; ++w4) {
            smk0[w4] = __builtin_amdgcn_readfirstlane(smaskw[(wave * 2 + 0) * 4 + w4]); smk1[w4] = __builtin_amdgcn_readfirstlane(smaskw[(wave * 2 + 1) * 4 + w4]);
            rmk0[w4] = maskw[tk0 * 4 + w4]; rmk1[w4] = maskw[(tk0 + 4) * 4 + w4];
        }
        const LAS unsigned char* const Kb_ = nullptr; (void)Kb_;
        const bf16* ksl = nkv + 256 + hk * 64;
        for (int prb = 0; prb <= PRB_S; ++prb) {
        NS_RESET();
#define KEY0_FORCED(i) (64 * (cb == 0 ? 0 : (cb == 1 ? 1 - (i) : ((i) == 0 ? cb : ((i) == 1 ? cb - 1 : 0)))))
        NS_PIPE(cb < 2 ? cb + 1 : 3, KEY0_FORCED, ksl, 768, vst, SEQ, 4, BUF4, {
            const int key0 = KEY0_FORCED(ti);
            const int db0 = trow[0] - key0 - 4 * kg, db1 = trow[1] - key0 - 4 * kg;
            if ((cb - (key0 >> 6)) < 14) {
                slot_tile<TM_SD, true>(cbuf + fb0, cbuf + fb1, q[0], db0, bt, A[0], 0.f, 0.f, bfarv, nullptr, key0, lane);
                slot_tile<TM_SD, true>(cbuf + fb0, cbuf + fb1, q[1], db1, bt, A[1], 0.f, 0.f, bfarv, nullptr, key0, lane);
            } else {
                slot_tile<TM_SD, false>(cbuf + fb0, cbuf + fb1, q[0], db0, bt, A[0], 0.f, 0.f, bfarv, nullptr, key0, lane);
                slot_tile<TM_SD, false>(cbuf + fb0, cbuf + fb1, q[1], db1, bt, A[1], 0.f, 0.f, bfarv, nullptr, key0, lane);
            }
        });
        if (cb >= 3) {
            const int nt2 = cb - 2, np2 = (nt2 + 1) >> 1;
            stage_dma(BUF4(0), ksl, 768, vst, SEQ, 64, wave, lane); if (nt2 > 1) stage_dma(BUF4(1), ksl, 768, vst, SEQ, 128, wave, lane);
            wait_tiles(0); NS_BAR();
            unsigned csm0 = smk0[0] >> 1, csm1 = smk1[0] >> 1, crm0 = rmk0[0] >> 1, crm1 = rmk1[0] >> 1;
            int j = 1;
            for (int p = 0; p < np2; ++p) {
                const int sb = (p & 1) * 2;
                if (p + 1 < np2) { stage_dma(BUF4(2 - sb), ksl, 768, vst, SEQ, 64 * (j + 2), wave, lane); if (j + 3 <= cb - 2) stage_dma(BUF4(3 - sb), ksl, 768, vst, SEQ, 64 * (j + 3), wave, lane); }
#pragma unroll 1
                for (int hh = 0; hh < 2; ++hh) {
                    if (j > cb - 2) break;
                    const bool a0 = PRB_ALLACT ? true : (csm0 & 1u), a1 = PRB_ALLACT ? true : (csm1 & 1u);
                    if (a0 || a1) {
                        const LAS unsigned char* cbuf = BUF4(sb + hh);
                        const int key0 = 64 * j;
                        const int db0 = trow[0] - key0 - 4 * kg, db1 = trow[1] - key0 - 4 * kg;
                        const bool nearb = (cb - j) < 14;
                        const float boff = nearb ? 0.f : bfarv;
                        const float mr0 = (crm0 & 1u) ? A[0].m - boff : 1e30f, mr1 = (crm1 & 1u) ? A[1].m - boff : 1e30f;
                        if (a0 && a1) {
                            if (nearb) slot_pair_ss<true>(cbuf + fb0, cbuf + fb1, q[0], q[1], db0, db1, bt, A[0], A[1], mr0, mr1);
                            else slot_pair_ss<false>(cbuf + fb0, cbuf + fb1, q[0], q[1], db0, db1, bt, A[0], A[1], mr0, mr1);
                        } else if (a0) {
                            if (nearb) slot_tile<TM_SS, true>(cbuf + fb0, cbuf + fb1, q[0], db0, bt, A[0], 0.f, mr0, 0.f, nullptr, key0, lane);
                            else slot_tile<TM_SS, false>(cbuf + fb0, cbuf + fb1, q[0], db0, bt, A[0], 0.f, mr0, 0.f, nullptr, key0, lane);
                        } else {
                            if (nearb) slot_tile<TM_SS, true>(cbuf + fb0, cbuf + fb1, q[1], db1, bt, A[1], 0.f, mr1, 0.f, nullptr, key0, lane);
                            else slot_tile<TM_SS, false>(cbuf + fb0, cbuf + fb1, q[1], db1, bt, A[1], 0.f, mr1, 0.f, nullptr, key0, lane);
                        }
                    }
                    ++j; csm0 >>= 1; csm1 >>= 1; crm0 >>= 1; crm1 >>= 1;
                    if ((j & 31) == 0) { const int w4 = j >> 5;
                        csm0 = w4 == 1 ? smk0[1] : (w4 == 2 ? smk0[2] : smk0[3]); csm1 = w4 == 1 ? smk1[1] : (w4 == 2 ? smk1[2] : smk1[3]);
                        crm0 = w4 == 1 ? rmk0[1] : (w4 == 2 ? rmk0[2] : rmk0[3]); crm1 = w4 == 1 ? rmk1[1] : (w4 == 2 ? rmk1[2] : rmk1[3]); }
                }
                wait_tiles(0); NS_BAR();
            }
        }
        }
#pragma unroll
        for (int sl = 0; sl < 2; ++sl) { const float gate = gts[sl][1]; const float sc = A[sl].l > 0.f ? gate * __builtin_amdgcn_rcpf(A[sl].l) : 0.f;
#pragma unroll
            for (int t = 0; t < 4; ++t) { LAS f32x4* tp = (LAS f32x4*)(totp + sl * 16 * 68 + 16 * t); *tp = *tp + A[sl].O[t] * sc; } }
    }
    {
        const int jw0 = cb >= 8 ? cb - 8 : 0;
#define KEY0_WIN(i) (64 * (jw0 + (i)))
        for (int prb = 0; prb <= PRB_W; ++prb) {
        NS_RESET();
        NS_PIPE(cb - jw0 + 1, KEY0_WIN, nkv + 512 + hk * 64, 768, vwt, SEQ, 4, BUF4, {

            slot_tile<TM_W, true>(cbuf + fb0, cbuf + fb1, q[0], trow[0] - KEY0_WIN(ti) - 4 * kg, bt, A[0], 0.f, 0.f, 0.f, nullptr, KEY0_WIN(ti), lane);
            slot_tile<TM_W, true>(cbuf + fb0, cbuf + fb1, q[1], trow[1] - KEY0_WIN(ti) - 4 * kg, bt, A[1], 0.f, 0.f, 0.f, nullptr, KEY0_WIN(ti), lane);
        });
        }
#pragma unroll
        for (int sl = 0; sl < 2; ++sl) { const float gate = gts[sl][2]; const float sc = A[sl].l > 0.f ? gate * __builtin_amdgcn_rcpf(A[sl].l) : 0.f;
#pragma unroll
            for (int t = 0; t < 4; ++t) { LAS f32x4* tp = (LAS f32x4*)(totp + sl * 16 * 68 + 16 * t); *tp = *tp + A[sl].O[t] * sc; } }
    }
    {
        int l2 = lane; asm volatile("" : "+v"(l2));
        const int n2 = l2 & 15, ts2 = n2 >> 2, g2 = n2 & 3, kg2 = l2 >> 4;
        const LAS float* tp2 = (const LAS float*)(F.lds + NL_TOT) + ((wave * 8 + ts2) * 4 + g2) * 68 + 4 * kg2;
        u32x2 zz[2][4];
#pragma unroll
        for (int sl = 0; sl < 2; ++sl)
#pragma unroll
            for (int t = 0; t < 4; ++t) zz[sl][t] = *(const u32x2*)(nz + ((size_t)b * SEQ + tw0 + 4 * sl + ts2) * 512 + (hk * 4 + g2) * 64 + 16 * t + 4 * kg2);
#pragma unroll
        for (int sl = 0; sl < 2; ++sl) {
            const size_t tk = (size_t)b * SEQ + tw0 + 4 * sl + ts2;
#pragma unroll
            for (int t = 0; t < 4; ++t) {
                const u32x2 z = zz[sl][t];
                const f32x4 tv = *(const LAS f32x4*)(tp2 + sl * 16 * 68 + 16 * t);
                u32x2 d; d.x = cvt_pk_bf16(tv[0] * __uint_as_float(z.x << 16), tv[1] * __uint_as_float(z.x & 0xffff0000u));
                d.y = cvt_pk_bf16(tv[2] * __uint_as_float(z.y << 16), tv[3] * __uint_as_float(z.y & 0xffff0000u));
                *(u32x2*)(mix + tk * DM + 512 + (hk * 4 + g2) * 64 + 16 * t + 4 * kg2) = d;
            }
        }
    }
    __syncthreads();
#undef NS_LOADK
#undef NS_LOADV
#undef NS_RESET
#undef NS_PIPE
#undef NS_SETBIT
}
#ifndef PRB_SCANONLY
#define PRB_SCANONLY 0
#endif
#ifndef DUP_P1
#define DUP_P1 0
#endif
#ifndef DUP_P2G
#define DUP_P2G 0
#endif
#ifndef DUP_P2
#define DUP_P2 0
#endif
#ifndef DUP_SCAN
#define DUP_SCAN 0
#endif
#ifndef DUP_NSA
#define DUP_NSA 0
#endif
__device__ __forceinline__ void p2_phase(const Frame& F) {
    int cw_head = -1;
#define P2_CW_LOAD(h_) do { if ((h_) != cw_head) { __syncthreads(); const float* cw = F.in[3]; \
        for (int i = F.tid; i < 4 * 3 * 128; i += 512) { const int j = i / 384, r = i - j * 384, part = r >> 7, c = r & 127; ((LAS float*)(F.lds + GL_CW))[i] = cw[j * 1536 + part * 512 + (h_) * 128 + c]; } \
        cw_head = (h_); __syncthreads(); } } while (0)
    for (int rep = 0; rep <= DUP_P2; ++rep)
    for (int task = blockIdx.x; task < 3072; task += gridDim.x) {
        if (task < 2048) { P2_CW_LOAD(task & 3); for (int r2 = 0; r2 <= DUP_P2G; ++r2) gdn_prep_item(F, task); }
        else if (task < 2560) compress_block(F, task - 2048);
        else vtranspose_task(F, task - 2560);
    }
}
__device__ __forceinline__ void p3_phase(const Frame& F) {
    for (int rep = 0; rep <= DUP_SCAN; ++rep)
        for (int bh = blockIdx.x; bh < 16; bh += gridDim.x) gdn_scan(F, bh);
    LAS int* nxt = (LAS int*)(F.lds + NL_NXT);
#if PRB_SCANONLY
    if (blockIdx.x < 16) return;
#endif
    for (int rep = 0; rep <= DUP_NSA; ++rep) {
        const int bhk = blockIdx.x & 7;
        unsigned* ctr = (unsigned*)(F.ws + WS_CTL) + 64 + 64 * bhk + 1024 * rep;
        for (;;) {
            __syncthreads();
            if (F.tid == 0) *nxt = (int)atomicAdd(ctr, 1u);
            __syncthreads();
            const int qi = *nxt;
            if (qi >= 128) break;
            nsa_item(F, qi * 8 + bhk);
        }
    }
}
typedef __attribute__((address_space(1))) unsigned gu32;
#define XB_TMO      128
#define XB_XCNT(j)  (256  + 64 * (j))
#define XB_XSUB(j)  (1280 + 64 * (j))
#define XB_XGEN(j)  (2304 + 64 * (j))
#define XB_TOP      3328
#define XB_TOPGEN   3392
#define XCD_BAR_WORDS 3456
#define XB_SPIN_CAP (1u << 18)

__device__ __forceinline__ unsigned xb_ld(unsigned* p)              { return __hip_atomic_load(p, __ATOMIC_RELAXED, __HIP_MEMORY_SCOPE_AGENT); }
__device__ __forceinline__ unsigned xb_add(unsigned* p, unsigned v) { return __hip_atomic_fetch_add(p, v, __ATOMIC_RELAXED, __HIP_MEMORY_SCOPE_AGENT); }
__device__ __forceinline__ unsigned xb_xcc_id() { return (unsigned)__builtin_amdgcn_s_getreg((3 << 11) | 20) & 0xFu; }
#define XB_SPIN(cond, bar) do { unsigned _sp = 0; while (cond) { __builtin_amdgcn_s_sleep(1); \
    if ((++_sp & 255u) == 0u) { if (xb_ld(&(bar)[XB_TMO])) break; if (_sp > XB_SPIN_CAP) { atomicAdd(&(bar)[XB_TMO], 1u); break; } } } } while (0)

struct XcdBarrier {
    unsigned* bar; unsigned x;
    volatile LAS unsigned* st;
};

__device__ __forceinline__ XcdBarrier xcd_barrier_post(unsigned* bar, volatile LAS unsigned* st) {
    XcdBarrier b; b.bar = bar; b.x = xb_xcc_id(); b.st = st;
    if (threadIdx.x == 0) (void)xb_add(&bar[XB_XCNT(b.x)], 1u);
    return b;
}
__device__ __forceinline__ void xcd_barrier_complete(unsigned* bar, unsigned x, unsigned& nloc, unsigned& nx) {
    const unsigned G = gridDim.x * gridDim.y * gridDim.z;
    unsigned sum, cnt, mine, sp = 0u;
    for (;;) {
        sum = 0u; cnt = 0u; mine = 0u;
#pragma unroll
        for (unsigned j = 0; j < 16; ++j) { const unsigned c = xb_ld(&bar[XB_XCNT(j)]); sum += c; cnt += (c > 0u) ? 1u : 0u; mine = (j == x) ? c : mine; }
        if (sum == G) break;
        __builtin_amdgcn_s_sleep(1);
        if ((++sp & 255u) == 0u) { if (xb_ld(&bar[XB_TMO])) break; if (sp > XB_SPIN_CAP) { atomicAdd(&bar[XB_TMO], 1u); break; } }
    }
    nloc = mine > 0u ? mine : 1u; nx = cnt > 0u ? cnt : 1u;
}

__device__ __forceinline__ void xcd_barrier(const XcdBarrier& b) {
    asm volatile("s_waitcnt vmcnt(0)" ::: "memory");
    __syncthreads();
    if (threadIdx.x == 0) {
        unsigned* bar = b.bar;
        __builtin_amdgcn_s_waitcnt(0);
        unsigned nloc = b.st[0], nx = b.st[1];
        if (nloc == 0u) { xcd_barrier_complete(bar, b.x, nloc, nx); b.st[0] = nloc; b.st[1] = nx; }
        const unsigned old = xb_add(&bar[XB_XSUB(b.x)], 1u);
        const unsigned gen = old / nloc;
        if (old + 1u == (gen + 1u) * nloc) {
            __builtin_amdgcn_fence(__ATOMIC_RELEASE, "agent");
            asm volatile("s_waitcnt vmcnt(0)" ::: "memory");
            const unsigned og = xb_add(&bar[XB_TOP], 1u);
            const unsigned tg = og / nx;
            if (og + 1u == (tg + 1u) * nx) xb_add(&bar[XB_TOPGEN], 1u);
            else XB_SPIN(xb_ld(&bar[XB_TOPGEN]) == tg, bar);
            __builtin_amdgcn_fence(__ATOMIC_ACQUIRE, "agent");
            xb_add(&bar[XB_XGEN(b.x)], 1u);
            asm volatile("s_waitcnt vmcnt(0)" ::: "memory");
        } else {
            XB_SPIN(xb_ld(&bar[XB_XGEN(b.x)]) == gen, bar);
            __builtin_amdgcn_fence(__ATOMIC_ACQUIRE, "agent");
            asm volatile("s_waitcnt vmcnt(0)" ::: "memory");
        }
    }
    __syncthreads();
}

constexpr int LDS_BARST = LDS_BYTES - 64;
struct Args { const float* in[16]; float* out; unsigned char* ws; int ph_lo, ph_hi, coop, pad; };
constexpr int N_PHASES = 6;

__global__ void __launch_bounds__(512, 2) hymba_fwd(Args a) {
    extern __shared__ __attribute__((aligned(16))) unsigned char lds_raw[];
    Frame F;
#pragma unroll
    for (int i = 0; i < 16; ++i) F.in[i] = a.in[i];
    F.out = a.out; F.ws = a.ws; F.lds = (LAS unsigned char*)lds_raw; F.ldsg = lds_raw;
    F.tid = threadIdx.x; F.lane = F.tid & 63; F.wave = __builtin_amdgcn_readfirstlane(F.tid >> 6);
    unsigned char* ws = a.ws;
    volatile LAS unsigned* barst = (volatile LAS unsigned*)(F.lds + LDS_BARST);
    if (F.tid < 2) barst[F.tid] = 0u;
    __syncthreads();
    XcdBarrier xbar; xbar.bar = (unsigned*)(ws + WS_CTL) + 4096; xbar.x = 0; xbar.st = nullptr;
    if (a.coop) xbar = xcd_barrier_post((unsigned*)(ws + WS_CTL) + 4096, barst);
    const int lo = a.ph_lo, hi = a.ph_hi;
#define IN(k) (lo <= (k) && (k) < hi)
#define SEAM(k) do { if (IN(k) && IN((k) + 1) && a.coop) { xcd_barrier(xbar); } __syncthreads(); } while (0)
#ifndef DUP_P0
#define DUP_P0 0
#endif
#ifndef DUP_P4
#define DUP_P4 0
#endif
    if (IN(0)) { _Pragma("unroll 1") for (int rep = 0; rep <= DUP_P0; ++rep) p0_prep(F); }
    SEAM(0);
    if (IN(1)) {
        pg8::Gemm g{(const bf16*)(ws + WS_XB), (const bf16*)(ws + WS_WTIN), T_TOK, NPROJ, DM};
        pg8::StaticOrder S; S.init(T_TOK, NPROJ, (int)gridDim.x, (int)blockIdx.x);
        EpiProj E{(bf16*)(ws + WS_GQKV), (bf16*)(ws + WS_GZ), (bf16*)(ws + WS_NQ), (bf16*)(ws + WS_NKV), (bf16*)(ws + WS_NZ), (const float*)(ws + WS_RS)};
        pg8::gemm_phase<EpiProj, pg8::StaticOrder, false>(F.lds, g, S, E, nullptr);
#if DUP_P1
        __syncthreads(); pg8::gemm_phase<EpiProj, pg8::StaticOrder, false>(F.lds, g, S, E, nullptr);
#endif
    }
    SEAM(1);
    if (IN(2)) p2_phase(F);
    SEAM(2);
    if (IN(3)) p3_phase(F);
    SEAM(3);
    if (IN(4)) {
        pg8::Gemm g{(const bf16*)(ws + WS_MIX), (const bf16*)(ws + WS_WTOUT), T_TOK, DM, DM};
        pg8::StaticOrder S; S.init(T_TOK, DM, (int)gridDim.x, (int)blockIdx.x);
        EpiOut E{F.in[0], F.out};
        pg8::gemm_phase<EpiOut, pg8::StaticOrder, false>(F.lds, g, S, E, nullptr);
#if DUP_P4
        __syncthreads(); pg8::gemm_phase<EpiOut, pg8::StaticOrder, false>(F.lds, g, S, E, nullptr);
#endif
    }
    SEAM(4);
    if (IN(5)) p5_final(F);
#undef IN
#undef SEAM
}

extern "C" void kernel_launch(void* const* d_in, const int* in_sizes, int n_in, void* d_out, int out_size, void* d_ws, size_t ws_size, hipStream_t stream) {
    static int grid = 0;
    if (grid == 0) {
        if (n_in != 16 || in_sizes[0] != T_TOK * DM || out_size != T_TOK * DM || ws_size < WS_END) { fprintf(stderr, "kernel_launch: unexpected shapes (n_in %d, ws %zu)\n", n_in, ws_size); grid = -1; return; }
        int dev = 0, cus = 0, per_cu = 0;
        if (hipGetDevice(&dev) != hipSuccess || hipDeviceGetAttribute(&cus, hipDeviceAttributeMultiprocessorCount, dev) != hipSuccess) { grid = -1; return; }
        if (hipFuncSetAttribute((const void*)hymba_fwd, hipFuncAttributeMaxDynamicSharedMemorySize, LDS_BYTES) != hipSuccess) { fprintf(stderr, "kernel_launch: hipFuncSetAttribute failed\n"); grid = -1; return; }
        if (hipOccupancyMaxActiveBlocksPerMultiprocessor(&per_cu, (const void*)hymba_fwd, 512, LDS_BYTES) != hipSuccess || per_cu < 1) { fprintf(stderr, "kernel_launch: occupancy query says %d\n", per_cu); per_cu = 1; }
        (void)hipGetLastError();
        grid = cus;
    }
    if (grid < 0) return;
    (void)hipMemsetAsync((char*)d_ws + WS_CTL, 0, 64 * 1024, stream);
    Args a{};
    for (int i = 0; i < 16; ++i) a.in[i] = (const float*)d_in[i];
    a.out = (float*)d_out; a.ws = (unsigned char*)d_ws;
#if MK_LAUNCHES == 1
    a.ph_lo = 0; a.ph_hi = N_PHASES; a.coop = 1;
    void* args[] = {&a};
    hipError_t e = hipLaunchCooperativeKernel((const void*)hymba_fwd, dim3(grid), dim3(512), args, LDS_BYTES, stream);
    if (e != hipSuccess) fprintf(stderr, "cooperative launch failed: %s (grid %d)\n", hipGetErrorString(e), grid);
#else
    for (int ph = 0; ph < N_PHASES; ++ph) {
        a.ph_lo = ph; a.ph_hi = ph + 1; a.coop = 0;
        hipLaunchKernelGGL(hymba_fwd, dim3(grid), dim3(512), LDS_BYTES, stream, a);
    }
#endif
}
```

```cpp
#include <hip/hip_runtime.h>
#include <hip/hip_cooperative_groups.h>
#include <cstdio>
#include <cstdint>
namespace cg = cooperative_groups;
#ifndef MK_LAUNCHES
#define MK_LAUNCHES 1
#endif

namespace pg8 {
#define PG8_LAS __attribute__((address_space(3)))
typedef unsigned short bf16_t;
typedef short bf16x8 __attribute__((ext_vector_type(8)));
typedef float f32x4 __attribute__((ext_vector_type(4)));
typedef unsigned u32x4 __attribute__((ext_vector_type(4)));
constexpr int BM = 256, BK = 64, HALF = 128, HTB = HALF * BK * 2  , STAGE_BYTES = 8 * HTB, NXCD = 8, WGM = 8;

__host__ __device__ __forceinline__ int lds_byte(int r, int c) { const int st = (r >> 4) * 2 + (c >> 5), rr = r & 15, cc = c & 31, ob = rr * 64 + cc * 2; return st * 1024 + (ob ^ (((ob >> 9) & 1) << 5)); }
__host__ __device__ __forceinline__ void stage_rc(int b, int& R, int& C) { const int st = b / 1024, sb = b % 1024, swz = sb ^ (((sb >> 9) & 1) << 5); R = (st >> 1) * 16 + swz / 64; C = (st & 1) * 32 + (swz % 64) / 2; }
__host__ __device__ __forceinline__ int perm32(int rho) { const int n = rho >> 4, i = rho & 15; return 8 * (i >> 2) + 4 * n + (i & 3); }

struct Unit { int pm, pn; };
struct Gemm { const bf16_t* A; const bf16_t* Bt; int M, N, K; };

struct StaticOrder {
    int nM, nN, nwg, G, c;
    __host__ __device__ void init(int M, int N, int G_, int c_) { nM = M / BM; nN = N / BM; nwg = nM * nN; G = G_; c = c_; }
    __host__ __device__ bool next(int i, Unit& u) const {
        const long L = (long)i * G + c; if (L >= nwg) return false;
        int wgid = (int)L; { const int q = nwg / NXCD, r = nwg % NXCD, xcd = wgid % NXCD, off = wgid / NXCD; wgid = (xcd < r ? xcd * (q + 1) : r * (q + 1) + (xcd - r) * q) + off; }
        const int nig = WGM * nN, gid = wgid / nig, fm = gid * WGM, gsz = (nM - fm) < WGM ? (nM - fm) : WGM;
        u.pm = fm + ((wgid % nig) % gsz); u.pn = (wgid % nig) / gsz; return true;
    }
    __device__ __forceinline__ void a_ready(const Unit&) const {}
    __device__ __forceinline__ void done(const Unit&) const {}
};
__device__ __forceinline__ unsigned cvt_pk_bf16(float lo, float hi) { unsigned r; asm volatile("v_cvt_pk_bf16_f32 %0, %1, %2" : "=v"(r) : "v"(lo), "v"(hi)); return r; }
typedef float f32x2 __attribute__((ext_vector_type(2)));
template <class Epi, class Sched, bool STAMP = false>
__device__ __forceinline__ void gemm_phase(PG8_LAS unsigned char* lds, const Gemm g, const Sched& S, const Epi& E, unsigned long long* stamps) {
    const int tid = threadIdx.x, wid = __builtin_amdgcn_readfirstlane(tid >> 6), lane = tid & 63, wr = wid >> 2, wc = wid & 3, fr = lane & 15, fq = lane >> 4;
    const int K = g.K, nt = K / BK;
    int ts_lo = 0, ts_hi = 0, nts = 0; const unsigned long long rt_entry = STAMP ? (unsigned long long)wall_clock64() : 0ull;
#define PG8_STAMP() do { if (STAMP && wid == 0 && nts < 64) { const unsigned long long _c = (unsigned long long)clock64(); \
        ts_lo = (lane == nts) ? (int)(unsigned)_c : ts_lo; ts_hi = (lane == nts) ? (int)(unsigned)(_c >> 32) : ts_hi; ++nts; } } while (0)
    PG8_STAMP();
    unsigned voffA[2], voffB[2];
#pragma unroll
    for (int i = 0; i < 2; ++i) { int R, C; stage_rc(tid * 16 + i * 8192, R, C); const int Rb = Epi::PERM ? ((R & ~31) + perm32(R & 31)) : R;
        voffA[i] = (unsigned)(R * K + C) * 2u; voffB[i] = (unsigned)(Rb * K + C) * 2u; }
    const size_t kstep = (size_t)(BK * 2);
    const size_t hstep = (size_t)HALF * K * 2;
    const size_t tstep = 2 * hstep;
    const unsigned ldsw = (unsigned)wid * 1024u;
    const int aoff = lds_byte(wr * 64 + fr, fq * 8), boff = lds_byte(wc * 32 + fr, fq * 8);
#define PG8_SA(b, h) (((b) * 2 + (h)) * HTB)
#define PG8_SB(b, h) ((4 + (b) * 2 + (h)) * HTB)
#define PG8_STAGE(bufoff, gbase, voff) do { _Pragma("unroll") for (int _i = 0; _i < 2; ++_i) \
        __builtin_amdgcn_global_load_lds((const unsigned*)((const char*)(gbase) + (voff)[_i]), (PG8_LAS unsigned*)(lds + (bufoff) + ldsw + _i * 8192), 16, 0, 0); } while (0)
#define PG8_LDA(dst, b, h) do { _Pragma("unroll") for (int m = 0; m < 4; ++m) _Pragma("unroll") for (int k = 0; k < 2; ++k) dst[m][k] = *(const PG8_LAS bf16x8*)(lds + PG8_SA(b, h) + aoff + m * 2048 + k * 1024); } while (0)
#define PG8_LDB(dst, b, h) do { _Pragma("unroll") for (int n = 0; n < 2; ++n) _Pragma("unroll") for (int k = 0; k < 2; ++k) dst[n][k] = *(const PG8_LAS bf16x8*)(lds + PG8_SB(b, h) + boff + n * 2048 + k * 1024); } while (0)
#define PG8_MMA(ai, bj, At, Bt) do { __builtin_amdgcn_s_setprio(1); _Pragma("unroll") for (int m = 0; m < 4; ++m) _Pragma("unroll") for (int n = 0; n < 2; ++n) _Pragma("unroll") for (int k = 0; k < 2; ++k) \
        acc[ai][bj][m][n] = __builtin_amdgcn_mfma_f32_16x16x32_bf16(Bt[n][k], At[m][k], acc[ai][bj][m][n], 0, 0, 0); __builtin_amdgcn_s_setprio(0); } while (0)
#define PG8_WAIT_V(n) asm volatile("s_waitcnt vmcnt(" #n ")" ::: "memory")
#define PG8_WAIT_L(n) asm volatile("s_waitcnt lgkmcnt(" #n ")" ::: "memory")
#define PG8_BAR __builtin_amdgcn_s_barrier()
#define PG8_SCHED __builtin_amdgcn_sched_barrier(0)
    Unit cur, nxt; int ui = 0;
    if (!S.next(0, cur)) return;
    f32x4 acc[2][2][4][2];
#pragma unroll
    for (int a = 0; a < 2; ++a)
#pragma unroll
        for (int b = 0; b < 2; ++b)
#pragma unroll
            for (int m = 0; m < 4; ++m)
#pragma unroll
                for (int n = 0; n < 2; ++n) acc[a][b][m][n] = (f32x4){0.f, 0.f, 0.f, 0.f};
    bf16x8 At[4][2], B0[2][2], B1[2][2];
    const char* cA = (const char*)g.A + (size_t)cur.pm * tstep; const char* cB = (const char*)g.Bt + (size_t)cur.pn * tstep;
    S.a_ready(cur);
    PG8_STAGE(PG8_SB(0, 0), cB, voffB); PG8_STAGE(PG8_SA(0, 0), cA, voffA); PG8_STAGE(PG8_SB(0, 1), cB + hstep, voffB); PG8_STAGE(PG8_SA(0, 1), cA + hstep, voffA);
    if (wr == 1) PG8_BAR;
    PG8_WAIT_V(4); PG8_BAR;
    PG8_STAGE(PG8_SB(1, 0), cB + kstep, voffB); PG8_STAGE(PG8_SA(1, 0), cA + kstep, voffA); PG8_STAGE(PG8_SB(1, 1), cB + hstep + kstep, voffB);
    PG8_WAIT_V(6); PG8_BAR;
    PG8_STAMP();
    for (;;) {
        const bool has_next = S.next(ui + 1, nxt);
        const char* nA = has_next ? (const char*)g.A + (size_t)nxt.pm * tstep : cA; const char* nB = has_next ? (const char*)g.Bt + (size_t)nxt.pn * tstep : cB;
        for (int t = 0; t < nt; t += 2) {
            const bool last = (t == nt - 2);
            const char* a1 = cA + (size_t)(t + 1) * kstep;
            const char* a2 = last ? nA : cA + (size_t)(t + 2) * kstep; const char* b2 = last ? nB : cB + (size_t)(t + 2) * kstep;
            const char* a3 = a2 + kstep; const char* b3 = b2 + kstep;
            if (last && has_next) S.a_ready(nxt);
            PG8_LDB(B0, 0, 0); PG8_SCHED; PG8_LDA(At, 0, 0); PG8_STAGE(PG8_SA(1, 1), a1 + hstep, voffA);
            PG8_WAIT_L(8); PG8_BAR; PG8_WAIT_L(0); PG8_MMA(0, 0, At, B0); PG8_BAR; PG8_SCHED;
            PG8_LDB(B1, 0, 1); PG8_STAGE(PG8_SB(0, 0), b2, voffB);
            PG8_BAR; PG8_WAIT_L(0); PG8_MMA(0, 1, At, B1); PG8_BAR;
            PG8_LDA(At, 0, 1); PG8_STAGE(PG8_SA(0, 0), a2, voffA);
            PG8_BAR; PG8_WAIT_L(0); PG8_MMA(1, 0, At, B0); PG8_BAR; PG8_SCHED;
            PG8_STAGE(PG8_SB(0, 1), b2 + hstep, voffB);
            PG8_WAIT_V(6); PG8_BAR; PG8_MMA(1, 1, At, B1); PG8_BAR;
            PG8_LDB(B0, 1, 0); PG8_SCHED; PG8_LDA(At, 1, 0); PG8_STAGE(PG8_SA(0, 1), a2 + hstep, voffA);
            PG8_WAIT_L(8); PG8_BAR; PG8_WAIT_L(0); PG8_MMA(0, 0, At, B0); PG8_BAR; PG8_SCHED;
            PG8_LDB(B1, 1, 1); PG8_STAGE(PG8_SB(1, 0), b3, voffB);
            PG8_BAR; PG8_WAIT_L(0); PG8_MMA(0, 1, At, B1); PG8_BAR;
            PG8_LDA(At, 1, 1); PG8_STAGE(PG8_SA(1, 0), a3, voffA);
            PG8_BAR; PG8_WAIT_L(0); PG8_MMA(1, 0, At, B0); PG8_BAR; PG8_SCHED;
            PG8_STAGE(PG8_SB(1, 1), b3 + hstep, voffB);
            PG8_WAIT_V(6); PG8_BAR; PG8_MMA(1, 1, At, B1); PG8_BAR;
        }
        PG8_STAMP();
        if constexpr (!Epi::AFTER_DRAIN) { E(acc, cur, wr, wc, fr, fq); S.done(cur); }
        PG8_STAMP();
        if (!has_next) break;
#pragma unroll
        for (int a = 0; a < 2; ++a)
#pragma unroll
            for (int b = 0; b < 2; ++b)
#pragma unroll
                for (int m = 0; m < 4; ++m)
#pragma unroll
                    for (int n = 0; n < 2; ++n) acc[a][b][m][n] = (f32x4){0.f, 0.f, 0.f, 0.f};
        cur = nxt; cA = nA; cB = nB; ++ui;
    }
    PG8_WAIT_V(0);
    if (wr == 0) PG8_BAR;
    PG8_BAR;
    if constexpr (Epi::AFTER_DRAIN) { E.fused(acc, cur, wr, wc, fr, fq, lds, wid, lane); S.done(cur); }
    PG8_STAMP();
    if (STAMP && wid == 0) { stamps[lane] = lane < nts ? (((unsigned long long)(unsigned)ts_hi << 32) | (unsigned)ts_lo) : 0ull;
        if (lane == 62) stamps[62] = rt_entry; if (lane == 63) stamps[63] = (unsigned long long)wall_clock64(); }
#undef PG8_STAMP
#undef PG8_SA
#undef PG8_SB
#undef PG8_STAGE
#undef PG8_LDA
#undef PG8_LDB
#undef PG8_MMA
#undef PG8_WAIT_V
#undef PG8_WAIT_L
#undef PG8_BAR
#undef PG8_SCHED
}
}
#define LAS __attribute__((address_space(3)))
typedef unsigned short bf16;
typedef short bf16x8 __attribute__((ext_vector_type(8)));
typedef short bf16x4 __attribute__((ext_vector_type(4)));
typedef float f32x4 __attribute__((ext_vector_type(4)));
typedef unsigned u32x4 __attribute__((ext_vector_type(4)));
typedef unsigned u32x2 __attribute__((ext_vector_type(2)));
typedef float f32x2_ __attribute__((ext_vector_type(2)));
typedef __bf16 bf16x2n __attribute__((ext_vector_type(2)));
__device__ __forceinline__ unsigned cvt_pk_bf16(float lo, float hi) { const f32x2_ v = {lo, hi}; const bf16x2n b = __builtin_convertvector(v, bf16x2n); return __builtin_bit_cast(unsigned, b); }

constexpr int T_TOK = 32768, SEQ = 8192, DM = 1024, NPROJ = 3840, PROJ_W = 3872;
constexpr float EPS = 1e-6f;
constexpr size_t MiB = 1u << 20;
constexpr size_t WS_CTL = 0;
constexpr size_t WS_WTIN = 1 * MiB;
constexpr size_t WS_WTOUT = 9 * MiB;
constexpr size_t WS_W1FK = 11 * MiB + 256 * 1024;
constexpr size_t WS_W1FV = 11 * MiB + 768 * 1024;
constexpr size_t WS_W2FK = 12 * MiB + 256 * 1024;
constexpr size_t WS_W2FV = 12 * MiB + 288 * 1024;
constexpr size_t WS_CPE = 32768;
constexpr size_t WS_BT = 12 * MiB + 384 * 1024;
constexpr size_t WS_RS = 13 * MiB;
constexpr size_t WS_SMALL = 14 * MiB;
constexpr size_t WS_XB = 32 * MiB;
constexpr size_t WS_MIX = 32 * MiB;
constexpr size_t WS_GQKV = 96 * MiB;
constexpr size_t WS_GZ = 192 * MiB;
constexpr size_t WS_NQ = 224 * MiB;
constexpr size_t WS_NKV = 256 * MiB;
constexpr size_t WS_NZ = 304 * MiB;
constexpr size_t WS_GREC = 336 * MiB;
constexpr size_t GREC_BYTES = 73728;
constexpr size_t WS_KCMP = 480 * MiB;
constexpr size_t WS_VCMPT = 480 * MiB + 512 * 1024;
constexpr size_t WS_VST = 482 * MiB;
constexpr size_t WS_VWT = 490 * MiB;
constexpr size_t WS_GLAST = 498 * MiB;
constexpr size_t WS_END = 499 * MiB;
constexpr int LDS_BYTES = 158720;

__device__ __forceinline__ float bf2f(unsigned short h) { return __uint_as_float((unsigned)h << 16); }
__device__ __forceinline__ unsigned short f2bf(float f) { return (unsigned short)(cvt_pk_bf16(f, 0.f) & 0xffffu); }
__device__ __forceinline__ float sigmoidf_(float v) { return 1.0f / (1.0f + __expf(-v)); }
__device__ __forceinline__ float siluf_(float v) { return v / (1.0f + __expf(-v)); }
__device__ __forceinline__ f32x4 mfma16(bf16x8 a, bf16x8 b, f32x4 c) { return __builtin_amdgcn_mfma_f32_16x16x32_bf16(a, b, c, 0, 0, 0); }
__device__ __forceinline__ int kperm(int g, int j) { return j < 4 ? 4 * g + j : 16 + 4 * g + (j - 4); }

struct Frame {
    const float* in[16]; float* out; unsigned char* ws; LAS unsigned char* lds; unsigned char* ldsg;
    int tid, lane, wave;
};

struct EpiProj {
    static constexpr bool PERM = true, AFTER_DRAIN = false;
    bf16* gqkv; bf16* gz; bf16* nq; bf16* nkv; bf16* nz; const float* rs;
    __device__ __forceinline__ void operator()(const f32x4 (&acc)[2][2][4][2], const pg8::Unit& u, int wr, int wc, int fr, int fq) const {
        const int pn = u.pn; bf16* base; int ldc, colt, act;
        if (pn < 6) { base = gqkv; ldc = 1536; colt = pn * 256; act = 0; }
        else if (pn < 8) { base = gz; ldc = 512; colt = (pn - 6) * 256; act = 1; }
        else if (pn < 10) { base = nq; ldc = 512; colt = (pn - 8) * 256; act = 2; }
        else if (pn < 13) { base = nkv; ldc = 768; colt = (pn - 10) * 256; act = 0; }
        else { base = nz; ldc = 512; colt = (pn - 13) * 256; act = 1; }
        const int row0 = u.pm * 256 + wr * 64 + fr, col0 = colt + wc * 32 + 8 * fq;
        float rsv[2][4];
#pragma unroll
        for (int ai = 0; ai < 2; ++ai)
#pragma unroll
            for (int m = 0; m < 4; ++m) rsv[ai][m] = rs[row0 + ai * 128 + m * 16];
#pragma unroll
        for (int ai = 0; ai < 2; ++ai)
#pragma unroll
            for (int m = 0; m < 4; ++m) {
                const int row = row0 + ai * 128 + m * 16; const float r = rsv[ai][m];
                bf16* rowp = base + (size_t)row * ldc + col0;
#pragma unroll
                for (int bj = 0; bj < 2; ++bj) {
                    f32x4 v0 = acc[ai][bj][m][0] * r, v1 = acc[ai][bj][m][1] * r;
                    if (act == 1) {
#pragma unroll
                        for (int j = 0; j < 4; ++j) { v0[j] = siluf_(v0[j]); v1[j] = siluf_(v1[j]); }
                    } else if (act == 2) { v0 = v0 * 0.18033688011112042f; v1 = v1 * 0.18033688011112042f; }
                    u32x4 w; w.x = cvt_pk_bf16(v0[0], v0[1]); w.y = cvt_pk_bf16(v0[2], v0[3]); w.z = cvt_pk_bf16(v1[0], v1[1]); w.w = cvt_pk_bf16(v1[2], v1[3]);
                    *(u32x4*)(rowp + bj * 128) = w;
                }
            }
    }
};
struct EpiOut {
    static constexpr bool PERM = false, AFTER_DRAIN = false;
    const float* __restrict__ x; float* __restrict__ out;
    __device__ __forceinline__ void operator()(const f32x4 (&acc)[2][2][4][2], const pg8::Unit& u, int wr, int wc, int fr, int fq) const {
        const int row0 = u.pm * 256 + wr * 64 + fr, col0 = u.pn * 256 + wc * 32 + 4 * fq;
        f32x4 xa[8], xb[8];
#define EO_LOAD(X_, AI, MH) do { _Pragma("unroll") for (int _m = 0; _m < 2; ++_m) _Pragma("unroll") for (int _bj = 0; _bj < 2; ++_bj) _Pragma("unroll") for (int _n = 0; _n < 2; ++_n) \
            X_[_m * 4 + _bj * 2 + _n] = *(const f32x4*)(x + (size_t)(row0 + (AI) * 128 + ((MH) * 2 + _m) * 16) * DM + col0 + _bj * 128 + _n * 16); } while (0)
#define EO_STORE(X_, AI, MH) do { asm volatile("" : "+v"(X_[0]), "+v"(X_[1]), "+v"(X_[2]), "+v"(X_[3]), "+v"(X_[4]), "+v"(X_[5]), "+v"(X_[6]), "+v"(X_[7])); \
            _Pragma("unroll") for (int _m = 0; _m < 2; ++_m) _Pragma("unroll") for (int _bj = 0; _bj < 2; ++_bj) _Pragma("unroll") for (int _n = 0; _n < 2; ++_n) \
            *(f32x4*)(out + (size_t)(row0 + (AI) * 128 + ((MH) * 2 + _m) * 16) * DM + col0 + _bj * 128 + _n * 16) = acc[AI][_bj][(MH) * 2 + _m][_n] + X_[_m * 4 + _bj * 2 + _n]; } while (0)
        EO_LOAD(xa, 0, 0); EO_LOAD(xb, 0, 1); EO_STORE(xa, 0, 0); EO_LOAD(xa, 1, 0); EO_STORE(xb, 0, 1); EO_LOAD(xb, 1, 1); EO_STORE(xa, 1, 0); EO_STORE(xb, 1, 1);
#undef EO_LOAD
#undef EO_STORE
    }
};

__device__ __forceinline__ int orig_col(int n) {
    return n < 2048 ? n : (n < 2560 ? 2056 + (n - 2048) : (n < 3328 ? 2568 + (n - 2560) : 3360 + (n - 3328)));
}
__device__ __forceinline__ int orig_small(int sc) { return sc < 8 ? 2048 + sc : 3336 + (sc - 8); }
__device__ __forceinline__ int rel_bucket(int dist) {
    const int n = dist < 0 ? 0 : dist;
    if (n < 16) return n;
    int b = 16;
    b += (n >= 21); b += (n >= 27); b += (n >= 35); b += (n >= 46); b += (n >= 59); b += (n >= 77); b += (n >= 99); b += (n >= 128);
    b += (n >= 166); b += (n >= 216); b += (n >= 280); b += (n >= 363); b += (n >= 470); b += (n >= 609); b += (n >= 790);
    return b;
}
__device__ __forceinline__ void transpose_tile(const Frame& F, const float* src, int sld, int srccol0, int k0, const float* scale, bf16* dst, int dld, int n0) {
    LAS float* tile = (LAS float*)F.lds;
    const int kk = F.tid >> 6, nn = F.tid & 63;
    float tv[8], tsc[8];
#pragma unroll
    for (int i = 0; i < 8; ++i) { const int k = kk + 8 * i; tv[i] = src[(size_t)(k0 + k) * sld + srccol0 + nn]; tsc[i] = scale ? scale[k0 + k] : 1.0f; }
#pragma unroll
    for (int i = 0; i < 8; ++i) { const int k = kk + 8 * i; tile[k * 65 + nn] = tv[i] * tsc[i]; }
    __syncthreads();
    const int n2 = F.tid >> 3, kc = F.tid & 7;
    float e[8];
#pragma unroll
    for (int j = 0; j < 8; ++j) e[j] = tile[(8 * kc + j) * 65 + n2];
    u32x4 w; w.x = cvt_pk_bf16(e[0], e[1]); w.y = cvt_pk_bf16(e[2], e[3]); w.z = cvt_pk_bf16(e[4], e[5]); w.w = cvt_pk_bf16(e[6], e[7]);
    *(u32x4*)(dst + (size_t)(n0 + n2) * dld + k0 + 8 * kc) = w;
    __syncthreads();
}

__device__ __forceinline__ void p0_prep(const Frame& F) {
    const float* x = F.in[0]; const float* nw = F.in[1]; const float* w_in = F.in[2];
    unsigned char* ws = F.ws;
    const int G = gridDim.x, bid = blockIdx.x;
    for (int task = bid; task < 1395; task += G) {
        if (task < 960) { const int nt = task / 16, kt = task % 16; transpose_tile(F, w_in, PROJ_W, orig_col(nt * 64), kt * 64, nw, (bf16*)(ws + WS_WTIN), DM, nt * 64); }
        else if (task < 1216) { const int t2 = task - 960, nt = t2 / 16, kt = t2 % 16; transpose_tile(F, F.in[13], DM, nt * 64, kt * 64, nullptr, (bf16*)(ws + WS_WTOUT), DM, nt * 64); }
        else if (task < 1344) {
            const int t2 = task - 1216, which = t2 >> 6, sub = t2 & 63;
            const float* w1 = F.in[which ? 11 : 9]; bf16* dst = (bf16*)(ws + (which ? WS_W1FV : WS_W1FK));
            const int mt = F.tid >> 6, l = F.tid & 63, m = l & 15, kg = l >> 4, ks = sub;
            float e[8];
#pragma unroll
            for (int j = 0; j < 8; ++j) e[j] = w1[(size_t)(32 * ks + 8 * kg + j) * 128 + 16 * mt + m];
            u32x4 w; w.x = cvt_pk_bf16(e[0], e[1]); w.y = cvt_pk_bf16(e[2], e[3]); w.z = cvt_pk_bf16(e[4], e[5]); w.w = cvt_pk_bf16(e[6], e[7]);
            *(u32x4*)(dst + ((size_t)(ks * 8 + mt) * 64 + l) * 8) = w;
        } else if (task < 1346) {
            const int which = task - 1344; const float* w2 = F.in[which ? 12 : 10]; bf16* dst = (bf16*)(ws + (which ? WS_W2FV : WS_W2FK));
            for (int i = F.tid; i < 1024; i += 512) {
                const int l = i & 63, ks = (i >> 6) & 3, mt = i >> 8, m = l & 15, kg = l >> 4;
                float e[8];
#pragma unroll
                for (int j = 0; j < 8; ++j) e[j] = w2[(size_t)(32 * ks + kperm(kg, j)) * 64 + 16 * mt + m];
                u32x4 w; w.x = cvt_pk_bf16(e[0], e[1]); w.y = cvt_pk_bf16(e[2], e[3]); w.z = cvt_pk_bf16(e[4], e[5]); w.w = cvt_pk_bf16(e[6], e[7]);
                *(u32x4*)(dst + (size_t)i * 8) = w;
            }
        } else if (task < 1378) {
            const int which = (task - 1346) >> 4, slice = (task - 1346) & 15; const float* pe = F.in[which ? 8 : 7]; const float* w1 = F.in[which ? 11 : 9];
            float* dst = (float*)(ws + WS_CPE) + which * 128;
            if (F.tid < 128) { const int sl = slice; float s = 0.f;
#pragma unroll 8
                for (int k = sl * 128; k < sl * 128 + 128; ++k) s += pe[k] * w1[(size_t)k * 128 + F.tid];
                atomicAdd(dst + F.tid, s); }
        } else {
            const int i = (task - 1378) * 512 + F.tid;
            if (i < 8 * 1025) { const int head = i / 1025, dist = i % 1025; ((float*)(ws + WS_BT))[i] = F.in[14][rel_bucket(dist) * 8 + head] * 1.4426950408889634f; }
        }
    }
    __syncthreads();
    {
        for (int i = F.tid; i < 32 * 2 * 64; i += 512) {
            const int l = i & 63, nt = (i >> 6) & 1, ks = i >> 7, kg = l >> 4, sc = 16 * nt + (l & 15), oc = orig_small(sc);
            float v[8], lo[8]; unsigned short hi[8];
#pragma unroll
            for (int j = 0; j < 8; ++j) { const int k = 32 * ks + 8 * kg + j; v[j] = w_in[(size_t)k * PROJ_W + oc] * nw[k]; hi[j] = f2bf(v[j]); lo[j] = v[j] - bf2f(hi[j]); }
            u32x4 wh, wl;
            wh.x = hi[0] | ((unsigned)hi[1] << 16); wh.y = hi[2] | ((unsigned)hi[3] << 16); wh.z = hi[4] | ((unsigned)hi[5] << 16); wh.w = hi[6] | ((unsigned)hi[7] << 16);
            wl.x = cvt_pk_bf16(lo[0], lo[1]); wl.y = cvt_pk_bf16(lo[2], lo[3]); wl.z = cvt_pk_bf16(lo[4], lo[5]); wl.w = cvt_pk_bf16(lo[6], lo[7]);
            *(LAS u32x4*)(F.lds + ((size_t)((ks * 2 + nt) * 2 + 0) * 64 + l) * 16) = wh;
            *(LAS u32x4*)(F.lds + ((size_t)((ks * 2 + nt) * 2 + 1) * 64 + l) * 16) = wl;
        }
    }
    __syncthreads();
    bf16* xb = (bf16*)(ws + WS_XB); float* rsv = (float*)(ws + WS_RS); float* small = (float*)(ws + WS_SMALL);
    const float* a_log = F.in[4]; const float* dt_bias = F.in[5];
    for (int tile = bid * 8 + F.wave; tile < T_TOK / 16; tile += G * 8) {
        const int l = F.lane, r = l & 15, kg = l >> 4; const int row = tile * 16 + r;
        const float* xr = x + (size_t)row * DM + 8 * kg;
        f32x4 acc0 = {0.f, 0.f, 0.f, 0.f}, acc1 = {0.f, 0.f, 0.f, 0.f};
        float ss = 0.f;
        f32x4 xc[8], xn[8];
#define P0_LOADG(X_, G_) do { _Pragma("unroll") for (int _q = 0; _q < 4; ++_q) { X_[2 * _q] = *(const f32x4*)(xr + 32 * (4 * (G_) + _q)); X_[2 * _q + 1] = *(const f32x4*)(xr + 32 * (4 * (G_) + _q) + 4); } } while (0)
#define P0_STEP(X_, G_) do { _Pragma("unroll") for (int _q = 0; _q < 4; ++_q) { const int ks = 4 * (G_) + _q; const f32x4 a0 = X_[2 * _q], a1 = X_[2 * _q + 1]; \
            ss += a0[0] * a0[0] + a0[1] * a0[1] + a0[2] * a0[2] + a0[3] * a0[3] + a1[0] * a1[0] + a1[1] * a1[1] + a1[2] * a1[2] + a1[3] * a1[3]; \
            u32x4 h; h.x = cvt_pk_bf16(a0[0], a0[1]); h.y = cvt_pk_bf16(a0[2], a0[3]); h.z = cvt_pk_bf16(a1[0], a1[1]); h.w = cvt_pk_bf16(a1[2], a1[3]); \
            *(u32x4*)(xb + (size_t)row * DM + 32 * ks + 8 * kg) = h; \
            u32x4 lo; \
            lo.x = cvt_pk_bf16(a0[0] - __uint_as_float(h.x << 16), a0[1] - __uint_as_float(h.x & 0xffff0000u)); \
            lo.y = cvt_pk_bf16(a0[2] - __uint_as_float(h.y << 16), a0[3] - __uint_as_float(h.y & 0xffff0000u)); \
            lo.z = cvt_pk_bf16(a1[0] - __uint_as_float(h.z << 16), a1[1] - __uint_as_float(h.z & 0xffff0000u)); \
            lo.w = cvt_pk_bf16(a1[2] - __uint_as_float(h.w << 16), a1[3] - __uint_as_float(h.w & 0xffff0000u)); \
            const bf16x8 ah = __builtin_bit_cast(bf16x8, h), al = __builtin_bit_cast(bf16x8, lo); \
            const LAS unsigned char* fb = F.lds + (size_t)(ks * 4) * 1024 + l * 16; \
            const bf16x8 b0h = *(const LAS bf16x8*)(fb), b0l = *(const LAS bf16x8*)(fb + 1024), b1h = *(const LAS bf16x8*)(fb + 2048), b1l = *(const LAS bf16x8*)(fb + 3072); \
            acc0 = mfma16(ah, b0h, acc0); acc0 = mfma16(al, b0h, acc0); acc0 = mfma16(ah, b0l, acc0); \
            acc1 = mfma16(ah, b1h, acc1); acc1 = mfma16(al, b1h, acc1); acc1 = mfma16(ah, b1l, acc1); } } while (0)
#define P0_PIN(X_) asm volatile("" : "+v"(X_[0]), "+v"(X_[1]), "+v"(X_[2]), "+v"(X_[3]), "+v"(X_[4]), "+v"(X_[5]), "+v"(X_[6]), "+v"(X_[7]))
        P0_LOADG(xc, 0);
#pragma unroll
        for (int gq = 0; gq < 8; gq += 2) {
            P0_LOADG(xn, gq + 1); P0_PIN(xc); P0_STEP(xc, gq);
            if (gq + 2 < 8) P0_LOADG(xc, gq + 2);
            P0_PIN(xn); P0_STEP(xn, gq + 1);
        }
#undef P0_LOADG
#undef P0_STEP
#undef P0_PIN
        const float dtb = dt_bias[r & 3], alg = a_log[r & 3];
        ss += __shfl_xor(ss, 16); ss += __shfl_xor(ss, 32);
        const float rs = rsqrtf(ss * (1.0f / 1024.f) + EPS);
        if (kg == 0) rsv[row] = rs;
#pragma unroll
        for (int reg = 0; reg < 4; ++reg) {
            const int rr = 4 * kg + reg; const float rsr = __shfl(rs, rr);
            const int orow = tile * 16 + rr;
            {
                const float v = acc0[reg] * rsr; const int c = r; float o;
                if (c < 4) o = sigmoidf_(v);
                else if (c < 8) { const float z = v + dtb; const float sp = z > 20.f ? z : log1pf(expf(z)); o = -expf(alg) * sp; }
                else o = sigmoidf_(v);
                small[(size_t)orow * 32 + c] = o;
            }
            { const float v = acc1[reg] * rsr; small[(size_t)orow * 32 + 16 + r] = sigmoidf_(v); }
        }
    }
}

__device__ __forceinline__ void p5_final(const Frame& F) {
    const float* fw = F.in[15]; float* out = F.out;
    f32x4 wv[4];
#pragma unroll
    for (int i = 0; i < 4; ++i) wv[i] = ((const f32x4*)fw)[F.lane + 64 * i];
    const int stride = gridDim.x * 8;
    int r = blockIdx.x * 8 + F.wave;
    f32x4 v[4], vn[4];
    if (r < T_TOK) {
#pragma unroll
        for (int i = 0; i < 4; ++i) v[i] = ((const f32x4*)(out + (size_t)r * DM))[F.lane + 64 * i];
    }
    for (; r < T_TOK; r += stride) {
        const int rn = r + stride;
        if (rn < T_TOK) {
#pragma unroll
            for (int i = 0; i < 4; ++i) vn[i] = ((const f32x4*)(out + (size_t)rn * DM))[F.lane + 64 * i];
        }
        asm volatile("" : "+v"(v[0]), "+v"(v[1]), "+v"(v[2]), "+v"(v[3]));
        float ss = 0.f;
#pragma unroll
        for (int i = 0; i < 4; ++i) ss += v[i][0] * v[i][0] + v[i][1] * v[i][1] + v[i][2] * v[i][2] + v[i][3] * v[i][3];
#pragma unroll
        for (int o = 32; o > 0; o >>= 1) ss += __shfl_xor(ss, o);
        const float rs = rsqrtf(ss * (1.0f / 1024.f) + EPS);
        f32x4* orow = (f32x4*)(out + (size_t)r * DM);
#pragma unroll
        for (int i = 0; i < 4; ++i) orow[F.lane + 64 * i] = v[i] * rs * wv[i];
#pragma unroll
        for (int i = 0; i < 4; ++i) v[i] = vn[i];
    }
}

#ifndef G_CONV
#define G_CONV 0
#endif
#ifndef G_MFMA
#define G_MFMA 0
#endif
#ifndef G_FRAG
#define G_FRAG 0
#endif
#ifndef G_OUT
#define G_OUT 0
#endif
__device__ __forceinline__ float dppf(float x, int ctrl_unused) { return x; }
#define DPP_F(x, CTRL, RM) __builtin_bit_cast(float, __builtin_amdgcn_update_dpp(0, __builtin_bit_cast(int, (x)), CTRL, RM, 0xf, true))
__device__ __forceinline__ float row16_sum(float x) {
    x += DPP_F(x, 0xB1, 0xf); x += DPP_F(x, 0x4E, 0xf); x += DPP_F(x, 0x141, 0xf); x += DPP_F(x, 0x140, 0xf); return x;
}
__device__ __forceinline__ float wave_prefix_sum(float v) {
    v += DPP_F(v, 0x111, 0xf); v += DPP_F(v, 0x112, 0xf); v += DPP_F(v, 0x114, 0xf); v += DPP_F(v, 0x118, 0xf);
    v += DPP_F(v, 0x142, 0xa); v += DPP_F(v, 0x143, 0xc); return v;
}
constexpr int GL_CW = 148224;
constexpr int REC_WNEG = 0, REC_QDEC = 16384, REC_ATTN = 32768, REC_KDT = 40960, REC_U = 57344, REC_LDS_BYTES = 57344;
__device__ __forceinline__ void gdn_prep_item(const Frame& F, int item) {
    int tid_ = F.tid; asm volatile("" : "+v"(tid_));
    const int tid = tid_;
    const int h = item & 3, n = (item >> 2) & 127, b = item >> 9;
    const int tok0 = b * SEQ + n * 64;
    LAS float* kf = (LAS float*)(F.lds); LAS float* vf = (LAS float*)(F.lds + 32768);
    LAS bf16* qb = (LAS bf16*)(F.lds + 65536); LAS bf16* kb = (LAS bf16*)(F.lds + 82944); LAS bf16* kbb = (LAS bf16*)(F.lds + 100352);
    LAS float* Lm = (LAS float*)(F.lds + 117760); LAS bf16* atb = (LAS bf16*)(F.lds + 134144); LAS float* gcs = (LAS float*)(F.lds + 143360);
    LAS float* tinv = (LAS float*)(F.lds + 144128);
    unsigned char* rec = F.ws + WS_GREC + (size_t)item * GREC_BYTES;
    const float* small = (const float*)(F.ws + WS_SMALL);
    {
        const int ln = tid & 63;
        const float beta = small[(size_t)(tok0 + ln) * 32 + h]; float c = small[(size_t)(tok0 + ln) * 32 + 4 + h];
        c = wave_prefix_sum(c);
        gcs[ln] = c; gcs[64 + ln] = beta; gcs[128 + ln] = expf(c);
        if (tid == 63) ((float*)(F.ws + WS_GLAST))[item] = expf(c);
    }
    for (int d1 = 0; d1 <= G_CONV; ++d1)
    {
        const bf16* gq = (const bf16*)(F.ws + WS_GQKV); const float* cw = F.in[3];
        const int grp = tid >> 4, li = tid & 15;
        u32x4 xin[3][5]; float pzv[5];
        {
            const int pos0 = n * 64 + grp * 2;
#pragma unroll
            for (int q5 = 0; q5 < 5; ++q5) {
                const int p = pos0 - 3 + q5; const int pc = p < 0 ? 0 : p; pzv[q5] = p < 0 ? 0.f : 1.f;
#pragma unroll
                for (int part = 0; part < 3; ++part) xin[part][q5] = *(const u32x4*)(gq + (size_t)(b * SEQ + pc) * 1536 + part * 512 + h * 128 + 8 * li);
            }
#pragma unroll
            for (int part = 0; part < 3; ++part) asm volatile("" : "+v"(xin[part][0]), "+v"(xin[part][1]), "+v"(xin[part][2]), "+v"(xin[part][3]), "+v"(xin[part][4]));
        }
#pragma unroll
        for (int rr = 0; rr < 2; ++rr) {
            const int c = grp * 2 + rr;
            const float betav = gcs[64 + c], egv = gcs[128 + c];
#pragma unroll
            for (int part = 0; part < 3; ++part) {
                float y[8];
#pragma unroll
                for (int e = 0; e < 8; ++e) y[e] = 0.f;
#pragma unroll
                for (int j = 0; j < 4; ++j) {
                    const float pz = pzv[rr + j];
                    {
                        const u32x4 xv = xin[part][rr + j];
                        const LAS float* cwl = (const LAS float*)(F.lds + GL_CW) + (j * 3 + part) * 128 + 8 * li;
                        const f32x4 w0 = *(const LAS f32x4*)cwl * pz, w1 = *(const LAS f32x4*)(cwl + 4) * pz;
                        y[0] += w0[0] * __uint_as_float(xv.x << 16); y[1] += w0[1] * __uint_as_float(xv.x & 0xffff0000u);
                        y[2] += w0[2] * __uint_as_float(xv.y << 16); y[3] += w0[3] * __uint_as_float(xv.y & 0xffff0000u);
                        y[4] += w1[0] * __uint_as_float(xv.z << 16); y[5] += w1[1] * __uint_as_float(xv.z & 0xffff0000u);
                        y[6] += w1[2] * __uint_as_float(xv.w << 16); y[7] += w1[3] * __uint_as_float(xv.w & 0xffff0000u);
                    }
                }
                float ss = 0.f;
#pragma unroll
                for (int e = 0; e < 8; ++e) { y[e] = siluf_(y[e]); ss += y[e] * y[e]; }
                if (part < 2) {
                    ss = row16_sum(ss);
                    const float sc = rsqrtf(ss + EPS) * (part == 0 ? 0.08838834764831845f : 1.0f);
#pragma unroll
                    for (int e = 0; e < 8; ++e) y[e] *= sc;
                }
                if (part == 0) {
                    u32x4 w; w.x = cvt_pk_bf16(y[0], y[1]); w.y = cvt_pk_bf16(y[2], y[3]); w.z = cvt_pk_bf16(y[4], y[5]); w.w = cvt_pk_bf16(y[6], y[7]);
                    *(LAS u32x4*)(qb + c * 136 + 8 * li) = w;
                    const int mt = c >> 4, m = c & 15, ks = li >> 2, a = (li & 3) >> 1, g0 = (2 * (li & 3)) & 3, g1 = (2 * (li & 3) + 1) & 3;
                    u32x2 d0, d1; d0.x = cvt_pk_bf16(y[0] * egv, y[1] * egv); d0.y = cvt_pk_bf16(y[2] * egv, y[3] * egv); d1.x = cvt_pk_bf16(y[4] * egv, y[5] * egv); d1.y = cvt_pk_bf16(y[6] * egv, y[7] * egv);
                    unsigned char* fb = rec + REC_QDEC + (size_t)(mt * 4 + ks) * 1024 + a * 8;
                    *(u32x2*)(fb + (g0 * 16 + m) * 16) = d0; *(u32x2*)(fb + (g1 * 16 + m) * 16) = d1;
                } else if (part == 1) {
                    *(LAS f32x4*)(kf + c * 128 + 8 * li) = (f32x4){y[0], y[1], y[2], y[3]}; *(LAS f32x4*)(kf + c * 128 + 8 * li + 4) = (f32x4){y[4], y[5], y[6], y[7]};
                    u32x4 w; w.x = cvt_pk_bf16(y[0], y[1]); w.y = cvt_pk_bf16(y[2], y[3]); w.z = cvt_pk_bf16(y[4], y[5]); w.w = cvt_pk_bf16(y[6], y[7]);
                    *(LAS u32x4*)(kb + c * 136 + 8 * li) = w;
                    w.x = cvt_pk_bf16(y[0] * betav, y[1] * betav); w.y = cvt_pk_bf16(y[2] * betav, y[3] * betav); w.z = cvt_pk_bf16(y[4] * betav, y[5] * betav); w.w = cvt_pk_bf16(y[6] * betav, y[7] * betav);
                    *(LAS u32x4*)(kbb + c * 136 + 8 * li) = w;
                } else {
                    *(LAS f32x4*)(vf + c * 128 + 8 * li) = (f32x4){y[0], y[1], y[2], y[3]}; *(LAS f32x4*)(vf + c * 128 + 8 * li + 4) = (f32x4){y[4], y[5], y[6], y[7]};
                }
            }
        }
    }
    __syncthreads();
    for (int d2 = 0; d2 <= G_MFMA; ++d2)
    {
        const int l = (tid & 63), m = l & 15, kg = l >> 4;
#pragma unroll
        for (int i = 0; i < 4; ++i) {
            const int tt = F.wave * 4 + i, which = tt >> 4, mi = (tt >> 2) & 3, ni = tt & 3;
            f32x4 acc = {0.f, 0.f, 0.f, 0.f};
            if (mi >= ni) {
                const LAS bf16* As = which ? qb : kbb;
#pragma unroll
                for (int ks = 0; ks < 4; ++ks) {
                    const bf16x8 a = *(const LAS bf16x8*)(As + (16 * mi + m) * 136 + 32 * ks + 8 * kg);
                    const bf16x8 bb = *(const LAS bf16x8*)(kb + (16 * ni + m) * 136 + 32 * ks + 8 * kg);
                    acc = mfma16(a, bb, acc);
                }
            }
            {
                const int jcol = 16 * ni + m; const float gj = gcs[jcol];
                const f32x4 gi = *(const LAS f32x4*)(gcs + 16 * mi + 4 * kg);
#pragma unroll
                for (int r = 0; r < 4; ++r) {
                    const int irow = 16 * mi + 4 * kg + r;
                    const float d = gi[r] - gj; const float dec = __expf(d < 0.f ? d : 0.f);
                    const float v = acc[r] * dec;
                    if (which == 0) Lm[jcol * 64 + irow] = (irow > jcol) ? v : 0.f;
                    else atb[irow * 72 + jcol] = f2bf((irow >= jcol) ? v : 0.f);
                }
            }
        }
    }
    __syncthreads();
    for (int d3 = 0; d3 <= G_FRAG; ++d3) {
    if (tid < 64) {
        const int ib = tid >> 4, c = tid & 15;
        float x[16];
#pragma unroll
        for (int i = 0; i < 16; ++i) x[i] = (i == c) ? 1.0f : 0.0f;
#pragma unroll
        for (int j = 0; j < 15; ++j) {
            const LAS f32x4* lp = (const LAS f32x4*)(Lm + (16 * ib + j) * 64 + 16 * ib);
#pragma unroll
            for (int q4 = 0; q4 < 4; ++q4) {
                if (4 * q4 + 3 > j) {
                    const f32x4 lv = lp[q4];
#pragma unroll
                    for (int e = 0; e < 4; ++e) if (4 * q4 + e > j) x[4 * q4 + e] -= lv[e] * x[j];
                }
            }
            asm volatile("" ::: "memory");
        }
#pragma unroll
        for (int i = 0; i < 16; ++i) tinv[(ib * 16 + c) * 16 + i] = x[i];
    }
    {
        const float gl = gcs[63];
#pragma unroll
        for (int q = 0; q < 2; ++q) {
            const int idx = tid + 512 * q, l = idx & 63, ks = (idx >> 6) & 1, mt = idx >> 7, m = l & 15, g = l >> 4;
            float e[8];
#pragma unroll
            for (int j = 0; j < 8; ++j) { const int cr = 32 * ks + kperm(g, j); e[j] = kf[cr * 128 + 16 * mt + m] * expf(gl - gcs[cr]); }
            u32x4 w; w.x = cvt_pk_bf16(e[0], e[1]); w.y = cvt_pk_bf16(e[2], e[3]); w.z = cvt_pk_bf16(e[4], e[5]); w.w = cvt_pk_bf16(e[6], e[7]);
            *(u32x4*)(rec + REC_KDT + (size_t)idx * 16) = w;
        }
        {
            const int idx = tid, l = idx & 63, ks = (idx >> 6) & 1, mt = idx >> 7, m = l & 15, g = l >> 4;
            const u32x2 a0 = *(const LAS u32x2*)(atb + (16 * mt + m) * 72 + 32 * ks + 4 * g), a1 = *(const LAS u32x2*)(atb + (16 * mt + m) * 72 + 32 * ks + 16 + 4 * g);
            *(u32x4*)(rec + REC_ATTN + (size_t)idx * 16) = (u32x4){a0.x, a0.y, a1.x, a1.y};
        }
    }
    }
    __syncthreads();
    {
        const int l = (tid & 63), li = l & 15, lk = l >> 4, w = F.wave; const bool isw = w >= 4;
        LAS float* base = isw ? (kf + 32 * (w - 4)) : (vf + 32 * w);
#pragma unroll
        for (int ib = 0; ib < 4; ++ib) {
            f32x4 acc[2];
#pragma unroll
            for (int nt = 0; nt < 2; ++nt)
#pragma unroll
                for (int r = 0; r < 4; ++r) { const int i = 16 * ib + 4 * lk + r; acc[nt][r] = base[i * 128 + 16 * nt + li] * gcs[64 + i] * (isw ? gcs[128 + i] : 1.0f); }
            if (ib > 0) {
                float av[12], b0[12], b1[12];
#pragma unroll
                for (int kk = 0; kk < 4 * ib; ++kk) { av[kk] = -Lm[(4 * kk + lk) * 64 + 16 * ib + li]; b0[kk] = base[(4 * kk + lk) * 128 + li]; b1[kk] = base[(4 * kk + lk) * 128 + 16 + li]; }
#pragma unroll
                for (int kk = 0; kk < 4 * ib; ++kk) asm volatile("" : "+v"(av[kk]), "+v"(b0[kk]), "+v"(b1[kk]));
#pragma unroll
                for (int kk = 0; kk < 4 * ib; ++kk) {
                    acc[0] = __builtin_amdgcn_mfma_f32_16x16x4f32(av[kk], b0[kk], acc[0], 0, 0, 0);
                    acc[1] = __builtin_amdgcn_mfma_f32_16x16x4f32(av[kk], b1[kk], acc[1], 0, 0, 0);
                }
            }
#pragma unroll
            for (int nt = 0; nt < 2; ++nt)
#pragma unroll
                for (int r = 0; r < 4; ++r) base[(16 * ib + 4 * lk + r) * 128 + 16 * nt + li] = acc[nt][r];
            f32x4 y[2] = {(f32x4){0.f, 0.f, 0.f, 0.f}, (f32x4){0.f, 0.f, 0.f, 0.f}};
            {
                float av[4], b0[4], b1[4];
#pragma unroll
                for (int kk = 0; kk < 4; ++kk) { av[kk] = tinv[(ib * 16 + 4 * kk + lk) * 16 + li]; b0[kk] = base[(16 * ib + 4 * kk + lk) * 128 + li]; b1[kk] = base[(16 * ib + 4 * kk + lk) * 128 + 16 + li]; }
#pragma unroll
                for (int kk = 0; kk < 4; ++kk) asm volatile("" : "+v"(av[kk]), "+v"(b0[kk]), "+v"(b1[kk]));
#pragma unroll
                for (int kk = 0; kk < 4; ++kk) {
                    y[0] = __builtin_amdgcn_mfma_f32_16x16x4f32(av[kk], b0[kk], y[0], 0, 0, 0);
                    y[1] = __builtin_amdgcn_mfma_f32_16x16x4f32(av[kk], b1[kk], y[1], 0, 0, 0);
                }
            }
#pragma unroll
            for (int nt = 0; nt < 2; ++nt)
#pragma unroll
                for (int r = 0; r < 4; ++r) base[(16 * ib + 4 * lk + r) * 128 + 16 * nt + li] = y[nt][r];
        }
    }
    __syncthreads();
    for (int d4 = 0; d4 <= G_OUT; ++d4)
    {
#pragma unroll
        for (int q = 0; q < 4; ++q) {
            const int idx = tid + 512 * q, l = idx & 63, mt = (idx >> 6) & 3, sl = idx >> 8, g4 = l >> 4, nn = l & 15;
            const LAS float* up = vf + (16 * mt + 4 * g4) * 128 + 16 * sl + nn;
            u32x2 d; d.x = cvt_pk_bf16(up[0], up[128]); d.y = cvt_pk_bf16(up[256], up[384]);
            *(u32x2*)(rec + REC_U + (size_t)idx * 8) = d;
        }
#pragma unroll
        for (int q = 0; q < 2; ++q) {
            const int idx = tid + 512 * q, l = idx & 63, ks = (idx >> 6) & 3, mt = idx >> 8, m = l & 15, g = l >> 4;
            const f32x4 a0 = *(const LAS f32x4*)(kf + (16 * mt + m) * 128 + 32 * ks + 4 * g), a1 = *(const LAS f32x4*)(kf + (16 * mt + m) * 128 + 32 * ks + 16 + 4 * g);
            u32x4 w; w.x = cvt_pk_bf16(-a0[0], -a0[1]); w.y = cvt_pk_bf16(-a0[2], -a0[3]); w.z = cvt_pk_bf16(-a1[0], -a1[1]); w.w = cvt_pk_bf16(-a1[2], -a1[3]);
            *(u32x4*)(rec + REC_WNEG + (size_t)idx * 16) = w;
        }
    }
    __syncthreads();
}

__device__ __forceinline__ bf16x8 acc2frag(const f32x4& lo, const f32x4& hi) {
    u32x4 w; w.x = cvt_pk_bf16(lo[0], lo[1]); w.y = cvt_pk_bf16(lo[2], lo[3]); w.z = cvt_pk_bf16(hi[0], hi[1]); w.w = cvt_pk_bf16(hi[2], hi[3]);
    return __builtin_bit_cast(bf16x8, w);
}
__device__ __forceinline__ void gdn_scan(const Frame& F, int bh) {
    const int tid = F.tid, lane = F.lane, s = F.wave;
    const int b = bh >> 2, h = bh & 3;
    LAS unsigned char* buf0 = F.lds; LAS float* ox = (LAS float*)(F.lds + 2 * REC_LDS_BYTES);
    const float* glast = (const float*)(F.ws + WS_GLAST);
    const bf16* gz = (const bf16*)(F.ws + WS_GZ); const float* gnw = F.in[6]; bf16* mix = (bf16*)(F.ws + WS_MIX);
    f32x4 S[8];
#pragma unroll
    for (int t = 0; t < 8; ++t) S[t] = (f32x4){0.f, 0.f, 0.f, 0.f};
    const unsigned char* const recbase = F.ws + WS_GREC + (size_t)(b * 512 + h) * GREC_BYTES;
#define recp(n) (recbase + (size_t)(n) * 4 * GREC_BYTES)
#define GS_STAGE(n, bufsel) do { const unsigned char* _r = recp(n); _Pragma("unroll") for (int _i = 0; _i < 7; ++_i) \
        __builtin_amdgcn_global_load_lds((const unsigned*)(_r + (size_t)(_i * 512 + tid) * 16), (LAS unsigned*)(buf0 + (bufsel) * REC_LDS_BYTES + (_i * 8 + s) * 1024), 16, 0, 0); } while (0)
    GS_STAGE(0, 0);
    u32x2 un[4];
#pragma unroll
    for (int mt = 0; mt < 4; ++mt) un[mt] = *(const u32x2*)(recp(0) + REC_U + (size_t)((s * 4 + mt) * 64 + lane) * 8);
    float egn = glast[(b * 128 + 0) * 4 + h];
    for (int n = 0; n < 128; ++n) {
        const int cur = n & 1;
        asm volatile("s_waitcnt vmcnt(0)" ::: "memory");
        __syncthreads();
        u32x2 uc[4];
#pragma unroll
        for (int mt = 0; mt < 4; ++mt) uc[mt] = un[mt];
        const float egl = egn;
        if (n + 1 < 128) {
            GS_STAGE(n + 1, cur ^ 1);
#pragma unroll
            for (int mt = 0; mt < 4; ++mt) un[mt] = *(const u32x2*)(recp(n + 1) + REC_U + (size_t)((s * 4 + mt) * 64 + lane) * 8);
            egn = glast[(b * 128 + n + 1) * 4 + h];
        }
        const LAS unsigned char* bp = buf0 + cur * REC_LDS_BYTES + lane * 16;
        const bf16* gzr = gz + (size_t)(b * SEQ + n * 64 + (tid >> 3)) * 512 + h * 128 + 16 * (tid & 7);
        const u32x4 gzp0 = *(const u32x4*)gzr, gzp1 = *(const u32x4*)(gzr + 8);
        bf16x8 Sb[4];
#pragma unroll
        for (int ks = 0; ks < 4; ++ks) Sb[ks] = acc2frag(S[2 * ks], S[2 * ks + 1]);
        f32x4 vn[4], o[4];
#pragma unroll
        for (int mt = 0; mt < 4; ++mt) {
            vn[mt] = (f32x4){__uint_as_float(uc[mt].x << 16), __uint_as_float(uc[mt].x & 0xffff0000u), __uint_as_float(uc[mt].y << 16), __uint_as_float(uc[mt].y & 0xffff0000u)};
#pragma unroll
            for (int ks = 0; ks < 4; ++ks) vn[mt] = mfma16(*(const LAS bf16x8*)(bp + REC_WNEG + (mt * 4 + ks) * 1024), Sb[ks], vn[mt]);
        }
        bf16x8 Vb[2];
#pragma unroll
        for (int ks = 0; ks < 2; ++ks) Vb[ks] = acc2frag(vn[2 * ks], vn[2 * ks + 1]);
#pragma unroll
        for (int mt = 0; mt < 4; ++mt) {
            o[mt] = (f32x4){0.f, 0.f, 0.f, 0.f};
#pragma unroll
            for (int ks = 0; ks < 4; ++ks) o[mt] = mfma16(*(const LAS bf16x8*)(bp + REC_QDEC + (mt * 4 + ks) * 1024), Sb[ks], o[mt]);
#pragma unroll
            for (int ks = 0; ks < 2; ++ks) o[mt] = mfma16(*(const LAS bf16x8*)(bp + REC_ATTN + (mt * 2 + ks) * 1024), Vb[ks], o[mt]);
        }
#pragma unroll
        for (int t = 0; t < 8; ++t) {
            S[t] = S[t] * egl;
#pragma unroll
            for (int ks = 0; ks < 2; ++ks) S[t] = mfma16(*(const LAS bf16x8*)(bp + REC_KDT + (t * 2 + ks) * 1024), Vb[ks], S[t]);
        }
        {
            const int g4 = lane >> 4, nn = lane & 15;
#pragma unroll
            for (int mt = 0; mt < 4; ++mt)
#pragma unroll
                for (int r = 0; r < 4; ++r) ox[(16 * mt + 4 * g4 + r) * 132 + 16 * s + nn] = o[mt][r];
        }
        __syncthreads();
        {
            const int row = tid >> 3, part = tid & 7; const int tok = b * SEQ + n * 64 + row;
            float v[16]; float ss = 0.f;
#pragma unroll
            for (int q = 0; q < 4; ++q) { const f32x4 t4 = *(const LAS f32x4*)(ox + row * 132 + 16 * part + 4 * q); v[4 * q] = t4[0]; v[4 * q + 1] = t4[1]; v[4 * q + 2] = t4[2]; v[4 * q + 3] = t4[3]; }
#pragma unroll
            for (int e = 0; e < 16; ++e) ss += v[e] * v[e];
            ss += __shfl_xor(ss, 1); ss += __shfl_xor(ss, 2); ss += __shfl_xor(ss, 4);
            const float rs = rsqrtf(ss * (1.0f / 128.f) + EPS);
            const u32x4 z0 = gzp0, z1 = gzp1;
            const unsigned zz[8] = {z0.x, z0.y, z0.z, z0.w, z1.x, z1.y, z1.z, z1.w};
            unsigned ow[8];
#pragma unroll
            for (int e = 0; e < 8; ++e) {
                const float w0 = gnw[16 * part + 2 * e], w1 = gnw[16 * part + 2 * e + 1];
                ow[e] = cvt_pk_bf16(v[2 * e] * rs * w0 * __uint_as_float(zz[e] << 16), v[2 * e + 1] * rs * w1 * __uint_as_float(zz[e] & 0xffff0000u));
            }
            bf16* mp = mix + (size_t)tok * DM + h * 128 + 16 * part;
            *(u32x4*)mp = (u32x4){ow[0], ow[1], ow[2], ow[3]}; *(u32x4*)(mp + 8) = (u32x4){ow[4], ow[5], ow[6], ow[7]};
        }
    }
#undef GS_STAGE
#undef recp
    asm volatile("s_waitcnt vmcnt(0)" ::: "memory");
    __syncthreads();
}
__device__ __forceinline__ int pos32(int key) { return (key & ~31) | (8 * ((key >> 2) & 3) + 4 * ((key >> 4) & 1) + (key & 3)); }
__device__ __forceinline__ void compress_block(const Frame& F, int task) {
    const int which = task >> 8, bhk = (task >> 5) & 7, rt = task & 31, b = bhk >> 1, hk = bhk & 1;
    int l_ = F.lane; asm volatile("" : "+v"(l_));
    const int l = l_, n = l & 15, kg = l >> 4, w = F.wave;
    const bf16* nkv = (const bf16*)(F.ws + WS_NKV);
    const bf16* w1f = (const bf16*)(F.ws + (which ? WS_W1FV : WS_W1FK)); const bf16* w2f = (const bf16*)(F.ws + (which ? WS_W2FV : WS_W2FK));
    const float* cpe = (const float*)(F.ws + WS_CPE) + which * 128;
    const int nc = 16 * rt + n;
    f32x4 acc[8];
#pragma unroll
    for (int t = 0; t < 8; ++t) acc[t] = (f32x4){0.f, 0.f, 0.f, 0.f};
    {
        bf16x8 ac[8], an[8], bc, bn;
#define CMP_LOAD(A_, B_, K8) do { const int _ks = 8 * w + (K8); int _tok = 16 * nc + (_ks >> 1); _tok = _tok < SEQ ? _tok : SEQ - 1; \
            B_ = *(const bf16x8*)(nkv + (size_t)(b * SEQ + _tok) * 768 + which * 128 + hk * 64 + (_ks & 1) * 32 + 8 * kg); \
            _Pragma("unroll") for (int _mt = 0; _mt < 8; ++_mt) A_[_mt] = *(const bf16x8*)(w1f + ((size_t)(_ks * 8 + _mt) * 64 + l) * 8); } while (0)
#define CMP_PIN(A_, B_) asm volatile("" : "+v"(A_[0]), "+v"(A_[1]), "+v"(A_[2]), "+v"(A_[3]), "+v"(A_[4]), "+v"(A_[5]), "+v"(A_[6]), "+v"(A_[7]), "+v"(B_))
        CMP_LOAD(ac, bc, 0);
#pragma unroll
        for (int k8 = 0; k8 < 8; k8 += 2) {
            CMP_LOAD(an, bn, k8 + 1);
            CMP_PIN(ac, bc);
#pragma unroll
            for (int mt = 0; mt < 8; ++mt) acc[mt] = mfma16(ac[mt], bc, acc[mt]);
            if (k8 + 2 < 8) CMP_LOAD(ac, bc, k8 + 2);
            CMP_PIN(an, bn);
#pragma unroll
            for (int mt = 0; mt < 8; ++mt) acc[mt] = mfma16(an[mt], bn, acc[mt]);
        }
#undef CMP_LOAD
#undef CMP_PIN
    }
    LAS f32x4* part = (LAS f32x4*)F.lds;
    LAS unsigned char* hfrag = F.lds + 65536;
#pragma unroll
    for (int mt = 0; mt < 8; ++mt) part[(w * 8 + mt) * 64 + l] = acc[mt];
    __syncthreads();
    {
        f32x4 h = part[w * 64 + l];
#pragma unroll
        for (int p = 1; p < 8; ++p) h = h + part[(p * 8 + w) * 64 + l];
#pragma unroll
        for (int r = 0; r < 4; ++r) h[r] = siluf_(h[r] + cpe[16 * w + 4 * kg + r]);
        u32x2 d; d.x = cvt_pk_bf16(h[0], h[1]); d.y = cvt_pk_bf16(h[2], h[3]);
        *(LAS u32x2*)(hfrag + ((w >> 1) * 64 + l) * 16 + (w & 1) * 8) = d;
    }
    __syncthreads();
    if (w < 4) {
        f32x4 o = {0.f, 0.f, 0.f, 0.f};
#pragma unroll
        for (int ks = 0; ks < 4; ++ks) o = mfma16(*(const bf16x8*)(w2f + ((size_t)(w * 4 + ks) * 64 + l) * 8), *(const LAS bf16x8*)(hfrag + (ks * 64 + l) * 16), o);
        const bool valid = nc < 511;
        if (which == 0) {
            bf16* kc = (bf16*)(F.ws + WS_KCMP) + ((size_t)bhk * 512 + nc) * 64;
            u32x2 d; d.x = valid ? cvt_pk_bf16(o[0], o[1]) : 0u; d.y = valid ? cvt_pk_bf16(o[2], o[3]) : 0u; *(u32x2*)(kc + 16 * w + 4 * kg) = d;
        } else {
            bf16* vt = (bf16*)(F.ws + WS_VCMPT) + (size_t)bhk * 64 * 512 + pos32(nc);
#pragma unroll
            for (int r = 0; r < 4; ++r) vt[(size_t)(16 * w + 4 * kg + r) * 512] = valid ? f2bf(o[r]) : (unsigned short)0;
        }
    }
    __syncthreads();
}
__device__ __forceinline__ void vtranspose_task(const Frame& F, int task) {
    const int which = task >> 8, bhk = (task >> 5) & 7, tg = task & 31, b = bhk >> 1, hk = bhk & 1;
    const bf16* nkv = (const bf16*)(F.ws + WS_NKV); bf16* dst = (bf16*)(F.ws + (which ? WS_VWT : WS_VST)) + (size_t)bhk * 64 * SEQ;
    LAS bf16* tile = (LAS bf16*)F.lds;
    const int t0 = tg * 256;
#pragma unroll
    for (int sub = 0; sub < 4; ++sub) {
        const int tk = sub * 64 + (F.tid >> 3), dc = F.tid & 7;
        const u32x4 v = *(const u32x4*)(nkv + (size_t)(b * SEQ + t0 + tk) * 768 + 384 + which * 256 + hk * 64 + 8 * dc);
        const unsigned vv[4] = {v.x, v.y, v.z, v.w};
#pragma unroll
        for (int e = 0; e < 4; ++e) { tile[(8 * dc + 2 * e) * 264 + pos32(tk)] = (unsigned short)(vv[e] & 0xffffu); tile[(8 * dc + 2 * e + 1) * 264 + pos32(tk)] = (unsigned short)(vv[e] >> 16); }
    }
    __syncthreads();
#pragma unroll
    for (int sub = 0; sub < 4; ++sub) {
        const int i = sub * 512 + F.tid, d = i >> 5, tc = i & 31;
        *(u32x4*)(dst + (size_t)d * SEQ + t0 + 8 * tc) = *(const LAS u32x4*)(tile + d * 264 + 8 * tc);
    }
    __syncthreads();
}
constexpr int NL_BT = 0, NL_IMP = 18496, NL_MASK = 51776, NL_SMASK = 52800, NL_KV = 53248, NL_NXT = 86016, NL_TOT = 86528;
#ifndef PRB_X1
#define PRB_X1 0
#endif
#ifndef PRB_C2
#define PRB_C2 0
#endif
#ifndef PRB_SETUP
#define PRB_SETUP 0
#endif
#ifndef PRB_SEL
#define PRB_SEL 0
#endif
#ifndef PRB_ALLACT
#define PRB_ALLACT 0
#endif
#ifndef PRB_S
#define PRB_S 0
#endif
#ifndef PRB_W
#define PRB_W 0
#endif
#ifndef PRB_C
#define PRB_C 0
#endif
constexpr int TM_C1 = 0, TM_C2 = 1, TM_SD = 2, TM_SS = 3, TM_W = 4;
#ifndef PRB_DMA
#define PRB_DMA 0
#endif
__device__ __forceinline__ void stage_dma(LAS unsigned char* buf, const bf16* Kb, int kstride, const bf16* VT, int vlen, int key0, int wave, int lane) {
    const int row = wave * 8 + (lane >> 3), ch = (lane & 7) ^ ((lane >> 3) & 7);
#if PRB_DMA
    __builtin_amdgcn_global_load_lds((const unsigned*)(Kb + (size_t)(key0 + row) * kstride + 8 * ch), (LAS unsigned*)(buf + wave * 1024), 16, 0, 0);
    __builtin_amdgcn_global_load_lds((const unsigned*)(VT + (size_t)row * vlen + key0 + 8 * ch), (LAS unsigned*)(buf + 8192 + wave * 1024), 16, 0, 0);
#endif
    __builtin_amdgcn_global_load_lds((const unsigned*)(Kb + (size_t)(key0 + row) * kstride + 8 * ch), (LAS unsigned*)(buf + wave * 1024), 16, 0, 0);
    __builtin_amdgcn_global_load_lds((const unsigned*)(VT + (size_t)row * vlen + key0 + 8 * ch), (LAS unsigned*)(buf + 8192 + wave * 1024), 16, 0, 0);
}
__device__ __forceinline__ void wait_tiles(int newer) {
#if PRB_DMA
    if (newer >= 2) asm volatile("s_waitcnt vmcnt(8)" ::: "memory"); else if (newer == 1) asm volatile("s_waitcnt vmcnt(4)" ::: "memory"); else asm volatile("s_waitcnt vmcnt(0)" ::: "memory");
#else
    if (newer >= 2) asm volatile("s_waitcnt vmcnt(4)" ::: "memory"); else if (newer == 1) asm volatile("s_waitcnt vmcnt(2)" ::: "memory"); else asm volatile("s_waitcnt vmcnt(0)" ::: "memory");
#endif
}
__device__ __forceinline__ bf16x8 tile_frag(const LAS unsigned char* buf, int row, int chunk) { return *(const LAS bf16x8*)(buf + row * 128 + ((chunk ^ (row & 7)) << 4)); }

struct SlotState { f32x4 O[4]; float m, l; };
__device__ __forceinline__ float kg_sum(float x) {
    const unsigned u = __builtin_bit_cast(unsigned, x); const auto r = __builtin_amdgcn_permlane16_swap(u, u, false, false);
    const float y = __builtin_bit_cast(float, (unsigned)r[0]) + __builtin_bit_cast(float, (unsigned)r[1]);
    const unsigned v = __builtin_bit_cast(unsigned, y); const auto q = __builtin_amdgcn_permlane32_swap(v, v, false, false);
    return __builtin_bit_cast(float, (unsigned)q[0]) + __builtin_bit_cast(float, (unsigned)q[1]);
}
__device__ __forceinline__ float kg_max(float x) {
    const unsigned u = __builtin_bit_cast(unsigned, x); const auto r = __builtin_amdgcn_permlane16_swap(u, u, false, false);
    const float y = fmaxf(__builtin_bit_cast(float, (unsigned)r[0]), __builtin_bit_cast(float, (unsigned)r[1]));
    const unsigned v = __builtin_bit_cast(unsigned, y); const auto q = __builtin_amdgcn_permlane32_swap(v, v, false, false);
    return fmaxf(__builtin_bit_cast(float, (unsigned)q[0]), __builtin_bit_cast(float, (unsigned)q[1]));
}

__device__ __forceinline__ void lds_add_f32(LAS float* p, float v) { asm volatile("ds_add_f32 %0, %1" :: "v"((unsigned)(size_t)p), "v"(v) : "memory"); }
__device__ __forceinline__ float quad_sum(float x) {
    x += __builtin_bit_cast(float, __builtin_amdgcn_update_dpp(0, __builtin_bit_cast(int, x), 0xB1, 0xf, 0xf, false));
    x += __builtin_bit_cast(float, __builtin_amdgcn_update_dpp(0, __builtin_bit_cast(int, x), 0x4E, 0xf, 0xf, false));
    return x;
}
constexpr int RT_LEN = 1156, RT_OFF = 1088;
template <int MODE, bool NEARB>
__device__ __forceinline__ void slot_tile(const LAS unsigned char* tb0, const LAS unsigned char* tb1, const bf16x8 (&q)[2], int dbase, const LAS float* rt, SlotState& A,
                                          float linv, float mrow, float bfar, LAS float* imp_row, int key0, int lane, float* carry = nullptr) {
    const int kg = lane >> 4;
    __builtin_amdgcn_sched_barrier(0);
    bf16x8 fr[4][2];
#pragma unroll
    for (int mt = 0; mt < 4; ++mt) { fr[mt][0] = *(const LAS bf16x8*)(tb0 + mt * 2048); fr[mt][1] = *(const LAS bf16x8*)(tb1 + mt * 2048); }
    asm volatile("" : "+v"(fr[0][0]), "+v"(fr[0][1]), "+v"(fr[1][0]), "+v"(fr[1][1]), "+v"(fr[2][0]), "+v"(fr[2][1]), "+v"(fr[3][0]), "+v"(fr[3][1]));
    f32x4 s[4];
    const float ini = (MODE == TM_SS) ? -mrow : 0.f;
#pragma unroll
    for (int mt = 0; mt < 4; ++mt) { s[mt] = mfma16(fr[mt][0], q[0], (f32x4){ini, ini, ini, ini}); s[mt] = mfma16(fr[mt][1], q[1], s[mt]); }
    if (MODE != TM_C1) {
        __builtin_amdgcn_sched_barrier(0);
#pragma unroll
        for (int t = 0; t < 4; ++t) { fr[t][0] = *(const LAS bf16x8*)(tb0 + 8192 + t * 2048); fr[t][1] = *(const LAS bf16x8*)(tb1 + 8192 + t * 2048); }
        __builtin_amdgcn_sched_barrier(0);
    }
    constexpr bool CMP = (MODE == TM_C1 || MODE == TM_C2);
    if (MODE == TM_SS) {
        if (NEARB) {
            const LAS float* rp = rt + (RT_OFF - dbase);
            f32x4 bv[4];
#pragma unroll
            for (int mt = 0; mt < 4; ++mt)
#pragma unroll
                for (int r = 0; r < 4; ++r) bv[mt][r] = rp[16 * mt + r];
            asm volatile("" : "+v"(bv[0]), "+v"(bv[1]), "+v"(bv[2]), "+v"(bv[3]));
#pragma unroll
            for (int mt = 0; mt < 4; ++mt) s[mt] = s[mt] + bv[mt];
        }
        float ps = 0.f;
#pragma unroll
        for (int mt = 0; mt < 4; ++mt)
#pragma unroll
            for (int r = 0; r < 4; ++r) { const float p = __builtin_amdgcn_exp2f(s[mt][r]); s[mt][r] = p; ps += p; }
        ps = kg_sum(ps);
        A.l += ps;
    } else {
        float tmax = -1e30f;
        if (NEARB) {
            const LAS float* rp = rt + (RT_OFF - dbase);
            f32x4 bv[4];
#pragma unroll
            for (int mt = 0; mt < 4; ++mt)
#pragma unroll
                for (int r = 0; r < 4; ++r) {
                    const int c = 16 * mt + r;
                    if (CMP) { const int dist = dbase - 16 * c; const int di = dist < 0 ? 0 : (dist > RT_OFF ? RT_OFF : dist); bv[mt][r] = rt[RT_OFF - di]; }
                    else bv[mt][r] = rp[c];
                }
            asm volatile("" : "+v"(bv[0]), "+v"(bv[1]), "+v"(bv[2]), "+v"(bv[3]));
#pragma unroll
            for (int mt = 0; mt < 4; ++mt)
#pragma unroll
                for (int r = 0; r < 4; ++r) {
                    const int c = 16 * mt + r;
                    const int dist = CMP ? dbase - 16 * c : dbase - c;
                    const bool ok = (MODE == TM_W) ? (dist >= 0 && dist < 512) : (dist >= 0);
                    s[mt][r] = ok ? s[mt][r] + bv[mt][r] : -1e30f;
                    tmax = fmaxf(tmax, s[mt][r]);
                }
        } else {
#pragma unroll
            for (int mt = 0; mt < 4; ++mt)
#pragma unroll
                for (int r = 0; r < 4; ++r) { s[mt][r] += bfar; tmax = fmaxf(tmax, s[mt][r]); }
        }
        if (MODE == TM_C2) {
#pragma unroll
            for (int mt = 0; mt < 4; ++mt)
#pragma unroll
                for (int r = 0; r < 4; ++r) s[mt][r] = __builtin_amdgcn_exp2f(s[mt][r] - A.m) * linv;
            const int g = lane & 3;
            float gsum[4], lv[4];
#pragma unroll
            for (int mt = 0; mt < 4; ++mt) { gsum[mt] = quad_sum(s[mt][0] + s[mt][1] + s[mt][2] + s[mt][3]); lv[mt] = quad_sum(s[mt][3]); }
#pragma unroll
            for (int mt = 0; mt < 4; ++mt) {
                const float up = __shfl_up(lv[mt], 16);
                const float wrap = mt > 0 ? __shfl(lv[mt - 1], (lane & 15) + 48) : *carry;
                const float prev = kg > 0 ? up : wrap;
                const int j = (key0 >> 2) + 4 * mt + kg;
                if (g == 0) asm volatile("ds_write_b32 %0, %1" :: "v"((unsigned)(size_t)(imp_row + j)), "v"(gsum[mt] + prev) : "memory");
            }
            *carry = __shfl(lv[3], (lane & 15) + 48);
        } else {
            tmax = kg_max(tmax);
            const float mnew = fmaxf(A.m, tmax), msafe = fmaxf(mnew, -1e29f), alpha = __builtin_amdgcn_exp2f(A.m - msafe);
            float ps = 0.f;
#pragma unroll
            for (int mt = 0; mt < 4; ++mt)
#pragma unroll
                for (int r = 0; r < 4; ++r) { const float p = __builtin_amdgcn_exp2f(s[mt][r] - msafe); s[mt][r] = p; ps += p; }
            ps = kg_sum(ps);
            A.l = A.l * alpha + ps; A.m = mnew;
            if (MODE != TM_C1) {
#pragma unroll
                for (int t = 0; t < 4; ++t) A.O[t] = A.O[t] * alpha;
            }
        }
    }
    if (MODE != TM_C1) {
        bf16x8 pf[2];
#pragma unroll
        for (int k2 = 0; k2 < 2; ++k2) {
            u32x4 w; w.x = cvt_pk_bf16(s[2 * k2][0], s[2 * k2][1]); w.y = cvt_pk_bf16(s[2 * k2][2], s[2 * k2][3]); w.z = cvt_pk_bf16(s[2 * k2 + 1][0], s[2 * k2 + 1][1]); w.w = cvt_pk_bf16(s[2 * k2 + 1][2], s[2 * k2 + 1][3]);
            pf[k2] = __builtin_bit_cast(bf16x8, w);
        }
#pragma unroll
        for (int t = 0; t < 4; ++t) { A.O[t] = mfma16(fr[t][0], pf[0], A.O[t]); A.O[t] = mfma16(fr[t][1], pf[1], A.O[t]); }
    }
}

#define SGB(mask, n) __builtin_amdgcn_sched_group_barrier(mask, n, 0)
template <bool NEARB>
__device__ __forceinline__ void slot_pair_ss(const LAS unsigned char* tb0, const LAS unsigned char* tb1, const bf16x8 (&q0)[2], const bf16x8 (&q1)[2],
                                             int dbase0, int dbase1, const LAS float* rt, SlotState& A0, SlotState& A1, float mrow0, float mrow1) {
    f32x4 s0[4], s1[4];
    __builtin_amdgcn_sched_barrier(0);
    bf16x8 kf[4][2], vf[4][2];
#pragma unroll
    for (int mt = 0; mt < 4; ++mt) { kf[mt][0] = *(const LAS bf16x8*)(tb0 + mt * 2048); kf[mt][1] = *(const LAS bf16x8*)(tb1 + mt * 2048); }
    asm volatile("" : "+v"(kf[0][0]), "+v"(kf[0][1]), "+v"(kf[1][0]), "+v"(kf[1][1]), "+v"(kf[2][0]), "+v"(kf[2][1]), "+v"(kf[3][0]), "+v"(kf[3][1]));
#pragma unroll
    for (int mt = 0; mt < 4; ++mt) { s0[mt] = mfma16(kf[mt][0], q0[0], (f32x4){-mrow0, -mrow0, -mrow0, -mrow0}); s0[mt] = mfma16(kf[mt][1], q0[1], s0[mt]); }
    __builtin_amdgcn_sched_barrier(0);
#pragma unroll
    for (int t = 0; t < 4; ++t) { vf[t][0] = *(const LAS bf16x8*)(tb0 + 8192 + t * 2048); vf[t][1] = *(const LAS bf16x8*)(tb1 + 8192 + t * 2048); }
    __builtin_amdgcn_sched_barrier(0);
#pragma unroll
    for (int mt = 0; mt < 4; ++mt) { s1[mt] = mfma16(kf[mt][0], q1[0], (f32x4){-mrow1, -mrow1, -mrow1, -mrow1}); s1[mt] = mfma16(kf[mt][1], q1[1], s1[mt]); }
    float ps0 = 0.f, ps1 = 0.f;
    if (NEARB) {
        const LAS float* rp0 = rt + (RT_OFF - dbase0);
        f32x4 bv[4];
#pragma unroll
        for (int mt = 0; mt < 4; ++mt)
#pragma unroll
            for (int r = 0; r < 4; ++r) bv[mt][r] = rp0[16 * mt + r];
        asm volatile("" : "+v"(bv[0]), "+v"(bv[1]), "+v"(bv[2]), "+v"(bv[3]));
#pragma unroll
        for (int mt = 0; mt < 4; ++mt) s0[mt] = s0[mt] + bv[mt];
    }
#pragma unroll
    for (int mt = 0; mt < 4; ++mt)
#pragma unroll
        for (int r = 0; r < 4; ++r) { const float p0 = __builtin_amdgcn_exp2f(s0[mt][r]); s0[mt][r] = p0; ps0 += p0; }
    bf16x8 pf0[2], pf1[2];
#pragma unroll
    for (int k2 = 0; k2 < 2; ++k2) {
        u32x4 w; w.x = cvt_pk_bf16(s0[2 * k2][0], s0[2 * k2][1]); w.y = cvt_pk_bf16(s0[2 * k2][2], s0[2 * k2][3]); w.z = cvt_pk_bf16(s0[2 * k2 + 1][0], s0[2 * k2 + 1][1]); w.w = cvt_pk_bf16(s0[2 * k2 + 1][2], s0[2 * k2 + 1][3]);
        pf0[k2] = __builtin_bit_cast(bf16x8, w);
    }
#pragma unroll
    for (int i = 0; i < 8; ++i) { SGB(0x8, 1); SGB(0x2, 5); SGB(0x400, 2); }
    __builtin_amdgcn_sched_barrier(0);
#pragma unroll
    for (int t = 0; t < 4; ++t) {
        A0.O[t] = mfma16(vf[t][0], pf0[0], A0.O[t]);
        A0.O[t] = mfma16(vf[t][1], pf0[1], A0.O[t]);
    }
    if (NEARB) {
        const LAS float* rp1 = rt + (RT_OFF - dbase1);
        f32x4 bv[4];
#pragma unroll
        for (int mt = 0; mt < 4; ++mt)
#pragma unroll
            for (int r = 0; r < 4; ++r) bv[mt][r] = rp1[16 * mt + r];
        asm volatile("" : "+v"(bv[0]), "+v"(bv[1]), "+v"(bv[2]), "+v"(bv[3]));
#pragma unroll
        for (int mt = 0; mt < 4; ++mt) s1[mt] = s1[mt] + bv[mt];
    }
#pragma unroll
    for (int mt = 0; mt < 4; ++mt)
#pragma unroll
        for (int r = 0; r < 4; ++r) { const float p1 = __builtin_amdgcn_exp2f(s1[mt][r]); s1[mt][r] = p1; ps1 += p1; }
#pragma unroll
    for (int k2 = 0; k2 < 2; ++k2) {
        u32x4 v; v.x = cvt_pk_bf16(s1[2 * k2][0], s1[2 * k2][1]); v.y = cvt_pk_bf16(s1[2 * k2][2], s1[2 * k2][3]); v.z = cvt_pk_bf16(s1[2 * k2 + 1][0], s1[2 * k2 + 1][1]); v.w = cvt_pk_bf16(s1[2 * k2 + 1][2], s1[2 * k2 + 1][3]);
        pf1[k2] = __builtin_bit_cast(bf16x8, v);
    }
#pragma unroll
    for (int i = 0; i < 8; ++i) { SGB(0x8, 1); SGB(0x2, 5); SGB(0x400, 2); }
    __builtin_amdgcn_sched_barrier(0);
#pragma unroll
    for (int t = 0; t < 4; ++t) {
        A1.O[t] = mfma16(vf[t][0], pf1[0], A1.O[t]);
        A1.O[t] = mfma16(vf[t][1], pf1[1], A1.O[t]);
    }
    ps0 = kg_sum(ps0); ps1 = kg_sum(ps1);
    A0.l += ps0; A1.l += ps1;
}

__device__ __forceinline__ void nsa_item(const Frame& F, int item, int& bt_hk) {
    const int bhk = item & 7, cb = 127 - (item >> 3), b = bhk >> 1, hk = bhk & 1;
    int tid_ = F.tid, lane_ = F.lane; asm volatile("" : "+v"(tid_), "+v"(lane_));
    const int tid = tid_, lane = lane_, wave = F.wave, n = lane & 15, ts = n >> 2, g = n & 3, kg = lane >> 4;
    const bf16* nq = (const bf16*)(F.ws + WS_NQ); const bf16* nkv = (const bf16*)(F.ws + WS_NKV) + (size_t)b * SEQ * 768;
    const bf16* kcmp = (const bf16*)(F.ws + WS_KCMP) + (size_t)bhk * 512 * 64; const bf16* vcmpt = (const bf16*)(F.ws + WS_VCMPT) + (size_t)bhk * 64 * 512;
    const bf16* vst = (const bf16*)(F.ws + WS_VST) + (size_t)bhk * 64 * SEQ; const bf16* vwt = (const bf16*)(F.ws + WS_VWT) + (size_t)bhk * 64 * SEQ;
    const float* small = (const float*)(F.ws + WS_SMALL); const bf16* nz = (const bf16*)(F.ws + WS_NZ); bf16* mix = (bf16*)(F.ws + WS_MIX);
    LAS float* btl = (LAS float*)(F.lds + NL_BT); LAS float* imp = (LAS float*)(F.lds + NL_IMP);
    LAS unsigned* maskw = (LAS unsigned*)(F.lds + NL_MASK); LAS unsigned* smaskw = (LAS unsigned*)(F.lds + NL_SMASK);
    LAS unsigned char* kvb = F.lds + NL_KV;
    const LAS float* bt = btl + g * RT_LEN;
    if (bt_hk != hk) {
        __syncthreads(); const float* btg = (const float*)(F.ws + WS_BT) + (size_t)(hk * 4) * 1025;
        for (int i = tid; i < 4 * RT_LEN; i += 512) { const int hh = i / RT_LEN, ii = i - hh * RT_LEN; const int d = RT_OFF - ii; btl[i] = d >= 0 ? btg[hh * 1025 + (d > 1024 ? 1024 : d)] : 0.f; }
        bt_hk = hk;
    }
    const int tw0 = cb * 64 + wave * 8;
    int trow[2]; size_t tokg[2]; bf16x8 q[2][2];
    LAS float* totp = (LAS float*)(F.lds + NL_TOT) + ((wave * 8 + ts) * 4 + g) * 68 + 4 * kg;
#pragma unroll
    for (int sl = 0; sl < 2; ++sl) {
        trow[sl] = tw0 + 4 * sl + ts; tokg[sl] = (size_t)b * SEQ + trow[sl];
        const bf16* qp = nq + tokg[sl] * 512 + (hk * 4 + g) * 64 + 8 * kg;
        q[sl][0] = *(const bf16x8*)qp; q[sl][1] = *(const bf16x8*)(qp + 32);
    }
    float gts[2][3];
#pragma unroll
    for (int sl = 0; sl < 2; ++sl)
#pragma unroll
        for (int br = 0; br < 3; ++br) gts[sl][br] = small[tokg[sl] * 32 + 8 + 8 * br + hk * 4 + g];
    SlotState A[2];
    const int fb0 = n * 128 + ((kg ^ (n & 7)) << 4), fb1 = n * 128 + (((4 + kg) ^ (n & 7)) << 4);
#define NS_LOADK(buf) do { _Pragma("unroll") for (int _mt = 0; _mt < 4; ++_mt) { kf[_mt][0] = *(const LAS bf16x8*)((buf) + fb0 + _mt * 2048); kf[_mt][1] = *(const LAS bf16x8*)((buf) + fb1 + _mt * 2048); } } while (0)
#define NS_LOADV(buf) do { _Pragma("unroll") for (int _t = 0; _t < 4; ++_t) _Pragma("unroll") for (int _ks = 0; _ks < 2; ++_ks) vf[_t][_ks] = tile_frag((buf) + 8192, 16 * _t + n, 4 * _ks + kg); } while (0)
#define NS_RESET() do { _Pragma("unroll") for (int _s = 0; _s < 2; ++_s) { A[_s].m = -1e30f; A[_s].l = 0.f; _Pragma("unroll") for (int _t = 0; _t < 4; ++_t) A[_s].O[_t] = (f32x4){0.f, 0.f, 0.f, 0.f}; } } while (0)
#define NS_BAR() do { asm volatile("s_waitcnt lgkmcnt(0)" ::: "memory"); __builtin_amdgcn_s_barrier(); asm volatile("" ::: "memory"); } while (0)
#define NS_PIPE(NT, KEY0, KB, KSTR, VTB, VLEN, NB, BUF, ...) do { \
        const int _nt = (NT); \
        for (int _p = 0; _p < (NB) - 1 && _p < _nt; ++_p) stage_dma(BUF(_p), KB, KSTR, VTB, VLEN, KEY0(_p), wave, lane); \
        wait_tiles((_nt - 1) < ((NB) - 2) ? (_nt - 1) : ((NB) - 2)); NS_BAR(); \
        for (int ti = 0; ti < _nt; ++ti) { \
            const LAS unsigned char* cbuf = BUF(ti & ((NB) - 1)); \
            if (ti + (NB) - 1 < _nt) stage_dma(BUF((ti + (NB) - 1) & ((NB) - 1)), KB, KSTR, VTB, VLEN, KEY0(ti + (NB) - 1), wave, lane); \
            __VA_ARGS__ \
            { const int _rem = _nt - 2 - ti; wait_tiles(_rem < 0 ? 0 : (_rem < (NB) - 2 ? _rem : (NB) - 2)); } \
            NS_BAR(); \
        } } while (0)
#define BUF2(i) (kvb + (i) * 16384)
#define BUF4(i) ((i) < 2 ? kvb + (i) * 16384 : (LAS unsigned char*)(F.lds + NL_IMP) + ((i) - 2) * 16384)
    __syncthreads();
    const float bfarv = bt[RT_OFF - 1024];
    const int ntc = ((4 * cb + 2) >> 6) + 1;
#define KEY0_LIN(i) (64 * (i))
    for (int prb = 0; prb <= PRB_C; ++prb) {
    NS_RESET();
    NS_PIPE(ntc, KEY0_LIN, kcmp, 64, vcmpt, 512, 2, BUF2, {

        const int db0 = trow[0] - 31 - 16 * (64 * ti + 4 * kg), db1 = trow[1] - 31 - 16 * (64 * ti + 4 * kg);
        if (64 * cb - 1024 * ti - 1039 >= 790) {
            slot_tile<TM_C1, false>(cbuf + fb0, cbuf + fb1, q[0], db0, bt, A[0], 0.f, 0.f, bfarv, nullptr, 64 * ti, lane);
            slot_tile<TM_C1, false>(cbuf + fb0, cbuf + fb1, q[1], db1, bt, A[1], 0.f, 0.f, bfarv, nullptr, 64 * ti, lane);
        } else {
            slot_tile<TM_C1, true>(cbuf + fb0, cbuf + fb1, q[0], db0, bt, A[0], 0.f, 0.f, bfarv, nullptr, 64 * ti, lane);
            slot_tile<TM_C1, true>(cbuf + fb0, cbuf + fb1, q[1], db1, bt, A[1], 0.f, 0.f, bfarv, nullptr, 64 * ti, lane);
        }
    });
    }
    {
        for (int prb2 = PRB_C2; prb2 >= 0; --prb2) {
        const float li0 = (prb2 == 0 && A[0].l > 0.f) ? __builtin_amdgcn_rcpf(A[0].l) : 0.f, li1 = (prb2 == 0 && A[1].l > 0.f) ? __builtin_amdgcn_rcpf(A[1].l) : 0.f;
        float cry0 = 0.f, cry1 = 0.f;
        NS_PIPE(ntc, KEY0_LIN, kcmp, 64, vcmpt, 512, 2, BUF2, {

            const int db0 = trow[0] - 31 - 16 * (64 * ti + 4 * kg), db1 = trow[1] - 31 - 16 * (64 * ti + 4 * kg);
            if (64 * cb - 1024 * ti - 1039 >= 790) {
                slot_tile<TM_C2, false>(cbuf + fb0, cbuf + fb1, q[0], db0, bt, A[0], li0, 0.f, bfarv, imp + (wave * 8 + ts) * 130, 64 * ti, lane, &cry0);
                slot_tile<TM_C2, false>(cbuf + fb0, cbuf + fb1, q[1], db1, bt, A[1], li1, 0.f, bfarv, imp + (wave * 8 + 4 + ts) * 130, 64 * ti, lane, &cry1);
            } else {
                slot_tile<TM_C2, true>(cbuf + fb0, cbuf + fb1, q[0], db0, bt, A[0], li0, 0.f, bfarv, imp + (wave * 8 + ts) * 130, 64 * ti, lane, &cry0);
                slot_tile<TM_C2, true>(cbuf + fb0, cbuf + fb1, q[1], db1, bt, A[1], li1, 0.f, bfarv, imp + (wave * 8 + 4 + ts) * 130, 64 * ti, lane, &cry1);
            }
        });
        }
#pragma unroll
        for (int sl = 0; sl < 2; ++sl) { const float gate = gts[sl][0];
#pragma unroll
            for (int t = 0; t < 4; ++t) *(LAS f32x4*)(totp + sl * 16 * 68 + 16 * t) = A[sl].O[t] * gate; }
    }
    const bf16* ksl = nkv + 256 + hk * 64;
    stage_dma(kvb, ksl, 768, vst, SEQ, 64 * cb, wave, lane);
    for (int prs = 0; prs <= PRB_SEL; ++prs)
    {
        const int tsl = lane >> 3, i = lane & 7; const int tk = wave * 8 + tsl;
        unsigned mw0 = 0u, mw1 = 0u, mw2 = 0u, mw3 = 0u;
#define NS_SETBIT(j) do { const unsigned _b = 1u << ((j) & 31); const int _w = (j) >> 5; mw0 |= _w == 0 ? _b : 0u; mw1 |= _w == 1 ? _b : 0u; mw2 |= _w == 2 ? _b : 0u; mw3 |= _w == 3 ? _b : 0u; } while (0)
        if (cb <= 15) { mw0 = (2u << cb) - 1u; }
        else {
            float val[16];
#pragma unroll
            for (int qq = 0; qq < 16; ++qq) { const int j = i + 8 * qq; val[qq] = (j >= 1 && j <= cb - 2) ? imp[tk * 130 + j] : -1.0f; }
            NS_SETBIT(0); NS_SETBIT(cb - 1); NS_SETBIT(cb);
            for (int round = 0; round < 13; ++round) {
                float bv = -2.0f; int bj = 1 << 20;
#pragma unroll
                for (int qq = 0; qq < 16; ++qq) if (val[qq] > bv) { bv = val[qq]; bj = i + 8 * qq; }
#define NS_DPP_STEP(CTRL) do { const float ov = __builtin_bit_cast(float, __builtin_amdgcn_update_dpp(0, __builtin_bit_cast(int, bv), CTRL, 0xf, 0xf, false)); \
                    const int oj = __builtin_amdgcn_update_dpp(0, bj, CTRL, 0xf, 0xf, false); if (ov > bv || (ov == bv && oj < bj)) { bv = ov; bj = oj; } } while (0)
                NS_DPP_STEP(0xB1); NS_DPP_STEP(0x4E); NS_DPP_STEP(0x141);
#pragma unroll
                for (int qq = 0; qq < 16; ++qq) if (bj == i + 8 * qq) val[qq] = -3.0f;
                NS_SETBIT(bj);
            }
        }
        if (i == 0) { maskw[tk * 4 + 0] = mw0; maskw[tk * 4 + 1] = mw1; maskw[tk * 4 + 2] = mw2; maskw[tk * 4 + 3] = mw3; }
        mw0 |= __shfl_xor(mw0, 8); mw0 |= __shfl_xor(mw0, 16); mw1 |= __shfl_xor(mw1, 8); mw1 |= __shfl_xor(mw1, 16);
        mw2 |= __shfl_xor(mw2, 8); mw2 |= __shfl_xor(mw2, 16); mw3 |= __shfl_xor(mw3, 8); mw3 |= __shfl_xor(mw3, 16);
        if ((lane & 31) == 0) { const int so = (wave * 2 + (lane >> 5)) * 4; smaskw[so] = mw0; smaskw[so + 1] = mw1; smaskw[so + 2] = mw2; smaskw[so + 3] = mw3; }
    }
    __syncthreads();
    {
        const int tk0 = wave * 8 + ts;
        unsigned smk0[4], smk1[4], rmk0[4], rmk1[4];
#pragma unroll
        for (int w4 = 0; w4 < 4; ++w4) {
            smk0[w4] = __builtin_amdgcn_readfirstlane(smaskw[(wave * 2 + 0) * 4 + w4]); smk1[w4] = __builtin_amdgcn_readfirstlane(smaskw[(wave * 2 + 1) * 4 + w4]);
            rmk0[w4] = maskw[tk0 * 4 + w4]; rmk1[w4] = maskw[(tk0 + 4) * 4 + w4];
        }
        const LAS unsigned char* const Kb_ = nullptr; (void)Kb_;
        {
        NS_RESET();
#define KEY0_FORCED(i) (64 * (cb == 0 ? 0 : (cb == 1 ? 1 - (i) : ((i) == 0 ? cb : ((i) == 1 ? cb - 1 : 0)))))
        const int ntd = cb < 2 ? cb + 1 : 3, nt2 = cb - 2;
        int nsp = 0;
        if (cb >= 3) { stage_dma(BUF4(2), ksl, 768, vst, SEQ, 64, wave, lane); nsp = 1; if (nt2 > 1) { stage_dma(BUF4(3), ksl, 768, vst, SEQ, 128, wave, lane); nsp = 2; } }
        wait_tiles(nsp); NS_BAR();
        for (int ti = 0; ti < ntd; ++ti) {
            const LAS unsigned char* cbuf = kvb + (ti & 1) * 16384;
            if (ti + 1 < ntd) stage_dma(kvb + ((ti + 1) & 1) * 16384, ksl, 768, vst, SEQ, KEY0_FORCED(ti + 1), wave, lane);
            const int key0 = KEY0_FORCED(ti);
            const int db0 = trow[0] - key0 - 4 * kg, db1 = trow[1] - key0 - 4 * kg;
            if ((cb - (key0 >> 6)) < 14) {
                slot_tile<TM_SD, true>(cbuf + fb0, cbuf + fb1, q[0], db0, bt, A[0], 0.f, 0.f, bfarv, nullptr, key0, lane);
                slot_tile<TM_SD, true>(cbuf + fb0, cbuf + fb1, q[1], db1, bt, A[1], 0.f, 0.f, bfarv, nullptr, key0, lane);
            } else {
                slot_tile<TM_SD, false>(cbuf + fb0, cbuf + fb1, q[0], db0, bt, A[0], 0.f, 0.f, bfarv, nullptr, key0, lane);
                slot_tile<TM_SD, false>(cbuf + fb0, cbuf + fb1, q[1], db1, bt, A[1], 0.f, 0.f, bfarv, nullptr, key0, lane);
            }
            wait_tiles(0); NS_BAR();
        }
        if (cb >= 3) {
            const int np2 = (nt2 + 1) >> 1;
            unsigned csm0 = smk0[0] >> 1, csm1 = smk1[0] >> 1, crm0 = rmk0[0] >> 1, crm1 = rmk1[0] >> 1;
            int j = 1;
            for (int p = 0; p < np2; ++p) {
                const int sb = 2 - (p & 1) * 2;
                if (p + 1 < np2) { stage_dma(BUF4(2 - sb), ksl, 768, vst, SEQ, 64 * (j + 2), wave, lane); if (j + 3 <= cb - 2) stage_dma(BUF4(3 - sb), ksl, 768, vst, SEQ, 64 * (j + 3), wave, lane); }
#pragma unroll 1
                for (int hh = 0; hh < 2; ++hh) {
                    if (j > cb - 2) break;
                    const bool a0 = PRB_ALLACT ? true : (csm0 & 1u), a1 = PRB_ALLACT ? true : (csm1 & 1u);
                    if (a0 || a1) {
                        const LAS unsigned char* cbuf = BUF4(sb + hh);
                        const int key0 = 64 * j;
                        const int db0 = trow[0] - key0 - 4 * kg, db1 = trow[1] - key0 - 4 * kg;
                        const bool nearb = (cb - j) < 14;
                        const float boff = nearb ? 0.f : bfarv;
                        const float mr0 = (crm0 & 1u) ? A[0].m - boff : 1e30f, mr1 = (crm1 & 1u) ? A[1].m - boff : 1e30f;
                        if (a0 && a1) {
                            if (nearb) slot_pair_ss<true>(cbuf + fb0, cbuf + fb1, q[0], q[1], db0, db1, bt, A[0], A[1], mr0, mr1);
                            else slot_pair_ss<false>(cbuf + fb0, cbuf + fb1, q[0], q[1], db0, db1, bt, A[0], A[1], mr0, mr1);
                        } else if (a0) {
                            if (nearb) slot_tile<TM_SS, true>(cbuf + fb0, cbuf + fb1, q[0], db0, bt, A[0], 0.f, mr0, 0.f, nullptr, key0, lane);
                            else slot_tile<TM_SS, false>(cbuf + fb0, cbuf + fb1, q[0], db0, bt, A[0], 0.f, mr0, 0.f, nullptr, key0, lane);
                        } else {
                            if (nearb) slot_tile<TM_SS, true>(cbuf + fb0, cbuf + fb1, q[1], db1, bt, A[1], 0.f, mr1, 0.f, nullptr, key0, lane);
                            else slot_tile<TM_SS, false>(cbuf + fb0, cbuf + fb1, q[1], db1, bt, A[1], 0.f, mr1, 0.f, nullptr, key0, lane);
                        }
                    }
                    ++j; csm0 >>= 1; csm1 >>= 1; crm0 >>= 1; crm1 >>= 1;
                    if ((j & 31) == 0) { const int w4 = j >> 5;
                        csm0 = w4 == 1 ? smk0[1] : (w4 == 2 ? smk0[2] : smk0[3]); csm1 = w4 == 1 ? smk1[1] : (w4 == 2 ? smk1[2] : smk1[3]);
                        crm0 = w4 == 1 ? rmk0[1] : (w4 == 2 ? rmk0[2] : rmk0[3]); crm1 = w4 == 1 ? rmk1[1] : (w4 == 2 ? rmk1[2] : rmk1[3]); }
                }
                wait_tiles(0); NS_BAR();
            }
        }
        }
#pragma unroll
        for (int sl = 0; sl < 2; ++sl) { const float gate = gts[sl][1]; const float sc = A[sl].l > 0.f ? gate * __builtin_amdgcn_rcpf(A[sl].l) : 0.f;
#pragma unroll
            for (int t = 0; t < 4; ++t) { LAS f32x4* tp = (LAS f32x4*)(totp + sl * 16 * 68 + 16 * t); *tp = *tp + A[sl].O[t] * sc; } }
    }
    {
        const int jw0 = cb >= 8 ? cb - 8 : 0;
#define KEY0_WIN(i) (64 * (jw0 + (i)))
        for (int prb = 0; prb <= PRB_W; ++prb) {
        NS_RESET();
        NS_PIPE(cb - jw0 + 1, KEY0_WIN, nkv + 512 + hk * 64, 768, vwt, SEQ, 4, BUF4, {

            slot_tile<TM_W, true>(cbuf + fb0, cbuf + fb1, q[0], trow[0] - KEY0_WIN(ti) - 4 * kg, bt, A[0], 0.f, 0.f, 0.f, nullptr, KEY0_WIN(ti), lane);
            slot_tile<TM_W, true>(cbuf + fb0, cbuf + fb1, q[1], trow[1] - KEY0_WIN(ti) - 4 * kg, bt, A[1], 0.f, 0.f, 0.f, nullptr, KEY0_WIN(ti), lane);
        });
        }
#pragma unroll
        for (int sl = 0; sl < 2; ++sl) { const float gate = gts[sl][2]; const float sc = A[sl].l > 0.f ? gate * __builtin_amdgcn_rcpf(A[sl].l) : 0.f;
#pragma unroll
            for (int t = 0; t < 4; ++t) { LAS f32x4* tp = (LAS f32x4*)(totp + sl * 16 * 68 + 16 * t); *tp = *tp + A[sl].O[t] * sc; } }
    }
    {
        int l2 = lane; asm volatile("" : "+v"(l2));
        const int n2 = l2 & 15, ts2 = n2 >> 2, g2 = n2 & 3, kg2 = l2 >> 4;
        const LAS float* tp2 = (const LAS float*)(F.lds + NL_TOT) + ((wave * 8 + ts2) * 4 + g2) * 68 + 4 * kg2;
        u32x2 zz[2][4];
#pragma unroll
        for (int sl = 0; sl < 2; ++sl)
#pragma unroll
            for (int t = 0; t < 4; ++t) zz[sl][t] = *(const u32x2*)(nz + ((size_t)b * SEQ + tw0 + 4 * sl + ts2) * 512 + (hk * 4 + g2) * 64 + 16 * t + 4 * kg2);
#pragma unroll
        for (int sl = 0; sl < 2; ++sl) {
            const size_t tk = (size_t)b * SEQ + tw0 + 4 * sl + ts2;
#pragma unroll
            for (int t = 0; t < 4; ++t) {
                const u32x2 z = zz[sl][t];
                const f32x4 tv = *(const LAS f32x4*)(tp2 + sl * 16 * 68 + 16 * t);
                u32x2 d; d.x = cvt_pk_bf16(tv[0] * __uint_as_float(z.x << 16), tv[1] * __uint_as_float(z.x & 0xffff0000u));
                d.y = cvt_pk_bf16(tv[2] * __uint_as_float(z.y << 16), tv[3] * __uint_as_float(z.y & 0xffff0000u));
                *(u32x2*)(mix + tk * DM + 512 + (hk * 4 + g2) * 64 + 16 * t + 4 * kg2) = d;
            }
        }
    }
    __syncthreads();
#undef NS_LOADK
#undef NS_LOADV
#undef NS_RESET
#undef NS_PIPE
#undef NS_SETBIT
}
#ifndef PRB_SCANONLY
#define PRB_SCANONLY 0
#endif
#ifndef DUP_P1
#define DUP_P1 0
#endif
#ifndef DUP_P2G
#define DUP_P2G 0
#endif
#ifndef DUP_P2
#define DUP_P2 0
#endif
#ifndef DUP_SCAN
#define DUP_SCAN 0
#endif
#ifndef DUP_NSA
#define DUP_NSA 0
#endif
__device__ __forceinline__ void p2_phase(const Frame& F) {
    int cw_head = -1;
#define P2_CW_LOAD(h_) do { if ((h_) != cw_head) { __syncthreads(); const float* cw = F.in[3]; \
        for (int i = F.tid; i < 4 * 3 * 128; i += 512) { const int j = i / 384, r = i - j * 384, part = r >> 7, c = r & 127; ((LAS float*)(F.lds + GL_CW))[i] = cw[j * 1536 + part * 512 + (h_) * 128 + c]; } \
        cw_head = (h_); __syncthreads(); } } while (0)
    for (int rep = 0; rep <= DUP_P2; ++rep)
    for (int task = blockIdx.x; task < 3072; task += gridDim.x) {
        if (task < 2048) { P2_CW_LOAD(task & 3); for (int r2 = 0; r2 <= DUP_P2G; ++r2) gdn_prep_item(F, task); }
        else if (task < 2560) compress_block(F, task - 2048);
        else vtranspose_task(F, task - 2560);
    }
}
__device__ __forceinline__ void p3_phase(const Frame& F) {
    for (int rep = 0; rep <= DUP_SCAN; ++rep)
        for (int bh = blockIdx.x; bh < 16; bh += gridDim.x) gdn_scan(F, bh);
    LAS int* nxt = (LAS int*)(F.lds + NL_NXT);
    int bt_hk = -1;
#if PRB_SCANONLY
    if (blockIdx.x < 16) return;
#endif
    for (int rep = 0; rep <= DUP_NSA; ++rep) {
        const int bhk = blockIdx.x & 7;
        unsigned* ctr = (unsigned*)(F.ws + WS_CTL) + 64 + 64 * bhk + 1024 * rep;
        for (;;) {
            __syncthreads();
            if (F.tid == 0) *nxt = (int)atomicAdd(ctr, 1u);
            __syncthreads();
            const int qi = *nxt;
            if (qi >= 128) break;
            nsa_item(F, qi * 8 + bhk, bt_hk);
        }
    }
}
typedef __attribute__((address_space(1))) unsigned gu32;
#define XB_TMO      128
#define XB_XCNT(j)  (256  + 64 * (j))
#define XB_XSUB(j)  (1280 + 64 * (j))
#define XB_XGEN(j)  (2304 + 64 * (j))
#define XB_TOP      3328
#define XB_TOPGEN   3392
#define XCD_BAR_WORDS 3456
#define XB_SPIN_CAP (1u << 18)

__device__ __forceinline__ unsigned xb_ld(unsigned* p)              { return __hip_atomic_load(p, __ATOMIC_RELAXED, __HIP_MEMORY_SCOPE_AGENT); }
__device__ __forceinline__ unsigned xb_add(unsigned* p, unsigned v) { return __hip_atomic_fetch_add(p, v, __ATOMIC_RELAXED, __HIP_MEMORY_SCOPE_AGENT); }
__device__ __forceinline__ unsigned xb_xcc_id() { return (unsigned)__builtin_amdgcn_s_getreg((3 << 11) | 20) & 0xFu; }
#define XB_SPIN(cond, bar) do { unsigned _sp = 0; while (cond) { __builtin_amdgcn_s_sleep(1); \
    if ((++_sp & 255u) == 0u) { if (xb_ld(&(bar)[XB_TMO])) break; if (_sp > XB_SPIN_CAP) { atomicAdd(&(bar)[XB_TMO], 1u); break; } } } } while (0)

struct XcdBarrier {
    unsigned* bar; unsigned x;
    volatile LAS unsigned* st;
};

__device__ __forceinline__ XcdBarrier xcd_barrier_post(unsigned* bar, volatile LAS unsigned* st) {
    XcdBarrier b; b.bar = bar; b.x = xb_xcc_id(); b.st = st;
    if (threadIdx.x == 0) (void)xb_add(&bar[XB_XCNT(b.x)], 1u);
    return b;
}
__device__ __forceinline__ void xcd_barrier_complete(unsigned* bar, unsigned x, unsigned& nloc, unsigned& nx) {
    const unsigned G = gridDim.x * gridDim.y * gridDim.z;
    unsigned sum, cnt, mine, sp = 0u;
    for (;;) {
        sum = 0u; cnt = 0u; mine = 0u;
#pragma unroll
        for (unsigned j = 0; j < 16; ++j) { const unsigned c = xb_ld(&bar[XB_XCNT(j)]); sum += c; cnt += (c > 0u) ? 1u : 0u; mine = (j == x) ? c : mine; }
        if (sum == G) break;
        __builtin_amdgcn_s_sleep(1);
        if ((++sp & 255u) == 0u) { if (xb_ld(&bar[XB_TMO])) break; if (sp > XB_SPIN_CAP) { atomicAdd(&bar[XB_TMO], 1u); break; } }
    }
    nloc = mine > 0u ? mine : 1u; nx = cnt > 0u ? cnt : 1u;
}

__device__ __forceinline__ void xcd_barrier(const XcdBarrier& b) {
    asm volatile("s_waitcnt vmcnt(0)" ::: "memory");
    __syncthreads();
    if (threadIdx.x == 0) {
        unsigned* bar = b.bar;
        __builtin_amdgcn_s_waitcnt(0);
        unsigned nloc = b.st[0], nx = b.st[1];
        if (nloc == 0u) { xcd_barrier_complete(bar, b.x, nloc, nx); b.st[0] = nloc; b.st[1] = nx; }
        const unsigned old = xb_add(&bar[XB_XSUB(b.x)], 1u);
        const unsigned gen = old / nloc;
        if (old + 1u == (gen + 1u) * nloc) {
            __builtin_amdgcn_fence(__ATOMIC_RELEASE, "agent");
            asm volatile("s_waitcnt vmcnt(0)" ::: "memory");
            const unsigned og = xb_add(&bar[XB_TOP], 1u);
            const unsigned tg = og / nx;
            if (og + 1u == (tg + 1u) * nx) xb_add(&bar[XB_TOPGEN], 1u);
            else XB_SPIN(xb_ld(&bar[XB_TOPGEN]) == tg, bar);
            __builtin_amdgcn_fence(__ATOMIC_ACQUIRE, "agent");
            xb_add(&bar[XB_XGEN(b.x)], 1u);
            asm volatile("s_waitcnt vmcnt(0)" ::: "memory");
        } else {
            XB_SPIN(xb_ld(&bar[XB_XGEN(b.x)]) == gen, bar);
            __builtin_amdgcn_fence(__ATOMIC_ACQUIRE, "agent");
            asm volatile("s_waitcnt vmcnt(0)" ::: "memory");
        }
    }
    __syncthreads();
}

constexpr int LDS_BARST = LDS_BYTES - 64;
struct Args { const float* in[16]; float* out; unsigned char* ws; int ph_lo, ph_hi, coop, pad; };
constexpr int N_PHASES = 6;

__global__ void __launch_bounds__(512, 2) hymba_fwd(Args a) {
    extern __shared__ __attribute__((aligned(16))) unsigned char lds_raw[];
    Frame F;
#pragma unroll
    for (int i = 0; i < 16; ++i) F.in[i] = a.in[i];
    F.out = a.out; F.ws = a.ws; F.lds = (LAS unsigned char*)lds_raw; F.ldsg = lds_raw;
    F.tid = threadIdx.x; F.lane = F.tid & 63; F.wave = __builtin_amdgcn_readfirstlane(F.tid >> 6);
    unsigned char* ws = a.ws;
    volatile LAS unsigned* barst = (volatile LAS unsigned*)(F.lds + LDS_BARST);
    if (F.tid < 2) barst[F.tid] = 0u;
    __syncthreads();
    XcdBarrier xbar; xbar.bar = (unsigned*)(ws + WS_CTL) + 4096; xbar.x = 0; xbar.st = nullptr;
    if (a.coop) xbar = xcd_barrier_post((unsigned*)(ws + WS_CTL) + 4096, barst);
    const int lo = a.ph_lo, hi = a.ph_hi;
#define IN(k) (lo <= (k) && (k) < hi)
#define SEAM(k) do { if (IN(k) && IN((k) + 1) && a.coop) { xcd_barrier(xbar); } __syncthreads(); } while (0)
#ifndef DUP_P0
#define DUP_P0 0
#endif
#ifndef DUP_P4
#define DUP_P4 0
#endif
    if (IN(0)) { _Pragma("unroll 1") for (int rep = 0; rep <= DUP_P0; ++rep) p0_prep(F); }
    SEAM(0);
    if (IN(1)) {
        pg8::Gemm g{(const bf16*)(ws + WS_XB), (const bf16*)(ws + WS_WTIN), T_TOK, NPROJ, DM};
        pg8::StaticOrder S; S.init(T_TOK, NPROJ, (int)gridDim.x, (int)blockIdx.x);
        EpiProj E{(bf16*)(ws + WS_GQKV), (bf16*)(ws + WS_GZ), (bf16*)(ws + WS_NQ), (bf16*)(ws + WS_NKV), (bf16*)(ws + WS_NZ), (const float*)(ws + WS_RS)};
        pg8::gemm_phase<EpiProj, pg8::StaticOrder, false>(F.lds, g, S, E, nullptr);
#if DUP_P1
        __syncthreads(); pg8::gemm_phase<EpiProj, pg8::StaticOrder, false>(F.lds, g, S, E, nullptr);
#endif
    }
    SEAM(1);
    if (IN(2)) p2_phase(F);
    SEAM(2);
    if (IN(3)) p3_phase(F);
    SEAM(3);
    if (IN(4)) {
        pg8::Gemm g{(const bf16*)(ws + WS_MIX), (const bf16*)(ws + WS_WTOUT), T_TOK, DM, DM};
        pg8::StaticOrder S; S.init(T_TOK, DM, (int)gridDim.x, (int)blockIdx.x);
        EpiOut E{F.in[0], F.out};
        pg8::gemm_phase<EpiOut, pg8::StaticOrder, false>(F.lds, g, S, E, nullptr);
#if DUP_P4
        __syncthreads(); pg8::gemm_phase<EpiOut, pg8::StaticOrder, false>(F.lds, g, S, E, nullptr);
#endif
    }
    SEAM(4);
    if (IN(5)) p5_final(F);
#undef IN
#undef SEAM
}

extern "C" void kernel_launch(void* const* d_in, const int* in_sizes, int n_in, void* d_out, int out_size, void* d_ws, size_t ws_size, hipStream_t stream) {
    static int grid = 0;
    if (grid == 0) {
        if (n_in != 16 || in_sizes[0] != T_TOK * DM || out_size != T_TOK * DM || ws_size < WS_END) { fprintf(stderr, "kernel_launch: unexpected shapes (n_in %d, ws %zu)\n", n_in, ws_size); grid = -1; return; }
        int dev = 0, cus = 0, per_cu = 0;
        if (hipGetDevice(&dev) != hipSuccess || hipDeviceGetAttribute(&cus, hipDeviceAttributeMultiprocessorCount, dev) != hipSuccess) { grid = -1; return; }
        if (hipFuncSetAttribute((const void*)hymba_fwd, hipFuncAttributeMaxDynamicSharedMemorySize, LDS_BYTES) != hipSuccess) { fprintf(stderr, "kernel_launch: hipFuncSetAttribute failed\n"); grid = -1; return; }
        if (hipOccupancyMaxActiveBlocksPerMultiprocessor(&per_cu, (const void*)hymba_fwd, 512, LDS_BYTES) != hipSuccess || per_cu < 1) { fprintf(stderr, "kernel_launch: occupancy query says %d\n", per_cu); per_cu = 1; }
        (void)hipGetLastError();
        grid = cus;
    }
    if (grid < 0) return;
    (void)hipMemsetAsync((char*)d_ws + WS_CTL, 0, 64 * 1024, stream);
    Args a{};
    for (int i = 0; i < 16; ++i) a.in[i] = (const float*)d_in[i];
    a.out = (float*)d_out; a.ws = (unsigned char*)d_ws;
#if MK_LAUNCHES == 1
    a.ph_lo = 0; a.ph_hi = N_PHASES; a.coop = 1;
    void* args[] = {&a};
    hipError_t e = hipLaunchCooperativeKernel((const void*)hymba_fwd, dim3(grid), dim3(512), args, LDS_BYTES, stream);
    if (e != hipSuccess) fprintf(stderr, "cooperative launch failed: %s (grid %d)\n", hipGetErrorString(e), grid);
#else
    for (int ph = 0; ph < N_PHASES; ++ph) {
        a.ph_lo = ph; a.ph_hi = ph + 1; a.coop = 0;
        hipLaunchKernelGGL(hymba_fwd, dim3(grid), dim3(512), LDS_BYTES, stream, a);
    }
#endif
}
```
